# Optimizing an MI355X kernel written in HIP

```python
import math
import jax, jax.numpy as jnp
from jax import lax
import numpy as np

D_MODEL = 1024
BATCH = 32
SEQ = 256
DEPTH = 1
DEC_BATCH = 2
DEC_SEQ = 2048
PAST_LEN = 512

GRID_W = 64
MLA_HEADS = 8
QK_NOPE = 128
QK_ROPE = 64
V_HEAD = 128
Q_LORA = 256
KV_LORA = 256
ROPE_BASE = 10000.0
ATTN_BLOCK = 128
SSD_HEADS = 16
SSD_HEADDIM = 64
SSD_INNER = SSD_HEADS * SSD_HEADDIM
SSD_GROUPS = 4
SSD_STATE = 64
SSD_CONV = 3
SSD_CHUNK = 128
SSD_CONV_DIM = SSD_INNER + 2 * SSD_GROUPS * SSD_STATE
D_FF = 2816
FFN_CONV = 3
EPS = 1e-6

IN_SPLITS = (Q_LORA, KV_LORA, QK_ROPE, SSD_INNER, SSD_INNER, SSD_GROUPS * SSD_STATE,
             SSD_GROUPS * SSD_STATE, 2 * SSD_HEADS, D_MODEL, D_MODEL)
IN_COLS = Q_LORA + KV_LORA + QK_ROPE + 2 * SSD_INNER + 2 * SSD_GROUPS * SSD_STATE + 2 * SSD_HEADS + 2 * D_MODEL

kernel_name = "hybrid_mla_ssd_convffn_diffusion_step"


def rmsnorm(x, g):
    x32 = x.astype(jnp.float32)
    y = x32 * lax.rsqrt(jnp.mean(x32 * x32, axis=-1, keepdims=True) + EPS)
    return (y * g.astype(jnp.float32)).astype(x.dtype)


def dwconv_centred(x, w, b):
    K = w.shape[0]
    pad = K // 2
    L = x.shape[1]
    xp = jnp.pad(x, ((0, 0), (pad, pad), (0, 0)))
    out = xp[:, 0:L] * w[0]
    for k in range(1, K):
        out = out + xp[:, k:k + L] * w[k]
    return out + b


def axial_angles(L):
    rows = L // GRID_W
    t = jnp.arange(rows * GRID_W)
    row = (t // GRID_W).astype(jnp.float32)
    col = (t % GRID_W).astype(jnp.float32)
    n = QK_ROPE // 4
    inv = ROPE_BASE ** (-jnp.arange(n, dtype=jnp.float32) / n)
    return jnp.stack([row[:, None] * inv, col[:, None] * inv], axis=1)


def rope_2d(x, ang):
    n = QK_ROPE // 4
    xr = x.reshape(x.shape[:-1] + (2, 2, n)).astype(jnp.float32)
    cos, sin = jnp.cos(ang), jnp.sin(ang)
    x0, x1 = xr[..., 0, :], xr[..., 1, :]
    out = jnp.stack([x0 * cos - x1 * sin, x0 * sin + x1 * cos], axis=-2)
    return out.reshape(x.shape).astype(x.dtype)


def block_attention(q, k, v):
    b, Lq, H, Dk = q.shape
    nb = Lq // ATTN_BLOCK
    scale = 1.0 / math.sqrt(QK_NOPE + QK_ROPE)
    qb = q.reshape(b, nb, ATTN_BLOCK, H, Dk).transpose(1, 0, 2, 3, 4)

    def one(qblk):
        s = jnp.einsum('bqhd,bkhd->bhqk', qblk, k).astype(jnp.float32) * scale
        p = jax.nn.softmax(s, axis=-1).astype(v.dtype)
        return jnp.einsum('bhqk,bkhd->bqhd', p, v)

    out = lax.map(one, qb)
    return out.transpose(1, 0, 2, 3, 4).reshape(b, Lq, H, v.shape[-1])


def mla_kv(ckv_n, kr, w_ukv):
    b, L, _ = ckv_n.shape
    kv = (ckv_n @ w_ukv).reshape(b, L, MLA_HEADS, QK_NOPE + V_HEAD)
    k_nope, v = kv[..., :QK_NOPE], kv[..., QK_NOPE:]
    k = jnp.concatenate([k_nope, jnp.broadcast_to(kr[:, :, None, :], (b, L, MLA_HEADS, QK_ROPE))], axis=-1)
    return k, v


def ssd_chunked_scan(x, dt, A, Bm, Cm, h0):
    b, L, H, P = x.shape
    Q = SSD_CHUNK
    nc = L // Q
    rep = H // SSD_GROUPS
    f32 = jnp.float32
    Bh = jnp.repeat(Bm.astype(f32), rep, axis=2).reshape(b, nc, Q, H, SSD_STATE)
    Ch = jnp.repeat(Cm.astype(f32), rep, axis=2).reshape(b, nc, Q, H, SSD_STATE)
    dtc = dt.astype(f32).reshape(b, nc, Q, H)
    xdt = x.astype(f32).reshape(b, nc, Q, H, P) * dtc[..., None]
    acum = jnp.cumsum(dtc * A.astype(f32), axis=2)
    seg = acum[:, :, :, None, :] - acum[:, :, None, :, :]
    causal = jnp.tril(jnp.ones((Q, Q), dtype=bool))[:, :, None]
    decay = jnp.where(causal, jnp.exp(jnp.where(causal, seg, 0.0)), 0.0)
    scores = jnp.einsum('bcihn,bcjhn->bcijh', Ch, Bh)
    y_diag = jnp.einsum('bcijh,bcjhp->bcihp', scores * decay, xdt)
    decay_end = jnp.exp(acum[:, :, -1:, :] - acum)
    chunk_states = jnp.einsum('bcjhn,bcjh,bcjhp->bchpn', Bh, decay_end, xdt)
    chunk_decay = jnp.exp(acum[:, :, -1, :])

    def step(h, inp):
        dec, st = inp
        return h * dec[:, :, None, None] + st, h

    hT, h_in = lax.scan(step, h0.astype(f32),
                        (chunk_decay.transpose(1, 0, 2), chunk_states.transpose(1, 0, 2, 3, 4)))
    h_in = h_in.transpose(1, 0, 2, 3, 4)
    y_off = jnp.einsum('bcihn,bchpn,bcih->bcihp', Ch, h_in, jnp.exp(acum))
    y = (y_diag + y_off).reshape(b, L, H, P)
    return y.astype(x.dtype), hT.astype(x.dtype)


def trunk_layer(x, c_vec, lp, latent, ctx):
    b, L, _ = x.shape
    mod = (jax.nn.silu(c_vec) @ lp['w_ada'] + lp['b_ada'])[:, None, :]
    sh1, sc1, g1, sh2, sc2, g2 = jnp.split(mod, 6, axis=-1)
    h = rmsnorm(x, lp['norm_attn_g']) * (1 + sc1) + sh1
    proj = h @ lp['w_in']
    cq, ckv, kr, z, xs, Bm, Cm, dt, gm, gs = jnp.split(proj, [int(s) for s in np.cumsum(IN_SPLITS)[:-1]], axis=-1)

    q = (rmsnorm(cq, lp['q_norm_g']) @ lp['w_uq']).reshape(b, L, MLA_HEADS, QK_NOPE + QK_ROPE)
    q_nope, q_rope = q[..., :QK_NOPE], q[..., QK_NOPE:]
    ckv_n = rmsnorm(ckv, lp['kv_norm_g'])
    if latent:
        ang = axial_angles(L)
        q_rope = rope_2d(q_rope, ang[:, None])
        kr = rope_2d(kr, ang)
    q = jnp.concatenate([q_nope, q_rope], axis=-1)
    k, v = mla_kv(ckv_n, kr, lp['w_ukv'])
    if ctx is not None:
        k_ctx, v_ctx = mla_kv(ctx[0], ctx[1], lp['w_ukv'])
        k = jnp.concatenate([k_ctx, k], axis=1)
        v = jnp.concatenate([v_ctx, v], axis=1)
    attn = block_attention(q, k, v)
    o_mla = attn.reshape(b, L, MLA_HEADS * V_HEAD) @ lp['w_o_mla']

    xbc = jax.nn.silu(dwconv_centred(jnp.concatenate([xs, Bm, Cm], axis=-1), lp['ssd_conv_w'], lp['ssd_conv_b']))
    xh = xbc[..., :SSD_INNER].reshape(b, L, SSD_HEADS, SSD_HEADDIM)
    Bg = xbc[..., SSD_INNER:SSD_INNER + SSD_GROUPS * SSD_STATE].reshape(b, L, SSD_GROUPS, SSD_STATE)
    Cg = xbc[..., SSD_INNER + SSD_GROUPS * SSD_STATE:].reshape(b, L, SSD_GROUPS, SSD_STATE)
    dt_all = jax.nn.softplus(dt.reshape(b, L, 2, SSD_HEADS).astype(jnp.float32) + lp['ssd_dt_bias'])
    A = -jnp.exp(lp['ssd_A_log'].astype(jnp.float32))
    if ctx is None:
        h0 = jnp.zeros((b, 2, SSD_HEADS, SSD_HEADDIM, SSD_STATE), jnp.float32)
    else:
        h0 = ctx[2]
    y_f, h_f = ssd_chunked_scan(xh, dt_all[:, :, 0], A[0], Bg, Cg, h0[:, 0])
    y_b, h_b = ssd_chunked_scan(jnp.flip(xh, 1), jnp.flip(dt_all[:, :, 1], 1), A[1],
                                jnp.flip(Bg, 1), jnp.flip(Cg, 1), h0[:, 1])
    y = y_f + jnp.flip(y_b, 1) + lp['ssd_D'][:, None] * xh
    y = rmsnorm(y.reshape(b, L, SSD_INNER) * jax.nn.silu(z), lp['ssd_norm_g'])
    o_ssd = y @ lp['w_o_ssd']

    merged = jax.nn.sigmoid(gm) * o_mla + jax.nn.sigmoid(gs) * o_ssd
    x = x + g1 * (merged @ lp['w_out'])

    h2 = rmsnorm(x, lp['norm_ffn_g']) * (1 + sc2) + sh2
    u = dwconv_centred(h2 @ lp['w_up'], lp['ffn_conv_w'], lp['ffn_conv_b'])
    x = x + g2 * ((jax.nn.silu(u[..., :D_FF]) * u[..., D_FF:]) @ lp['w_down'])
    return x, (ckv_n, kr, jnp.stack([h_f, h_b], axis=1))


def setup_inputs(seed: int = 0) -> dict:
    key = jax.random.key(seed)
    ks = iter(jax.random.split(key, 48))

    def nrm(shape, scale):
        return jax.random.normal(next(ks), shape, jnp.float32) * scale

    def gain(shape):
        return 1.0 + nrm(shape, 0.02)

    dt0 = jnp.exp(jax.random.uniform(next(ks), (DEPTH, 2, SSD_HEADS), jnp.float32,
                                     minval=math.log(1e-3), maxval=math.log(1e-1)))
    return {
        "x_prompt": nrm((BATCH, SEQ, D_MODEL), 1.0),
        "x_sample": nrm((DEC_BATCH, DEC_SEQ, D_MODEL), 1.0),
        "c": nrm((DEC_BATCH, D_MODEL), 1.0),
        "cache_ckv": nrm((DEC_BATCH, DEPTH, PAST_LEN, KV_LORA), 1.0),
        "cache_krope": nrm((DEC_BATCH, DEPTH, PAST_LEN, QK_ROPE), 1.0),
        "state_ssd": nrm((DEC_BATCH, DEPTH, 2, SSD_HEADS, SSD_HEADDIM, SSD_STATE), 0.1),
        "c_ctx": nrm((D_MODEL,), 1.0),
        "w_ada": nrm((DEPTH, D_MODEL, 6 * D_MODEL), D_MODEL ** -0.5),
        "b_ada": nrm((DEPTH, 6 * D_MODEL), 0.02),
        "norm_attn_g": gain((DEPTH, D_MODEL)),
        "w_in": nrm((DEPTH, D_MODEL, IN_COLS), D_MODEL ** -0.5),
        "q_norm_g": gain((DEPTH, Q_LORA)),
        "kv_norm_g": gain((DEPTH, KV_LORA)),
        "w_uq": nrm((DEPTH, Q_LORA, MLA_HEADS * (QK_NOPE + QK_ROPE)), Q_LORA ** -0.5),
        "w_ukv": nrm((DEPTH, KV_LORA, MLA_HEADS * (QK_NOPE + V_HEAD)), KV_LORA ** -0.5),
        "w_o_mla": nrm((DEPTH, MLA_HEADS * V_HEAD, D_MODEL), (MLA_HEADS * V_HEAD) ** -0.5),
        "ssd_conv_w": nrm((DEPTH, SSD_CONV, SSD_CONV_DIM), SSD_CONV ** -0.5),
        "ssd_conv_b": nrm((DEPTH, SSD_CONV_DIM), 0.02),
        "ssd_dt_bias": dt0 + jnp.log(-jnp.expm1(-dt0)),
        "ssd_A_log": jnp.log(jax.random.uniform(next(ks), (DEPTH, 2, SSD_HEADS), jnp.float32, minval=1.0, maxval=16.0)),
        "ssd_D": gain((DEPTH, SSD_HEADS)),
        "ssd_norm_g": gain((DEPTH, SSD_INNER)),
        "w_o_ssd": nrm((DEPTH, SSD_INNER, D_MODEL), SSD_INNER ** -0.5),
        "w_out": nrm((DEPTH, D_MODEL, D_MODEL), D_MODEL ** -0.5),
        "norm_ffn_g": gain((DEPTH, D_MODEL)),
        "w_up": nrm((DEPTH, D_MODEL, 2 * D_FF), D_MODEL ** -0.5),
        "ffn_conv_w": nrm((DEPTH, FFN_CONV, 2 * D_FF), FFN_CONV ** -0.5),
        "ffn_conv_b": nrm((DEPTH, 2 * D_FF), 0.02),
        "w_down": nrm((DEPTH, D_FF, D_MODEL), D_FF ** -0.5),
        "final_norm_g": gain((D_MODEL,)),
    }


def reference(x_prompt, x_sample, c, cache_ckv, cache_krope, state_ssd, c_ctx,
              w_ada, b_ada, norm_attn_g, w_in, q_norm_g, kv_norm_g, w_uq, w_ukv, w_o_mla,
              ssd_conv_w, ssd_conv_b, ssd_dt_bias, ssd_A_log, ssd_D, ssd_norm_g, w_o_ssd,
              w_out, norm_ffn_g, w_up, ffn_conv_w, ffn_conv_b, w_down, final_norm_g):
    xp = x_prompt
    xs = x_sample
    new_ckv, new_krope, new_ssd = [], [], []
    for l in range(DEPTH):
        lp = {
            'w_ada': w_ada[l], 'b_ada': b_ada[l], 'norm_attn_g': norm_attn_g[l], 'w_in': w_in[l],
            'q_norm_g': q_norm_g[l], 'kv_norm_g': kv_norm_g[l], 'w_uq': w_uq[l], 'w_ukv': w_ukv[l],
            'w_o_mla': w_o_mla[l], 'ssd_conv_w': ssd_conv_w[l], 'ssd_conv_b': ssd_conv_b[l],
            'ssd_dt_bias': ssd_dt_bias[l], 'ssd_A_log': ssd_A_log[l], 'ssd_D': ssd_D[l],
            'ssd_norm_g': ssd_norm_g[l], 'w_o_ssd': w_o_ssd[l], 'w_out': w_out[l],
            'norm_ffn_g': norm_ffn_g[l], 'w_up': w_up[l], 'ffn_conv_w': ffn_conv_w[l],
            'ffn_conv_b': ffn_conv_b[l], 'w_down': w_down[l],
        }
        xp, (ckv_l, kr_l, st_l) = trunk_layer(xp, c_ctx[None, :], lp, False, None)
        new_ckv.append(ckv_l)
        new_krope.append(kr_l)
        new_ssd.append(st_l)
        xs, _ = trunk_layer(xs, c, lp, True, (cache_ckv[:, l], cache_krope[:, l], state_ssd[:, l]))
    y_prompt = rmsnorm(xp, final_norm_g)
    y_sample = rmsnorm(xs, final_norm_g)
    return (y_prompt, y_sample, jnp.stack(new_ckv, axis=1), jnp.stack(new_krope, axis=1), jnp.stack(new_ssd, axis=1))
```

```cpp
#include <hip/hip_runtime.h>
#include <hip/hip_cooperative_groups.h>
#include <cstdio>
#include <cstdint>
namespace cg = cooperative_groups;

namespace pg8 {
#define PG8_LAS __attribute__((address_space(3)))
typedef unsigned short bf16_t;
typedef short bf16x8 __attribute__((ext_vector_type(8)));
typedef float f32x4 __attribute__((ext_vector_type(4)));
typedef unsigned u32x4 __attribute__((ext_vector_type(4)));
constexpr int BM = 256, BK = 64, HALF = 128, HTB = HALF * BK * 2  , STAGE_BYTES = 8 * HTB, NXCD = 8, WGM = 8;

__host__ __device__ __forceinline__ int lds_byte(int r, int c) { const int st = (r >> 4) * 2 + (c >> 5), rr = r & 15, cc = c & 31, ob = rr * 64 + cc * 2; return st * 1024 + (ob ^ (((ob >> 9) & 1) << 5)); }
__host__ __device__ __forceinline__ void stage_rc(int b, int& R, int& C) { const int st = b / 1024, sb = b % 1024, swz = sb ^ (((sb >> 9) & 1) << 5); R = (st >> 1) * 16 + swz / 64; C = (st & 1) * 32 + (swz % 64) / 2; }
__host__ __device__ __forceinline__ int perm32(int rho) { const int n = rho >> 4, i = rho & 15; return 8 * (i >> 2) + 4 * n + (i & 3); }

struct Unit { int pm, pn; };
struct Gemm { const bf16_t* A; const bf16_t* Bt; int M, N, K; };

struct StaticOrder {
    int nM, nN, nwg, G, c;
    __host__ __device__ void init(int M, int N, int G_, int c_) { nM = M / BM; nN = N / BM; nwg = nM * nN; G = G_; c = c_; }
    __host__ __device__ bool next(int i, Unit& u) const {
        const long L = (long)i * G + c; if (L >= nwg) return false;
        int wgid = (int)L; { const int q = nwg / NXCD, r = nwg % NXCD, xcd = wgid % NXCD, off = wgid / NXCD; wgid = (xcd < r ? xcd * (q + 1) : r * (q + 1) + (xcd - r) * q) + off; }
        const int nig = WGM * nN, gid = wgid / nig, fm = gid * WGM, gsz = (nM - fm) < WGM ? (nM - fm) : WGM;
        u.pm = fm + ((wgid % nig) % gsz); u.pn = (wgid % nig) / gsz; return true;
    }
    __device__ __forceinline__ void a_ready(const Unit&) const {}
    __device__ __forceinline__ void done(const Unit&) const {}
};


template <class Epi, class Sched, bool ALIGN_EPI = false, bool SP2 = false>
__device__ __forceinline__ void gemm_phase(PG8_LAS unsigned char* lds, const Gemm g, const Sched& S, const Epi& E) {
    int tid_ = threadIdx.x; asm volatile("" : "+v"(tid_));
    const int tid = tid_, wid = __builtin_amdgcn_readfirstlane(tid >> 6), lane = tid & 63, wr = wid >> 2, wc = wid & 3, fr = lane & 15, fq = lane >> 4;
    const int K = g.K, nt = K / BK;
    unsigned voffA[2], voffB[2];
#pragma unroll
    for (int i = 0; i < 2; ++i) { int R, C; stage_rc(tid * 16 + i * 8192, R, C); const int Rb = Epi::PERM ? ((R & ~31) + perm32(R & 31)) : R;
        voffA[i] = (unsigned)(R * K + C) * 2u; voffB[i] = (unsigned)(Rb * K + C) * 2u; }
    const size_t kstep = (size_t)(BK * 2);
    const size_t hstep = (size_t)HALF * K * 2;
    const size_t tstep = 2 * hstep;
    const unsigned ldsw = (unsigned)wid * 1024u;
    const int aoff = lds_byte(wr * 64 + fr, fq * 8), boff = lds_byte(wc * 32 + fr, fq * 8);
#define PG8_SA(b, h) (((b) * 2 + (h)) * HTB)
#define PG8_SB(b, h) ((4 + (b) * 2 + (h)) * HTB)
#define PG8_STAGE(bufoff, gbase, voff) do { _Pragma("unroll") for (int _i = 0; _i < 2; ++_i) \
        __builtin_amdgcn_global_load_lds((const unsigned*)((const char*)(gbase) + (voff)[_i]), (PG8_LAS unsigned*)(lds + (bufoff) + ldsw + _i * 8192), 16, 0, 0); } while (0)
#define PG8_LDA(dst, b, h) do { _Pragma("unroll") for (int m = 0; m < 4; ++m) _Pragma("unroll") for (int k = 0; k < 2; ++k) dst[m][k] = *(const PG8_LAS bf16x8*)(lds + PG8_SA(b, h) + aoff + m * 2048 + k * 1024); } while (0)
#define PG8_LDB(dst, b, h) do { _Pragma("unroll") for (int n = 0; n < 2; ++n) _Pragma("unroll") for (int k = 0; k < 2; ++k) dst[n][k] = *(const PG8_LAS bf16x8*)(lds + PG8_SB(b, h) + boff + n * 2048 + k * 1024); } while (0)
#define PG8_MMA(ai, bj, At, Bt) do { __builtin_amdgcn_s_setprio(1); _Pragma("unroll") for (int m = 0; m < 4; ++m) _Pragma("unroll") for (int n = 0; n < 2; ++n) _Pragma("unroll") for (int k = 0; k < 2; ++k) \
        acc[ai][bj][m][n] = __builtin_amdgcn_mfma_f32_16x16x32_bf16(Bt[n][k], At[m][k], acc[ai][bj][m][n], 0, 0, 0); __builtin_amdgcn_s_setprio(0); } while (0)
#define PG8_WAIT_V(n) asm volatile("s_waitcnt vmcnt(" #n ")" ::: "memory")
#define PG8_WAIT_L(n) asm volatile("s_waitcnt lgkmcnt(" #n ")" ::: "memory")
#define PG8_BAR __builtin_amdgcn_s_barrier()
#define PG8_SCHED __builtin_amdgcn_sched_barrier(0)
    Unit cur, nxt; int ui = 0;
    if (!S.next(0, cur)) return;
    f32x4 acc[2][2][4][2];
#pragma unroll
    for (int a = 0; a < 2; ++a)
#pragma unroll
        for (int b = 0; b < 2; ++b)
#pragma unroll
            for (int m = 0; m < 4; ++m)
#pragma unroll
                for (int n = 0; n < 2; ++n) acc[a][b][m][n] = (f32x4){0.f, 0.f, 0.f, 0.f};
    bf16x8 At[4][2], B0[2][2], B1[2][2];
    const char* cA = (const char*)g.A + (size_t)cur.pm * tstep; const char* cB = (const char*)g.Bt + (size_t)cur.pn * tstep;
    S.a_ready(cur);
    if constexpr (SP2) {
        PG8_STAGE(PG8_SB(0, 0), cB, voffB); PG8_STAGE(PG8_SB(0, 1), cB + hstep, voffB); PG8_STAGE(PG8_SA(0, 0), cA, voffA); PG8_STAGE(PG8_SA(0, 1), cA + hstep, voffA);
        if (wr == 1) PG8_BAR;
        PG8_WAIT_V(2); PG8_BAR;
        PG8_STAGE(PG8_SB(1, 0), cB + kstep, voffB); PG8_STAGE(PG8_SA(1, 0), cA + kstep, voffA); PG8_STAGE(PG8_SB(1, 1), cB + hstep + kstep, voffB);
        PG8_WAIT_V(6); PG8_BAR;
    } else {
        PG8_STAGE(PG8_SB(0, 0), cB, voffB); PG8_STAGE(PG8_SA(0, 0), cA, voffA); PG8_STAGE(PG8_SB(0, 1), cB + hstep, voffB); PG8_STAGE(PG8_SA(0, 1), cA + hstep, voffA);
        if (wr == 1) PG8_BAR;
        PG8_WAIT_V(4); PG8_BAR;
        PG8_STAGE(PG8_SB(1, 0), cB + kstep, voffB); PG8_STAGE(PG8_SA(1, 0), cA + kstep, voffA); PG8_STAGE(PG8_SB(1, 1), cB + hstep + kstep, voffB);
        PG8_WAIT_V(6); PG8_BAR;
    }
    for (;;) {
        const bool has_next = S.next(ui + 1, nxt);
        const char* nA = has_next ? (const char*)g.A + (size_t)nxt.pm * tstep : cA; const char* nB = has_next ? (const char*)g.Bt + (size_t)nxt.pn * tstep : cB;
        for (int t = 0; t < nt; t += 2) {
            const bool last = (t == nt - 2);
            const char* a1 = cA + (size_t)(t + 1) * kstep;
            const char* a2 = last ? nA : cA + (size_t)(t + 2) * kstep; const char* b2 = last ? nB : cB + (size_t)(t + 2) * kstep;
            const char* a3 = a2 + kstep; const char* b3 = b2 + kstep;
            if (last && has_next) S.a_ready(nxt);
            if constexpr (SP2) {
            PG8_LDB(B0, 0, 0); PG8_LDB(B1, 0, 1); PG8_SCHED; PG8_LDA(At, 0, 0); PG8_STAGE(PG8_SA(1, 1), a1 + hstep, voffA);
            PG8_WAIT_V(8); PG8_WAIT_L(0); PG8_BAR; PG8_MMA(0, 0, At, B0); PG8_MMA(0, 1, At, B1); PG8_BAR; PG8_SCHED;
            PG8_LDA(At, 0, 1); PG8_STAGE(PG8_SB(0, 0), b2, voffB); PG8_STAGE(PG8_SB(0, 1), b2 + hstep, voffB); PG8_STAGE(PG8_SA(0, 0), a2, voffA);
            PG8_WAIT_V(8); PG8_WAIT_L(0); PG8_BAR; PG8_MMA(1, 0, At, B0); PG8_MMA(1, 1, At, B1); PG8_BAR; PG8_SCHED;
            PG8_LDB(B0, 1, 0); PG8_LDB(B1, 1, 1); PG8_SCHED; PG8_LDA(At, 1, 0); PG8_STAGE(PG8_SA(0, 1), a2 + hstep, voffA);
            PG8_WAIT_V(8); PG8_WAIT_L(0); PG8_BAR; PG8_MMA(0, 0, At, B0); PG8_MMA(0, 1, At, B1); PG8_BAR; PG8_SCHED;
            PG8_LDA(At, 1, 1); PG8_STAGE(PG8_SB(1, 0), b3, voffB); PG8_STAGE(PG8_SB(1, 1), b3 + hstep, voffB); PG8_STAGE(PG8_SA(1, 0), a3, voffA);
            PG8_WAIT_V(8); PG8_WAIT_L(0); PG8_BAR; PG8_MMA(1, 0, At, B0); PG8_MMA(1, 1, At, B1); PG8_BAR; PG8_SCHED;
            } else {
            PG8_LDB(B0, 0, 0); PG8_SCHED; PG8_LDA(At, 0, 0); PG8_STAGE(PG8_SA(1, 1), a1 + hstep, voffA);
            PG8_WAIT_L(8); PG8_BAR; PG8_WAIT_L(0); PG8_MMA(0, 0, At, B0); PG8_BAR; PG8_SCHED;
            PG8_LDB(B1, 0, 1); PG8_STAGE(PG8_SB(0, 0), b2, voffB);
            PG8_BAR; PG8_WAIT_L(0); PG8_MMA(0, 1, At, B1); PG8_BAR;
            PG8_LDA(At, 0, 1); PG8_STAGE(PG8_SA(0, 0), a2, voffA);
            PG8_BAR; PG8_WAIT_L(0); PG8_MMA(1, 0, At, B0); PG8_BAR; PG8_SCHED;
            PG8_STAGE(PG8_SB(0, 1), b2 + hstep, voffB);
            PG8_WAIT_V(6); PG8_BAR; PG8_MMA(1, 1, At, B1); PG8_BAR;
            PG8_LDB(B0, 1, 0); PG8_SCHED; PG8_LDA(At, 1, 0); PG8_STAGE(PG8_SA(0, 1), a2 + hstep, voffA);
            PG8_WAIT_L(8); PG8_BAR; PG8_WAIT_L(0); PG8_MMA(0, 0, At, B0); PG8_BAR; PG8_SCHED;
            PG8_LDB(B1, 1, 1); PG8_STAGE(PG8_SB(1, 0), b3, voffB);
            PG8_BAR; PG8_WAIT_L(0); PG8_MMA(0, 1, At, B1); PG8_BAR;
            PG8_LDA(At, 1, 1); PG8_STAGE(PG8_SA(1, 0), a3, voffA);
            PG8_BAR; PG8_WAIT_L(0); PG8_MMA(1, 0, At, B0); PG8_BAR; PG8_SCHED;
            PG8_STAGE(PG8_SB(1, 1), b3 + hstep, voffB);
            PG8_WAIT_V(6); PG8_BAR; PG8_MMA(1, 1, At, B1); PG8_BAR;
            }
        }
        if constexpr (ALIGN_EPI) { if (wr == 0) PG8_BAR; }
        if constexpr (!Epi::AFTER_DRAIN) { E(acc, cur, wr, wc, fr, fq); S.done(cur); }
        if (!has_next) break;
#pragma unroll
        for (int a = 0; a < 2; ++a)
#pragma unroll
            for (int b = 0; b < 2; ++b)
#pragma unroll
                for (int m = 0; m < 4; ++m)
#pragma unroll
                    for (int n = 0; n < 2; ++n) acc[a][b][m][n] = (f32x4){0.f, 0.f, 0.f, 0.f};
        cur = nxt; cA = nA; cB = nB; ++ui;
        if constexpr (ALIGN_EPI) { if (wr == 1) PG8_BAR; }
    }
    PG8_WAIT_V(0);
    if constexpr (!ALIGN_EPI) { if (wr == 0) PG8_BAR; }
    PG8_BAR;
    if constexpr (Epi::AFTER_DRAIN) { E.fused(acc, cur, wr, wc, fr, fq, lds, wid, lane); S.done(cur); }
#undef PG8_SA
#undef PG8_SB
#undef PG8_STAGE
#undef PG8_LDA
#undef PG8_LDB
#undef PG8_MMA
#undef PG8_WAIT_V
#undef PG8_WAIT_L
#undef PG8_BAR
#undef PG8_SCHED
}
}

#ifndef PG8_SP2
#define PG8_SP2 true
#endif
#ifndef PG8_ALIGN
#define PG8_ALIGN true
#endif

#define LAS __attribute__((address_space(3)))
using pg8::bf16_t; using pg8::f32x4; using pg8::bf16x8; using pg8::u32x4;
typedef unsigned u32x2 __attribute__((ext_vector_type(2)));
typedef float f32x2 __attribute__((ext_vector_type(2)));

constexpr int DM = 1024;
constexpr int RP = 8192, RS = 4096, R = 12288;
constexpr int SEQP = 256, SEQS = 2048, PAST = 512, KVS = PAST + SEQS;
constexpr int KVR = RP + 2 * KVS;
constexpr int NH = 8;
constexpr int INC = 5216, INP = 5376;
constexpr int DFF = 2816, UPN = 5632;
constexpr float EPS = 1e-6f;
constexpr float ATT_SCALE = 0.07216878364870322f;

enum { I_XP = 0, I_XS, I_C, I_CKV, I_CKR, I_SSD, I_CCTX, I_WADA, I_BADA, I_GATTN, I_WIN, I_GQ, I_GKV, I_WUQ, I_WUKV, I_WOMLA,
       I_CONVW, I_CONVB, I_DTB, I_ALOG, I_SSDD, I_GSSD, I_WOSSD, I_WOUT, I_GFFN, I_WUP, I_FCW, I_FCB, I_WDOWN, I_GFIN };

constexpr size_t O_Y = 0, O_CKV = (size_t)R * DM, O_KR = O_CKV + (size_t)RP * 256, O_SSD = O_KR + (size_t)RP * 64;

constexpr size_t MiB = 1u << 20;
constexpr size_t WS_CTL = 0, CTL_ZERO = 65536;
constexpr size_t WS_MOD = 64 * 1024;
constexpr size_t WS_CUP = 160 * 1024;
constexpr size_t WS_ROPE = 256 * 1024;
constexpr size_t WS_SSQ_CQ = 1 * MiB;
constexpr size_t WS_SSQ_CKV = 1 * MiB + 204800;
constexpr size_t WS_SSQ_Y = 1 * MiB + 430080;
constexpr size_t WS_SSQ2 = 1 * MiB + 1216512;
constexpr size_t WS_DT = 3 * MiB;
constexpr size_t WS_WIN = 5 * MiB;
constexpr size_t WS_WUQ = WS_WIN + (size_t)INP * 1024 * 2;
constexpr size_t WS_WUKV = WS_WUQ + 1536 * 256 * 2;
constexpr size_t WS_WOMLA = WS_WUKV + 2048 * 256 * 2;
constexpr size_t WS_WOSSD = WS_WOMLA + 2 * MiB;
constexpr size_t WS_WOUT = WS_WOSSD + 2 * MiB;
constexpr size_t WS_WUP = WS_WOUT + 2 * MiB;
constexpr size_t WS_WDOWN = WS_WUP + (size_t)UPN * 1024 * 2;
static_assert(WS_WDOWN + (size_t)1024 * DFF * 2 <= 40 * MiB, "weights");
constexpr size_t WS_CQ = 40 * MiB;
constexpr size_t WS_CKVA = 46 * MiB;
constexpr size_t WS_KROPE = 46 * MiB + (size_t)KVR * 256 * 2;
constexpr size_t WS_Z = 55 * MiB;
constexpr size_t WS_XBC = 79 * MiB;
constexpr size_t WS_H = 115 * MiB;
constexpr size_t WS_XC = 115 * MiB;
constexpr size_t WS_QN = 115 * MiB;
constexpr size_t WS_QR = 139 * MiB;
constexpr size_t WS_KV = 151 * MiB;
constexpr size_t WS_YF = 151 * MiB;
constexpr size_t WS_ST = 203 * MiB;
constexpr size_t WS_MERGED = 151 * MiB;
constexpr size_t WS_A1 = 55 * MiB;
constexpr size_t WS_U = 115 * MiB;
constexpr size_t WS_UG = 40 * MiB;
constexpr size_t WS_END = 251 * MiB;
static_assert(WS_KROPE + (size_t)KVR * 64 * 2 <= WS_Z && WS_KV + (size_t)KVR * 2048 * 2 <= WS_ST && WS_ST + (size_t)R * 1024 * 4 <= WS_END, "map");
static_assert(WS_U + (size_t)R * UPN * 2 <= WS_END && WS_UG + (size_t)R * DFF * 2 <= WS_U, "map2");

constexpr int LDS_BYTES = 147456;
constexpr int NT = 512;

struct Params { const float* in[30]; float* out; unsigned char* ws; };
#define PHASE_IDS int tid = threadIdx.x; asm volatile("" : "+v"(tid)); const int lane = tid & 63, wave = __builtin_amdgcn_readfirstlane(tid >> 6), G = gridDim.x; (void)lane; (void)wave; (void)G;

#define LDS_WAIT() asm volatile("s_waitcnt lgkmcnt(0)" ::: "memory")
__device__ __forceinline__ unsigned f2bf(float f) { unsigned u = __builtin_bit_cast(unsigned, f); return (u + 0x7fffu + ((u >> 16) & 1u)) >> 16; }
__device__ __forceinline__ float bf2f(unsigned short b) { return __builtin_bit_cast(float, (unsigned)b << 16); }
__device__ __forceinline__ unsigned pk2(float lo, float hi) { return f2bf(lo) | (f2bf(hi) << 16); }
__device__ __forceinline__ float bflo(unsigned w) { return __builtin_bit_cast(float, w << 16); }
__device__ __forceinline__ float bfhi(unsigned w) { return __builtin_bit_cast(float, w & 0xffff0000u); }
__device__ __forceinline__ float wave_sum(float v) {
#pragma unroll
    for (int o = 1; o < 64; o <<= 1) v += __shfl_xor(v, o);
    return v;
}
__device__ __forceinline__ float wave_max(float v) {
#pragma unroll
    for (int o = 1; o < 64; o <<= 1) v = fmaxf(v, __shfl_xor(v, o));
    return v;
}
__device__ __forceinline__ float siluf(float x) { return x / (1.f + __expf(-x)); }
__device__ __forceinline__ float sigm(float x) { return 1.f / (1.f + __expf(-x)); }
__device__ __forceinline__ float softplusf(float x) { return x > 20.f ? x : log1pf(__expf(x)); }
__device__ __forceinline__ int grp_of_row(int row) { return row < RP ? 0 : 1 + ((row - RP) >> 11); }
__device__ __forceinline__ int kvrow_of_row(int row) { return row < RP ? row : RP + ((row - RP) >> 11) * KVS + PAST + ((row - RP) & 2047); }
__device__ __forceinline__ const float* xrow_ptr(const Params& P, int row) { return row < RP ? P.in[I_XP] + (size_t)row * DM : P.in[I_XS] + (size_t)(row - RP) * DM; }

__device__ __forceinline__ void transpose_item(const float* W, int K, int N, bf16_t* WT, int k0, int n0, int drow0, const float* kscale, LAS float* scr, int lane) {
#pragma unroll 8
    for (int i = 0; i < 32; ++i) { const int kk = 2 * i + (lane >> 5); float w = W[(size_t)(k0 + kk) * N + n0 + (lane & 31)]; if (kscale) w *= kscale[k0 + kk]; scr[kk * 33 + (lane & 31)] = w; }
    LDS_WAIT(); asm volatile("" ::: "memory");
    const int c = lane & 7;
#pragma unroll
    for (int j = 0; j < 4; ++j) { const int n = (lane >> 3) + 8 * j; const LAS float* s = scr + (8 * c) * 33 + n;
        u32x4 o; o.x = pk2(s[0 * 33], s[1 * 33]); o.y = pk2(s[2 * 33], s[3 * 33]); o.z = pk2(s[4 * 33], s[5 * 33]); o.w = pk2(s[6 * 33], s[7 * 33]);
        *(u32x4*)(WT + (size_t)(drow0 + n) * K + k0 + 8 * c) = o; }
    LDS_WAIT(); asm volatile("" ::: "memory");
}
__device__ __forceinline__ int win_dst(int n0) {
    if (n0 < 512) return n0;
    if (n0 < 576) return 5120 + (n0 - 512);
    if (n0 < 1600) return 512 + (n0 - 576);
    if (n0 < 2624) return 1536 + (n0 - 1600);
    if (n0 < 2880) return 2560 + (n0 - 2624);
    if (n0 < 3136) return 2816 + (n0 - 2880);
    if (n0 < 3168) return 5184 + (n0 - 3136);
    if (n0 < 4192) return 3072 + (n0 - 3168);
    return 4096 + (n0 - 4192);
}
__device__ __forceinline__ int wuq_dst(int n0) { const int h = n0 / 192, d0 = n0 - h * 192; return d0 < 128 ? h * 128 + d0 : 1024 + h * 64 + (d0 - 128); }

template <int CW>
__device__ __forceinline__ void gemv3_block(const LAS float* vec  , const float* W, int N, int col0, const float* bias, float* out, int ldo, LAS float* red, int tid) {
    const int j = tid & 31, kq = tid >> 5;
    float a0 = 0.f, a1 = 0.f, a2 = 0.f;
    if (j < CW) {
        const float* wp = W + (size_t)(kq * 64) * N + col0 + j;
#pragma unroll 8
        for (int k = 0; k < 64; ++k) { const float w = wp[(size_t)k * N]; const int kk = kq * 64 + k; a0 += vec[kk] * w; a1 += vec[1024 + kk] * w; a2 += vec[2048 + kk] * w; }
    }
    red[(kq * 3 + 0) * 32 + j] = a0; red[(kq * 3 + 1) * 32 + j] = a1; red[(kq * 3 + 2) * 32 + j] = a2;
    __syncthreads();
    if (tid < 96) { const int g = tid >> 5, jj = tid & 31;
        if (jj < CW) { float s = 0.f;
#pragma unroll
            for (int q = 0; q < 16; ++q) s += red[(q * 3 + g) * 32 + jj];
            out[(size_t)g * ldo + col0 + jj] = s + (bias ? bias[col0 + jj] : 0.f); } }
    __syncthreads();
}

__device__ __forceinline__ void phase_p0(const Params& P, LAS unsigned char* lds) {
    PHASE_IDS unsigned char* ws = P.ws;
    {
        LAS float* sc = (LAS float*)lds; LAS float* red = sc + 3072;
        for (int i = tid; i < 3072; i += NT) { const int g = i >> 10, k = i & 1023; const float c = (g == 0) ? P.in[I_CCTX][k] : P.in[I_C][(g - 1) * 1024 + k]; sc[i] = siluf(c); }
        __syncthreads();
        for (int cb = blockIdx.x; cb < 256; cb += G) gemv3_block<24>(sc, P.in[I_WADA], 6144, cb * 24, P.in[I_BADA], (float*)(ws + WS_MOD), 6144, red, tid);
    }
    {
        LAS float* scr = (LAS float*)(lds + wave * 16384);
        const int gw = blockIdx.x * 8 + wave, NGW = G * 8;
        constexpr int I_IN = 16 * 163, I_UQ = 4 * 48, I_UKV = 4 * 64, I_SQ = 16 * 32, I_UP = 16 * 176, I_DN = 44 * 32;
        constexpr int NITEMS = I_IN + I_UQ + I_UKV + 3 * I_SQ + I_UP + I_DN;
        for (int it = gw; it < NITEMS; it += NGW) {
            int r = it;
            if (r < I_IN) { const int kb = r / 163, nb = r % 163; transpose_item(P.in[I_WIN], 1024, INC, (bf16_t*)(ws + WS_WIN), kb * 64, nb * 32, win_dst(nb * 32), nullptr, scr, lane); continue; } r -= I_IN;
            if (r < I_UQ) { const int kb = r / 48, nb = r % 48; transpose_item(P.in[I_WUQ], 256, 1536, (bf16_t*)(ws + WS_WUQ), kb * 64, nb * 32, wuq_dst(nb * 32), P.in[I_GQ], scr, lane); continue; } r -= I_UQ;
            if (r < I_UKV) { const int kb = r / 64, nb = r % 64; transpose_item(P.in[I_WUKV], 256, 2048, (bf16_t*)(ws + WS_WUKV), kb * 64, nb * 32, nb * 32, P.in[I_GKV], scr, lane); continue; } r -= I_UKV;
            if (r < I_SQ) { const int kb = r / 32, nb = r % 32; transpose_item(P.in[I_WOMLA], 1024, 1024, (bf16_t*)(ws + WS_WOMLA), kb * 64, nb * 32, nb * 32, nullptr, scr, lane); continue; } r -= I_SQ;
            if (r < I_SQ) { const int kb = r / 32, nb = r % 32; transpose_item(P.in[I_WOSSD], 1024, 1024, (bf16_t*)(ws + WS_WOSSD), kb * 64, nb * 32, nb * 32, P.in[I_GSSD], scr, lane); continue; } r -= I_SQ;
            if (r < I_SQ) { const int kb = r / 32, nb = r % 32; transpose_item(P.in[I_WOUT], 1024, 1024, (bf16_t*)(ws + WS_WOUT), kb * 64, nb * 32, nb * 32, nullptr, scr, lane); continue; } r -= I_SQ;
            if (r < I_UP) { const int kb = r / 176, nb = r % 176; transpose_item(P.in[I_WUP], 1024, UPN, (bf16_t*)(ws + WS_WUP), kb * 64, nb * 32, nb * 32, nullptr, scr, lane); continue; } r -= I_UP;
            { const int kb = r / 32, nb = r % 32; transpose_item(P.in[I_WDOWN], DFF, 1024, (bf16_t*)(ws + WS_WDOWN), kb * 64, nb * 32, nb * 32, nullptr, scr, lane); }
        }
    }
    {
        const int gt = blockIdx.x * NT + tid, GT = G * NT;
        for (int i = gt; i < 160 * 1024 / 8; i += GT) *(u32x4*)((bf16_t*)(ws + WS_WIN) + (size_t)5216 * 1024 + (size_t)i * 8) = (u32x4){0u, 0u, 0u, 0u};
        for (int i = gt; i < 2048 * 32; i += GT) { const int t = i >> 5, a = (i >> 4) & 1, fi = i & 15; const float pos = (float)(a ? (t & 63) : (t >> 6));
            const float inv = exp2f(-(float)fi * 0.8304820237218406f); const float ang = pos * inv;
            ((f32x2*)(ws + WS_ROPE))[i] = (f32x2){__cosf(ang), __sinf(ang)}; }
        for (int i = gt; i < 2 * PAST * 256; i += GT) { const int k = i & 255, s = (i >> 8) & 511, b = i >> 17;
            ((bf16_t*)(ws + WS_CKVA))[(size_t)(RP + b * KVS + s) * 256 + k] = (bf16_t)f2bf(P.in[I_CKV][i] / P.in[I_GKV][k]); }
        for (int i = gt; i < 2 * PAST * 64; i += GT) { const int j = i & 63, s = (i >> 6) & 511, b = i >> 15;
            ((bf16_t*)(ws + WS_KROPE))[(size_t)(RP + b * KVS + s) * 64 + j] = (bf16_t)f2bf(P.in[I_CKR][i]); }
        for (int i = gt; i < 2 * PAST; i += GT) { const int s = i & 511, b = i >> 9;
            *(f32x4*)((float*)(ws + WS_SSQ_CKV) + (size_t)(RP + b * KVS + s) * 4) = (f32x4){256.f * (1.f - EPS), 0.f, 0.f, 0.f}; }
    }
}

__device__ __forceinline__ void phase_p1(const Params& P, LAS unsigned char* lds) {
    PHASE_IDS unsigned char* ws = P.ws; const float* mod = (const float*)(ws + WS_MOD);
    {
        LAS float* sh = (LAS float*)lds; LAS float* red = sh + 3072;
        for (int i = tid; i < 3072; i += NT) { const int g = i >> 10, k = i & 1023; sh[i] = mod[g * 6144 + 3072 + k]; }
        __syncthreads();
        for (int cb = blockIdx.x; cb < 256; cb += G) gemv3_block<22>(sh, P.in[I_WUP], UPN, cb * 22, nullptr, (float*)(ws + WS_CUP), UPN, red, tid);
    }
    const int gw = blockIdx.x * 8 + wave, NGW = G * 8;
    const float* gat = P.in[I_GATTN];
    for (int row = gw; row < R; row += NGW) {
        const f32x4* xr = (const f32x4*)xrow_ptr(P, row) + lane; const int g = grp_of_row(row);
        f32x4 v[4]; float s = 0.f;
#pragma unroll
        for (int j = 0; j < 4; ++j) { v[j] = xr[64 * j]; s += (v[j].x * v[j].x + v[j].y * v[j].y) + (v[j].z * v[j].z + v[j].w * v[j].w); }
        const float rs = rsqrtf(wave_sum(s) * (1.f / DM) + EPS);
        u32x2* o8 = (u32x2*)((bf16_t*)(ws + WS_H) + (size_t)row * DM) + lane;
#pragma unroll
        for (int j = 0; j < 4; ++j) { const int c = 4 * lane + 256 * j;
            const f32x4 gg = *(const f32x4*)(gat + c), sc = *(const f32x4*)(mod + g * 6144 + 1024 + c), sh = *(const f32x4*)(mod + g * 6144 + c);
            const f32x4 h = v[j] * rs * gg * (sc + 1.f) + sh;
            o8[64 * j] = (u32x2){pk2(h.x, h.y), pk2(h.z, h.w)}; }
    }
}

typedef const f32x4 (&AccRef)[2][2][4][2];
#define EPI_ROWS(pm) _Pragma("unroll") for (int ai = 0; ai < 2; ++ai) _Pragma("unroll") for (int m = 0; m < 4; ++m) { const int row = (pm) * 256 + ai * 128 + wr * 64 + m * 16 + fr;
#define EPI_COLS _Pragma("unroll") for (int bj = 0; bj < 2; ++bj) _Pragma("unroll") for (int n = 0; n < 2; ++n) { const int col = bj * 128 + wc * 32 + n * 16 + fq * 4; const f32x4 v = acc[ai][bj][m][n];
#define EPI_END }
__device__ __forceinline__ void st_bf4(bf16_t* p, f32x4 v) { *(u32x2*)p = (u32x2){pk2(v.x, v.y), pk2(v.z, v.w)}; }
__device__ __forceinline__ f32x4 ld_bf4(const bf16_t* p) { const u32x2 w = *(const u32x2*)p; return (f32x4){bflo(w.x), bfhi(w.x), bflo(w.y), bfhi(w.y)}; }
__device__ __forceinline__ float quad_sum16(float s) { s += __shfl_xor(s, 16); s += __shfl_xor(s, 32); return s; }

struct EpiIn {
    static constexpr bool PERM = false, AFTER_DRAIN = false;
    bf16_t *cq, *ckv, *z, *xbc, *sgm, *sgs, *krope; float *ssq_cq, *ssq_ckv, *dt, *new_ckv, *new_krope; const float* dt_bias; const f32x2* rope;
    __device__ __forceinline__ void operator()(AccRef acc, const pg8::Unit& u, int wr, int wc, int fr, int fq) const {
        const int pn = u.pn;
        if (pn < 2) {
            EPI_ROWS(u.pm)
                const int orow = pn == 0 ? row : kvrow_of_row(row); bf16_t* dst = (pn == 0 ? cq : ckv) + (size_t)orow * 256; float s = 0.f;
                EPI_COLS
                    st_bf4(dst + col, v); s += (v.x * v.x + v.y * v.y) + (v.z * v.z + v.w * v.w);
                    if (pn == 1 && row < RP) *(f32x4*)(new_ckv + (size_t)row * 256 + col) = v;
                EPI_END
                s = quad_sum16(s);
                if (fq == 0) (pn == 0 ? ssq_cq : ssq_ckv)[(size_t)orow * 4 + wc] = s;
            EPI_END
        } else if (pn < 12) {
            bf16_t* base = pn < 6 ? z : xbc; const int ld = pn < 6 ? 1024 : 1536, c0 = pn < 6 ? (pn - 2) * 256 : (pn - 6) * 256;
            EPI_ROWS(u.pm)
                bf16_t* dst = base + (size_t)row * ld + c0;
                EPI_COLS st_bf4(dst + col, v); EPI_END
            EPI_END
        } else if (pn < 20) {
            bf16_t* base = pn < 16 ? sgm : sgs; const int c0 = (pn & 3) * 256;
            EPI_ROWS(u.pm)
                bf16_t* dst = base + (size_t)row * 1024 + c0;
                EPI_COLS st_bf4(dst + col, (f32x4){sigm(v.x), sigm(v.y), sigm(v.z), sigm(v.w)}); EPI_END
            EPI_END
        } else {
            if (wc < 2) {
                EPI_ROWS(u.pm)
                    const f32x4 x0 = acc[ai][0][m][0], x1 = acc[ai][0][m][1]; const int i0 = fq * 4;
                    if (row < RP) {
                        st_bf4(krope + (size_t)row * 64 + wc * 32 + i0, x0); st_bf4(krope + (size_t)row * 64 + wc * 32 + 16 + i0, x1);
                        *(f32x4*)(new_krope + (size_t)row * 64 + wc * 32 + i0) = x0; *(f32x4*)(new_krope + (size_t)row * 64 + wc * 32 + 16 + i0) = x1;
                    } else {
                        const int t = (row - RP) & 2047; const f32x2* rp = rope + t * 32 + wc * 16 + i0; f32x4 o0, o1;
#pragma unroll
                        for (int e = 0; e < 4; ++e) { const f32x2 cs = rp[e]; o0[e] = x0[e] * cs.x - x1[e] * cs.y; o1[e] = x0[e] * cs.y + x1[e] * cs.x; }
                        bf16_t* dst = krope + (size_t)kvrow_of_row(row) * 64 + wc * 32 + i0; st_bf4(dst, o0); st_bf4(dst + 16, o1);
                    }
                EPI_END
            } else if (wc == 2) {
                EPI_ROWS(u.pm)
#pragma unroll
                    for (int n = 0; n < 2; ++n) { const int j = n * 16 + fq * 4; const f32x4 v = acc[ai][0][m][n]; const f32x4 b = *(const f32x4*)(dt_bias + j);
                        *(f32x4*)(dt + (size_t)row * 32 + j) = (f32x4){softplusf(v.x + b.x), softplusf(v.y + b.y), softplusf(v.z + b.z), softplusf(v.w + b.w)}; }
                EPI_END
            }
        }
    }
};

struct EpiQ {
    static constexpr bool PERM = false, AFTER_DRAIN = false;
    bf16_t *qn, *qr; const float* ssq; const f32x2* rope;
    __device__ __forceinline__ void operator()(AccRef acc, const pg8::Unit& u, int wr, int wc, int fr, int fq) const {
        const int pn = u.pn;
        EPI_ROWS(u.pm)
            const f32x4 sq = *(const f32x4*)(ssq + (size_t)row * 4); const float rs = rsqrtf(((sq.x + sq.y) + (sq.z + sq.w)) * (1.f / 256.f) + EPS);
            if (pn < 4) {
                bf16_t* dst = qn + (size_t)row * 1024 + pn * 256;
                EPI_COLS st_bf4(dst + col, v * rs); EPI_END
            } else {
                bf16_t* dst = qr + (size_t)row * 512 + (pn - 4) * 256;
#pragma unroll
                for (int bj = 0; bj < 2; ++bj) { const int cb = bj * 128 + wc * 32, i0 = fq * 4; const f32x4 x0 = acc[ai][bj][m][0] * rs, x1 = acc[ai][bj][m][1] * rs;
                    if (row < RP) { st_bf4(dst + cb + i0, x0); st_bf4(dst + cb + 16 + i0, x1); }
                    else { const int t = (row - RP) & 2047; const f32x2* rp = rope + t * 32 + (wc & 1) * 16 + i0; f32x4 o0, o1;
#pragma unroll
                        for (int e = 0; e < 4; ++e) { const f32x2 cs = rp[e]; o0[e] = x0[e] * cs.x - x1[e] * cs.y; o1[e] = x0[e] * cs.y + x1[e] * cs.x; }
                        st_bf4(dst + cb + i0, o0); st_bf4(dst + cb + 16 + i0, o1); } }
            }
        EPI_END
    }
};
struct EpiKV {
    static constexpr bool PERM = false, AFTER_DRAIN = false;
    bf16_t* kv; const float* ssq;
    __device__ __forceinline__ void operator()(AccRef acc, const pg8::Unit& u, int wr, int wc, int fr, int fq) const {
        EPI_ROWS(u.pm)
            const f32x4 sq = *(const f32x4*)(ssq + (size_t)row * 4); const float rs = rsqrtf(((sq.x + sq.y) + (sq.z + sq.w)) * (1.f / 256.f) + EPS);
            bf16_t* dst = kv + (size_t)row * 2048 + u.pn * 256;
            EPI_COLS st_bf4(dst + col, v * rs); EPI_END
        EPI_END
    }
};
struct EpiMla {
    static constexpr bool PERM = false, AFTER_DRAIN = false;
    const bf16_t* sgm; float* t;
    __device__ __forceinline__ void operator()(AccRef acc, const pg8::Unit& u, int wr, int wc, int fr, int fq) const {
        EPI_ROWS(u.pm)
            const size_t off = (size_t)row * 1024 + u.pn * 256;
            EPI_COLS *(f32x4*)(t + off + col) = ld_bf4(sgm + off + col) * v; EPI_END
        EPI_END
    }
};
struct EpiSsd {
    static constexpr bool PERM = false, AFTER_DRAIN = false;
    const bf16_t* sgs; const float* t; const float* ssq_y; bf16_t* merged;
    __device__ __forceinline__ void operator()(AccRef acc, const pg8::Unit& u, int wr, int wc, int fr, int fq) const {
        EPI_ROWS(u.pm)
            float s = 0.f;
#pragma unroll
            for (int q = 0; q < 4; ++q) { const f32x4 a = *(const f32x4*)(ssq_y + (size_t)row * 16 + q * 4); s += (a.x + a.y) + (a.z + a.w); }
            const float rs = rsqrtf(s * (1.f / 1024.f) + EPS); const size_t off = (size_t)row * 1024 + u.pn * 256;
            EPI_COLS st_bf4(merged + off + col, *(const f32x4*)(t + off + col) + ld_bf4(sgs + off + col) * (v * rs)); EPI_END
        EPI_END
    }
};
struct EpiOut {
    static constexpr bool PERM = false, AFTER_DRAIN = false;
    const float *xp, *xs, *mod, *gffn; float* x1; bf16_t* a1; float* ssq2;
    __device__ __forceinline__ void operator()(AccRef acc, const pg8::Unit& u, int wr, int wc, int fr, int fq) const {
        const int g = u.pm < 32 ? 0 : 1 + ((u.pm - 32) >> 3); const float* md = mod + g * 6144;
        EPI_ROWS(u.pm)
            const float* xr = row < RP ? xp + (size_t)row * DM : xs + (size_t)(row - RP) * DM; const size_t off = (size_t)row * 1024; float s = 0.f;
            EPI_COLS
                const int c = u.pn * 256 + col; const f32x4 x1v = *(const f32x4*)(xr + c) + *(const f32x4*)(md + 2048 + c) * v;
                *(f32x4*)(x1 + off + c) = x1v; s += (x1v.x * x1v.x + x1v.y * x1v.y) + (x1v.z * x1v.z + x1v.w * x1v.w);
                st_bf4(a1 + off + c, x1v * *(const f32x4*)(gffn + c) * (*(const f32x4*)(md + 4096 + c) + 1.f));
            EPI_END
            s = quad_sum16(s);
            if (fq == 0) ssq2[(size_t)row * 16 + u.pn * 4 + wc] = s;
        EPI_END
    }
};
struct EpiUp {
    static constexpr bool PERM = false, AFTER_DRAIN = false;
    const float *ssq2, *cup; bf16_t* uo;
    __device__ __forceinline__ void operator()(AccRef acc, const pg8::Unit& u, int wr, int wc, int fr, int fq) const {
        const int g = u.pm < 32 ? 0 : 1 + ((u.pm - 32) >> 3); const float* cu = cup + g * UPN + u.pn * 256;
        EPI_ROWS(u.pm)
            float s = 0.f;
#pragma unroll
            for (int q = 0; q < 4; ++q) { const f32x4 a = *(const f32x4*)(ssq2 + (size_t)row * 16 + q * 4); s += (a.x + a.y) + (a.z + a.w); }
            const float rs = rsqrtf(s * (1.f / 1024.f) + EPS); bf16_t* dst = uo + (size_t)row * UPN + u.pn * 256;
            EPI_COLS st_bf4(dst + col, v * rs + *(const f32x4*)(cu + col)); EPI_END
        EPI_END
    }
};
struct EpiDown {
    static constexpr bool PERM = false, AFTER_DRAIN = false;
    const float* mod; float* x;
    __device__ __forceinline__ void operator()(AccRef acc, const pg8::Unit& u, int wr, int wc, int fr, int fq) const {
        const int g = u.pm < 32 ? 0 : 1 + ((u.pm - 32) >> 3); const float* g2 = mod + g * 6144 + 5120 + u.pn * 256;
        EPI_ROWS(u.pm)
            float* xr = x + (size_t)row * 1024 + u.pn * 256;
            EPI_COLS *(f32x4*)(xr + col) = *(const f32x4*)(xr + col) + *(const f32x4*)(g2 + col) * v; EPI_END
        EPI_END
    }
};

template <class Epi>
__device__ __forceinline__ void run_gemm(LAS unsigned char* lds, const bf16_t* A, const bf16_t* Bt, int M, int N, int K, int G, int c, const Epi& E) {
    pg8::Gemm g{A, Bt, M, N, K}; pg8::StaticOrder S; S.init(M, N, G, c);
    pg8::gemm_phase<Epi, pg8::StaticOrder, PG8_ALIGN, PG8_SP2>(lds, g, S, E);
}

__device__ __forceinline__ void phase_conv(const Params& P) {
    PHASE_IDS unsigned char* ws = P.ws; const bf16_t* xbc = (const bf16_t*)(ws + WS_XBC); bf16_t* xc = (bf16_t*)(ws + WS_XC);
    const float* cw = P.in[I_CONVW]; const float* cb = P.in[I_CONVB];
    const int gt = blockIdx.x * NT + tid, GT = G * NT;
    for (int i = gt; i < R * (1536 / 4); i += GT) {
        const int row = i / 384, c = (i % 384) * 4; const int t = row < RP ? (row & 255) : ((row - RP) & 2047), L = row < RP ? SEQP : SEQS;
        f32x4 a = *(const f32x4*)(cb + c);
        if (t > 0) a += ld_bf4(xbc + (size_t)(row - 1) * 1536 + c) * *(const f32x4*)(cw + c);
        a += ld_bf4(xbc + (size_t)row * 1536 + c) * *(const f32x4*)(cw + 1536 + c);
        if (t < L - 1) a += ld_bf4(xbc + (size_t)(row + 1) * 1536 + c) * *(const f32x4*)(cw + 3072 + c);
        st_bf4(xc + (size_t)row * 1536 + c, (f32x4){siluf(a.x), siluf(a.y), siluf(a.z), siluf(a.w)});
    }
    const int gw = blockIdx.x * 8 + wave, NGW = G * 8;
    float* nck = P.out + O_CKV; const float* ssq = (const float*)(ws + WS_SSQ_CKV); const float* gk = P.in[I_GKV];
    for (int row = gw; row < RP; row += NGW) {
        const f32x4 sq = *(const f32x4*)(ssq + (size_t)row * 4); const float rs = rsqrtf(((sq.x + sq.y) + (sq.z + sq.w)) * (1.f / 256.f) + EPS);
        f32x4* p = (f32x4*)(nck + (size_t)row * 256) + lane; *p = *p * rs * *(const f32x4*)(gk + 4 * lane);
    }
}
__device__ __forceinline__ void phase_ssd_naive(const Params& P) {
    PHASE_IDS unsigned char* ws = P.ws; const bf16_t* xc = (const bf16_t*)(ws + WS_XC); const float* dt = (const float*)(ws + WS_DT);
    const int gw = blockIdx.x * 8 + wave, NGW = G * 8;
    for (int task = gw; task < 64 + 1024; task += NGW) {
        int b, dir, h, L, row0; bool smp = task < 64;
        if (smp) { b = task >> 5; dir = (task >> 4) & 1; h = task & 15; L = SEQS; row0 = RP + b * SEQS; }
        else { const int q = task - 64; b = q >> 5; dir = (q >> 4) & 1; h = q & 15; L = SEQP; row0 = b * SEQP; }
        const float A = -__expf(P.in[I_ALOG][dir * 16 + h]); const int g = h >> 2;
        float hs[64];
#pragma unroll
        for (int n = 0; n < 64; ++n) hs[n] = smp ? P.in[I_SSD][((((size_t)b * 2 + dir) * 16 + h) * 64 + lane) * 64 + n] : 0.f;
        float* yo = (float*)(ws + (dir ? WS_ST : WS_YF));
        for (int step = 0; step < L; ++step) {
            const int row = row0 + (dir ? L - 1 - step : step);
            const float dtv = dt[(size_t)row * 32 + dir * 16 + h]; const float a = __expf(dtv * A);
            const float xd = bf2f(xc[(size_t)row * 1536 + h * 64 + lane]) * dtv;
            const u32x4* Bp = (const u32x4*)(xc + (size_t)row * 1536 + 1024 + g * 64); const u32x4* Cp = (const u32x4*)(xc + (size_t)row * 1536 + 1280 + g * 64);
            float y = 0.f;
#pragma unroll
            for (int q = 0; q < 8; ++q) { const u32x4 bw = Bp[q], cw = Cp[q];
#pragma unroll
                for (int e = 0; e < 4; ++e) { const int n = q * 8 + e * 2;
                    hs[n] = hs[n] * a + xd * bflo(bw[e]); y += bflo(cw[e]) * hs[n];
                    hs[n + 1] = hs[n + 1] * a + xd * bfhi(bw[e]); y += bfhi(cw[e]) * hs[n + 1]; } }
            yo[(size_t)row * 1024 + h * 64 + lane] = y;
        }
        if (!smp) { float* so = P.out + O_SSD + ((((size_t)b * 2 + dir) * 16 + h) * 64 + lane) * 64;
#pragma unroll
            for (int n = 0; n < 64; n += 4) *(f32x4*)(so + n) = (f32x4){hs[n], hs[n + 1], hs[n + 2], hs[n + 3]}; }
    }
}
__device__ __forceinline__ void phase_gate(const Params& P) {
    PHASE_IDS unsigned char* ws = P.ws; const float* yf = (const float*)(ws + WS_YF); const float* yb = (const float*)(ws + WS_ST);
    const bf16_t* xc = (const bf16_t*)(ws + WS_XC); bf16_t* z = (bf16_t*)(ws + WS_Z); float* ssq = (float*)(ws + WS_SSQ_Y);
    const int gw = blockIdx.x * 8 + wave, NGW = G * 8;
    for (int row = gw; row < R; row += NGW) {
#pragma unroll
        for (int j = 0; j < 4; ++j) { const int c = 4 * lane + 256 * j, h = c >> 6; const float Dh = P.in[I_SSDD][h];
            const f32x4 zz = ld_bf4(z + (size_t)row * 1024 + c), xx = ld_bf4(xc + (size_t)row * 1536 + c);
            f32x4 v = *(const f32x4*)(yf + (size_t)row * 1024 + c) + *(const f32x4*)(yb + (size_t)row * 1024 + c) + xx * Dh;
            v = v * (f32x4){siluf(zz.x), siluf(zz.y), siluf(zz.z), siluf(zz.w)};
            float s = (v.x * v.x + v.y * v.y) + (v.z * v.z + v.w * v.w);
            s += __shfl_xor(s, 1); s += __shfl_xor(s, 2); s += __shfl_xor(s, 4); s += __shfl_xor(s, 8);
            st_bf4(z + (size_t)row * 1024 + c, v);
            if ((lane & 15) == 0) ssq[(size_t)row * 16 + h] = s; }
    }
}
__device__ __forceinline__ void phase_attn_naive(const Params& P, LAS unsigned char* lds) {
    PHASE_IDS unsigned char* ws = P.ws; bf16_t* qn = (bf16_t*)(ws + WS_QN); const bf16_t* qr = (const bf16_t*)(ws + WS_QR);
    const bf16_t* kv = (const bf16_t*)(ws + WS_KV); const bf16_t* kr = (const bf16_t*)(ws + WS_KROPE);
    LAS float* qs = (LAS float*)lds + wave * 192;
    const int gw = blockIdx.x * 8 + wave, NGW = G * 8;
    for (int task = gw; task < R * NH; task += NGW) {
        const int rr = task >> 3, h = task & 7; const int row = rr < RS ? RP + rr : rr - RS;
        int kv0, nk; if (row < RP) { kv0 = (row >> 8) * SEQP; nk = SEQP; } else { kv0 = RP + ((row - RP) >> 11) * KVS; nk = KVS; }
        qs[lane] = bf2f(qn[(size_t)row * 1024 + h * 128 + lane]); qs[64 + lane] = bf2f(qn[(size_t)row * 1024 + h * 128 + 64 + lane]);
        qs[128 + lane] = bf2f(qr[(size_t)row * 512 + h * 64 + lane]);
        LDS_WAIT(); asm volatile("" ::: "memory");
        float m = -1e30f, l = 0.f, o0 = 0.f, o1 = 0.f;
        for (int k0 = 0; k0 < nk; k0 += 64) {
            const size_t krow = (size_t)(kv0 + k0 + lane);
            const u32x4* kp = (const u32x4*)(kv + krow * 2048 + h * 256); const u32x4* rp = (const u32x4*)(kr + krow * 64);
            float s = 0.f;
#pragma unroll 4
            for (int q = 0; q < 16; ++q) { const u32x4 w = kp[q];
#pragma unroll
                for (int e = 0; e < 4; ++e) s += qs[q * 8 + e * 2] * bflo(w[e]) + qs[q * 8 + e * 2 + 1] * bfhi(w[e]); }
#pragma unroll 4
            for (int q = 0; q < 8; ++q) { const u32x4 w = rp[q];
#pragma unroll
                for (int e = 0; e < 4; ++e) s += qs[128 + q * 8 + e * 2] * bflo(w[e]) + qs[128 + q * 8 + e * 2 + 1] * bfhi(w[e]); }
            s *= ATT_SCALE;
            const float mn = fmaxf(m, wave_max(s)); const float p = __expf(s - mn), al = __expf(m - mn);
            l = l * al + wave_sum(p); o0 *= al; o1 *= al; m = mn;
            const bf16_t* vp = kv + (size_t)(kv0 + k0) * 2048 + h * 256 + 128;
#pragma unroll 8
            for (int j = 0; j < 64; ++j) { const float pj = __shfl(p, j); o0 += pj * bf2f(vp[(size_t)j * 2048 + lane]); o1 += pj * bf2f(vp[(size_t)j * 2048 + 64 + lane]); }
        }
        const float il = 1.f / l;
        qn[(size_t)row * 1024 + h * 128 + lane] = (bf16_t)f2bf(o0 * il); qn[(size_t)row * 1024 + h * 128 + 64 + lane] = (bf16_t)f2bf(o1 * il);
        asm volatile("" ::: "memory");
    }
}
__device__ __forceinline__ f32x4 conv3_at(const bf16_t* u, int row, int t, int L, int c, const float* fw, const float* fb) {
    f32x4 a = *(const f32x4*)(fb + c);
    if (t > 0) a += ld_bf4(u + (size_t)(row - 1) * UPN + c) * *(const f32x4*)(fw + c);
    a += ld_bf4(u + (size_t)row * UPN + c) * *(const f32x4*)(fw + UPN + c);
    if (t < L - 1) a += ld_bf4(u + (size_t)(row + 1) * UPN + c) * *(const f32x4*)(fw + 2 * UPN + c);
    return a;
}
__device__ __forceinline__ void phase_convgate(const Params& P) {
    PHASE_IDS unsigned char* ws = P.ws; const bf16_t* u = (const bf16_t*)(ws + WS_U); bf16_t* ug = (bf16_t*)(ws + WS_UG);
    const float* fw = P.in[I_FCW]; const float* fb = P.in[I_FCB];
    const int gt = blockIdx.x * NT + tid, GT = G * NT;
    for (int i = gt; i < R * (DFF / 4); i += GT) {
        const int row = i / (DFF / 4), c = (i % (DFF / 4)) * 4; const int t = row < RP ? (row & 255) : ((row - RP) & 2047), L = row < RP ? SEQP : SEQS;
        const f32x4 a = conv3_at(u, row, t, L, c, fw, fb), b = conv3_at(u, row, t, L, DFF + c, fw, fb);
        st_bf4(ug + (size_t)row * DFF + c, (f32x4){siluf(a.x), siluf(a.y), siluf(a.z), siluf(a.w)} * b);
    }
}
__device__ __forceinline__ void phase_final(const Params& P) {
    PHASE_IDS const int gw = blockIdx.x * 8 + wave, NGW = G * 8; const float* gf = P.in[I_GFIN];
    for (int row = gw; row < R; row += NGW) {
        f32x4* xr = (f32x4*)(P.out + (size_t)row * DM) + lane; f32x4 v[4]; float s = 0.f;
#pragma unroll
        for (int j = 0; j < 4; ++j) { v[j] = xr[64 * j]; s += (v[j].x * v[j].x + v[j].y * v[j].y) + (v[j].z * v[j].z + v[j].w * v[j].w); }
        const float rs = rsqrtf(wave_sum(s) * (1.f / DM) + EPS);
#pragma unroll
        for (int j = 0; j < 4; ++j) xr[64 * j] = v[j] * rs * *(const f32x4*)(gf + 4 * lane + 256 * j);
    }
}

__global__ void __launch_bounds__(NT, 2) mega_fwd(Params P) {
    extern __shared__ __attribute__((aligned(16))) unsigned char lds_raw[];
    LAS unsigned char* lds = (LAS unsigned char*)lds_raw;
    cg::grid_group grid = cg::this_grid();
    const int G = gridDim.x, bx = blockIdx.x;
    unsigned char* ws = P.ws;
#define GSYNC() grid.sync()

    phase_p0(P, lds);
    GSYNC();
    phase_p1(P, lds);
    GSYNC();
    {
        EpiIn E{(bf16_t*)(ws + WS_CQ), (bf16_t*)(ws + WS_CKVA), (bf16_t*)(ws + WS_Z), (bf16_t*)(ws + WS_XBC), (bf16_t*)P.out, (bf16_t*)P.out + (size_t)R * 1024, (bf16_t*)(ws + WS_KROPE),
                (float*)(ws + WS_SSQ_CQ), (float*)(ws + WS_SSQ_CKV), (float*)(ws + WS_DT), P.out + O_CKV, P.out + O_KR, P.in[I_DTB], (const f32x2*)(ws + WS_ROPE)};
        run_gemm(lds, (const bf16_t*)(ws + WS_H), (const bf16_t*)(ws + WS_WIN), R, INP, 1024, G, bx, E);
    }
    GSYNC();
    phase_conv(P);
    GSYNC();
    phase_ssd_naive(P);
    GSYNC();
    phase_gate(P);
    GSYNC();
    {
        EpiQ EQ{(bf16_t*)(ws + WS_QN), (bf16_t*)(ws + WS_QR), (const float*)(ws + WS_SSQ_CQ), (const f32x2*)(ws + WS_ROPE)};
        run_gemm(lds, (const bf16_t*)(ws + WS_CQ), (const bf16_t*)(ws + WS_WUQ), R, 1536, 256, G, bx, EQ);
        EpiKV EK{(bf16_t*)(ws + WS_KV), (const float*)(ws + WS_SSQ_CKV)};
        run_gemm(lds, (const bf16_t*)(ws + WS_CKVA), (const bf16_t*)(ws + WS_WUKV), KVR, 2048, 256, G, (bx + 224) % G, EK);
    }
    GSYNC();
    phase_attn_naive(P, lds);
    GSYNC();
    {
        EpiMla EM{(const bf16_t*)P.out, (float*)(ws + WS_ST)};
        run_gemm(lds, (const bf16_t*)(ws + WS_QN), (const bf16_t*)(ws + WS_WOMLA), R, 1024, 1024, G, bx, EM);
        EpiSsd ES{(const bf16_t*)P.out + (size_t)R * 1024, (const float*)(ws + WS_ST), (const float*)(ws + WS_SSQ_Y), (bf16_t*)(ws + WS_MERGED)};
        run_gemm(lds, (const bf16_t*)(ws + WS_Z), (const bf16_t*)(ws + WS_WOSSD), R, 1024, 1024, G, bx, ES);
    }
    GSYNC();
    {
        EpiOut E{P.in[I_XP], P.in[I_XS], (const float*)(ws + WS_MOD), P.in[I_GFFN], P.out, (bf16_t*)(ws + WS_A1), (float*)(ws + WS_SSQ2)};
        run_gemm(lds, (const bf16_t*)(ws + WS_MERGED), (const bf16_t*)(ws + WS_WOUT), R, 1024, 1024, G, bx, E);
    }
    GSYNC();
    {
        EpiUp E{(const float*)(ws + WS_SSQ2), (const float*)(ws + WS_CUP), (bf16_t*)(ws + WS_U)};
        run_gemm(lds, (const bf16_t*)(ws + WS_A1), (const bf16_t*)(ws + WS_WUP), R, UPN, 1024, G, bx, E);
    }
    GSYNC();
    phase_convgate(P);
    GSYNC();
    {
        EpiDown E{(const float*)(ws + WS_MOD), P.out};
        run_gemm(lds, (const bf16_t*)(ws + WS_UG), (const bf16_t*)(ws + WS_WDOWN), R, 1024, DFF, G, bx, E);
    }
    GSYNC();
    phase_final(P);
}

extern "C" void kernel_launch(void* const* d_in, const int* in_sizes, int n_in, void* d_out, int out_size, void* d_ws, size_t ws_size, hipStream_t stream) {
    static int grid = 0;
    if (grid == 0) {
        if (n_in != 30 || ws_size < WS_END || out_size != (int)(O_SSD + (size_t)32 * 2 * 16 * 64 * 64)) {
            fprintf(stderr, "kernel_launch: unexpected shapes: n_in %d out %d ws %zu (need %zu)\n", n_in, out_size, ws_size, (size_t)WS_END); grid = -1; return; }
        int dev = 0, cus = 0, per_cu = 0;
        if (hipGetDevice(&dev) != hipSuccess || hipDeviceGetAttribute(&cus, hipDeviceAttributeMultiprocessorCount, dev) != hipSuccess) { grid = -1; return; }
        if (hipFuncSetAttribute((const void*)mega_fwd, hipFuncAttributeMaxDynamicSharedMemorySize, LDS_BYTES) != hipSuccess) { fprintf(stderr, "kernel_launch: hipFuncSetAttribute failed\n"); grid = -1; return; }
        if (hipOccupancyMaxActiveBlocksPerMultiprocessor(&per_cu, (const void*)mega_fwd, NT, LDS_BYTES) != hipSuccess || per_cu < 1) { fprintf(stderr, "kernel_launch: occupancy query failed (%d)\n", per_cu); (void)hipGetLastError(); grid = -1; return; }
        grid = cus;
    }
    if (grid < 0) return;
    (void)hipMemsetAsync((char*)d_ws + WS_CTL, 0, CTL_ZERO, stream);
    Params p{};
    for (int i = 0; i < 30; ++i) p.in[i] = (const float*)d_in[i];
    p.out = (float*)d_out; p.ws = (unsigned char*)d_ws;
    void* args[] = {&p};
    hipError_t e = hipLaunchCooperativeKernel((const void*)mega_fwd, dim3(grid), dim3(NT), args, LDS_BYTES, stream);
    if (e != hipSuccess) fprintf(stderr, "kernel_launch: cooperative launch failed: %s (grid %d)\n", hipGetErrorString(e), grid);
}
```

```cpp
#include <hip/hip_runtime.h>
#include <hip/hip_cooperative_groups.h>
#include <cstdio>
#include <cstdint>
namespace cg = cooperative_groups;

namespace pg8 {
#define PG8_LAS __attribute__((address_space(3)))
typedef unsigned short bf16_t;
typedef short bf16x8 __attribute__((ext_vector_type(8)));
typedef float f32x4 __attribute__((ext_vector_type(4)));
typedef unsigned u32x4 __attribute__((ext_vector_type(4)));
constexpr int BM = 256, BK = 64, HALF = 128, HTB = HALF * BK * 2  , STAGE_BYTES = 8 * HTB, NXCD = 8, WGM = 8;

__host__ __device__ __forceinline__ int lds_byte(int r, int c) { const int st = (r >> 4) * 2 + (c >> 5), rr = r & 15, cc = c & 31, ob = rr * 64 + cc * 2; return st * 1024 + (ob ^ (((ob >> 9) & 1) << 5)); }
__host__ __device__ __forceinline__ void stage_rc(int b, int& R, int& C) { const int st = b / 1024, sb = b % 1024, swz = sb ^ (((sb >> 9) & 1) << 5); R = (st >> 1) * 16 + swz / 64; C = (st & 1) * 32 + (swz % 64) / 2; }
__host__ __device__ __forceinline__ int perm32(int rho) { const int n = rho >> 4, i = rho & 15; return 8 * (i >> 2) + 4 * n + (i & 3); }

struct Unit { int pm, pn; };
struct Gemm { const bf16_t* A; const bf16_t* Bt; int M, N, K; };

struct StaticOrder {
    int nM, nN, nwg, G, c;
    __host__ __device__ void init(int M, int N, int G_, int c_) { nM = M / BM; nN = N / BM; nwg = nM * nN; G = G_; c = c_; }
    __host__ __device__ bool next(int i, Unit& u) const {
        const long L = (long)i * G + c; if (L >= nwg) return false;
        int wgid = (int)L; { const int q = nwg / NXCD, r = nwg % NXCD, xcd = wgid % NXCD, off = wgid / NXCD; wgid = (xcd < r ? xcd * (q + 1) : r * (q + 1) + (xcd - r) * q) + off; }
        const int nig = WGM * nN, gid = wgid / nig, fm = gid * WGM, gsz = (nM - fm) < WGM ? (nM - fm) : WGM;
        u.pm = fm + ((wgid % nig) % gsz); u.pn = (wgid % nig) / gsz; return true;
    }
    __device__ __forceinline__ void a_ready(const Unit&) const {}
    __device__ __forceinline__ void done(const Unit&) const {}
};


template <class Epi, class Sched, bool ALIGN_EPI = false, bool SP2 = false>
__device__ __forceinline__ void gemm_phase(PG8_LAS unsigned char* lds, const Gemm g, const Sched& S, const Epi& E) {
    int tid_ = threadIdx.x; asm volatile("" : "+v"(tid_));
    const int tid = tid_, wid = __builtin_amdgcn_readfirstlane(tid >> 6), lane = tid & 63, wr = wid >> 2, wc = wid & 3, fr = lane & 15, fq = lane >> 4;
    const int K = g.K, nt = K / BK;
    unsigned voffA[2], voffB[2];
#pragma unroll
    for (int i = 0; i < 2; ++i) { int R, C; stage_rc(tid * 16 + i * 8192, R, C); const int Rb = Epi::PERM ? ((R & ~31) + perm32(R & 31)) : R;
        voffA[i] = (unsigned)(R * K + C) * 2u; voffB[i] = (unsigned)(Rb * K + C) * 2u; }
    const size_t kstep = (size_t)(BK * 2);
    const size_t hstep = (size_t)HALF * K * 2;
    const size_t tstep = 2 * hstep;
    const unsigned ldsw = (unsigned)wid * 1024u;
    const int aoff = lds_byte(wr * 64 + fr, fq * 8), boff = lds_byte(wc * 32 + fr, fq * 8);
#define PG8_SA(b, h) (((b) * 2 + (h)) * HTB)
#define PG8_SB(b, h) ((4 + (b) * 2 + (h)) * HTB)
#define PG8_STAGE(bufoff, gbase, voff) do { _Pragma("unroll") for (int _i = 0; _i < 2; ++_i) \
        __builtin_amdgcn_global_load_lds((const unsigned*)((const char*)(gbase) + (voff)[_i]), (PG8_LAS unsigned*)(lds + (bufoff) + ldsw + _i * 8192), 16, 0, 0); } while (0)
#define PG8_LDA(dst, b, h) do { _Pragma("unroll") for (int m = 0; m < 4; ++m) _Pragma("unroll") for (int k = 0; k < 2; ++k) dst[m][k] = *(const PG8_LAS bf16x8*)(lds + PG8_SA(b, h) + aoff + m * 2048 + k * 1024); } while (0)
#define PG8_LDB(dst, b, h) do { _Pragma("unroll") for (int n = 0; n < 2; ++n) _Pragma("unroll") for (int k = 0; k < 2; ++k) dst[n][k] = *(const PG8_LAS bf16x8*)(lds + PG8_SB(b, h) + boff + n * 2048 + k * 1024); } while (0)
#define PG8_MMA(ai, bj, At, Bt) do { __builtin_amdgcn_s_setprio(1); _Pragma("unroll") for (int m = 0; m < 4; ++m) _Pragma("unroll") for (int n = 0; n < 2; ++n) _Pragma("unroll") for (int k = 0; k < 2; ++k) \
        acc[ai][bj][m][n] = __builtin_amdgcn_mfma_f32_16x16x32_bf16(Bt[n][k], At[m][k], acc[ai][bj][m][n], 0, 0, 0); __builtin_amdgcn_s_setprio(0); } while (0)
#define PG8_WAIT_V(n) asm volatile("s_waitcnt vmcnt(" #n ")" ::: "memory")
#define PG8_WAIT_L(n) asm volatile("s_waitcnt lgkmcnt(" #n ")" ::: "memory")
#define PG8_BAR __builtin_amdgcn_s_barrier()
#define PG8_SCHED __builtin_amdgcn_sched_barrier(0)
    Unit cur, nxt; int ui = 0;
    if (!S.next(0, cur)) return;
    f32x4 acc[2][2][4][2];
#pragma unroll
    for (int a = 0; a < 2; ++a)
#pragma unroll
        for (int b = 0; b < 2; ++b)
#pragma unroll
            for (int m = 0; m < 4; ++m)
#pragma unroll
                for (int n = 0; n < 2; ++n) acc[a][b][m][n] = (f32x4){0.f, 0.f, 0.f, 0.f};
    bf16x8 At[4][2], B0[2][2], B1[2][2];
    const char* cA = (const char*)g.A + (size_t)cur.pm * tstep; const char* cB = (const char*)g.Bt + (size_t)cur.pn * tstep;
    S.a_ready(cur);
    if constexpr (SP2) {
        PG8_STAGE(PG8_SB(0, 0), cB, voffB); PG8_STAGE(PG8_SB(0, 1), cB + hstep, voffB); PG8_STAGE(PG8_SA(0, 0), cA, voffA); PG8_STAGE(PG8_SA(0, 1), cA + hstep, voffA);
        if (wr == 1) PG8_BAR;
        PG8_WAIT_V(2); PG8_BAR;
        PG8_STAGE(PG8_SB(1, 0), cB + kstep, voffB); PG8_STAGE(PG8_SA(1, 0), cA + kstep, voffA); PG8_STAGE(PG8_SB(1, 1), cB + hstep + kstep, voffB);
        PG8_WAIT_V(6); PG8_BAR;
    } else {
        PG8_STAGE(PG8_SB(0, 0), cB, voffB); PG8_STAGE(PG8_SA(0, 0), cA, voffA); PG8_STAGE(PG8_SB(0, 1), cB + hstep, voffB); PG8_STAGE(PG8_SA(0, 1), cA + hstep, voffA);
        if (wr == 1) PG8_BAR;
        PG8_WAIT_V(4); PG8_BAR;
        PG8_STAGE(PG8_SB(1, 0), cB + kstep, voffB); PG8_STAGE(PG8_SA(1, 0), cA + kstep, voffA); PG8_STAGE(PG8_SB(1, 1), cB + hstep + kstep, voffB);
        PG8_WAIT_V(6); PG8_BAR;
    }
    for (;;) {
        const bool has_next = S.next(ui + 1, nxt);
        const char* nA = has_next ? (const char*)g.A + (size_t)nxt.pm * tstep : cA; const char* nB = has_next ? (const char*)g.Bt + (size_t)nxt.pn * tstep : cB;
        for (int t = 0; t < nt; t += 2) {
            const bool last = (t == nt - 2);
            const char* a1 = cA + (size_t)(t + 1) * kstep;
            const char* a2 = last ? nA : cA + (size_t)(t + 2) * kstep; const char* b2 = last ? nB : cB + (size_t)(t + 2) * kstep;
            const char* a3 = a2 + kstep; const char* b3 = b2 + kstep;
            if (last && has_next) S.a_ready(nxt);
            if constexpr (SP2) {
            PG8_LDB(B0, 0, 0); PG8_LDB(B1, 0, 1); PG8_SCHED; PG8_LDA(At, 0, 0); PG8_STAGE(PG8_SA(1, 1), a1 + hstep, voffA);
            PG8_WAIT_V(8); PG8_WAIT_L(0); PG8_BAR; PG8_MMA(0, 0, At, B0); PG8_MMA(0, 1, At, B1); PG8_BAR; PG8_SCHED;
            PG8_LDA(At, 0, 1); PG8_STAGE(PG8_SB(0, 0), b2, voffB); PG8_STAGE(PG8_SB(0, 1), b2 + hstep, voffB); PG8_STAGE(PG8_SA(0, 0), a2, voffA);
            PG8_WAIT_V(8); PG8_WAIT_L(0); PG8_BAR; PG8_MMA(1, 0, At, B0); PG8_MMA(1, 1, At, B1); PG8_BAR; PG8_SCHED;
            PG8_LDB(B0, 1, 0); PG8_LDB(B1, 1, 1); PG8_SCHED; PG8_LDA(At, 1, 0); PG8_STAGE(PG8_SA(0, 1), a2 + hstep, voffA);
            PG8_WAIT_V(8); PG8_WAIT_L(0); PG8_BAR; PG8_MMA(0, 0, At, B0); PG8_MMA(0, 1, At, B1); PG8_BAR; PG8_SCHED;
            PG8_LDA(At, 1, 1); PG8_STAGE(PG8_SB(1, 0), b3, voffB); PG8_STAGE(PG8_SB(1, 1), b3 + hstep, voffB); PG8_STAGE(PG8_SA(1, 0), a3, voffA);
            PG8_WAIT_V(8); PG8_WAIT_L(0); PG8_BAR; PG8_MMA(1, 0, At, B0); PG8_MMA(1, 1, At, B1); PG8_BAR; PG8_SCHED;
            } else {
            PG8_LDB(B0, 0, 0); PG8_SCHED; PG8_LDA(At, 0, 0); PG8_STAGE(PG8_SA(1, 1), a1 + hstep, voffA);
            PG8_WAIT_L(8); PG8_BAR; PG8_WAIT_L(0); PG8_MMA(0, 0, At, B0); PG8_BAR; PG8_SCHED;
            PG8_LDB(B1, 0, 1); PG8_STAGE(PG8_SB(0, 0), b2, voffB);
            PG8_BAR; PG8_WAIT_L(0); PG8_MMA(0, 1, At, B1); PG8_BAR;
            PG8_LDA(At, 0, 1); PG8_STAGE(PG8_SA(0, 0), a2, voffA);
            PG8_BAR; PG8_WAIT_L(0); PG8_MMA(1, 0, At, B0); PG8_BAR; PG8_SCHED;
            PG8_STAGE(PG8_SB(0, 1), b2 + hstep, voffB);
            PG8_WAIT_V(6); PG8_BAR; PG8_MMA(1, 1, At, B1); PG8_BAR;
            PG8_LDB(B0, 1, 0); PG8_SCHED; PG8_LDA(At, 1, 0); PG8_STAGE(PG8_SA(0, 1), a2 + hstep, voffA);
            PG8_WAIT_L(8); PG8_BAR; PG8_WAIT_L(0); PG8_MMA(0, 0, At, B0); PG8_BAR; PG8_SCHED;
            PG8_LDB(B1, 1, 1); PG8_STAGE(PG8_SB(1, 0), b3, voffB);
            PG8_BAR; PG8_WAIT_L(0); PG8_MMA(0, 1, At, B1); PG8_BAR;
            PG8_LDA(At, 1, 1); PG8_STAGE(PG8_SA(1, 0), a3, voffA);
            PG8_BAR; PG8_WAIT_L(0); PG8_MMA(1, 0, At, B0); PG8_BAR; PG8_SCHED;
            PG8_STAGE(PG8_SB(1, 1), b3 + hstep, voffB);
            PG8_WAIT_V(6); PG8_BAR; PG8_MMA(1, 1, At, B1); PG8_BAR;
            }
        }
        if constexpr (ALIGN_EPI) { if (wr == 0) PG8_BAR; }
        if constexpr (!Epi::AFTER_DRAIN) { E(acc, cur, wr, wc, fr, fq); S.done(cur); }
        if (!has_next) break;
#pragma unroll
        for (int a = 0; a < 2; ++a)
#pragma unroll
            for (int b = 0; b < 2; ++b)
#pragma unroll
                for (int m = 0; m < 4; ++m)
#pragma unroll
                    for (int n = 0; n < 2; ++n) acc[a][b][m][n] = (f32x4){0.f, 0.f, 0.f, 0.f};
        cur = nxt; cA = nA; cB = nB; ++ui;
        if constexpr (ALIGN_EPI) { if (wr == 1) PG8_BAR; }
    }
    PG8_WAIT_V(0);
    if constexpr (!ALIGN_EPI) { if (wr == 0) PG8_BAR; }
    PG8_BAR;
    if constexpr (Epi::AFTER_DRAIN) { E.fused(acc, cur, wr, wc, fr, fq, lds, wid, lane); S.done(cur); }
#undef PG8_SA
#undef PG8_SB
#undef PG8_STAGE
#undef PG8_LDA
#undef PG8_LDB
#undef PG8_MMA
#undef PG8_WAIT_V
#undef PG8_WAIT_L
#undef PG8_BAR
#undef PG8_SCHED
}
}

#ifndef PG8_SP2
#define PG8_SP2 true
#endif
#ifndef PG8_ALIGN
#define PG8_ALIGN true
#endif

#define LAS __attribute__((address_space(3)))
using pg8::bf16_t; using pg8::f32x4; using pg8::bf16x8; using pg8::u32x4;
typedef unsigned u32x2 __attribute__((ext_vector_type(2)));
typedef float f32x2 __attribute__((ext_vector_type(2)));

constexpr int DM = 1024;
constexpr int RP = 8192, RS = 4096, R = 12288;
constexpr int SEQP = 256, SEQS = 2048, PAST = 512, KVS = PAST + SEQS;
constexpr int KVR = RP + 2 * KVS;
constexpr int NH = 8;
constexpr int INC = 5216, INP = 5376;
constexpr int DFF = 2816, UPN = 5632;
constexpr float EPS = 1e-6f;
constexpr float ATT_SCALE = 0.07216878364870322f;

enum { I_XP = 0, I_XS, I_C, I_CKV, I_CKR, I_SSD, I_CCTX, I_WADA, I_BADA, I_GATTN, I_WIN, I_GQ, I_GKV, I_WUQ, I_WUKV, I_WOMLA,
       I_CONVW, I_CONVB, I_DTB, I_ALOG, I_SSDD, I_GSSD, I_WOSSD, I_WOUT, I_GFFN, I_WUP, I_FCW, I_FCB, I_WDOWN, I_GFIN };

constexpr size_t O_Y = 0, O_CKV = (size_t)R * DM, O_KR = O_CKV + (size_t)RP * 256, O_SSD = O_KR + (size_t)RP * 64;

constexpr size_t MiB = 1u << 20;
constexpr size_t WS_CTL = 0, CTL_ZERO = 65536;
constexpr size_t WS_MOD = 64 * 1024;
constexpr size_t WS_CUP = 160 * 1024;
constexpr size_t WS_ROPE = 256 * 1024;
constexpr size_t WS_SSQ_CQ = 1 * MiB;
constexpr size_t WS_SSQ_CKV = 1 * MiB + 204800;
constexpr size_t WS_SSQ_Y = 1 * MiB + 430080;
constexpr size_t WS_SSQ2 = 1 * MiB + 1216512;
constexpr size_t WS_DT = 3 * MiB;
constexpr size_t WS_WIN = 5 * MiB;
constexpr size_t WS_WUQ = WS_WIN + (size_t)INP * 1024 * 2;
constexpr size_t WS_WUKV = WS_WUQ + 1536 * 256 * 2;
constexpr size_t WS_WOMLA = WS_WUKV + 2048 * 256 * 2;
constexpr size_t WS_WOSSD = WS_WOMLA + 2 * MiB;
constexpr size_t WS_WOUT = WS_WOSSD + 2 * MiB;
constexpr size_t WS_WUP = WS_WOUT + 2 * MiB;
constexpr size_t WS_WDOWN = WS_WUP + (size_t)UPN * 1024 * 2;
static_assert(WS_WDOWN + (size_t)1024 * DFF * 2 <= 40 * MiB, "weights");
constexpr size_t WS_CQ = 40 * MiB;
constexpr size_t WS_CKVA = 46 * MiB;
constexpr size_t WS_KROPE = 46 * MiB + (size_t)KVR * 256 * 2;
constexpr size_t WS_Z = 55 * MiB;
constexpr size_t WS_XBC = 79 * MiB;
constexpr size_t WS_H = 115 * MiB;
constexpr size_t WS_XC = 115 * MiB;
constexpr size_t WS_QN = 115 * MiB;
constexpr size_t WS_QR = 139 * MiB;
constexpr size_t WS_KV = 151 * MiB;
constexpr size_t WS_YF = 151 * MiB;
constexpr size_t WS_ST = 203 * MiB;
constexpr size_t WS_MERGED = 151 * MiB;
constexpr size_t WS_A1 = 55 * MiB;
constexpr size_t WS_U = 115 * MiB;
constexpr size_t WS_UG = 40 * MiB;
constexpr size_t WS_END = 251 * MiB;
static_assert(WS_KROPE + (size_t)KVR * 64 * 2 <= WS_Z && WS_KV + (size_t)KVR * 2048 * 2 <= WS_ST && WS_ST + (size_t)R * 1024 * 4 <= WS_END, "map");
static_assert(WS_U + (size_t)R * UPN * 2 <= WS_END && WS_UG + (size_t)R * DFF * 2 <= WS_U, "map2");

constexpr int LDS_BYTES = 147456;
constexpr int NT = 512;

struct Params { const float* in[30]; float* out; unsigned char* ws; };
#define PHASE_IDS int tid = threadIdx.x; asm volatile("" : "+v"(tid)); const int lane = tid & 63, wave = __builtin_amdgcn_readfirstlane(tid >> 6), G = gridDim.x; (void)lane; (void)wave; (void)G;

#define LDS_WAIT() asm volatile("s_waitcnt lgkmcnt(0)" ::: "memory")
__device__ __forceinline__ unsigned f2bf(float f) { unsigned u = __builtin_bit_cast(unsigned, f); return (u + 0x7fffu + ((u >> 16) & 1u)) >> 16; }
__device__ __forceinline__ float bf2f(unsigned short b) { return __builtin_bit_cast(float, (unsigned)b << 16); }
__device__ __forceinline__ unsigned pk2(float lo, float hi) { return f2bf(lo) | (f2bf(hi) << 16); }
__device__ __forceinline__ float bflo(unsigned w) { return __builtin_bit_cast(float, w << 16); }
__device__ __forceinline__ float bfhi(unsigned w) { return __builtin_bit_cast(float, w & 0xffff0000u); }
__device__ __forceinline__ float wave_sum(float v) {
#pragma unroll
    for (int o = 1; o < 64; o <<= 1) v += __shfl_xor(v, o);
    return v;
}
__device__ __forceinline__ float wave_max(float v) {
#pragma unroll
    for (int o = 1; o < 64; o <<= 1) v = fmaxf(v, __shfl_xor(v, o));
    return v;
}
__device__ __forceinline__ float siluf(float x) { return x / (1.f + __expf(-x)); }
__device__ __forceinline__ float sigm(float x) { return 1.f / (1.f + __expf(-x)); }
__device__ __forceinline__ float softplusf(float x) { return x > 20.f ? x : log1pf(__expf(x)); }
__device__ __forceinline__ int grp_of_row(int row) { return row < RP ? 0 : 1 + ((row - RP) >> 11); }
__device__ __forceinline__ int kvrow_of_row(int row) { return row < RP ? row : RP + ((row - RP) >> 11) * KVS + PAST + ((row - RP) & 2047); }
__device__ __forceinline__ const float* xrow_ptr(const Params& P, int row) { return row < RP ? P.in[I_XP] + (size_t)row * DM : P.in[I_XS] + (size_t)(row - RP) * DM; }

__device__ __forceinline__ void transpose_item(const float* W, int K, int N, bf16_t* WT, int k0, int n0, int drow0, const float* kscale, LAS float* scr, int lane) {
#pragma unroll 8
    for (int i = 0; i < 32; ++i) { const int kk = 2 * i + (lane >> 5); float w = W[(size_t)(k0 + kk) * N + n0 + (lane & 31)]; if (kscale) w *= kscale[k0 + kk]; scr[kk * 33 + (lane & 31)] = w; }
    LDS_WAIT(); asm volatile("" ::: "memory");
    const int c = lane & 7;
#pragma unroll
    for (int j = 0; j < 4; ++j) { const int n = (lane >> 3) + 8 * j; const LAS float* s = scr + (8 * c) * 33 + n;
        u32x4 o; o.x = pk2(s[0 * 33], s[1 * 33]); o.y = pk2(s[2 * 33], s[3 * 33]); o.z = pk2(s[4 * 33], s[5 * 33]); o.w = pk2(s[6 * 33], s[7 * 33]);
        *(u32x4*)(WT + (size_t)(drow0 + n) * K + k0 + 8 * c) = o; }
    LDS_WAIT(); asm volatile("" ::: "memory");
}
__device__ __forceinline__ int win_dst(int n0) {
    if (n0 < 512) return n0;
    if (n0 < 576) return 5120 + (n0 - 512);
    if (n0 < 1600) return 512 + (n0 - 576);
    if (n0 < 2624) return 1536 + (n0 - 1600);
    if (n0 < 2880) return 2560 + (n0 - 2624);
    if (n0 < 3136) return 2816 + (n0 - 2880);
    if (n0 < 3168) return 5184 + (n0 - 3136);
    if (n0 < 4192) return 3072 + (n0 - 3168);
    return 4096 + (n0 - 4192);
}
__device__ __forceinline__ int wuq_dst(int n0) { const int h = n0 / 192, d0 = n0 - h * 192; return d0 < 128 ? h * 128 + d0 : 1024 + h * 64 + (d0 - 128); }

template <int CW>
__device__ __forceinline__ void gemv3_block(const LAS float* vec  , const float* W, int N, int col0, const float* bias, float* out, int ldo, LAS float* red, int tid) {
    const int j = tid & 31, kq = tid >> 5;
    float a0 = 0.f, a1 = 0.f, a2 = 0.f;
    if (j < CW) {
        const float* wp = W + (size_t)(kq * 64) * N + col0 + j;
#pragma unroll 8
        for (int k = 0; k < 64; ++k) { const float w = wp[(size_t)k * N]; const int kk = kq * 64 + k; a0 += vec[kk] * w; a1 += vec[1024 + kk] * w; a2 += vec[2048 + kk] * w; }
    }
    red[(kq * 3 + 0) * 32 + j] = a0; red[(kq * 3 + 1) * 32 + j] = a1; red[(kq * 3 + 2) * 32 + j] = a2;
    __syncthreads();
    if (tid < 96) { const int g = tid >> 5, jj = tid & 31;
        if (jj < CW) { float s = 0.f;
#pragma unroll
            for (int q = 0; q < 16; ++q) s += red[(q * 3 + g) * 32 + jj];
            out[(size_t)g * ldo + col0 + jj] = s + (bias ? bias[col0 + jj] : 0.f); } }
    __syncthreads();
}

__device__ __forceinline__ void phase_p0(const Params& P, LAS unsigned char* lds) {
    PHASE_IDS unsigned char* ws = P.ws;
    {
        LAS float* sc = (LAS float*)lds; LAS float* red = sc + 3072;
        for (int i = tid; i < 3072; i += NT) { const int g = i >> 10, k = i & 1023; const float c = (g == 0) ? P.in[I_CCTX][k] : P.in[I_C][(g - 1) * 1024 + k]; sc[i] = siluf(c); }
        __syncthreads();
        for (int cb = blockIdx.x; cb < 256; cb += G) gemv3_block<24>(sc, P.in[I_WADA], 6144, cb * 24, P.in[I_BADA], (float*)(ws + WS_MOD), 6144, red, tid);
    }
    {
        LAS float* scr = (LAS float*)(lds + wave * 16384);
        const int gw = blockIdx.x * 8 + wave, NGW = G * 8;
        constexpr int I_IN = 16 * 163, I_UQ = 4 * 48, I_UKV = 4 * 64, I_SQ = 16 * 32, I_UP = 16 * 176, I_DN = 44 * 32;
        constexpr int NITEMS = I_IN + I_UQ + I_UKV + 3 * I_SQ + I_UP + I_DN;
        for (int it = gw; it < NITEMS; it += NGW) {
            int r = it;
            if (r < I_IN) { const int kb = r / 163, nb = r % 163; transpose_item(P.in[I_WIN], 1024, INC, (bf16_t*)(ws + WS_WIN), kb * 64, nb * 32, win_dst(nb * 32), nullptr, scr, lane); continue; } r -= I_IN;
            if (r < I_UQ) { const int kb = r / 48, nb = r % 48; transpose_item(P.in[I_WUQ], 256, 1536, (bf16_t*)(ws + WS_WUQ), kb * 64, nb * 32, wuq_dst(nb * 32), P.in[I_GQ], scr, lane); continue; } r -= I_UQ;
            if (r < I_UKV) { const int kb = r / 64, nb = r % 64; transpose_item(P.in[I_WUKV], 256, 2048, (bf16_t*)(ws + WS_WUKV), kb * 64, nb * 32, nb * 32, P.in[I_GKV], scr, lane); continue; } r -= I_UKV;
            if (r < I_SQ) { const int kb = r / 32, nb = r % 32; transpose_item(P.in[I_WOMLA], 1024, 1024, (bf16_t*)(ws + WS_WOMLA), kb * 64, nb * 32, nb * 32, nullptr, scr, lane); continue; } r -= I_SQ;
            if (r < I_SQ) { const int kb = r / 32, nb = r % 32; transpose_item(P.in[I_WOSSD], 1024, 1024, (bf16_t*)(ws + WS_WOSSD), kb * 64, nb * 32, nb * 32, P.in[I_GSSD], scr, lane); continue; } r -= I_SQ;
            if (r < I_SQ) { const int kb = r / 32, nb = r % 32; transpose_item(P.in[I_WOUT], 1024, 1024, (bf16_t*)(ws + WS_WOUT), kb * 64, nb * 32, nb * 32, nullptr, scr, lane); continue; } r -= I_SQ;
            if (r < I_UP) { const int kb = r / 176, nb = r % 176; transpose_item(P.in[I_WUP], 1024, UPN, (bf16_t*)(ws + WS_WUP), kb * 64, nb * 32, nb * 32, nullptr, scr, lane); continue; } r -= I_UP;
            { const int kb = r / 32, nb = r % 32; transpose_item(P.in[I_WDOWN], DFF, 1024, (bf16_t*)(ws + WS_WDOWN), kb * 64, nb * 32, nb * 32, nullptr, scr, lane); }
        }
    }
    {
        const int gt = blockIdx.x * NT + tid, GT = G * NT;
        for (int i = gt; i < 160 * 1024 / 8; i += GT) *(u32x4*)((bf16_t*)(ws + WS_WIN) + (size_t)5216 * 1024 + (size_t)i * 8) = (u32x4){0u, 0u, 0u, 0u};
        for (int i = gt; i < 2048 * 32; i += GT) { const int t = i >> 5, a = (i >> 4) & 1, fi = i & 15; const float pos = (float)(a ? (t & 63) : (t >> 6));
            const float inv = exp2f(-(float)fi * 0.8304820237218406f); const float ang = pos * inv;
            ((f32x2*)(ws + WS_ROPE))[i] = (f32x2){__cosf(ang), __sinf(ang)}; }
        for (int i = gt; i < 2 * PAST * 256; i += GT) { const int k = i & 255, s = (i >> 8) & 511, b = i >> 17;
            ((bf16_t*)(ws + WS_CKVA))[(size_t)(RP + b * KVS + s) * 256 + k] = (bf16_t)f2bf(P.in[I_CKV][i] / P.in[I_GKV][k]); }
        for (int i = gt; i < 2 * PAST * 64; i += GT) { const int j = i & 63, s = (i >> 6) & 511, b = i >> 15;
            ((bf16_t*)(ws + WS_KROPE))[(size_t)(RP + b * KVS + s) * 64 + j] = (bf16_t)f2bf(P.in[I_CKR][i]); }
        for (int i = gt; i < 2 * PAST; i += GT) { const int s = i & 511, b = i >> 9;
            *(f32x4*)((float*)(ws + WS_SSQ_CKV) + (size_t)(RP + b * KVS + s) * 4) = (f32x4){256.f * (1.f - EPS), 0.f, 0.f, 0.f}; }
    }
}

__device__ __forceinline__ void phase_p1(const Params& P, LAS unsigned char* lds) {
    PHASE_IDS unsigned char* ws = P.ws; const float* mod = (const float*)(ws + WS_MOD);
    {
        LAS float* sh = (LAS float*)lds; LAS float* red = sh + 3072;
        for (int i = tid; i < 3072; i += NT) { const int g = i >> 10, k = i & 1023; sh[i] = mod[g * 6144 + 3072 + k]; }
        __syncthreads();
        for (int cb = blockIdx.x; cb < 256; cb += G) gemv3_block<22>(sh, P.in[I_WUP], UPN, cb * 22, nullptr, (float*)(ws + WS_CUP), UPN, red, tid);
    }
    const int gw = blockIdx.x * 8 + wave, NGW = G * 8;
    const float* gat = P.in[I_GATTN];
    for (int row = gw; row < R; row += NGW) {
        const f32x4* xr = (const f32x4*)xrow_ptr(P, row) + lane; const int g = grp_of_row(row);
        f32x4 v[4]; float s = 0.f;
#pragma unroll
        for (int j = 0; j < 4; ++j) { v[j] = xr[64 * j]; s += (v[j].x * v[j].x + v[j].y * v[j].y) + (v[j].z * v[j].z + v[j].w * v[j].w); }
        const float rs = rsqrtf(wave_sum(s) * (1.f / DM) + EPS);
        u32x2* o8 = (u32x2*)((bf16_t*)(ws + WS_H) + (size_t)row * DM) + lane;
#pragma unroll
        for (int j = 0; j < 4; ++j) { const int c = 4 * lane + 256 * j;
            const f32x4 gg = *(const f32x4*)(gat + c), sc = *(const f32x4*)(mod + g * 6144 + 1024 + c), sh = *(const f32x4*)(mod + g * 6144 + c);
            const f32x4 h = v[j] * rs * gg * (sc + 1.f) + sh;
            o8[64 * j] = (u32x2){pk2(h.x, h.y), pk2(h.z, h.w)}; }
    }
}

typedef const f32x4 (&AccRef)[2][2][4][2];
#define EPI_ROWS(pm) _Pragma("unroll") for (int ai = 0; ai < 2; ++ai) _Pragma("unroll") for (int m = 0; m < 4; ++m) { const int row = (pm) * 256 + ai * 128 + wr * 64 + m * 16 + fr;
#define EPI_COLS _Pragma("unroll") for (int bj = 0; bj < 2; ++bj) _Pragma("unroll") for (int n = 0; n < 2; ++n) { const int col = bj * 128 + wc * 32 + n * 16 + fq * 4; const f32x4 v = acc[ai][bj][m][n];
#define EPI_END }
__device__ __forceinline__ void st_bf4(bf16_t* p, f32x4 v) { *(u32x2*)p = (u32x2){pk2(v.x, v.y), pk2(v.z, v.w)}; }
__device__ __forceinline__ f32x4 ld_bf4(const bf16_t* p) { const u32x2 w = *(const u32x2*)p; return (f32x4){bflo(w.x), bfhi(w.x), bflo(w.y), bfhi(w.y)}; }
__device__ __forceinline__ float quad_sum16(float s) { s += __shfl_xor(s, 16); s += __shfl_xor(s, 32); return s; }

struct EpiIn {
    static constexpr bool PERM = false, AFTER_DRAIN = false;
    bf16_t *cq, *ckv, *z, *xbc, *sgm, *sgs, *krope; float *ssq_cq, *ssq_ckv, *dt, *new_ckv, *new_krope; const float* dt_bias; const f32x2* rope;
    __device__ __forceinline__ void operator()(AccRef acc, const pg8::Unit& u, int wr, int wc, int fr, int fq) const {
        const int pn = u.pn;
        if (pn < 2) {
            EPI_ROWS(u.pm)
                const int orow = pn == 0 ? row : kvrow_of_row(row); bf16_t* dst = (pn == 0 ? cq : ckv) + (size_t)orow * 256; float s = 0.f;
                EPI_COLS
                    st_bf4(dst + col, v); s += (v.x * v.x + v.y * v.y) + (v.z * v.z + v.w * v.w);
                    if (pn == 1 && row < RP) *(f32x4*)(new_ckv + (size_t)row * 256 + col) = v;
                EPI_END
                s = quad_sum16(s);
                if (fq == 0) (pn == 0 ? ssq_cq : ssq_ckv)[(size_t)orow * 4 + wc] = s;
            EPI_END
        } else if (pn < 12) {
            bf16_t* base = pn < 6 ? z : xbc; const int ld = pn < 6 ? 1024 : 1536, c0 = pn < 6 ? (pn - 2) * 256 : (pn - 6) * 256;
            EPI_ROWS(u.pm)
                bf16_t* dst = base + (size_t)row * ld + c0;
                EPI_COLS st_bf4(dst + col, v); EPI_END
            EPI_END
        } else if (pn < 20) {
            bf16_t* base = pn < 16 ? sgm : sgs; const int c0 = (pn & 3) * 256;
            EPI_ROWS(u.pm)
                bf16_t* dst = base + (size_t)row * 1024 + c0;
                EPI_COLS st_bf4(dst + col, (f32x4){sigm(v.x), sigm(v.y), sigm(v.z), sigm(v.w)}); EPI_END
            EPI_END
        } else {
            if (wc < 2) {
                EPI_ROWS(u.pm)
                    const f32x4 x0 = acc[ai][0][m][0], x1 = acc[ai][0][m][1]; const int i0 = fq * 4;
                    if (row < RP) {
                        st_bf4(krope + (size_t)row * 64 + wc * 32 + i0, x0); st_bf4(krope + (size_t)row * 64 + wc * 32 + 16 + i0, x1);
                        *(f32x4*)(new_krope + (size_t)row * 64 + wc * 32 + i0) = x0; *(f32x4*)(new_krope + (size_t)row * 64 + wc * 32 + 16 + i0) = x1;
                    } else {
                        const int t = (row - RP) & 2047; const f32x2* rp = rope + t * 32 + wc * 16 + i0; f32x4 o0, o1;
#pragma unroll
                        for (int e = 0; e < 4; ++e) { const f32x2 cs = rp[e]; o0[e] = x0[e] * cs.x - x1[e] * cs.y; o1[e] = x0[e] * cs.y + x1[e] * cs.x; }
                        bf16_t* dst = krope + (size_t)kvrow_of_row(row) * 64 + wc * 32 + i0; st_bf4(dst, o0); st_bf4(dst + 16, o1);
                    }
                EPI_END
            } else if (wc == 2) {
                EPI_ROWS(u.pm)
#pragma unroll
                    for (int n = 0; n < 2; ++n) { const int j = n * 16 + fq * 4; const f32x4 v = acc[ai][0][m][n]; const f32x4 b = *(const f32x4*)(dt_bias + j);
                        *(f32x4*)(dt + (size_t)row * 32 + j) = (f32x4){softplusf(v.x + b.x), softplusf(v.y + b.y), softplusf(v.z + b.z), softplusf(v.w + b.w)}; }
                EPI_END
            }
        }
    }
};

struct EpiQ {
    static constexpr bool PERM = false, AFTER_DRAIN = false;
    bf16_t *qn, *qr; const float* ssq; const f32x2* rope;
    __device__ __forceinline__ void operator()(AccRef acc, const pg8::Unit& u, int wr, int wc, int fr, int fq) const {
        const int pn = u.pn;
        EPI_ROWS(u.pm)
            const f32x4 sq = *(const f32x4*)(ssq + (size_t)row * 4); const float rs = rsqrtf(((sq.x + sq.y) + (sq.z + sq.w)) * (1.f / 256.f) + EPS);
            if (pn < 4) {
                bf16_t* dst = qn + (size_t)row * 1024 + pn * 256;
                EPI_COLS st_bf4(dst + col, v * rs); EPI_END
            } else {
                bf16_t* dst = qr + (size_t)row * 512 + (pn - 4) * 256;
#pragma unroll
                for (int bj = 0; bj < 2; ++bj) { const int cb = bj * 128 + wc * 32, i0 = fq * 4; const f32x4 x0 = acc[ai][bj][m][0] * rs, x1 = acc[ai][bj][m][1] * rs;
                    if (row < RP) { st_bf4(dst + cb + i0, x0); st_bf4(dst + cb + 16 + i0, x1); }
                    else { const int t = (row - RP) & 2047; const f32x2* rp = rope + t * 32 + (wc & 1) * 16 + i0; f32x4 o0, o1;
#pragma unroll
                        for (int e = 0; e < 4; ++e) { const f32x2 cs = rp[e]; o0[e] = x0[e] * cs.x - x1[e] * cs.y; o1[e] = x0[e] * cs.y + x1[e] * cs.x; }
                        st_bf4(dst + cb + i0, o0); st_bf4(dst + cb + 16 + i0, o1); } }
            }
        EPI_END
    }
};
struct EpiKV {
    static constexpr bool PERM = false, AFTER_DRAIN = false;
    bf16_t* kv; const float* ssq;
    __device__ __forceinline__ void operator()(AccRef acc, const pg8::Unit& u, int wr, int wc, int fr, int fq) const {
        EPI_ROWS(u.pm)
            const f32x4 sq = *(const f32x4*)(ssq + (size_t)row * 4); const float rs = rsqrtf(((sq.x + sq.y) + (sq.z + sq.w)) * (1.f / 256.f) + EPS);
            bf16_t* dst = kv + (size_t)row * 2048 + u.pn * 256;
            EPI_COLS st_bf4(dst + col, v * rs); EPI_END
        EPI_END
    }
};
struct EpiMla {
    static constexpr bool PERM = false, AFTER_DRAIN = false;
    const bf16_t* sgm; float* t;
    __device__ __forceinline__ void operator()(AccRef acc, const pg8::Unit& u, int wr, int wc, int fr, int fq) const {
        EPI_ROWS(u.pm)
            const size_t off = (size_t)row * 1024 + u.pn * 256;
            EPI_COLS *(f32x4*)(t + off + col) = ld_bf4(sgm + off + col) * v; EPI_END
        EPI_END
    }
};
struct EpiSsd {
    static constexpr bool PERM = false, AFTER_DRAIN = false;
    const bf16_t* sgs; const float* t; const float* ssq_y; bf16_t* merged;
    __device__ __forceinline__ void operator()(AccRef acc, const pg8::Unit& u, int wr, int wc, int fr, int fq) const {
        EPI_ROWS(u.pm)
            float s = 0.f;
#pragma unroll
            for (int q = 0; q < 4; ++q) { const f32x4 a = *(const f32x4*)(ssq_y + (size_t)row * 16 + q * 4); s += (a.x + a.y) + (a.z + a.w); }
            const float rs = rsqrtf(s * (1.f / 1024.f) + EPS); const size_t off = (size_t)row * 1024 + u.pn * 256;
            EPI_COLS st_bf4(merged + off + col, *(const f32x4*)(t + off + col) + ld_bf4(sgs + off + col) * (v * rs)); EPI_END
        EPI_END
    }
};
struct EpiOut {
    static constexpr bool PERM = false, AFTER_DRAIN = false;
    const float *xp, *xs, *mod, *gffn; float* x1; bf16_t* a1; float* ssq2;
    __device__ __forceinline__ void operator()(AccRef acc, const pg8::Unit& u, int wr, int wc, int fr, int fq) const {
        const int g = u.pm < 32 ? 0 : 1 + ((u.pm - 32) >> 3); const float* md = mod + g * 6144;
        EPI_ROWS(u.pm)
            const float* xr = row < RP ? xp + (size_t)row * DM : xs + (size_t)(row - RP) * DM; const size_t off = (size_t)row * 1024; float s = 0.f;
            EPI_COLS
                const int c = u.pn * 256 + col; const f32x4 x1v = *(const f32x4*)(xr + c) + *(const f32x4*)(md + 2048 + c) * v;
                *(f32x4*)(x1 + off + c) = x1v; s += (x1v.x * x1v.x + x1v.y * x1v.y) + (x1v.z * x1v.z + x1v.w * x1v.w);
                st_bf4(a1 + off + c, x1v * *(const f32x4*)(gffn + c) * (*(const f32x4*)(md + 4096 + c) + 1.f));
            EPI_END
            s = quad_sum16(s);
            if (fq == 0) ssq2[(size_t)row * 16 + u.pn * 4 + wc] = s;
        EPI_END
    }
};
struct EpiUp {
    static constexpr bool PERM = false, AFTER_DRAIN = false;
    const float *ssq2, *cup; bf16_t* uo;
    __device__ __forceinline__ void operator()(AccRef acc, const pg8::Unit& u, int wr, int wc, int fr, int fq) const {
        const int g = u.pm < 32 ? 0 : 1 + ((u.pm - 32) >> 3); const float* cu = cup + g * UPN + u.pn * 256;
        EPI_ROWS(u.pm)
            float s = 0.f;
#pragma unroll
            for (int q = 0; q < 4; ++q) { const f32x4 a = *(const f32x4*)(ssq2 + (size_t)row * 16 + q * 4); s += (a.x + a.y) + (a.z + a.w); }
            const float rs = rsqrtf(s * (1.f / 1024.f) + EPS); bf16_t* dst = uo + (size_t)row * UPN + u.pn * 256;
            EPI_COLS st_bf4(dst + col, v * rs + *(const f32x4*)(cu + col)); EPI_END
        EPI_END
    }
};
struct EpiDown {
    static constexpr bool PERM = false, AFTER_DRAIN = false;
    const float* mod; float* x;
    __device__ __forceinline__ void operator()(AccRef acc, const pg8::Unit& u, int wr, int wc, int fr, int fq) const {
        const int g = u.pm < 32 ? 0 : 1 + ((u.pm - 32) >> 3); const float* g2 = mod + g * 6144 + 5120 + u.pn * 256;
        EPI_ROWS(u.pm)
            float* xr = x + (size_t)row * 1024 + u.pn * 256;
            EPI_COLS *(f32x4*)(xr + col) = *(const f32x4*)(xr + col) + *(const f32x4*)(g2 + col) * v; EPI_END
        EPI_END
    }
};

template <class Epi>
__device__ __forceinline__ void run_gemm(LAS unsigned char* lds, const bf16_t* A, const bf16_t* Bt, int M, int N, int K, int G, int c, const Epi& E) {
    pg8::Gemm g{A, Bt, M, N, K}; pg8::StaticOrder S; S.init(M, N, G, c);
    pg8::gemm_phase<Epi, pg8::StaticOrder, PG8_ALIGN, PG8_SP2>(lds, g, S, E);
}

__device__ __forceinline__ void phase_conv(const Params& P) {
    PHASE_IDS unsigned char* ws = P.ws; const bf16_t* xbc = (const bf16_t*)(ws + WS_XBC); bf16_t* xc = (bf16_t*)(ws + WS_XC);
    const float* cw = P.in[I_CONVW]; const float* cb = P.in[I_CONVB];
    const int gt = blockIdx.x * NT + tid, GT = G * NT;
    for (int i = gt; i < R * (1536 / 4); i += GT) {
        const int row = i / 384, c = (i % 384) * 4; const int t = row < RP ? (row & 255) : ((row - RP) & 2047), L = row < RP ? SEQP : SEQS;
        f32x4 a = *(const f32x4*)(cb + c);
        if (t > 0) a += ld_bf4(xbc + (size_t)(row - 1) * 1536 + c) * *(const f32x4*)(cw + c);
        a += ld_bf4(xbc + (size_t)row * 1536 + c) * *(const f32x4*)(cw + 1536 + c);
        if (t < L - 1) a += ld_bf4(xbc + (size_t)(row + 1) * 1536 + c) * *(const f32x4*)(cw + 3072 + c);
        st_bf4(xc + (size_t)row * 1536 + c, (f32x4){siluf(a.x), siluf(a.y), siluf(a.z), siluf(a.w)});
    }
    const int gw = blockIdx.x * 8 + wave, NGW = G * 8;
    float* nck = P.out + O_CKV; const float* ssq = (const float*)(ws + WS_SSQ_CKV); const float* gk = P.in[I_GKV];
    for (int row = gw; row < RP; row += NGW) {
        const f32x4 sq = *(const f32x4*)(ssq + (size_t)row * 4); const float rs = rsqrtf(((sq.x + sq.y) + (sq.z + sq.w)) * (1.f / 256.f) + EPS);
        f32x4* p = (f32x4*)(nck + (size_t)row * 256) + lane; *p = *p * rs * *(const f32x4*)(gk + 4 * lane);
    }
}
__device__ __forceinline__ void phase_ssd_naive(const Params& P) {
    PHASE_IDS unsigned char* ws = P.ws; const bf16_t* xc = (const bf16_t*)(ws + WS_XC); const float* dt = (const float*)(ws + WS_DT);
    const int gw = blockIdx.x * 8 + wave, NGW = G * 8;
    for (int task = gw; task < 64 + 1024; task += NGW) {
        int b, dir, h, L, row0; bool smp = task < 64;
        if (smp) { b = task >> 5; dir = (task >> 4) & 1; h = task & 15; L = SEQS; row0 = RP + b * SEQS; }
        else { const int q = task - 64; b = q >> 5; dir = (q >> 4) & 1; h = q & 15; L = SEQP; row0 = b * SEQP; }
        const float A = -__expf(P.in[I_ALOG][dir * 16 + h]); const int g = h >> 2;
        float hs[64];
#pragma unroll
        for (int n = 0; n < 64; ++n) hs[n] = smp ? P.in[I_SSD][((((size_t)b * 2 + dir) * 16 + h) * 64 + lane) * 64 + n] : 0.f;
        float* yo = (float*)(ws + (dir ? WS_ST : WS_YF));
        for (int step = 0; step < L; ++step) {
            const int row = row0 + (dir ? L - 1 - step : step);
            const float dtv = dt[(size_t)row * 32 + dir * 16 + h]; const float a = __expf(dtv * A);
            const float xd = bf2f(xc[(size_t)row * 1536 + h * 64 + lane]) * dtv;
            const u32x4* Bp = (const u32x4*)(xc + (size_t)row * 1536 + 1024 + g * 64); const u32x4* Cp = (const u32x4*)(xc + (size_t)row * 1536 + 1280 + g * 64);
            float y = 0.f;
#pragma unroll
            for (int q = 0; q < 8; ++q) { const u32x4 bw = Bp[q], cw = Cp[q];
#pragma unroll
                for (int e = 0; e < 4; ++e) { const int n = q * 8 + e * 2;
                    hs[n] = hs[n] * a + xd * bflo(bw[e]); y += bflo(cw[e]) * hs[n];
                    hs[n + 1] = hs[n + 1] * a + xd * bfhi(bw[e]); y += bfhi(cw[e]) * hs[n + 1]; } }
            yo[(size_t)row * 1024 + h * 64 + lane] = y;
        }
        if (!smp) { float* so = P.out + O_SSD + ((((size_t)b * 2 + dir) * 16 + h) * 64 + lane) * 64;
#pragma unroll
            for (int n = 0; n < 64; n += 4) *(f32x4*)(so + n) = (f32x4){hs[n], hs[n + 1], hs[n + 2], hs[n + 3]}; }
    }
}
__device__ __forceinline__ void phase_gate(const Params& P) {
    PHASE_IDS unsigned char* ws = P.ws; const float* yf = (const float*)(ws + WS_YF); const float* yb = (const float*)(ws + WS_ST);
    const bf16_t* xc = (const bf16_t*)(ws + WS_XC); bf16_t* z = (bf16_t*)(ws + WS_Z); float* ssq = (float*)(ws + WS_SSQ_Y);
    const int gw = blockIdx.x * 8 + wave, NGW = G * 8;
    for (int row = gw; row < R; row += NGW) {
#pragma unroll
        for (int j = 0; j < 4; ++j) { const int c = 4 * lane + 256 * j, h = c >> 6; const float Dh = P.in[I_SSDD][h];
            const f32x4 zz = ld_bf4(z + (size_t)row * 1024 + c), xx = ld_bf4(xc + (size_t)row * 1536 + c);
            f32x4 v = *(const f32x4*)(yf + (size_t)row * 1024 + c) + *(const f32x4*)(yb + (size_t)row * 1024 + c) + xx * Dh;
            v = v * (f32x4){siluf(zz.x), siluf(zz.y), siluf(zz.z), siluf(zz.w)};
            float s = (v.x * v.x + v.y * v.y) + (v.z * v.z + v.w * v.w);
            s += __shfl_xor(s, 1); s += __shfl_xor(s, 2); s += __shfl_xor(s, 4); s += __shfl_xor(s, 8);
            st_bf4(z + (size_t)row * 1024 + c, v);
            if ((lane & 15) == 0) ssq[(size_t)row * 16 + h] = s; }
    }
}
__device__ __forceinline__ void phase_attn_naive(const Params& P, LAS unsigned char* lds) {
    PHASE_IDS unsigned char* ws = P.ws; bf16_t* qn = (bf16_t*)(ws + WS_QN); const bf16_t* qr = (const bf16_t*)(ws + WS_QR);
    const bf16_t* kv = (const bf16_t*)(ws + WS_KV); const bf16_t* kr = (const bf16_t*)(ws + WS_KROPE);
    LAS float* qs = (LAS float*)lds + wave * 192;
    const int gw = blockIdx.x * 8 + wave, NGW = G * 8;
    for (int task = gw; task < R * NH; task += NGW) {
        const int rr = task >> 3, h = task & 7; const int row = rr < RS ? RP + rr : rr - RS;
        int kv0, nk; if (row < RP) { kv0 = (row >> 8) * SEQP; nk = SEQP; } else { kv0 = RP + ((row - RP) >> 11) * KVS; nk = KVS; }
        qs[lane] = bf2f(qn[(size_t)row * 1024 + h * 128 + lane]); qs[64 + lane] = bf2f(qn[(size_t)row * 1024 + h * 128 + 64 + lane]);
        qs[128 + lane] = bf2f(qr[(size_t)row * 512 + h * 64 + lane]);
        LDS_WAIT(); asm volatile("" ::: "memory");
        float m = -1e30f, l = 0.f, o0 = 0.f, o1 = 0.f;
        for (int k0 = 0; k0 < nk; k0 += 64) {
            const size_t krow = (size_t)(kv0 + k0 + lane);
            const u32x4* kp = (const u32x4*)(kv + krow * 2048 + h * 256); const u32x4* rp = (const u32x4*)(kr + krow * 64);
            float s = 0.f;
#pragma unroll 4
            for (int q = 0; q < 16; ++q) { const u32x4 w = kp[q];
#pragma unroll
                for (int e = 0; e < 4; ++e) s += qs[q * 8 + e * 2] * bflo(w[e]) + qs[q * 8 + e * 2 + 1] * bfhi(w[e]); }
#pragma unroll 4
            for (int q = 0; q < 8; ++q) { const u32x4 w = rp[q];
#pragma unroll
                for (int e = 0; e < 4; ++e) s += qs[128 + q * 8 + e * 2] * bflo(w[e]) + qs[128 + q * 8 + e * 2 + 1] * bfhi(w[e]); }
            s *= ATT_SCALE;
            const float mn = fmaxf(m, wave_max(s)); const float p = __expf(s - mn), al = __expf(m - mn);
            l = l * al + wave_sum(p); o0 *= al; o1 *= al; m = mn;
            const bf16_t* vp = kv + (size_t)(kv0 + k0) * 2048 + h * 256 + 128;
#pragma unroll 8
            for (int j = 0; j < 64; ++j) { const float pj = __shfl(p, j); o0 += pj * bf2f(vp[(size_t)j * 2048 + lane]); o1 += pj * bf2f(vp[(size_t)j * 2048 + 64 + lane]); }
        }
        const float il = 1.f / l;
        qn[(size_t)row * 1024 + h * 128 + lane] = (bf16_t)f2bf(o0 * il); qn[(size_t)row * 1024 + h * 128 + 64 + lane] = (bf16_t)f2bf(o1 * il);
        asm volatile("" ::: "memory");
    }
}
namespace att {
using s16x4 = __attribute__((ext_vector_type(4))) short;
using f32x16 = __attribute__((ext_vector_type(16))) float;
constexpr int QBLK = 32, KVBLK = 64;
constexpr float SCALE = ATT_SCALE, THR = 8.f;
constexpr int SHM_V = 16384, SHM_K = 16384, SHM_KR = 8192;
constexpr int L_V = 0, L_K = 2 * SHM_V, L_KR = L_K + 2 * SHM_K, L_WS = L_KR + 2 * SHM_KR, L_QR = L_WS + 8 * 64 * 4, L_END = L_QR + 8 * 4096;
#define KSWZ(row, colB) ((row) * 256 + ((colB) ^ (((row) & 7) << 4)))
#define KRSWZ(row, colB) ((row) * 128 + ((colB) ^ ((((row) >> 1) & 7) << 4)))
#define SBAR() __builtin_amdgcn_sched_barrier(0)
__device__ __forceinline__ int crow(int r, int hi) { return (r & 3) + 8 * (r >> 2) + 4 * hi; }
__device__ __forceinline__ unsigned cvtpk(float lo, float hi) { unsigned r; asm volatile("v_cvt_pk_bf16_f32 %0, %1, %2" : "=v"(r) : "v"(lo), "v"(hi)); return r; }
__device__ __forceinline__ void partialSM(f32x16& p0, f32x16& p1, float& m_reg, float& mn, float& alpha) {
  constexpr float C = SCALE * 1.4426950408889634f;
  float pmax = p0[0];
#pragma unroll
  for (int r = 1; r < 16; ++r) pmax = fmaxf(pmax, p0[r]);
#pragma unroll
  for (int r = 0; r < 16; ++r) pmax = fmaxf(pmax, p1[r]);
  { auto rr = __builtin_amdgcn_permlane32_swap(__float_as_uint(pmax), __float_as_uint(pmax), false, false);
    pmax = fmaxf(__uint_as_float(rr[0]), __uint_as_float(rr[1])); }
  if (__builtin_expect(__all(pmax - m_reg <= THR / SCALE), 1)) { mn = m_reg; alpha = 1.f; }
  else { mn = fmaxf(m_reg, pmax); alpha = __builtin_amdgcn_exp2f((m_reg - mn) * C); m_reg = mn; }
  float mnC = -mn * C;
#pragma unroll
  for (int r = 0; r < 16; ++r) p0[r] = fmaf(p0[r], C, mnC);
#pragma unroll
  for (int r = 0; r < 16; ++r) p1[r] = fmaf(p1[r], C, mnC);
#pragma unroll
  for (int r = 0; r < 16; ++r) p0[r] = __builtin_amdgcn_exp2f(p0[r]);
}
__device__ __forceinline__ void finishSM(f32x16& p0, f32x16& p1, float alpha, float& l_reg, bf16x8& pa0, bf16x8& pa1, bf16x8& pa2, bf16x8& pa3) {
#pragma unroll
  for (int r = 0; r < 16; ++r) p1[r] = __builtin_amdgcn_exp2f(p1[r]);
  float ps = 0;
#pragma unroll
  for (int r = 0; r < 16; ++r) ps += p0[r];
#pragma unroll
  for (int r = 0; r < 16; ++r) ps += p1[r];
  { auto rr = __builtin_amdgcn_permlane32_swap(__float_as_uint(ps), __float_as_uint(ps), false, false);
    ps = __uint_as_float(rr[0]) + __uint_as_float(rr[1]); }
  l_reg = l_reg * alpha + ps;
#define PK4(P, BASE, OUT) do { unsigned a0 = cvtpk(P[BASE + 0], P[BASE + 1]), a1 = cvtpk(P[BASE + 2], P[BASE + 3]);   \
    unsigned b0 = cvtpk(P[BASE + 4], P[BASE + 5]), b1 = cvtpk(P[BASE + 6], P[BASE + 7]);                              \
    auto r0 = __builtin_amdgcn_permlane32_swap(a0, b0, false, false); auto r1 = __builtin_amdgcn_permlane32_swap(a1, b1, false, false); \
    u32x4 w = {r0[0], r1[0], r0[1], r1[1]}; OUT = *reinterpret_cast<bf16x8*>(&w); } while (0)
  PK4(p0, 0, pa0); PK4(p0, 8, pa1); PK4(p1, 0, pa2); PK4(p1, 8, pa3);
#undef PK4
}
__device__ __forceinline__ void qkt(f32x16& p0, f32x16& p1, const LAS char* Ks, const LAS char* Krs, const bf16x8* qr, const LAS char* qrl, int r32, int hi) {
  p0 = f32x16{}; p1 = f32x16{};
#pragma unroll
  for (int d0 = 0; d0 < 8; ++d0) { const int cb = (d0 * 16 + hi * 8) * 2;
    const bf16x8 b0 = *reinterpret_cast<const LAS bf16x8*>(Ks + KSWZ(r32, cb));
    const bf16x8 b1 = *reinterpret_cast<const LAS bf16x8*>(Ks + KSWZ(32 + r32, cb));
    p0 = __builtin_amdgcn_mfma_f32_32x32x16_bf16(b0, qr[d0], p0, 0, 0, 0);
    p1 = __builtin_amdgcn_mfma_f32_32x32x16_bf16(b1, qr[d0], p1, 0, 0, 0); }
#pragma unroll
  for (int d0 = 0; d0 < 4; ++d0) { const int cb = (d0 * 16 + hi * 8) * 2;
    const bf16x8 b0 = *reinterpret_cast<const LAS bf16x8*>(Krs + KRSWZ(r32, cb));
    const bf16x8 b1 = *reinterpret_cast<const LAS bf16x8*>(Krs + KRSWZ(32 + r32, cb));
    const bf16x8 qq = *reinterpret_cast<const LAS bf16x8*>(qrl + d0 * 1024);
    p0 = __builtin_amdgcn_mfma_f32_32x32x16_bf16(b0, qq, p0, 0, 0, 0);
    p1 = __builtin_amdgcn_mfma_f32_32x32x16_bf16(b1, qq, p1, 0, 0, 0); }
}
__device__ __forceinline__ int v_st(int k, int c) { const int kk = (k & ~0xC) | ((k & 4) << 1) | ((k & 8) >> 1); return ((kk >> 3) * 4 + (c >> 5)) * 512 + ((kk & 7) * 32 + (c & 31)) * 2; }
__device__ __forceinline__ int v_rd_base(int lane) { return ((lane & 3) << 3) | (((lane >> 2) & 3) << 6) | (((lane >> 4) & 1) << 5) | (((lane >> 5) & 1) << 8); }
constexpr int v_rd_off(int d0, int ks, int half) { return d0 * 512 + ks * 4096 + half * 2048; }
template <int OFF> __device__ __forceinline__ s16x4 tr_read(int vb) {
  s16x4 r; asm volatile("ds_read_b64_tr_b16 %0, %1 offset:%2" : "=&v"(r) : "v"(vb), "i"(OFF) : "memory"); return r;
}
template <int D0> __device__ __forceinline__ void pv_one(f32x16& od, int vb, bf16x8 pa0, bf16x8 pa1, bf16x8 pa2, bf16x8 pa3) {
  const s16x4 l0 = tr_read<v_rd_off(D0, 0, 0)>(vb), h0 = tr_read<v_rd_off(D0, 0, 1)>(vb), l1 = tr_read<v_rd_off(D0, 1, 0)>(vb), h1 = tr_read<v_rd_off(D0, 1, 1)>(vb);
  const s16x4 l2 = tr_read<v_rd_off(D0, 2, 0)>(vb), h2 = tr_read<v_rd_off(D0, 2, 1)>(vb), l3 = tr_read<v_rd_off(D0, 3, 0)>(vb), h3 = tr_read<v_rd_off(D0, 3, 1)>(vb);
  asm volatile("s_waitcnt lgkmcnt(0)" ::: "memory"); SBAR();
#define PK(L, H) (bf16x8){L[0], L[1], L[2], L[3], H[0], H[1], H[2], H[3]}
  od = __builtin_amdgcn_mfma_f32_32x32x16_bf16(pa0, PK(l0, h0), od, 0, 0, 0);
  od = __builtin_amdgcn_mfma_f32_32x32x16_bf16(pa1, PK(l1, h1), od, 0, 0, 0);
  od = __builtin_amdgcn_mfma_f32_32x32x16_bf16(pa2, PK(l2, h2), od, 0, 0, 0);
  od = __builtin_amdgcn_mfma_f32_32x32x16_bf16(pa3, PK(l3, h3), od, 0, 0, 0);
#undef PK
}
__device__ __forceinline__ void pv_d0(f32x16* o, int vb, bf16x8 pa0, bf16x8 pa1, bf16x8 pa2, bf16x8 pa3) {
  pv_one<0>(o[0], vb, pa0, pa1, pa2, pa3); pv_one<1>(o[1], vb, pa0, pa1, pa2, pa3); pv_one<2>(o[2], vb, pa0, pa1, pa2, pa3); pv_one<3>(o[3], vb, pa0, pa1, pa2, pa3);
}
__device__ __forceinline__ void attn_unit(const bf16_t* __restrict__ Qn, const bf16_t* __restrict__ Qr, const bf16_t* __restrict__ Kh, const bf16_t* __restrict__ Vh,
                                          const bf16_t* __restrict__ Krh, bf16_t* Ob, int seq, LAS char* lds, int tid) {
  constexpr int LDQ = 1024, LDQR = 512, LDK = 2048, LDKR = 64, LDO = 1024;
  const int wid = tid >> 6, lane = tid & 63, r32 = lane & 31, hi = lane >> 5;
  LAS char* V_lds = lds + L_V; LAS char* K_lds = lds + L_K; LAS char* KR_lds = lds + L_KR;
  LAS float* wsf = (LAS float*)(lds + L_WS) + wid * 64; LAS float* li_l = wsf; LAS float* al_l = wsf + 32;
  float m_reg = -1e30f, l_reg = 0; f32x16 o[4] = {}; bf16x8 qr[8];
  LAS char* qrl = lds + L_QR + wid * 4096 + lane * 16;
  { const unsigned qo = (unsigned)((wid * QBLK + r32) * LDQ + hi * 8);
#pragma unroll
    for (int d0 = 0; d0 < 8; ++d0) qr[d0] = *reinterpret_cast<const bf16x8*>(Qn + (qo + d0 * 16));
    const unsigned qo2 = (unsigned)((wid * QBLK + r32) * LDQR + hi * 8);
#pragma unroll
    for (int d0 = 0; d0 < 4; ++d0) *reinterpret_cast<LAS bf16x8*>(qrl + d0 * 1024) = *reinterpret_cast<const bf16x8*>(Qr + (qo2 + d0 * 16)); }
  const int sr = tid >> 4, sc = (tid & 15) * 8, vst0 = v_st(sr, sc), vst1 = v_st(32 + sr, sc);
  const int rr_ = tid >> 3, rc_ = (tid & 7) * 8, krst = KRSWZ(rr_, rc_ * 2);
  const int vb0 = (int)(unsigned)(uintptr_t)V_lds + v_rd_base(lane);
  constexpr int SDEPTH = 1;
  struct { bf16x8 vs0, vs1, ks0, ks1, kr; } sr_[SDEPTH];
  const unsigned kvo = (unsigned)(sr * LDK + sc), kro = (unsigned)(rr_ * LDKR + rc_);
#define SLOAD(i, k0) do { const bf16_t* vp_ = Vh + (size_t)(k0) * LDK; const bf16_t* kp_ = Kh + (size_t)(k0) * LDK; const bf16_t* rp_ = Krh + (size_t)(k0) * LDKR; \
    sr_[i].vs0 = *reinterpret_cast<const bf16x8*>(vp_ + kvo); sr_[i].vs1 = *reinterpret_cast<const bf16x8*>(vp_ + (kvo + 32u * LDK)); \
    sr_[i].ks0 = *reinterpret_cast<const bf16x8*>(kp_ + kvo); sr_[i].ks1 = *reinterpret_cast<const bf16x8*>(kp_ + (kvo + 32u * LDK)); \
    sr_[i].kr = *reinterpret_cast<const bf16x8*>(rp_ + kro); } while (0)
#define SWRITE(b, i) do { *(LAS bf16x8*)(V_lds + (b) * SHM_V + vst0) = sr_[i].vs0; *(LAS bf16x8*)(V_lds + (b) * SHM_V + vst1) = sr_[i].vs1; const int kc = sc * 2; \
    *(LAS bf16x8*)(K_lds + (b) * SHM_K + KSWZ(sr, kc)) = sr_[i].ks0; *(LAS bf16x8*)(K_lds + (b) * SHM_K + KSWZ(32 + sr, kc)) = sr_[i].ks1; \
    *(LAS bf16x8*)(KR_lds + (b) * SHM_KR + krst) = sr_[i].kr; } while (0)
#define SWAIT() do { if constexpr (SDEPTH == 2) asm volatile("s_waitcnt vmcnt(5)" ::: "memory"); else asm volatile("s_waitcnt vmcnt(0)" ::: "memory"); } while (0)
#define RESC(a) do { if (__any((a) < 1.f)) { if (hi == 0) al_l[r32] = (a); asm volatile("s_waitcnt lgkmcnt(0)" ::: "memory"); \
    _Pragma("unroll") for (int d = 0; d < 4; ++d) _Pragma("unroll") for (int r = 0; r < 16; ++r) o[d][r] *= al_l[crow(r, hi)]; } } while (0)
  f32x16 pA0, pA1, pB0, pB1; float mnA, mnB, alA, alB; bf16x8 pa0, pa1, pa2, pa3; const int NTL = seq / KVBLK;
  constexpr int SE = 0, SO = SDEPTH - 1;
  SLOAD(SE, 0); asm volatile("s_waitcnt vmcnt(0)" ::: "memory"); SWRITE(0, SE); __syncthreads();
  qkt(pA0, pA1, K_lds, KR_lds, qr, qrl, r32, hi); partialSM(pA0, pA1, m_reg, mnA, alA);
  SLOAD(SO, KVBLK); if constexpr (SDEPTH == 2) { if (2 < NTL) SLOAD(SE, 2 * KVBLK); }
  SWAIT(); SWRITE(1, SO); __syncthreads();
  for (int j = 1; j + 1 < NTL; j += 2) {
    SBAR(); qkt(pB0, pB1, K_lds + SHM_K, KR_lds + SHM_KR, qr, qrl, r32, hi);
    finishSM(pA0, pA1, alA, l_reg, pa0, pa1, pa2, pa3); SBAR();
    SLOAD(SO, (j + SDEPTH) * KVBLK); SBAR();
    pv_d0(o, vb0, pa0, pa1, pa2, pa3); partialSM(pB0, pB1, m_reg, mnB, alB);
    __syncthreads(); SWAIT(); SWRITE(0, SE);
    RESC(alB); __syncthreads();
    SBAR(); qkt(pA0, pA1, K_lds, KR_lds, qr, qrl, r32, hi);
    finishSM(pB0, pB1, alB, l_reg, pa0, pa1, pa2, pa3); SBAR();
    if (SDEPTH == 1 || j + 3 < NTL) SLOAD(SE, (j + 1 + SDEPTH) * KVBLK); SBAR();
    pv_d0(o, vb0 + SHM_V, pa0, pa1, pa2, pa3); partialSM(pA0, pA1, m_reg, mnA, alA);
    __syncthreads(); SWAIT(); SWRITE(1, SO);
    RESC(alA); __syncthreads();
  }
  SBAR(); qkt(pB0, pB1, K_lds + SHM_K, KR_lds + SHM_KR, qr, qrl, r32, hi);
  finishSM(pA0, pA1, alA, l_reg, pa0, pa1, pa2, pa3); SBAR();
  pv_d0(o, vb0, pa0, pa1, pa2, pa3); partialSM(pB0, pB1, m_reg, mnB, alB);
  __syncthreads(); RESC(alB);
  finishSM(pB0, pB1, alB, l_reg, pa0, pa1, pa2, pa3); SBAR();
  pv_d0(o, vb0 + SHM_V, pa0, pa1, pa2, pa3);
  if (hi == 0) li_l[r32] = l_reg; asm volatile("s_waitcnt lgkmcnt(0)" ::: "memory");
  float rli[16];
#pragma unroll
  for (int r = 0; r < 16; ++r) rli[r] = __builtin_amdgcn_rcpf(li_l[crow(r, hi)]);
#pragma unroll
  for (int r = 0; r < 16; ++r) { const unsigned oo = (unsigned)((wid * QBLK + crow(r, hi)) * LDO + r32);
#pragma unroll
    for (int d0 = 0; d0 < 4; ++d0) Ob[oo + d0 * 32] = (bf16_t)f2bf(o[d0][r] * rli[r]); }
  __syncthreads();
#undef SLOAD
#undef SWRITE
#undef SWAIT
#undef RESC
}
}

__device__ __forceinline__ void phase_attn(const Params& P, LAS unsigned char* lds) {
    PHASE_IDS unsigned char* ws = P.ws; bf16_t* qn = (bf16_t*)(ws + WS_QN); const bf16_t* qr = (const bf16_t*)(ws + WS_QR);
    const bf16_t* kv = (const bf16_t*)(ws + WS_KV); const bf16_t* kr = (const bf16_t*)(ws + WS_KROPE);
    for (int u = blockIdx.x; u < 384; u += G) {
        int row0, kv0, h, seq;
        if (u < 128) { const int x = u & 7, k = u >> 3, bh = x + 8 * (k >> 3), qb = k & 7, b = bh >> 3; h = bh & 7; row0 = RP + b * SEQS + qb * 256; kv0 = RP + b * KVS; seq = KVS; }
        else { const int q = u - 128, b = q >> 3; h = q & 7; row0 = b * SEQP; kv0 = row0; seq = SEQP; }
        int t2 = tid; asm volatile("" : "+v"(t2));
        att::attn_unit(qn + (size_t)row0 * 1024 + h * 128, qr + (size_t)row0 * 512 + h * 64, kv + (size_t)kv0 * 2048 + h * 256, kv + (size_t)kv0 * 2048 + h * 256 + 128,
                       kr + (size_t)kv0 * 64, qn + (size_t)row0 * 1024 + h * 128, seq, (LAS char*)lds, t2);
    }
}
__device__ __forceinline__ f32x4 conv3_at(const bf16_t* u, int row, int t, int L, int c, const float* fw, const float* fb) {
    f32x4 a = *(const f32x4*)(fb + c);
    if (t > 0) a += ld_bf4(u + (size_t)(row - 1) * UPN + c) * *(const f32x4*)(fw + c);
    a += ld_bf4(u + (size_t)row * UPN + c) * *(const f32x4*)(fw + UPN + c);
    if (t < L - 1) a += ld_bf4(u + (size_t)(row + 1) * UPN + c) * *(const f32x4*)(fw + 2 * UPN + c);
    return a;
}
__device__ __forceinline__ void phase_convgate(const Params& P) {
    PHASE_IDS unsigned char* ws = P.ws; const bf16_t* u = (const bf16_t*)(ws + WS_U); bf16_t* ug = (bf16_t*)(ws + WS_UG);
    const float* fw = P.in[I_FCW]; const float* fb = P.in[I_FCB];
    const int gt = blockIdx.x * NT + tid, GT = G * NT;
    for (int i = gt; i < R * (DFF / 4); i += GT) {
        const int row = i / (DFF / 4), c = (i % (DFF / 4)) * 4; const int t = row < RP ? (row & 255) : ((row - RP) & 2047), L = row < RP ? SEQP : SEQS;
        const f32x4 a = conv3_at(u, row, t, L, c, fw, fb), b = conv3_at(u, row, t, L, DFF + c, fw, fb);
        st_bf4(ug + (size_t)row * DFF + c, (f32x4){siluf(a.x), siluf(a.y), siluf(a.z), siluf(a.w)} * b);
    }
}
__device__ __forceinline__ void phase_final(const Params& P) {
    PHASE_IDS const int gw = blockIdx.x * 8 + wave, NGW = G * 8; const float* gf = P.in[I_GFIN];
    for (int row = gw; row < R; row += NGW) {
        f32x4* xr = (f32x4*)(P.out + (size_t)row * DM) + lane; f32x4 v[4]; float s = 0.f;
#pragma unroll
        for (int j = 0; j < 4; ++j) { v[j] = xr[64 * j]; s += (v[j].x * v[j].x + v[j].y * v[j].y) + (v[j].z * v[j].z + v[j].w * v[j].w); }
        const float rs = rsqrtf(wave_sum(s) * (1.f / DM) + EPS);
#pragma unroll
        for (int j = 0; j < 4; ++j) xr[64 * j] = v[j] * rs * *(const f32x4*)(gf + 4 * lane + 256 * j);
    }
}

__global__ void __launch_bounds__(NT, 2) mega_fwd(Params P) {
    extern __shared__ __attribute__((aligned(16))) unsigned char lds_raw[];
    LAS unsigned char* lds = (LAS unsigned char*)lds_raw;
    cg::grid_group grid = cg::this_grid();
    const int G = gridDim.x, bx = blockIdx.x;
    unsigned char* ws = P.ws;
#define GSYNC() grid.sync()

#ifdef ONLY_ATT
    phase_attn(P, lds);
    return;
#endif
    phase_p0(P, lds);
    GSYNC();
    phase_p1(P, lds);
    GSYNC();
    {
        EpiIn E{(bf16_t*)(ws + WS_CQ), (bf16_t*)(ws + WS_CKVA), (bf16_t*)(ws + WS_Z), (bf16_t*)(ws + WS_XBC), (bf16_t*)P.out, (bf16_t*)P.out + (size_t)R * 1024, (bf16_t*)(ws + WS_KROPE),
                (float*)(ws + WS_SSQ_CQ), (float*)(ws + WS_SSQ_CKV), (float*)(ws + WS_DT), P.out + O_CKV, P.out + O_KR, P.in[I_DTB], (const f32x2*)(ws + WS_ROPE)};
        run_gemm(lds, (const bf16_t*)(ws + WS_H), (const bf16_t*)(ws + WS_WIN), R, INP, 1024, G, bx, E);
    }
    GSYNC();
    phase_conv(P);
    GSYNC();
    phase_ssd_naive(P);
    GSYNC();
    phase_gate(P);
    GSYNC();
    {
        EpiQ EQ{(bf16_t*)(ws + WS_QN), (bf16_t*)(ws + WS_QR), (const float*)(ws + WS_SSQ_CQ), (const f32x2*)(ws + WS_ROPE)};
        run_gemm(lds, (const bf16_t*)(ws + WS_CQ), (const bf16_t*)(ws + WS_WUQ), R, 1536, 256, G, bx, EQ);
        EpiKV EK{(bf16_t*)(ws + WS_KV), (const float*)(ws + WS_SSQ_CKV)};
        run_gemm(lds, (const bf16_t*)(ws + WS_CKVA), (const bf16_t*)(ws + WS_WUKV), KVR, 2048, 256, G, (bx + 224) % G, EK);
    }
    GSYNC();
    phase_attn(P, lds);
    GSYNC();
    {
        EpiMla EM{(const bf16_t*)P.out, (float*)(ws + WS_ST)};
        run_gemm(lds, (const bf16_t*)(ws + WS_QN), (const bf16_t*)(ws + WS_WOMLA), R, 1024, 1024, G, bx, EM);
        EpiSsd ES{(const bf16_t*)P.out + (size_t)R * 1024, (const float*)(ws + WS_ST), (const float*)(ws + WS_SSQ_Y), (bf16_t*)(ws + WS_MERGED)};
        run_gemm(lds, (const bf16_t*)(ws + WS_Z), (const bf16_t*)(ws + WS_WOSSD), R, 1024, 1024, G, bx, ES);
    }
    GSYNC();
    {
        EpiOut E{P.in[I_XP], P.in[I_XS], (const float*)(ws + WS_MOD), P.in[I_GFFN], P.out, (bf16_t*)(ws + WS_A1), (float*)(ws + WS_SSQ2)};
        run_gemm(lds, (const bf16_t*)(ws + WS_MERGED), (const bf16_t*)(ws + WS_WOUT), R, 1024, 1024, G, bx, E);
    }
    GSYNC();
    {
        EpiUp E{(const float*)(ws + WS_SSQ2), (const float*)(ws + WS_CUP), (bf16_t*)(ws + WS_U)};
        run_gemm(lds, (const bf16_t*)(ws + WS_A1), (const bf16_t*)(ws + WS_WUP), R, UPN, 1024, G, bx, E);
    }
    GSYNC();
    phase_convgate(P);
    GSYNC();
    {
        EpiDown E{(const float*)(ws + WS_MOD), P.out};
        run_gemm(lds, (const bf16_t*)(ws + WS_UG), (const bf16_t*)(ws + WS_WDOWN), R, 1024, DFF, G, bx, E);
    }
    GSYNC();
    phase_final(P);
}

extern "C" void kernel_launch(void* const* d_in, const int* in_sizes, int n_in, void* d_out, int out_size, void* d_ws, size_t ws_size, hipStream_t stream) {
    static int grid = 0;
    if (grid == 0) {
        if (n_in != 30 || ws_size < WS_END || out_size != (int)(O_SSD + (size_t)32 * 2 * 16 * 64 * 64)) {
            fprintf(stderr, "kernel_launch: unexpected shapes: n_in %d out %d ws %zu (need %zu)\n", n_in, out_size, ws_size, (size_t)WS_END); grid = -1; return; }
        int dev = 0, cus = 0, per_cu = 0;
        if (hipGetDevice(&dev) != hipSuccess || hipDeviceGetAttribute(&cus, hipDeviceAttributeMultiprocessorCount, dev) != hipSuccess) { grid = -1; return; }
        if (hipFuncSetAttribute((const void*)mega_fwd, hipFuncAttributeMaxDynamicSharedMemorySize, LDS_BYTES) != hipSuccess) { fprintf(stderr, "kernel_launch: hipFuncSetAttribute failed\n"); grid = -1; return; }
        if (hipOccupancyMaxActiveBlocksPerMultiprocessor(&per_cu, (const void*)mega_fwd, NT, LDS_BYTES) != hipSuccess || per_cu < 1) { fprintf(stderr, "kernel_launch: occupancy query failed (%d)\n", per_cu); (void)hipGetLastError(); grid = -1; return; }
        grid = cus;
    }
    if (grid < 0) return;
    (void)hipMemsetAsync((char*)d_ws + WS_CTL, 0, CTL_ZERO, stream);
    Params p{};
    for (int i = 0; i < 30; ++i) p.in[i] = (const float*)d_in[i];
    p.out = (float*)d_out; p.ws = (unsigned char*)d_ws;
    void* args[] = {&p};
    hipError_t e = hipLaunchCooperativeKernel((const void*)mega_fwd, dim3(grid), dim3(NT), args, LDS_BYTES, stream);
    if (e != hipSuccess) fprintf(stderr, "kernel_launch: cooperative launch failed: %s (grid %d)\n", hipGetErrorString(e), grid);
}
```

```cpp
#include <hip/hip_runtime.h>
#include <hip/hip_cooperative_groups.h>
#include <cstdio>
#include <cstdint>
namespace cg = cooperative_groups;

namespace pg8 {
#define PG8_LAS __attribute__((address_space(3)))
typedef unsigned short bf16_t;
typedef short bf16x8 __attribute__((ext_vector_type(8)));
typedef float f32x4 __attribute__((ext_vector_type(4)));
typedef unsigned u32x4 __attribute__((ext_vector_type(4)));
constexpr int BM = 256, BK = 64, HALF = 128, HTB = HALF * BK * 2  , STAGE_BYTES = 8 * HTB, NXCD = 8, WGM = 8;

__host__ __device__ __forceinline__ int lds_byte(int r, int c) { const int st = (r >> 4) * 2 + (c >> 5), rr = r & 15, cc = c & 31, ob = rr * 64 + cc * 2; return st * 1024 + (ob ^ (((ob >> 9) & 1) << 5)); }
__host__ __device__ __forceinline__ void stage_rc(int b, int& R, int& C) { const int st = b / 1024, sb = b % 1024, swz = sb ^ (((sb >> 9) & 1) << 5); R = (st >> 1) * 16 + swz / 64; C = (st & 1) * 32 + (swz % 64) / 2; }
__host__ __device__ __forceinline__ int perm32(int rho) { const int n = rho >> 4, i = rho & 15; return 8 * (i >> 2) + 4 * n + (i & 3); }

struct Unit { int pm, pn; };
struct Gemm { const bf16_t* A; const bf16_t* Bt; int M, N, K; };

struct StaticOrder {
    int nM, nN, nwg, G, c;
    __host__ __device__ void init(int M, int N, int G_, int c_) { nM = M / BM; nN = N / BM; nwg = nM * nN; G = G_; c = c_; }
    __host__ __device__ bool next(int i, Unit& u) const {
        const long L = (long)i * G + c; if (L >= nwg) return false;
        int wgid = (int)L; { const int q = nwg / NXCD, r = nwg % NXCD, xcd = wgid % NXCD, off = wgid / NXCD; wgid = (xcd < r ? xcd * (q + 1) : r * (q + 1) + (xcd - r) * q) + off; }
        const int nig = WGM * nN, gid = wgid / nig, fm = gid * WGM, gsz = (nM - fm) < WGM ? (nM - fm) : WGM;
        u.pm = fm + ((wgid % nig) % gsz); u.pn = (wgid % nig) / gsz; return true;
    }
    __device__ __forceinline__ void a_ready(const Unit&) const {}
    __device__ __forceinline__ void done(const Unit&) const {}
};


template <class Epi, class Sched, bool ALIGN_EPI = false, bool SP2 = false>
__device__ __forceinline__ void gemm_phase(PG8_LAS unsigned char* lds, const Gemm g, const Sched& S, const Epi& E) {
    int tid_ = threadIdx.x; asm volatile("" : "+v"(tid_));
    const int tid = tid_, wid = __builtin_amdgcn_readfirstlane(tid >> 6), lane = tid & 63, wr = wid >> 2, wc = wid & 3, fr = lane & 15, fq = lane >> 4;
    const int K = g.K, nt = K / BK;
    unsigned voffA[2], voffB[2];
#pragma unroll
    for (int i = 0; i < 2; ++i) { int R, C; stage_rc(tid * 16 + i * 8192, R, C); const int Rb = Epi::PERM ? ((R & ~31) + perm32(R & 31)) : R;
        voffA[i] = (unsigned)(R * K + C) * 2u; voffB[i] = (unsigned)(Rb * K + C) * 2u; }
    const size_t kstep = (size_t)(BK * 2);
    const size_t hstep = (size_t)HALF * K * 2;
    const size_t tstep = 2 * hstep;
    const unsigned ldsw = (unsigned)wid * 1024u;
    const int aoff = lds_byte(wr * 64 + fr, fq * 8), boff = lds_byte(wc * 32 + fr, fq * 8);
#define PG8_SA(b, h) (((b) * 2 + (h)) * HTB)
#define PG8_SB(b, h) ((4 + (b) * 2 + (h)) * HTB)
#define PG8_STAGE(bufoff, gbase, voff) do { _Pragma("unroll") for (int _i = 0; _i < 2; ++_i) \
        __builtin_amdgcn_global_load_lds((const unsigned*)((const char*)(gbase) + (voff)[_i]), (PG8_LAS unsigned*)(lds + (bufoff) + ldsw + _i * 8192), 16, 0, 0); } while (0)
#define PG8_LDA(dst, b, h) do { _Pragma("unroll") for (int m = 0; m < 4; ++m) _Pragma("unroll") for (int k = 0; k < 2; ++k) dst[m][k] = *(const PG8_LAS bf16x8*)(lds + PG8_SA(b, h) + aoff + m * 2048 + k * 1024); } while (0)
#define PG8_LDB(dst, b, h) do { _Pragma("unroll") for (int n = 0; n < 2; ++n) _Pragma("unroll") for (int k = 0; k < 2; ++k) dst[n][k] = *(const PG8_LAS bf16x8*)(lds + PG8_SB(b, h) + boff + n * 2048 + k * 1024); } while (0)
#define PG8_MMA(ai, bj, At, Bt) do { __builtin_amdgcn_s_setprio(1); _Pragma("unroll") for (int m = 0; m < 4; ++m) _Pragma("unroll") for (int n = 0; n < 2; ++n) _Pragma("unroll") for (int k = 0; k < 2; ++k) \
        acc[ai][bj][m][n] = __builtin_amdgcn_mfma_f32_16x16x32_bf16(Bt[n][k], At[m][k], acc[ai][bj][m][n], 0, 0, 0); __builtin_amdgcn_s_setprio(0); } while (0)
#define PG8_WAIT_V(n) asm volatile("s_waitcnt vmcnt(" #n ")" ::: "memory")
#define PG8_WAIT_L(n) asm volatile("s_waitcnt lgkmcnt(" #n ")" ::: "memory")
#define PG8_BAR __builtin_amdgcn_s_barrier()
#define PG8_SCHED __builtin_amdgcn_sched_barrier(0)
    Unit cur, nxt; int ui = 0;
    if (!S.next(0, cur)) return;
    f32x4 acc[2][2][4][2];
#pragma unroll
    for (int a = 0; a < 2; ++a)
#pragma unroll
        for (int b = 0; b < 2; ++b)
#pragma unroll
            for (int m = 0; m < 4; ++m)
#pragma unroll
                for (int n = 0; n < 2; ++n) acc[a][b][m][n] = (f32x4){0.f, 0.f, 0.f, 0.f};
    bf16x8 At[4][2], B0[2][2], B1[2][2];
    const char* cA = (const char*)g.A + (size_t)cur.pm * tstep; const char* cB = (const char*)g.Bt + (size_t)cur.pn * tstep;
    S.a_ready(cur);
    if constexpr (SP2) {
        PG8_STAGE(PG8_SB(0, 0), cB, voffB); PG8_STAGE(PG8_SB(0, 1), cB + hstep, voffB); PG8_STAGE(PG8_SA(0, 0), cA, voffA); PG8_STAGE(PG8_SA(0, 1), cA + hstep, voffA);
        if (wr == 1) PG8_BAR;
        PG8_WAIT_V(2); PG8_BAR;
        PG8_STAGE(PG8_SB(1, 0), cB + kstep, voffB); PG8_STAGE(PG8_SA(1, 0), cA + kstep, voffA); PG8_STAGE(PG8_SB(1, 1), cB + hstep + kstep, voffB);
        PG8_WAIT_V(6); PG8_BAR;
    } else {
        PG8_STAGE(PG8_SB(0, 0), cB, voffB); PG8_STAGE(PG8_SA(0, 0), cA, voffA); PG8_STAGE(PG8_SB(0, 1), cB + hstep, voffB); PG8_STAGE(PG8_SA(0, 1), cA + hstep, voffA);
        if (wr == 1) PG8_BAR;
        PG8_WAIT_V(4); PG8_BAR;
        PG8_STAGE(PG8_SB(1, 0), cB + kstep, voffB); PG8_STAGE(PG8_SA(1, 0), cA + kstep, voffA); PG8_STAGE(PG8_SB(1, 1), cB + hstep + kstep, voffB);
        PG8_WAIT_V(6); PG8_BAR;
    }
    for (;;) {
        const bool has_next = S.next(ui + 1, nxt);
        const char* nA = has_next ? (const char*)g.A + (size_t)nxt.pm * tstep : cA; const char* nB = has_next ? (const char*)g.Bt + (size_t)nxt.pn * tstep : cB;
        for (int t = 0; t < nt; t += 2) {
            const bool last = (t == nt - 2);
            const char* a1 = cA + (size_t)(t + 1) * kstep;
            const char* a2 = last ? nA : cA + (size_t)(t + 2) * kstep; const char* b2 = last ? nB : cB + (size_t)(t + 2) * kstep;
            const char* a3 = a2 + kstep; const char* b3 = b2 + kstep;
            if (last && has_next) S.a_ready(nxt);
            if constexpr (SP2) {
            PG8_LDB(B0, 0, 0); PG8_LDB(B1, 0, 1); PG8_SCHED; PG8_LDA(At, 0, 0); PG8_STAGE(PG8_SA(1, 1), a1 + hstep, voffA);
            PG8_WAIT_V(8); PG8_WAIT_L(0); PG8_BAR; PG8_MMA(0, 0, At, B0); PG8_MMA(0, 1, At, B1); PG8_BAR; PG8_SCHED;
            PG8_LDA(At, 0, 1); PG8_STAGE(PG8_SB(0, 0), b2, voffB); PG8_STAGE(PG8_SB(0, 1), b2 + hstep, voffB); PG8_STAGE(PG8_SA(0, 0), a2, voffA);
            PG8_WAIT_V(8); PG8_WAIT_L(0); PG8_BAR; PG8_MMA(1, 0, At, B0); PG8_MMA(1, 1, At, B1); PG8_BAR; PG8_SCHED;
            PG8_LDB(B0, 1, 0); PG8_LDB(B1, 1, 1); PG8_SCHED; PG8_LDA(At, 1, 0); PG8_STAGE(PG8_SA(0, 1), a2 + hstep, voffA);
            PG8_WAIT_V(8); PG8_WAIT_L(0); PG8_BAR; PG8_MMA(0, 0, At, B0); PG8_MMA(0, 1, At, B1); PG8_BAR; PG8_SCHED;
            PG8_LDA(At, 1, 1); PG8_STAGE(PG8_SB(1, 0), b3, voffB); PG8_STAGE(PG8_SB(1, 1), b3 + hstep, voffB); PG8_STAGE(PG8_SA(1, 0), a3, voffA);
            PG8_WAIT_V(8); PG8_WAIT_L(0); PG8_BAR; PG8_MMA(1, 0, At, B0); PG8_MMA(1, 1, At, B1); PG8_BAR; PG8_SCHED;
            } else {
            PG8_LDB(B0, 0, 0); PG8_SCHED; PG8_LDA(At, 0, 0); PG8_STAGE(PG8_SA(1, 1), a1 + hstep, voffA);
            PG8_WAIT_L(8); PG8_BAR; PG8_WAIT_L(0); PG8_MMA(0, 0, At, B0); PG8_BAR; PG8_SCHED;
            PG8_LDB(B1, 0, 1); PG8_STAGE(PG8_SB(0, 0), b2, voffB);
            PG8_BAR; PG8_WAIT_L(0); PG8_MMA(0, 1, At, B1); PG8_BAR;
            PG8_LDA(At, 0, 1); PG8_STAGE(PG8_SA(0, 0), a2, voffA);
            PG8_BAR; PG8_WAIT_L(0); PG8_MMA(1, 0, At, B0); PG8_BAR; PG8_SCHED;
            PG8_STAGE(PG8_SB(0, 1), b2 + hstep, voffB);
            PG8_WAIT_V(6); PG8_BAR; PG8_MMA(1, 1, At, B1); PG8_BAR;
            PG8_LDB(B0, 1, 0); PG8_SCHED; PG8_LDA(At, 1, 0); PG8_STAGE(PG8_SA(0, 1), a2 + hstep, voffA);
            PG8_WAIT_L(8); PG8_BAR; PG8_WAIT_L(0); PG8_MMA(0, 0, At, B0); PG8_BAR; PG8_SCHED;
            PG8_LDB(B1, 1, 1); PG8_STAGE(PG8_SB(1, 0), b3, voffB);
            PG8_BAR; PG8_WAIT_L(0); PG8_MMA(0, 1, At, B1); PG8_BAR;
            PG8_LDA(At, 1, 1); PG8_STAGE(PG8_SA(1, 0), a3, voffA);
            PG8_BAR; PG8_WAIT_L(0); PG8_MMA(1, 0, At, B0); PG8_BAR; PG8_SCHED;
            PG8_STAGE(PG8_SB(1, 1), b3 + hstep, voffB);
            PG8_WAIT_V(6); PG8_BAR; PG8_MMA(1, 1, At, B1); PG8_BAR;
            }
        }
        if constexpr (ALIGN_EPI) { if (wr == 0) PG8_BAR; }
        if constexpr (!Epi::AFTER_DRAIN) { E(acc, cur, wr, wc, fr, fq); S.done(cur); }
        if (!has_next) break;
#pragma unroll
        for (int a = 0; a < 2; ++a)
#pragma unroll
            for (int b = 0; b < 2; ++b)
#pragma unroll
                for (int m = 0; m < 4; ++m)
#pragma unroll
                    for (int n = 0; n < 2; ++n) acc[a][b][m][n] = (f32x4){0.f, 0.f, 0.f, 0.f};
        cur = nxt; cA = nA; cB = nB; ++ui;
        if constexpr (ALIGN_EPI) { if (wr == 1) PG8_BAR; }
    }
    PG8_WAIT_V(0);
    if constexpr (!ALIGN_EPI) { if (wr == 0) PG8_BAR; }
    PG8_BAR;
    if constexpr (Epi::AFTER_DRAIN) { E.fused(acc, cur, wr, wc, fr, fq, lds, wid, lane); S.done(cur); }
#undef PG8_SA
#undef PG8_SB
#undef PG8_STAGE
#undef PG8_LDA
#undef PG8_LDB
#undef PG8_MMA
#undef PG8_WAIT_V
#undef PG8_WAIT_L
#undef PG8_BAR
#undef PG8_SCHED
}
}

#ifndef PG8_SP2
#define PG8_SP2 true
#endif
#ifndef PG8_ALIGN
#define PG8_ALIGN true
#endif

#define LAS __attribute__((address_space(3)))
using pg8::bf16_t; using pg8::f32x4; using pg8::bf16x8; using pg8::u32x4;
typedef unsigned u32x2 __attribute__((ext_vector_type(2)));
typedef float f32x2 __attribute__((ext_vector_type(2)));

constexpr int DM = 1024;
constexpr int RP = 8192, RS = 4096, R = 12288;
constexpr int SEQP = 256, SEQS = 2048, PAST = 512, KVS = PAST + SEQS;
constexpr int KVR = RP + 2 * KVS;
constexpr int NH = 8;
constexpr int INC = 5216, INP = 5376;
constexpr int DFF = 2816, UPN = 5632;
constexpr float EPS = 1e-6f;
constexpr float ATT_SCALE = 0.07216878364870322f;

enum { I_XP = 0, I_XS, I_C, I_CKV, I_CKR, I_SSD, I_CCTX, I_WADA, I_BADA, I_GATTN, I_WIN, I_GQ, I_GKV, I_WUQ, I_WUKV, I_WOMLA,
       I_CONVW, I_CONVB, I_DTB, I_ALOG, I_SSDD, I_GSSD, I_WOSSD, I_WOUT, I_GFFN, I_WUP, I_FCW, I_FCB, I_WDOWN, I_GFIN };

constexpr size_t O_Y = 0, O_CKV = (size_t)R * DM, O_KR = O_CKV + (size_t)RP * 256, O_SSD = O_KR + (size_t)RP * 64;

constexpr size_t MiB = 1u << 20;
constexpr size_t WS_CTL = 0, CTL_ZERO = 65536;
constexpr size_t WS_MOD = 64 * 1024;
constexpr size_t WS_CUP = 160 * 1024;
constexpr size_t WS_ROPE = 256 * 1024;
constexpr size_t WS_SSQ_CQ = 1 * MiB;
constexpr size_t WS_SSQ_CKV = 1 * MiB + 204800;
constexpr size_t WS_SSQ_Y = 1 * MiB + 430080;
constexpr size_t WS_SSQ2 = 1 * MiB + 1216512;
constexpr size_t WS_DT = 3 * MiB;
constexpr size_t WS_DEC = 3 * MiB + 1572864;
constexpr size_t WS_WIN = 5 * MiB;
constexpr size_t WS_WUQ = WS_WIN + (size_t)INP * 1024 * 2;
constexpr size_t WS_WUKV = WS_WUQ + 1536 * 256 * 2;
constexpr size_t WS_WOMLA = WS_WUKV + 2048 * 256 * 2;
constexpr size_t WS_WOSSD = WS_WOMLA + 2 * MiB;
constexpr size_t WS_WOUT = WS_WOSSD + 2 * MiB;
constexpr size_t WS_WUP = WS_WOUT + 2 * MiB;
constexpr size_t WS_WDOWN = WS_WUP + (size_t)UPN * 1024 * 2;
static_assert(WS_WDOWN + (size_t)1024 * DFF * 2 <= 40 * MiB, "weights");
constexpr size_t WS_CQ = 40 * MiB;
constexpr size_t WS_CKVA = 46 * MiB;
constexpr size_t WS_KROPE = 46 * MiB + (size_t)KVR * 256 * 2;
constexpr size_t WS_Z = 55 * MiB;
constexpr size_t WS_XBC = 79 * MiB;
constexpr size_t WS_H = 115 * MiB;
constexpr size_t WS_XC = 115 * MiB;
constexpr size_t WS_QN = 79 * MiB;
constexpr size_t WS_QR = 103 * MiB;
constexpr size_t WS_KV = 151 * MiB;
constexpr size_t WS_YF = 151 * MiB;
constexpr size_t WS_ST = 203 * MiB;
constexpr size_t WS_MERGED = 151 * MiB;
constexpr size_t WS_A1 = 55 * MiB;
constexpr size_t WS_U = 115 * MiB;
constexpr size_t WS_UG = 40 * MiB;
constexpr size_t WS_END = 251 * MiB;
static_assert(WS_KROPE + (size_t)KVR * 64 * 2 <= WS_Z && WS_KV + (size_t)KVR * 2048 * 2 <= WS_ST && WS_ST + (size_t)R * 1024 * 4 <= WS_END, "map");
static_assert(WS_U + (size_t)R * UPN * 2 <= WS_END && WS_UG + (size_t)R * DFF * 2 <= WS_U, "map2");

constexpr int LDS_BYTES = 147456;
constexpr int NT = 512;

struct Params { const float* in[30]; float* out; unsigned char* ws; };
#define PHASE_IDS int tid = threadIdx.x; asm volatile("" : "+v"(tid)); const int lane = tid & 63, wave = __builtin_amdgcn_readfirstlane(tid >> 6), G = gridDim.x; (void)lane; (void)wave; (void)G;

#define LDS_WAIT() asm volatile("s_waitcnt lgkmcnt(0)" ::: "memory")
__device__ __forceinline__ unsigned f2bf(float f) { unsigned u = __builtin_bit_cast(unsigned, f); return (u + 0x7fffu + ((u >> 16) & 1u)) >> 16; }
__device__ __forceinline__ float bf2f(unsigned short b) { return __builtin_bit_cast(float, (unsigned)b << 16); }
__device__ __forceinline__ unsigned pk2(float lo, float hi) { return f2bf(lo) | (f2bf(hi) << 16); }
__device__ __forceinline__ float bflo(unsigned w) { return __builtin_bit_cast(float, w << 16); }
__device__ __forceinline__ float bfhi(unsigned w) { return __builtin_bit_cast(float, w & 0xffff0000u); }
__device__ __forceinline__ float wave_sum(float v) {
#pragma unroll
    for (int o = 1; o < 64; o <<= 1) v += __shfl_xor(v, o);
    return v;
}
__device__ __forceinline__ float wave_max(float v) {
#pragma unroll
    for (int o = 1; o < 64; o <<= 1) v = fmaxf(v, __shfl_xor(v, o));
    return v;
}
__device__ __forceinline__ float siluf(float x) { return x / (1.f + __expf(-x)); }
__device__ __forceinline__ float sigm(float x) { return 1.f / (1.f + __expf(-x)); }
__device__ __forceinline__ float softplusf(float x) { return x > 20.f ? x : log1pf(__expf(x)); }
__device__ __forceinline__ int grp_of_row(int row) { return row < RP ? 0 : 1 + ((row - RP) >> 11); }
__device__ __forceinline__ int kvrow_of_row(int row) { return row < RP ? row : RP + ((row - RP) >> 11) * KVS + PAST + ((row - RP) & 2047); }
__device__ __forceinline__ const float* xrow_ptr(const Params& P, int row) { return row < RP ? P.in[I_XP] + (size_t)row * DM : P.in[I_XS] + (size_t)(row - RP) * DM; }

__device__ __forceinline__ void transpose_item(const float* W, int K, int N, bf16_t* WT, int k0, int n0, int drow0, const float* kscale, LAS float* scr, int lane) {
#pragma unroll 8
    for (int i = 0; i < 32; ++i) { const int kk = 2 * i + (lane >> 5); float w = W[(size_t)(k0 + kk) * N + n0 + (lane & 31)]; if (kscale) w *= kscale[k0 + kk]; scr[kk * 33 + (lane & 31)] = w; }
    LDS_WAIT(); asm volatile("" ::: "memory");
    const int c = lane & 7;
#pragma unroll
    for (int j = 0; j < 4; ++j) { const int n = (lane >> 3) + 8 * j; const LAS float* s = scr + (8 * c) * 33 + n;
        u32x4 o; o.x = pk2(s[0 * 33], s[1 * 33]); o.y = pk2(s[2 * 33], s[3 * 33]); o.z = pk2(s[4 * 33], s[5 * 33]); o.w = pk2(s[6 * 33], s[7 * 33]);
        *(u32x4*)(WT + (size_t)(drow0 + n) * K + k0 + 8 * c) = o; }
    LDS_WAIT(); asm volatile("" ::: "memory");
}
__device__ __forceinline__ int win_dst(int n0) {
    if (n0 < 512) return n0;
    if (n0 < 576) return 5120 + (n0 - 512);
    if (n0 < 1600) return 512 + (n0 - 576);
    if (n0 < 2624) return 1536 + (n0 - 1600);
    if (n0 < 2880) return 2560 + (n0 - 2624);
    if (n0 < 3136) return 2816 + (n0 - 2880);
    if (n0 < 3168) return 5184 + (n0 - 3136);
    if (n0 < 4192) return 3072 + (n0 - 3168);
    return 4096 + (n0 - 4192);
}
__device__ __forceinline__ int wuq_dst(int n0) { const int h = n0 / 192, d0 = n0 - h * 192; return d0 < 128 ? h * 128 + d0 : 1024 + h * 64 + (d0 - 128); }

template <int CW>
__device__ __forceinline__ void gemv3_block(const LAS float* vec  , const float* W, int N, int col0, const float* bias, float* out, int ldo, LAS float* red, int tid) {
    const int j = tid & 31, kq = tid >> 5;
    float a0 = 0.f, a1 = 0.f, a2 = 0.f;
    if (j < CW) {
        const float* wp = W + (size_t)(kq * 64) * N + col0 + j;
#pragma unroll 8
        for (int k = 0; k < 64; ++k) { const float w = wp[(size_t)k * N]; const int kk = kq * 64 + k; a0 += vec[kk] * w; a1 += vec[1024 + kk] * w; a2 += vec[2048 + kk] * w; }
    }
    red[(kq * 3 + 0) * 32 + j] = a0; red[(kq * 3 + 1) * 32 + j] = a1; red[(kq * 3 + 2) * 32 + j] = a2;
    __syncthreads();
    if (tid < 96) { const int g = tid >> 5, jj = tid & 31;
        if (jj < CW) { float s = 0.f;
#pragma unroll
            for (int q = 0; q < 16; ++q) s += red[(q * 3 + g) * 32 + jj];
            out[(size_t)g * ldo + col0 + jj] = s + (bias ? bias[col0 + jj] : 0.f); } }
    __syncthreads();
}

__device__ __forceinline__ void phase_p0(const Params& P, LAS unsigned char* lds) {
    PHASE_IDS unsigned char* ws = P.ws;
    {
        LAS float* sc = (LAS float*)lds; LAS float* red = sc + 3072;
        for (int i = tid; i < 3072; i += NT) { const int g = i >> 10, k = i & 1023; const float c = (g == 0) ? P.in[I_CCTX][k] : P.in[I_C][(g - 1) * 1024 + k]; sc[i] = siluf(c); }
        __syncthreads();
        for (int cb = blockIdx.x; cb < 256; cb += G) gemv3_block<24>(sc, P.in[I_WADA], 6144, cb * 24, P.in[I_BADA], (float*)(ws + WS_MOD), 6144, red, tid);
    }
    {
        LAS float* scr = (LAS float*)(lds + wave * 16384);
        const int gw = blockIdx.x * 8 + wave, NGW = G * 8;
        constexpr int I_IN = 16 * 163, I_UQ = 4 * 48, I_UKV = 4 * 64, I_SQ = 16 * 32, I_UP = 16 * 176, I_DN = 44 * 32;
        constexpr int NITEMS = I_IN + I_UQ + I_UKV + 3 * I_SQ + I_UP + I_DN;
        for (int it = gw; it < NITEMS; it += NGW) {
            int r = it;
            if (r < I_IN) { const int kb = r / 163, nb = r % 163; transpose_item(P.in[I_WIN], 1024, INC, (bf16_t*)(ws + WS_WIN), kb * 64, nb * 32, win_dst(nb * 32), nullptr, scr, lane); continue; } r -= I_IN;
            if (r < I_UQ) { const int kb = r / 48, nb = r % 48; transpose_item(P.in[I_WUQ], 256, 1536, (bf16_t*)(ws + WS_WUQ), kb * 64, nb * 32, wuq_dst(nb * 32), P.in[I_GQ], scr, lane); continue; } r -= I_UQ;
            if (r < I_UKV) { const int kb = r / 64, nb = r % 64; transpose_item(P.in[I_WUKV], 256, 2048, (bf16_t*)(ws + WS_WUKV), kb * 64, nb * 32, nb * 32, P.in[I_GKV], scr, lane); continue; } r -= I_UKV;
            if (r < I_SQ) { const int kb = r / 32, nb = r % 32; transpose_item(P.in[I_WOMLA], 1024, 1024, (bf16_t*)(ws + WS_WOMLA), kb * 64, nb * 32, nb * 32, nullptr, scr, lane); continue; } r -= I_SQ;
            if (r < I_SQ) { const int kb = r / 32, nb = r % 32; transpose_item(P.in[I_WOSSD], 1024, 1024, (bf16_t*)(ws + WS_WOSSD), kb * 64, nb * 32, nb * 32, P.in[I_GSSD], scr, lane); continue; } r -= I_SQ;
            if (r < I_SQ) { const int kb = r / 32, nb = r % 32; transpose_item(P.in[I_WOUT], 1024, 1024, (bf16_t*)(ws + WS_WOUT), kb * 64, nb * 32, nb * 32, nullptr, scr, lane); continue; } r -= I_SQ;
            if (r < I_UP) { const int kb = r / 176, nb = r % 176; transpose_item(P.in[I_WUP], 1024, UPN, (bf16_t*)(ws + WS_WUP), kb * 64, nb * 32, nb * 32, nullptr, scr, lane); continue; } r -= I_UP;
            { const int kb = r / 32, nb = r % 32; transpose_item(P.in[I_WDOWN], DFF, 1024, (bf16_t*)(ws + WS_WDOWN), kb * 64, nb * 32, nb * 32, nullptr, scr, lane); }
        }
    }
    {
        const int gt = blockIdx.x * NT + tid, GT = G * NT;
        for (int i = gt; i < 160 * 1024 / 8; i += GT) *(u32x4*)((bf16_t*)(ws + WS_WIN) + (size_t)5216 * 1024 + (size_t)i * 8) = (u32x4){0u, 0u, 0u, 0u};
        for (int i = gt; i < 2048 * 32; i += GT) { const int t = i >> 5, a = (i >> 4) & 1, fi = i & 15; const float pos = (float)(a ? (t & 63) : (t >> 6));
            const float inv = exp2f(-(float)fi * 0.8304820237218406f); const float ang = pos * inv;
            ((f32x2*)(ws + WS_ROPE))[i] = (f32x2){__cosf(ang), __sinf(ang)}; }
        for (int i = gt; i < 2 * PAST * 256; i += GT) { const int k = i & 255, s = (i >> 8) & 511, b = i >> 17;
            ((bf16_t*)(ws + WS_CKVA))[(size_t)(RP + b * KVS + s) * 256 + k] = (bf16_t)f2bf(P.in[I_CKV][i] / P.in[I_GKV][k]); }
        for (int i = gt; i < 2 * PAST * 64; i += GT) { const int j = i & 63, s = (i >> 6) & 511, b = i >> 15;
            ((bf16_t*)(ws + WS_KROPE))[(size_t)(RP + b * KVS + s) * 64 + j] = (bf16_t)f2bf(P.in[I_CKR][i]); }
        for (int i = gt; i < 2 * PAST; i += GT) { const int s = i & 511, b = i >> 9;
            *(f32x4*)((float*)(ws + WS_SSQ_CKV) + (size_t)(RP + b * KVS + s) * 4) = (f32x4){256.f * (1.f - EPS), 0.f, 0.f, 0.f}; }
    }
}

__device__ __forceinline__ void phase_p1(const Params& P, LAS unsigned char* lds) {
    PHASE_IDS unsigned char* ws = P.ws; const float* mod = (const float*)(ws + WS_MOD);
    {
        LAS float* sh = (LAS float*)lds; LAS float* red = sh + 3072;
        for (int i = tid; i < 3072; i += NT) { const int g = i >> 10, k = i & 1023; sh[i] = mod[g * 6144 + 3072 + k]; }
        __syncthreads();
        for (int cb = blockIdx.x; cb < 256; cb += G) gemv3_block<22>(sh, P.in[I_WUP], UPN, cb * 22, nullptr, (float*)(ws + WS_CUP), UPN, red, tid);
    }
    const int gw = blockIdx.x * 8 + wave, NGW = G * 8;
    const float* gat = P.in[I_GATTN];
    for (int row = gw; row < R; row += NGW) {
        const f32x4* xr = (const f32x4*)xrow_ptr(P, row) + lane; const int g = grp_of_row(row);
        f32x4 v[4]; float s = 0.f;
#pragma unroll
        for (int j = 0; j < 4; ++j) { v[j] = xr[64 * j]; s += (v[j].x * v[j].x + v[j].y * v[j].y) + (v[j].z * v[j].z + v[j].w * v[j].w); }
        const float rs = rsqrtf(wave_sum(s) * (1.f / DM) + EPS);
        u32x2* o8 = (u32x2*)((bf16_t*)(ws + WS_H) + (size_t)row * DM) + lane;
#pragma unroll
        for (int j = 0; j < 4; ++j) { const int c = 4 * lane + 256 * j;
            const f32x4 gg = *(const f32x4*)(gat + c), sc = *(const f32x4*)(mod + g * 6144 + 1024 + c), sh = *(const f32x4*)(mod + g * 6144 + c);
            const f32x4 h = v[j] * rs * gg * (sc + 1.f) + sh;
            o8[64 * j] = (u32x2){pk2(h.x, h.y), pk2(h.z, h.w)}; }
    }
}

typedef const f32x4 (&AccRef)[2][2][4][2];
#define EPI_ROWS(pm) _Pragma("unroll") for (int ai = 0; ai < 2; ++ai) _Pragma("unroll") for (int m = 0; m < 4; ++m) { const int row = (pm) * 256 + ai * 128 + wr * 64 + m * 16 + fr;
#define EPI_COLS _Pragma("unroll") for (int bj = 0; bj < 2; ++bj) _Pragma("unroll") for (int n = 0; n < 2; ++n) { const int col = bj * 128 + wc * 32 + n * 16 + fq * 4; const f32x4 v = acc[ai][bj][m][n];
#define EPI_END }
__device__ __forceinline__ void st_bf4(bf16_t* p, f32x4 v) { *(u32x2*)p = (u32x2){pk2(v.x, v.y), pk2(v.z, v.w)}; }
__device__ __forceinline__ f32x4 ld_bf4(const bf16_t* p) { const u32x2 w = *(const u32x2*)p; return (f32x4){bflo(w.x), bfhi(w.x), bflo(w.y), bfhi(w.y)}; }
__device__ __forceinline__ float quad_sum16(float s) { s += __shfl_xor(s, 16); s += __shfl_xor(s, 32); return s; }

struct EpiIn {
    static constexpr bool PERM = false, AFTER_DRAIN = false;
    bf16_t *cq, *ckv, *z, *xbc, *sgm, *sgs, *krope; float *ssq_cq, *ssq_ckv, *dt, *new_ckv, *new_krope; const float* dt_bias; const f32x2* rope;
    __device__ __forceinline__ void operator()(AccRef acc, const pg8::Unit& u, int wr, int wc, int fr, int fq) const {
        const int pn = u.pn;
        if (pn < 2) {
            EPI_ROWS(u.pm)
                const int orow = pn == 0 ? row : kvrow_of_row(row); bf16_t* dst = (pn == 0 ? cq : ckv) + (size_t)orow * 256; float s = 0.f;
                EPI_COLS
                    st_bf4(dst + col, v); s += (v.x * v.x + v.y * v.y) + (v.z * v.z + v.w * v.w);
                    if (pn == 1 && row < RP) *(f32x4*)(new_ckv + (size_t)row * 256 + col) = v;
                EPI_END
                s = quad_sum16(s);
                if (fq == 0) (pn == 0 ? ssq_cq : ssq_ckv)[(size_t)orow * 4 + wc] = s;
            EPI_END
        } else if (pn < 12) {
            bf16_t* base = pn < 6 ? z : xbc; const int ld = pn < 6 ? 1024 : 1536, c0 = pn < 6 ? (pn - 2) * 256 : (pn - 6) * 256;
            EPI_ROWS(u.pm)
                bf16_t* dst = base + (size_t)row * ld + c0;
                EPI_COLS st_bf4(dst + col, v); EPI_END
            EPI_END
        } else if (pn < 20) {
            bf16_t* base = pn < 16 ? sgm : sgs; const int c0 = (pn & 3) * 256;
            EPI_ROWS(u.pm)
                bf16_t* dst = base + (size_t)row * 1024 + c0;
                EPI_COLS st_bf4(dst + col, (f32x4){sigm(v.x), sigm(v.y), sigm(v.z), sigm(v.w)}); EPI_END
            EPI_END
        } else {
            if (wc < 2) {
                EPI_ROWS(u.pm)
                    const f32x4 x0 = acc[ai][0][m][0], x1 = acc[ai][0][m][1]; const int i0 = fq * 4;
                    if (row < RP) {
                        st_bf4(krope + (size_t)row * 64 + wc * 32 + i0, x0); st_bf4(krope + (size_t)row * 64 + wc * 32 + 16 + i0, x1);
                        *(f32x4*)(new_krope + (size_t)row * 64 + wc * 32 + i0) = x0; *(f32x4*)(new_krope + (size_t)row * 64 + wc * 32 + 16 + i0) = x1;
                    } else {
                        const int t = (row - RP) & 2047; const f32x2* rp = rope + t * 32 + wc * 16 + i0; f32x4 o0, o1;
#pragma unroll
                        for (int e = 0; e < 4; ++e) { const f32x2 cs = rp[e]; o0[e] = x0[e] * cs.x - x1[e] * cs.y; o1[e] = x0[e] * cs.y + x1[e] * cs.x; }
                        bf16_t* dst = krope + (size_t)kvrow_of_row(row) * 64 + wc * 32 + i0; st_bf4(dst, o0); st_bf4(dst + 16, o1);
                    }
                EPI_END
            } else if (wc == 2) {
                EPI_ROWS(u.pm)
#pragma unroll
                    for (int n = 0; n < 2; ++n) { const int j = n * 16 + fq * 4; const f32x4 v = acc[ai][0][m][n]; const f32x4 b = *(const f32x4*)(dt_bias + j);
                        *(f32x4*)(dt + (size_t)row * 32 + j) = (f32x4){softplusf(v.x + b.x), softplusf(v.y + b.y), softplusf(v.z + b.z), softplusf(v.w + b.w)}; }
                EPI_END
            }
        }
    }
};

struct EpiQ {
    static constexpr bool PERM = false, AFTER_DRAIN = false;
    bf16_t *qn, *qr; const float* ssq; const f32x2* rope;
    __device__ __forceinline__ void operator()(AccRef acc, const pg8::Unit& u, int wr, int wc, int fr, int fq) const {
        const int pn = u.pn;
        EPI_ROWS(u.pm)
            const f32x4 sq = *(const f32x4*)(ssq + (size_t)row * 4); const float rs = rsqrtf(((sq.x + sq.y) + (sq.z + sq.w)) * (1.f / 256.f) + EPS);
            if (pn < 4) {
                bf16_t* dst = qn + (size_t)row * 1024 + pn * 256;
                EPI_COLS st_bf4(dst + col, v * rs); EPI_END
            } else {
                bf16_t* dst = qr + (size_t)row * 512 + (pn - 4) * 256;
#pragma unroll
                for (int bj = 0; bj < 2; ++bj) { const int cb = bj * 128 + wc * 32, i0 = fq * 4; const f32x4 x0 = acc[ai][bj][m][0] * rs, x1 = acc[ai][bj][m][1] * rs;
                    if (row < RP) { st_bf4(dst + cb + i0, x0); st_bf4(dst + cb + 16 + i0, x1); }
                    else { const int t = (row - RP) & 2047; const f32x2* rp = rope + t * 32 + (wc & 1) * 16 + i0; f32x4 o0, o1;
#pragma unroll
                        for (int e = 0; e < 4; ++e) { const f32x2 cs = rp[e]; o0[e] = x0[e] * cs.x - x1[e] * cs.y; o1[e] = x0[e] * cs.y + x1[e] * cs.x; }
                        st_bf4(dst + cb + i0, o0); st_bf4(dst + cb + 16 + i0, o1); } }
            }
        EPI_END
    }
};
struct EpiKV {
    static constexpr bool PERM = false, AFTER_DRAIN = false;
    bf16_t* kv; const float* ssq;
    __device__ __forceinline__ void operator()(AccRef acc, const pg8::Unit& u, int wr, int wc, int fr, int fq) const {
        EPI_ROWS(u.pm)
            const f32x4 sq = *(const f32x4*)(ssq + (size_t)row * 4); const float rs = rsqrtf(((sq.x + sq.y) + (sq.z + sq.w)) * (1.f / 256.f) + EPS);
            bf16_t* dst = kv + (size_t)row * 2048 + u.pn * 256;
            EPI_COLS st_bf4(dst + col, v * rs); EPI_END
        EPI_END
    }
};
struct EpiMla {
    static constexpr bool PERM = false, AFTER_DRAIN = false;
    const bf16_t* sgm; float* t;
    __device__ __forceinline__ void operator()(AccRef acc, const pg8::Unit& u, int wr, int wc, int fr, int fq) const {
        EPI_ROWS(u.pm)
            const size_t off = (size_t)row * 1024 + u.pn * 256;
            EPI_COLS *(f32x4*)(t + off + col) = ld_bf4(sgm + off + col) * v; EPI_END
        EPI_END
    }
};
struct EpiSsd {
    static constexpr bool PERM = false, AFTER_DRAIN = false;
    const bf16_t* sgs; const float* t; const float* ssq_y; bf16_t* merged;
    __device__ __forceinline__ void operator()(AccRef acc, const pg8::Unit& u, int wr, int wc, int fr, int fq) const {
        EPI_ROWS(u.pm)
            float s = 0.f;
#pragma unroll
            for (int q = 0; q < 4; ++q) { const f32x4 a = *(const f32x4*)(ssq_y + (size_t)row * 16 + q * 4); s += (a.x + a.y) + (a.z + a.w); }
            const float rs = rsqrtf(s * (1.f / 1024.f) + EPS); const size_t off = (size_t)row * 1024 + u.pn * 256;
            EPI_COLS st_bf4(merged + off + col, *(const f32x4*)(t + off + col) + ld_bf4(sgs + off + col) * (v * rs)); EPI_END
        EPI_END
    }
};
struct EpiOut {
    static constexpr bool PERM = false, AFTER_DRAIN = false;
    const float *xp, *xs, *mod, *gffn; float* x1; bf16_t* a1; float* ssq2;
    __device__ __forceinline__ void operator()(AccRef acc, const pg8::Unit& u, int wr, int wc, int fr, int fq) const {
        const int g = u.pm < 32 ? 0 : 1 + ((u.pm - 32) >> 3); const float* md = mod + g * 6144;
        EPI_ROWS(u.pm)
            const float* xr = row < RP ? xp + (size_t)row * DM : xs + (size_t)(row - RP) * DM; const size_t off = (size_t)row * 1024; float s = 0.f;
            EPI_COLS
                const int c = u.pn * 256 + col; const f32x4 x1v = *(const f32x4*)(xr + c) + *(const f32x4*)(md + 2048 + c) * v;
                *(f32x4*)(x1 + off + c) = x1v; s += (x1v.x * x1v.x + x1v.y * x1v.y) + (x1v.z * x1v.z + x1v.w * x1v.w);
                st_bf4(a1 + off + c, x1v * *(const f32x4*)(gffn + c) * (*(const f32x4*)(md + 4096 + c) + 1.f));
            EPI_END
            s = quad_sum16(s);
            if (fq == 0) ssq2[(size_t)row * 16 + u.pn * 4 + wc] = s;
        EPI_END
    }
};
struct EpiUp {
    static constexpr bool PERM = false, AFTER_DRAIN = false;
    const float *ssq2, *cup; bf16_t* uo;
    __device__ __forceinline__ void operator()(AccRef acc, const pg8::Unit& u, int wr, int wc, int fr, int fq) const {
        const int g = u.pm < 32 ? 0 : 1 + ((u.pm - 32) >> 3); const float* cu = cup + g * UPN + u.pn * 256;
        EPI_ROWS(u.pm)
            float s = 0.f;
#pragma unroll
            for (int q = 0; q < 4; ++q) { const f32x4 a = *(const f32x4*)(ssq2 + (size_t)row * 16 + q * 4); s += (a.x + a.y) + (a.z + a.w); }
            const float rs = rsqrtf(s * (1.f / 1024.f) + EPS); bf16_t* dst = uo + (size_t)row * UPN + u.pn * 256;
            EPI_COLS st_bf4(dst + col, v * rs + *(const f32x4*)(cu + col)); EPI_END
        EPI_END
    }
};
struct EpiDown {
    static constexpr bool PERM = false, AFTER_DRAIN = false;
    const float* mod; float* x;
    __device__ __forceinline__ void operator()(AccRef acc, const pg8::Unit& u, int wr, int wc, int fr, int fq) const {
        const int g = u.pm < 32 ? 0 : 1 + ((u.pm - 32) >> 3); const float* g2 = mod + g * 6144 + 5120 + u.pn * 256;
        EPI_ROWS(u.pm)
            float* xr = x + (size_t)row * 1024 + u.pn * 256;
            EPI_COLS *(f32x4*)(xr + col) = *(const f32x4*)(xr + col) + *(const f32x4*)(g2 + col) * v; EPI_END
        EPI_END
    }
};

template <class Epi>
__device__ __forceinline__ void run_gemm(LAS unsigned char* lds, const bf16_t* A, const bf16_t* Bt, int M, int N, int K, int G, int c, const Epi& E) {
    pg8::Gemm g{A, Bt, M, N, K}; pg8::StaticOrder S; S.init(M, N, G, c);
    pg8::gemm_phase<Epi, pg8::StaticOrder, PG8_ALIGN, PG8_SP2>(lds, g, S, E);
}

__device__ __forceinline__ void phase_conv(const Params& P) {
    PHASE_IDS unsigned char* ws = P.ws; const bf16_t* xbc = (const bf16_t*)(ws + WS_XBC); bf16_t* xc = (bf16_t*)(ws + WS_XC);
    const float* cw = P.in[I_CONVW]; const float* cb = P.in[I_CONVB];
    const int gt = blockIdx.x * NT + tid, GT = G * NT;
    for (int i = gt; i < R * (1536 / 4); i += GT) {
        const int row = i / 384, c = (i % 384) * 4; const int t = row < RP ? (row & 255) : ((row - RP) & 2047), L = row < RP ? SEQP : SEQS;
        f32x4 a = *(const f32x4*)(cb + c);
        if (t > 0) a += ld_bf4(xbc + (size_t)(row - 1) * 1536 + c) * *(const f32x4*)(cw + c);
        a += ld_bf4(xbc + (size_t)row * 1536 + c) * *(const f32x4*)(cw + 1536 + c);
        if (t < L - 1) a += ld_bf4(xbc + (size_t)(row + 1) * 1536 + c) * *(const f32x4*)(cw + 3072 + c);
        st_bf4(xc + (size_t)row * 1536 + c, (f32x4){siluf(a.x), siluf(a.y), siluf(a.z), siluf(a.w)});
    }
    const int gw = blockIdx.x * 8 + wave, NGW = G * 8;
    float* nck = P.out + O_CKV; const float* ssq = (const float*)(ws + WS_SSQ_CKV); const float* gk = P.in[I_GKV];
    for (int row = gw; row < RP; row += NGW) {
        const f32x4 sq = *(const f32x4*)(ssq + (size_t)row * 4); const float rs = rsqrtf(((sq.x + sq.y) + (sq.z + sq.w)) * (1.f / 256.f) + EPS);
        f32x4* p = (f32x4*)(nck + (size_t)row * 256) + lane; *p = *p * rs * *(const f32x4*)(gk + 4 * lane);
    }
}
__device__ __forceinline__ void phase_ssd_naive(const Params& P) {
    PHASE_IDS unsigned char* ws = P.ws; const bf16_t* xc = (const bf16_t*)(ws + WS_XC); const float* dt = (const float*)(ws + WS_DT);
    const int gw = blockIdx.x * 8 + wave, NGW = G * 8;
    for (int task = gw; task < 64 + 1024; task += NGW) {
        int b, dir, h, L, row0; bool smp = task < 64;
        if (smp) { b = task >> 5; dir = (task >> 4) & 1; h = task & 15; L = SEQS; row0 = RP + b * SEQS; }
        else { const int q = task - 64; b = q >> 5; dir = (q >> 4) & 1; h = q & 15; L = SEQP; row0 = b * SEQP; }
        const float A = -__expf(P.in[I_ALOG][dir * 16 + h]); const int g = h >> 2;
        float hs[64];
#pragma unroll
        for (int n = 0; n < 64; ++n) hs[n] = smp ? P.in[I_SSD][((((size_t)b * 2 + dir) * 16 + h) * 64 + lane) * 64 + n] : 0.f;
        float* yo = (float*)(ws + (dir ? WS_ST : WS_YF));
        for (int step = 0; step < L; ++step) {
            const int row = row0 + (dir ? L - 1 - step : step);
            const float dtv = dt[(size_t)row * 32 + dir * 16 + h]; const float a = __expf(dtv * A);
            const float xd = bf2f(xc[(size_t)row * 1536 + h * 64 + lane]) * dtv;
            const u32x4* Bp = (const u32x4*)(xc + (size_t)row * 1536 + 1024 + g * 64); const u32x4* Cp = (const u32x4*)(xc + (size_t)row * 1536 + 1280 + g * 64);
            float y = 0.f;
#pragma unroll
            for (int q = 0; q < 8; ++q) { const u32x4 bw = Bp[q], cw = Cp[q];
#pragma unroll
                for (int e = 0; e < 4; ++e) { const int n = q * 8 + e * 2;
                    hs[n] = hs[n] * a + xd * bflo(bw[e]); y += bflo(cw[e]) * hs[n];
                    hs[n + 1] = hs[n + 1] * a + xd * bfhi(bw[e]); y += bfhi(cw[e]) * hs[n + 1]; } }
            yo[(size_t)row * 1024 + h * 64 + lane] = y;
        }
        if (!smp) { float* so = P.out + O_SSD + ((((size_t)b * 2 + dir) * 16 + h) * 64 + lane) * 64;
#pragma unroll
            for (int n = 0; n < 64; n += 4) *(f32x4*)(so + n) = (f32x4){hs[n], hs[n + 1], hs[n + 2], hs[n + 3]}; }
    }
}
__device__ __forceinline__ void phase_gate(const Params& P) {
    PHASE_IDS unsigned char* ws = P.ws; const float* yf = (const float*)(ws + WS_YF); const float* yb = (const float*)(ws + WS_ST);
    const bf16_t* xc = (const bf16_t*)(ws + WS_XC); bf16_t* z = (bf16_t*)(ws + WS_Z); float* ssq = (float*)(ws + WS_SSQ_Y);
    const int gw = blockIdx.x * 8 + wave, NGW = G * 8;
    for (int row = gw; row < R; row += NGW) {
#pragma unroll
        for (int j = 0; j < 4; ++j) { const int c = 4 * lane + 256 * j, h = c >> 6; const float Dh = P.in[I_SSDD][h];
            const f32x4 zz = ld_bf4(z + (size_t)row * 1024 + c), xx = ld_bf4(xc + (size_t)row * 1536 + c);
            f32x4 v = *(const f32x4*)(yf + (size_t)row * 1024 + c) + *(const f32x4*)(yb + (size_t)row * 1024 + c) + xx * Dh;
            v = v * (f32x4){siluf(zz.x), siluf(zz.y), siluf(zz.z), siluf(zz.w)};
            float s = (v.x * v.x + v.y * v.y) + (v.z * v.z + v.w * v.w);
            s += __shfl_xor(s, 1); s += __shfl_xor(s, 2); s += __shfl_xor(s, 4); s += __shfl_xor(s, 8);
            st_bf4(z + (size_t)row * 1024 + c, v);
            if ((lane & 15) == 0) ssq[(size_t)row * 16 + h] = s; }
    }
}
__device__ __forceinline__ void phase_attn_naive(const Params& P, LAS unsigned char* lds) {
    PHASE_IDS unsigned char* ws = P.ws; bf16_t* qn = (bf16_t*)(ws + WS_QN); const bf16_t* qr = (const bf16_t*)(ws + WS_QR);
    const bf16_t* kv = (const bf16_t*)(ws + WS_KV); const bf16_t* kr = (const bf16_t*)(ws + WS_KROPE);
    LAS float* qs = (LAS float*)lds + wave * 192;
    const int gw = blockIdx.x * 8 + wave, NGW = G * 8;
    for (int task = gw; task < R * NH; task += NGW) {
        const int rr = task >> 3, h = task & 7; const int row = rr < RS ? RP + rr : rr - RS;
        int kv0, nk; if (row < RP) { kv0 = (row >> 8) * SEQP; nk = SEQP; } else { kv0 = RP + ((row - RP) >> 11) * KVS; nk = KVS; }
        qs[lane] = bf2f(qn[(size_t)row * 1024 + h * 128 + lane]); qs[64 + lane] = bf2f(qn[(size_t)row * 1024 + h * 128 + 64 + lane]);
        qs[128 + lane] = bf2f(qr[(size_t)row * 512 + h * 64 + lane]);
        LDS_WAIT(); asm volatile("" ::: "memory");
        float m = -1e30f, l = 0.f, o0 = 0.f, o1 = 0.f;
        for (int k0 = 0; k0 < nk; k0 += 64) {
            const size_t krow = (size_t)(kv0 + k0 + lane);
            const u32x4* kp = (const u32x4*)(kv + krow * 2048 + h * 256); const u32x4* rp = (const u32x4*)(kr + krow * 64);
            float s = 0.f;
#pragma unroll 4
            for (int q = 0; q < 16; ++q) { const u32x4 w = kp[q];
#pragma unroll
                for (int e = 0; e < 4; ++e) s += qs[q * 8 + e * 2] * bflo(w[e]) + qs[q * 8 + e * 2 + 1] * bfhi(w[e]); }
#pragma unroll 4
            for (int q = 0; q < 8; ++q) { const u32x4 w = rp[q];
#pragma unroll
                for (int e = 0; e < 4; ++e) s += qs[128 + q * 8 + e * 2] * bflo(w[e]) + qs[128 + q * 8 + e * 2 + 1] * bfhi(w[e]); }
            s *= ATT_SCALE;
            const float mn = fmaxf(m, wave_max(s)); const float p = __expf(s - mn), al = __expf(m - mn);
            l = l * al + wave_sum(p); o0 *= al; o1 *= al; m = mn;
            const bf16_t* vp = kv + (size_t)(kv0 + k0) * 2048 + h * 256 + 128;
#pragma unroll 8
            for (int j = 0; j < 64; ++j) { const float pj = __shfl(p, j); o0 += pj * bf2f(vp[(size_t)j * 2048 + lane]); o1 += pj * bf2f(vp[(size_t)j * 2048 + 64 + lane]); }
        }
        const float il = 1.f / l;
        qn[(size_t)row * 1024 + h * 128 + lane] = (bf16_t)f2bf(o0 * il); qn[(size_t)row * 1024 + h * 128 + 64 + lane] = (bf16_t)f2bf(o1 * il);
        asm volatile("" ::: "memory");
    }
}
namespace att {
using s16x4 = __attribute__((ext_vector_type(4))) short;
using f32x16 = __attribute__((ext_vector_type(16))) float;
constexpr int QBLK = 32, KVBLK = 64;
constexpr float SCALE = ATT_SCALE, THR = 8.f;
constexpr int SHM_V = 16384, SHM_K = 16384, SHM_KR = 8192;
constexpr int L_V = 0, L_K = 2 * SHM_V, L_KR = L_K + 2 * SHM_K, L_WS = L_KR + 2 * SHM_KR, L_QR = L_WS + 8 * 64 * 4, L_END = L_QR + 8 * 4096;
#define KSWZ(row, colB) ((row) * 256 + ((colB) ^ (((row) & 7) << 4)))
#define KRSWZ(row, colB) ((row) * 128 + ((colB) ^ ((((row) >> 1) & 7) << 4)))
#define SBAR() __builtin_amdgcn_sched_barrier(0)
__device__ __forceinline__ int crow(int r, int hi) { return (r & 3) + 8 * (r >> 2) + 4 * hi; }
__device__ __forceinline__ unsigned cvtpk(float lo, float hi) { unsigned r; asm volatile("v_cvt_pk_bf16_f32 %0, %1, %2" : "=v"(r) : "v"(lo), "v"(hi)); return r; }
__device__ __forceinline__ void partialSM(f32x16& p0, f32x16& p1, float& m_reg, float& mn, float& alpha) {
  constexpr float C = SCALE * 1.4426950408889634f;
  float pmax = p0[0];
#pragma unroll
  for (int r = 1; r < 16; ++r) pmax = fmaxf(pmax, p0[r]);
#pragma unroll
  for (int r = 0; r < 16; ++r) pmax = fmaxf(pmax, p1[r]);
  { auto rr = __builtin_amdgcn_permlane32_swap(__float_as_uint(pmax), __float_as_uint(pmax), false, false);
    pmax = fmaxf(__uint_as_float(rr[0]), __uint_as_float(rr[1])); }
  if (__builtin_expect(__all(pmax - m_reg <= THR / SCALE), 1)) { mn = m_reg; alpha = 1.f; }
  else { mn = fmaxf(m_reg, pmax); alpha = __builtin_amdgcn_exp2f((m_reg - mn) * C); m_reg = mn; }
  float mnC = -mn * C;
#pragma unroll
  for (int r = 0; r < 16; ++r) p0[r] = fmaf(p0[r], C, mnC);
#pragma unroll
  for (int r = 0; r < 16; ++r) p1[r] = fmaf(p1[r], C, mnC);
#pragma unroll
  for (int r = 0; r < 16; ++r) p0[r] = __builtin_amdgcn_exp2f(p0[r]);
}
__device__ __forceinline__ void finishSM(f32x16& p0, f32x16& p1, float alpha, float& l_reg, bf16x8& pa0, bf16x8& pa1, bf16x8& pa2, bf16x8& pa3) {
#pragma unroll
  for (int r = 0; r < 16; ++r) p1[r] = __builtin_amdgcn_exp2f(p1[r]);
  float ps = 0;
#pragma unroll
  for (int r = 0; r < 16; ++r) ps += p0[r];
#pragma unroll
  for (int r = 0; r < 16; ++r) ps += p1[r];
  { auto rr = __builtin_amdgcn_permlane32_swap(__float_as_uint(ps), __float_as_uint(ps), false, false);
    ps = __uint_as_float(rr[0]) + __uint_as_float(rr[1]); }
  l_reg = l_reg * alpha + ps;
#define PK4(P, BASE, OUT) do { unsigned a0 = cvtpk(P[BASE + 0], P[BASE + 1]), a1 = cvtpk(P[BASE + 2], P[BASE + 3]);   \
    unsigned b0 = cvtpk(P[BASE + 4], P[BASE + 5]), b1 = cvtpk(P[BASE + 6], P[BASE + 7]);                              \
    auto r0 = __builtin_amdgcn_permlane32_swap(a0, b0, false, false); auto r1 = __builtin_amdgcn_permlane32_swap(a1, b1, false, false); \
    u32x4 w = {r0[0], r1[0], r0[1], r1[1]}; OUT = *reinterpret_cast<bf16x8*>(&w); } while (0)
  PK4(p0, 0, pa0); PK4(p0, 8, pa1); PK4(p1, 0, pa2); PK4(p1, 8, pa3);
#undef PK4
}
__device__ __forceinline__ void qkt(f32x16& p0, f32x16& p1, const LAS char* Ks, const LAS char* Krs, const bf16x8* qr, const LAS char* qrl, int r32, int hi) {
  p0 = f32x16{}; p1 = f32x16{};
#pragma unroll
  for (int d0 = 0; d0 < 8; ++d0) { const int cb = (d0 * 16 + hi * 8) * 2;
    const bf16x8 b0 = *reinterpret_cast<const LAS bf16x8*>(Ks + KSWZ(r32, cb));
    const bf16x8 b1 = *reinterpret_cast<const LAS bf16x8*>(Ks + KSWZ(32 + r32, cb));
    p0 = __builtin_amdgcn_mfma_f32_32x32x16_bf16(b0, qr[d0], p0, 0, 0, 0);
    p1 = __builtin_amdgcn_mfma_f32_32x32x16_bf16(b1, qr[d0], p1, 0, 0, 0); }
#pragma unroll
  for (int d0 = 0; d0 < 4; ++d0) { const int cb = (d0 * 16 + hi * 8) * 2;
    const bf16x8 b0 = *reinterpret_cast<const LAS bf16x8*>(Krs + KRSWZ(r32, cb));
    const bf16x8 b1 = *reinterpret_cast<const LAS bf16x8*>(Krs + KRSWZ(32 + r32, cb));
    const bf16x8 qq = *reinterpret_cast<const LAS bf16x8*>(qrl + d0 * 1024);
    p0 = __builtin_amdgcn_mfma_f32_32x32x16_bf16(b0, qq, p0, 0, 0, 0);
    p1 = __builtin_amdgcn_mfma_f32_32x32x16_bf16(b1, qq, p1, 0, 0, 0); }
}
__device__ __forceinline__ int v_st(int k, int c) { const int kk = (k & ~0xC) | ((k & 4) << 1) | ((k & 8) >> 1); return ((kk >> 3) * 4 + (c >> 5)) * 512 + ((kk & 7) * 32 + (c & 31)) * 2; }
__device__ __forceinline__ int v_rd_base(int lane) { return ((lane & 3) << 3) | (((lane >> 2) & 3) << 6) | (((lane >> 4) & 1) << 5) | (((lane >> 5) & 1) << 8); }
constexpr int v_rd_off(int d0, int ks, int half) { return d0 * 512 + ks * 4096 + half * 2048; }
template <int OFF> __device__ __forceinline__ s16x4 tr_read(int vb) {
  s16x4 r; asm volatile("ds_read_b64_tr_b16 %0, %1 offset:%2" : "=&v"(r) : "v"(vb), "i"(OFF) : "memory"); return r;
}
template <int D0> __device__ __forceinline__ void pv_one(f32x16& od, int vb, bf16x8 pa0, bf16x8 pa1, bf16x8 pa2, bf16x8 pa3) {
  const s16x4 l0 = tr_read<v_rd_off(D0, 0, 0)>(vb), h0 = tr_read<v_rd_off(D0, 0, 1)>(vb), l1 = tr_read<v_rd_off(D0, 1, 0)>(vb), h1 = tr_read<v_rd_off(D0, 1, 1)>(vb);
  const s16x4 l2 = tr_read<v_rd_off(D0, 2, 0)>(vb), h2 = tr_read<v_rd_off(D0, 2, 1)>(vb), l3 = tr_read<v_rd_off(D0, 3, 0)>(vb), h3 = tr_read<v_rd_off(D0, 3, 1)>(vb);
  asm volatile("s_waitcnt lgkmcnt(0)" ::: "memory"); SBAR();
#define PK(L, H) (bf16x8){L[0], L[1], L[2], L[3], H[0], H[1], H[2], H[3]}
  od = __builtin_amdgcn_mfma_f32_32x32x16_bf16(pa0, PK(l0, h0), od, 0, 0, 0);
  od = __builtin_amdgcn_mfma_f32_32x32x16_bf16(pa1, PK(l1, h1), od, 0, 0, 0);
  od = __builtin_amdgcn_mfma_f32_32x32x16_bf16(pa2, PK(l2, h2), od, 0, 0, 0);
  od = __builtin_amdgcn_mfma_f32_32x32x16_bf16(pa3, PK(l3, h3), od, 0, 0, 0);
#undef PK
}
__device__ __forceinline__ void pv_d0(f32x16* o, int vb, bf16x8 pa0, bf16x8 pa1, bf16x8 pa2, bf16x8 pa3) {
  pv_one<0>(o[0], vb, pa0, pa1, pa2, pa3); pv_one<1>(o[1], vb, pa0, pa1, pa2, pa3); pv_one<2>(o[2], vb, pa0, pa1, pa2, pa3); pv_one<3>(o[3], vb, pa0, pa1, pa2, pa3);
}
__device__ __forceinline__ void attn_unit(const bf16_t* __restrict__ Qn, const bf16_t* __restrict__ Qr, const bf16_t* __restrict__ Kh, const bf16_t* __restrict__ Vh,
                                          const bf16_t* __restrict__ Krh, bf16_t* Ob, int seq, LAS char* lds, int tid) {
  constexpr int LDQ = 1024, LDQR = 512, LDK = 2048, LDKR = 64, LDO = 1024;
  const int wid = tid >> 6, lane = tid & 63, r32 = lane & 31, hi = lane >> 5;
  LAS char* V_lds = lds + L_V; LAS char* K_lds = lds + L_K; LAS char* KR_lds = lds + L_KR;
  LAS float* wsf = (LAS float*)(lds + L_WS) + wid * 64; LAS float* li_l = wsf; LAS float* al_l = wsf + 32;
  float m_reg = -1e30f, l_reg = 0; f32x16 o[4] = {}; bf16x8 qr[8];
  LAS char* qrl = lds + L_QR + wid * 4096 + lane * 16;
  { const unsigned qo = (unsigned)((wid * QBLK + r32) * LDQ + hi * 8);
#pragma unroll
    for (int d0 = 0; d0 < 8; ++d0) qr[d0] = *reinterpret_cast<const bf16x8*>(Qn + (qo + d0 * 16));
    const unsigned qo2 = (unsigned)((wid * QBLK + r32) * LDQR + hi * 8);
#pragma unroll
    for (int d0 = 0; d0 < 4; ++d0) *reinterpret_cast<LAS bf16x8*>(qrl + d0 * 1024) = *reinterpret_cast<const bf16x8*>(Qr + (qo2 + d0 * 16)); }
  const int sr = tid >> 4, sc = (tid & 15) * 8, vst0 = v_st(sr, sc), vst1 = v_st(32 + sr, sc);
  const int rr_ = tid >> 3, rc_ = (tid & 7) * 8, krst = KRSWZ(rr_, rc_ * 2);
  const int vb0 = (int)(unsigned)(uintptr_t)V_lds + v_rd_base(lane);
  constexpr int SDEPTH = 1;
  struct { bf16x8 vs0, vs1, ks0, ks1, kr; } sr_[SDEPTH];
  const unsigned kvo = (unsigned)(sr * LDK + sc), kro = (unsigned)(rr_ * LDKR + rc_);
#define SLOAD(i, k0) do { const bf16_t* vp_ = Vh + (size_t)(k0) * LDK; const bf16_t* kp_ = Kh + (size_t)(k0) * LDK; const bf16_t* rp_ = Krh + (size_t)(k0) * LDKR; \
    sr_[i].vs0 = *reinterpret_cast<const bf16x8*>(vp_ + kvo); sr_[i].vs1 = *reinterpret_cast<const bf16x8*>(vp_ + (kvo + 32u * LDK)); \
    sr_[i].ks0 = *reinterpret_cast<const bf16x8*>(kp_ + kvo); sr_[i].ks1 = *reinterpret_cast<const bf16x8*>(kp_ + (kvo + 32u * LDK)); \
    sr_[i].kr = *reinterpret_cast<const bf16x8*>(rp_ + kro); } while (0)
#define SWRITE(b, i) do { *(LAS bf16x8*)(V_lds + (b) * SHM_V + vst0) = sr_[i].vs0; *(LAS bf16x8*)(V_lds + (b) * SHM_V + vst1) = sr_[i].vs1; const int kc = sc * 2; \
    *(LAS bf16x8*)(K_lds + (b) * SHM_K + KSWZ(sr, kc)) = sr_[i].ks0; *(LAS bf16x8*)(K_lds + (b) * SHM_K + KSWZ(32 + sr, kc)) = sr_[i].ks1; \
    *(LAS bf16x8*)(KR_lds + (b) * SHM_KR + krst) = sr_[i].kr; } while (0)
#define SWAIT() do { if constexpr (SDEPTH == 2) asm volatile("s_waitcnt vmcnt(5)" ::: "memory"); else asm volatile("s_waitcnt vmcnt(0)" ::: "memory"); } while (0)
#define RESC(a) do { if (__any((a) < 1.f)) { if (hi == 0) al_l[r32] = (a); asm volatile("s_waitcnt lgkmcnt(0)" ::: "memory"); \
    _Pragma("unroll") for (int d = 0; d < 4; ++d) _Pragma("unroll") for (int r = 0; r < 16; ++r) o[d][r] *= al_l[crow(r, hi)]; } } while (0)
  f32x16 pA0, pA1, pB0, pB1; float mnA, mnB, alA, alB; bf16x8 pa0, pa1, pa2, pa3; const int NTL = seq / KVBLK;
  constexpr int SE = 0, SO = SDEPTH - 1;
  SLOAD(SE, 0); asm volatile("s_waitcnt vmcnt(0)" ::: "memory"); SWRITE(0, SE); __syncthreads();
  qkt(pA0, pA1, K_lds, KR_lds, qr, qrl, r32, hi); partialSM(pA0, pA1, m_reg, mnA, alA);
  SLOAD(SO, KVBLK); if constexpr (SDEPTH == 2) { if (2 < NTL) SLOAD(SE, 2 * KVBLK); }
  SWAIT(); SWRITE(1, SO); __syncthreads();
  for (int j = 1; j + 1 < NTL; j += 2) {
    SBAR(); qkt(pB0, pB1, K_lds + SHM_K, KR_lds + SHM_KR, qr, qrl, r32, hi);
    finishSM(pA0, pA1, alA, l_reg, pa0, pa1, pa2, pa3); SBAR();
    SLOAD(SO, (j + SDEPTH) * KVBLK); SBAR();
    pv_d0(o, vb0, pa0, pa1, pa2, pa3); partialSM(pB0, pB1, m_reg, mnB, alB);
    __syncthreads(); SWAIT(); SWRITE(0, SE);
    RESC(alB); __syncthreads();
    SBAR(); qkt(pA0, pA1, K_lds, KR_lds, qr, qrl, r32, hi);
    finishSM(pB0, pB1, alB, l_reg, pa0, pa1, pa2, pa3); SBAR();
    if (SDEPTH == 1 || j + 3 < NTL) SLOAD(SE, (j + 1 + SDEPTH) * KVBLK); SBAR();
    pv_d0(o, vb0 + SHM_V, pa0, pa1, pa2, pa3); partialSM(pA0, pA1, m_reg, mnA, alA);
    __syncthreads(); SWAIT(); SWRITE(1, SO);
    RESC(alA); __syncthreads();
  }
  SBAR(); qkt(pB0, pB1, K_lds + SHM_K, KR_lds + SHM_KR, qr, qrl, r32, hi);
  finishSM(pA0, pA1, alA, l_reg, pa0, pa1, pa2, pa3); SBAR();
  pv_d0(o, vb0, pa0, pa1, pa2, pa3); partialSM(pB0, pB1, m_reg, mnB, alB);
  __syncthreads(); RESC(alB);
  finishSM(pB0, pB1, alB, l_reg, pa0, pa1, pa2, pa3); SBAR();
  pv_d0(o, vb0 + SHM_V, pa0, pa1, pa2, pa3);
  if (hi == 0) li_l[r32] = l_reg; asm volatile("s_waitcnt lgkmcnt(0)" ::: "memory");
  float rli[16];
#pragma unroll
  for (int r = 0; r < 16; ++r) rli[r] = __builtin_amdgcn_rcpf(li_l[crow(r, hi)]);
#pragma unroll
  for (int r = 0; r < 16; ++r) { const unsigned oo = (unsigned)((wid * QBLK + crow(r, hi)) * LDO + r32);
#pragma unroll
    for (int d0 = 0; d0 < 4; ++d0) Ob[oo + d0 * 32] = (bf16_t)f2bf(o[d0][r] * rli[r]); }
  __syncthreads();
#undef SLOAD
#undef SWRITE
#undef SWAIT
#undef RESC
}
}

__device__ __forceinline__ void phase_attn(const Params& P, LAS unsigned char* lds) {
    PHASE_IDS unsigned char* ws = P.ws; bf16_t* qn = (bf16_t*)(ws + WS_QN); const bf16_t* qr = (const bf16_t*)(ws + WS_QR);
    const bf16_t* kv = (const bf16_t*)(ws + WS_KV); const bf16_t* kr = (const bf16_t*)(ws + WS_KROPE);
    for (int u = blockIdx.x; u < 384; u += G) {
        int row0, kv0, h, seq;
        if (u < 128) { const int x = u & 7, k = u >> 3, bh = x + 8 * (k >> 3), qb = k & 7, b = bh >> 3; h = bh & 7; row0 = RP + b * SEQS + qb * 256; kv0 = RP + b * KVS; seq = KVS; }
        else { const int q = u - 128, b = q >> 3; h = q & 7; row0 = b * SEQP; kv0 = row0; seq = SEQP; }
        int t2 = tid; asm volatile("" : "+v"(t2));
        att::attn_unit(qn + (size_t)row0 * 1024 + h * 128, qr + (size_t)row0 * 512 + h * 64, kv + (size_t)kv0 * 2048 + h * 256, kv + (size_t)kv0 * 2048 + h * 256 + 128,
                       kr + (size_t)kv0 * 64, qn + (size_t)row0 * 1024 + h * 128, seq, (LAS char*)lds, t2);
    }
}
namespace ssd {
typedef short v4i16_t __attribute__((ext_vector_type(4)));
constexpr int RSB = 144;
constexpr int TB = 128 * RSB;
constexpr int L_X = 0, L_B = TB, L_C = 2 * TB, L_HF = 3 * TB, L_HB = 3 * TB + 64 * RSB, L_ARR = 3 * TB + 128 * RSB, L_SC = L_ARR + 2048, L_END = L_SC + 64;
struct UnitInfo { int b, c, h, nc, row0; bool smp; };
__device__ __forceinline__ UnitInfo decode(int u) { UnitInfo I; if (u < 512) { I.smp = true; I.b = u >> 8; I.c = (u >> 4) & 15; I.h = u & 15; I.nc = 16; I.row0 = RP + I.b * SEQS + I.c * 128; }
    else { const int q = u - 512; I.smp = false; I.b = q >> 5; I.c = (q >> 4) & 1; I.h = q & 15; I.nc = 2; I.row0 = I.b * SEQP + I.c * 128; } return I; }
__device__ __forceinline__ int unit_id(bool smp, int b, int c, int h) { return smp ? ((b * 16 + c) * 16 + h) : 512 + ((b * 2 + c) * 16 + h); }
__device__ __forceinline__ bf16x8 tr2(const LAS char* p0, const LAS char* p1) {
    const v4i16_t a = __builtin_amdgcn_ds_read_tr16_b64_v4i16((LAS v4i16_t*)p0), b = __builtin_amdgcn_ds_read_tr16_b64_v4i16((LAS v4i16_t*)p1);
    return (bf16x8){a[0], a[1], a[2], a[3], b[0], b[1], b[2], b[3]};
}
__device__ __forceinline__ float wave_incl_scan(float v, int lane) {
#pragma unroll
    for (int o = 1; o < 64; o <<= 1) { const float t = __shfl_up(v, o); if (lane >= o) v += t; }
    return v;
}
__device__ __forceinline__ void chunk_scalars(const float* dt, int row0, int h, float Af, float Ab, LAS f32x4* arr, LAS float* sc, int lane) {
    const float df0 = dt[(size_t)(row0 + lane) * 32 + h], df1 = dt[(size_t)(row0 + 64 + lane) * 32 + h];
    const float db0 = dt[(size_t)(row0 + lane) * 32 + 16 + h], db1 = dt[(size_t)(row0 + 64 + lane) * 32 + 16 + h];
    const float af0 = df0 * Af, af1 = df1 * Af, ab0 = db0 * Ab, ab1 = db1 * Ab;
    const float s0 = wave_incl_scan(af0, lane), t0 = __shfl(s0, 63), s1 = wave_incl_scan(af1, lane) + t0;
    const float r0 = wave_incl_scan(ab0, lane), u0 = __shfl(r0, 63), r1 = wave_incl_scan(ab1, lane) + u0, tot = __shfl(r1, 63);
    arr[lane] = (f32x4){s0, tot - (r0 - ab0), df0, db0};
    arr[64 + lane] = (f32x4){s1, tot - (r1 - ab1), df1, db1};
    if (lane == 63) { sc[0] = s1; sc[1] = tot; }
}
__device__ __forceinline__ void pass_a_unit(const Params& P, int u, LAS char* lds, int tid) {
    unsigned char* ws = P.ws; const bf16_t* xc = (const bf16_t*)(ws + WS_XC); const float* dt = (const float*)(ws + WS_DT);
    const int lane = tid & 63, wave = tid >> 6; const UnitInfo I = decode(u); const int g = I.h >> 2;
    LAS f32x4* arr = (LAS f32x4*)(lds + L_ARR); LAS float* sc = (LAS float*)(lds + L_SC);
    const float Af = -__expf(P.in[I_ALOG][I.h]), Ab = -__expf(P.in[I_ALOG][16 + I.h]);
    if (wave == 0) chunk_scalars(dt, I.row0, I.h, Af, Ab, arr, sc, lane);
    __syncthreads();
    { const int r = tid >> 2, c0 = (tid & 3) * 16; const f32x4 a = arr[r]; const float totf = sc[0], totb = sc[1];
      const float wf = a.z * __expf(totf - a.x), wb = a.w * __expf(totb - a.y);
      const bf16_t* xr = xc + (size_t)(I.row0 + r) * 1536;
#pragma unroll
      for (int q = 0; q < 2; ++q) { const int cc = c0 + q * 8;
          const u32x4 xv = *(const u32x4*)(xr + I.h * 64 + cc); const u32x4 bv = *(const u32x4*)(xr + 1024 + g * 64 + cc);
          u32x4 of, ob;
#pragma unroll
          for (int e = 0; e < 4; ++e) { const float lo = bflo(xv[e]), hi = bfhi(xv[e]); of[e] = pk2(lo * wf, hi * wf); ob[e] = pk2(lo * wb, hi * wb); }
          *(LAS u32x4*)(lds + L_X + r * RSB + cc * 2) = of; *(LAS u32x4*)(lds + L_C + r * RSB + cc * 2) = ob; *(LAS u32x4*)(lds + L_B + r * RSB + cc * 2) = bv; } }
    __syncthreads();
    { const int d = wave >> 2, pt = wave & 3, gq = lane >> 4, q4 = (lane >> 2) & 3, p4 = lane & 3;
      const LAS char* xb = lds + (d ? L_C : L_X) + (8 * gq + q4) * RSB + (16 * pt + 4 * p4) * 2;
      const LAS char* bb = lds + L_B + (8 * gq + q4) * RSB + (4 * p4) * 2;
      f32x4 acc[4] = {};
#pragma unroll
      for (int s4 = 0; s4 < 4; ++s4) { const bf16x8 af = tr2(xb + s4 * 32 * RSB, xb + s4 * 32 * RSB + 4 * RSB);
#pragma unroll
          for (int nt = 0; nt < 4; ++nt) { const bf16x8 bf = tr2(bb + s4 * 32 * RSB + nt * 32, bb + s4 * 32 * RSB + 4 * RSB + nt * 32);
              acc[nt] = __builtin_amdgcn_mfma_f32_16x16x32_bf16(af, bf, acc[nt], 0, 0, 0); } }
      float* So = (float*)(ws + WS_ST) + ((size_t)u * 2 + d) * 4096;
#pragma unroll
      for (int nt = 0; nt < 4; ++nt)
#pragma unroll
          for (int r = 0; r < 4; ++r) So[(16 * pt + 4 * gq + r) * 64 + nt * 16 + (lane & 15)] = acc[nt][r];
    }
    if (tid == 0) { float* dec = (float*)(ws + WS_DEC) + (size_t)u * 2; dec[0] = __expf(sc[0]); dec[1] = __expf(sc[1]); }
    __syncthreads();
}
__device__ __forceinline__ void pass_b_unit(const Params& P, int u, LAS char* lds, int tid) {
    unsigned char* ws = P.ws; const bf16_t* xc = (const bf16_t*)(ws + WS_XC); const float* dt = (const float*)(ws + WS_DT);
    const float* ST = (const float*)(ws + WS_ST); const float* DEC = (const float*)(ws + WS_DEC);
    const int lane = tid & 63, wave = tid >> 6; const UnitInfo I = decode(u); const int g = I.h >> 2;
    LAS f32x4* arr = (LAS f32x4*)(lds + L_ARR); LAS float* sc = (LAS float*)(lds + L_SC);
    const float Af = -__expf(P.in[I_ALOG][I.h]), Ab = -__expf(P.in[I_ALOG][16 + I.h]);
    if (wave == 0) chunk_scalars(dt, I.row0, I.h, Af, Ab, arr, sc, lane);
    { const int r = tid >> 2, c0 = (tid & 3) * 16; const bf16_t* xr = xc + (size_t)(I.row0 + r) * 1536;
#pragma unroll
      for (int q = 0; q < 2; ++q) { const int cc = c0 + q * 8;
          *(LAS u32x4*)(lds + L_X + r * RSB + cc * 2) = *(const u32x4*)(xr + I.h * 64 + cc);
          *(LAS u32x4*)(lds + L_B + r * RSB + cc * 2) = *(const u32x4*)(xr + 1024 + g * 64 + cc);
          *(LAS u32x4*)(lds + L_C + r * RSB + cc * 2) = *(const u32x4*)(xr + 1280 + g * 64 + cc); } }
    { const int p = tid >> 3, n0 = (tid & 7) * 8; const size_t eo = (size_t)p * 64 + n0;
      f32x4 hf0, hf1, hb0, hb1;
      if (I.smp) { const float* h0 = P.in[I_SSD] + (((size_t)I.b * 2 + 0) * 16 + I.h) * 4096 + eo; hf0 = *(const f32x4*)h0; hf1 = *(const f32x4*)(h0 + 4);
                   const float* h1 = P.in[I_SSD] + (((size_t)I.b * 2 + 1) * 16 + I.h) * 4096 + eo; hb0 = *(const f32x4*)h1; hb1 = *(const f32x4*)(h1 + 4); }
      else { hf0 = hf1 = hb0 = hb1 = (f32x4){0.f, 0.f, 0.f, 0.f}; }
      for (int cc = 0; cc < I.c; ++cc) { const int uu = unit_id(I.smp, I.b, cc, I.h); const float d = DEC[(size_t)uu * 2]; const float* sp = ST + ((size_t)uu * 2) * 4096 + eo;
          hf0 = hf0 * d + *(const f32x4*)sp; hf1 = hf1 * d + *(const f32x4*)(sp + 4); }
      for (int cc = I.nc - 1; cc > I.c; --cc) { const int uu = unit_id(I.smp, I.b, cc, I.h); const float d = DEC[(size_t)uu * 2 + 1]; const float* sp = ST + ((size_t)uu * 2 + 1) * 4096 + eo;
          hb0 = hb0 * d + *(const f32x4*)sp; hb1 = hb1 * d + *(const f32x4*)(sp + 4); }
      *(LAS u32x4*)(lds + L_HF + p * RSB + n0 * 2) = (u32x4){pk2(hf0.x, hf0.y), pk2(hf0.z, hf0.w), pk2(hf1.x, hf1.y), pk2(hf1.z, hf1.w)};
      *(LAS u32x4*)(lds + L_HB + p * RSB + n0 * 2) = (u32x4){pk2(hb0.x, hb0.y), pk2(hb0.z, hb0.w), pk2(hb1.x, hb1.y), pk2(hb1.z, hb1.w)};
      if (!I.smp) {
          if (I.c == I.nc - 1) { const float d = DEC[(size_t)u * 2]; const float* sp = ST + ((size_t)u * 2) * 4096 + eo; float* o = P.out + O_SSD + (((size_t)I.b * 2 + 0) * 16 + I.h) * 4096 + eo;
              *(f32x4*)o = hf0 * d + *(const f32x4*)sp; *(f32x4*)(o + 4) = hf1 * d + *(const f32x4*)(sp + 4); }
          if (I.c == 0) { const float d = DEC[(size_t)u * 2 + 1]; const float* sp = ST + ((size_t)u * 2 + 1) * 4096 + eo; float* o = P.out + O_SSD + (((size_t)I.b * 2 + 1) * 16 + I.h) * 4096 + eo;
              *(f32x4*)o = hb0 * d + *(const f32x4*)sp; *(f32x4*)(o + 4) = hb1 * d + *(const f32x4*)(sp + 4); } } }
    __syncthreads();
    const int i0 = 16 * wave, li = lane & 15, gq = lane >> 4, q4 = (lane >> 2) & 3, p4 = lane & 3, ii = i0 + li;
    bf16x8 cf[2];
#pragma unroll
    for (int ks = 0; ks < 2; ++ks) cf[ks] = *(const LAS bf16x8*)(lds + L_C + ii * RSB + (8 * gq + 32 * ks) * 2);
    const f32x4 ai = arr[ii];
    bf16x8 pf[4];
#pragma unroll
    for (int s4 = 0; s4 < 4; ++s4) {
        unsigned pk[4];
#pragma unroll
        for (int half = 0; half < 2; ++half) { const int t = 2 * s4 + half, jb = 16 * t + 4 * gq;
            f32x4 sacc = {0.f, 0.f, 0.f, 0.f};
#pragma unroll
            for (int ks = 0; ks < 2; ++ks) { const bf16x8 bfr = *(const LAS bf16x8*)(lds + L_B + (16 * t + li) * RSB + (8 * gq + 32 * ks) * 2);
                sacc = __builtin_amdgcn_mfma_f32_16x16x32_bf16(bfr, cf[ks], sacc, 0, 0, 0); }
            float m[4];
#pragma unroll
            for (int r = 0; r < 4; ++r) { const int j = jb + r; const f32x4 aj = arr[j];
                const bool lower = j < ii; const float arg = lower ? ai.x - aj.x : ai.y - aj.y; const float w = lower ? aj.z : aj.w;
                float mm = __expf(arg) * w; if (j == ii) mm = ai.z + ai.w; m[r] = sacc[r] * mm; }
            pk[half * 2 + 0] = pk2(m[0], m[1]); pk[half * 2 + 1] = pk2(m[2], m[3]); }
        const u32x4 w4 = {pk[0], pk[1], pk[2], pk[3]}; pf[s4] = *reinterpret_cast<const bf16x8*>(&w4);
    }
    const float ef = __expf(ai.x), eb = __expf(ai.y), Dh = P.in[I_SSDD][I.h];
    bf16_t* zrow = (bf16_t*)(ws + WS_Z) + (size_t)(I.row0 + ii) * 1024 + I.h * 64;
    float ssq = 0.f;
#pragma unroll
    for (int pt = 0; pt < 4; ++pt) {
        f32x4 yd = {0.f, 0.f, 0.f, 0.f}, yf = {0.f, 0.f, 0.f, 0.f}, yb = {0.f, 0.f, 0.f, 0.f};
#pragma unroll
        for (int s4 = 0; s4 < 4; ++s4) { const LAS char* xb = lds + L_X + (32 * s4 + 4 * gq + q4) * RSB + (16 * pt + 4 * p4) * 2;
            const bf16x8 xf = tr2(xb, xb + 16 * RSB);
            yd = __builtin_amdgcn_mfma_f32_16x16x32_bf16(xf, pf[s4], yd, 0, 0, 0); }
#pragma unroll
        for (int ks = 0; ks < 2; ++ks) { const bf16x8 hfr = *(const LAS bf16x8*)(lds + L_HF + (16 * pt + li) * RSB + (8 * gq + 32 * ks) * 2);
            const bf16x8 hbr = *(const LAS bf16x8*)(lds + L_HB + (16 * pt + li) * RSB + (8 * gq + 32 * ks) * 2);
            yf = __builtin_amdgcn_mfma_f32_16x16x32_bf16(hfr, cf[ks], yf, 0, 0, 0);
            yb = __builtin_amdgcn_mfma_f32_16x16x32_bf16(hbr, cf[ks], yb, 0, 0, 0); }
        const int pc = 16 * pt + 4 * gq;
        const u32x2 xw = *(const LAS u32x2*)(lds + L_X + ii * RSB + pc * 2);
        const f32x4 xx = {bflo(xw.x), bfhi(xw.x), bflo(xw.y), bfhi(xw.y)};
        const f32x4 zz = ld_bf4(zrow + pc);
        f32x4 y = yd + yf * ef + yb * eb + xx * Dh;
        y = y * (f32x4){siluf(zz.x), siluf(zz.y), siluf(zz.z), siluf(zz.w)};
        ssq += (y.x * y.x + y.y * y.y) + (y.z * y.z + y.w * y.w);
        st_bf4(zrow + pc, y);
    }
    ssq += __shfl_xor(ssq, 16); ssq += __shfl_xor(ssq, 32);
    if (gq == 0) ((float*)(ws + WS_SSQ_Y))[(size_t)(I.row0 + ii) * 16 + I.h] = ssq;
    __syncthreads();
}
}

__device__ __forceinline__ f32x4 conv3_at(const bf16_t* u, int row, int t, int L, int c, const float* fw, const float* fb) {
    f32x4 a = *(const f32x4*)(fb + c);
    if (t > 0) a += ld_bf4(u + (size_t)(row - 1) * UPN + c) * *(const f32x4*)(fw + c);
    a += ld_bf4(u + (size_t)row * UPN + c) * *(const f32x4*)(fw + UPN + c);
    if (t < L - 1) a += ld_bf4(u + (size_t)(row + 1) * UPN + c) * *(const f32x4*)(fw + 2 * UPN + c);
    return a;
}
__device__ __forceinline__ void phase_convgate(const Params& P) {
    PHASE_IDS unsigned char* ws = P.ws; const bf16_t* u = (const bf16_t*)(ws + WS_U); bf16_t* ug = (bf16_t*)(ws + WS_UG);
    const float* fw = P.in[I_FCW]; const float* fb = P.in[I_FCB];
    const int gt = blockIdx.x * NT + tid, GT = G * NT;
    for (int i = gt; i < R * (DFF / 4); i += GT) {
        const int row = i / (DFF / 4), c = (i % (DFF / 4)) * 4; const int t = row < RP ? (row & 255) : ((row - RP) & 2047), L = row < RP ? SEQP : SEQS;
        const f32x4 a = conv3_at(u, row, t, L, c, fw, fb), b = conv3_at(u, row, t, L, DFF + c, fw, fb);
        st_bf4(ug + (size_t)row * DFF + c, (f32x4){siluf(a.x), siluf(a.y), siluf(a.z), siluf(a.w)} * b);
    }
}
__device__ __forceinline__ void phase_final(const Params& P) {
    PHASE_IDS const int gw = blockIdx.x * 8 + wave, NGW = G * 8; const float* gf = P.in[I_GFIN];
    for (int row = gw; row < R; row += NGW) {
        f32x4* xr = (f32x4*)(P.out + (size_t)row * DM) + lane; f32x4 v[4]; float s = 0.f;
#pragma unroll
        for (int j = 0; j < 4; ++j) { v[j] = xr[64 * j]; s += (v[j].x * v[j].x + v[j].y * v[j].y) + (v[j].z * v[j].z + v[j].w * v[j].w); }
        const float rs = rsqrtf(wave_sum(s) * (1.f / DM) + EPS);
#pragma unroll
        for (int j = 0; j < 4; ++j) xr[64 * j] = v[j] * rs * *(const f32x4*)(gf + 4 * lane + 256 * j);
    }
}

__device__ __forceinline__ void phase_ssd_a(const Params& P, LAS unsigned char* lds) {
    PHASE_IDS
    for (int u = blockIdx.x; u < 1536; u += G) { int t2 = tid; asm volatile("" : "+v"(t2)); ssd::pass_a_unit(P, u, (LAS char*)lds, t2); }
}
__device__ __forceinline__ void phase_mix(const Params& P, LAS unsigned char* lds) {
    PHASE_IDS unsigned char* ws = P.ws; bf16_t* qn = (bf16_t*)(ws + WS_QN); const bf16_t* qr = (const bf16_t*)(ws + WS_QR);
    const bf16_t* kv = (const bf16_t*)(ws + WS_KV); const bf16_t* kr = (const bf16_t*)(ws + WS_KROPE);
    const int nbA = G / 2, bx = blockIdx.x;
    if (bx < nbA) {
        for (int u = bx; u < 128; u += nbA) {
            const int x = u & 7, k = u >> 3, bh = x + 8 * (k >> 3), qb = k & 7, b = bh >> 3, h = bh & 7, row0 = RP + b * SEQS + qb * 256, kv0 = RP + b * KVS;
            int t2 = tid; asm volatile("" : "+v"(t2));
            att::attn_unit(qn + (size_t)row0 * 1024 + h * 128, qr + (size_t)row0 * 512 + h * 64, kv + (size_t)kv0 * 2048 + h * 256, kv + (size_t)kv0 * 2048 + h * 256 + 128,
                           kr + (size_t)kv0 * 64, qn + (size_t)row0 * 1024 + h * 128, KVS, (LAS char*)lds, t2);
        }
    } else {
        const int k0 = bx - nbA, nb2 = G - nbA;
        for (int q = k0; q < 256; q += nb2) {
            const int b = q >> 3, h = q & 7, row0 = b * SEQP;
            int t2 = tid; asm volatile("" : "+v"(t2));
            att::attn_unit(qn + (size_t)row0 * 1024 + h * 128, qr + (size_t)row0 * 512 + h * 64, kv + (size_t)row0 * 2048 + h * 256, kv + (size_t)row0 * 2048 + h * 256 + 128,
                           kr + (size_t)row0 * 64, qn + (size_t)row0 * 1024 + h * 128, SEQP, (LAS char*)lds, t2);
        }
        for (int u = k0; u < 1536; u += nb2) { int t2 = tid; asm volatile("" : "+v"(t2)); ssd::pass_b_unit(P, u, (LAS char*)lds, t2); }
    }
}
__global__ void __launch_bounds__(NT, 2) mega_fwd(Params P) {
    extern __shared__ __attribute__((aligned(16))) unsigned char lds_raw[];
    LAS unsigned char* lds = (LAS unsigned char*)lds_raw;
    cg::grid_group grid = cg::this_grid();
    const int G = gridDim.x, bx = blockIdx.x;
    unsigned char* ws = P.ws;
#define GSYNC() grid.sync()

#ifdef ONLY_ATT
    phase_attn(P, lds);
    return;
#endif
    phase_p0(P, lds);
    GSYNC();
    phase_p1(P, lds);
    GSYNC();
    {
        EpiIn E{(bf16_t*)(ws + WS_CQ), (bf16_t*)(ws + WS_CKVA), (bf16_t*)(ws + WS_Z), (bf16_t*)(ws + WS_XBC), (bf16_t*)P.out, (bf16_t*)P.out + (size_t)R * 1024, (bf16_t*)(ws + WS_KROPE),
                (float*)(ws + WS_SSQ_CQ), (float*)(ws + WS_SSQ_CKV), (float*)(ws + WS_DT), P.out + O_CKV, P.out + O_KR, P.in[I_DTB], (const f32x2*)(ws + WS_ROPE)};
        run_gemm(lds, (const bf16_t*)(ws + WS_H), (const bf16_t*)(ws + WS_WIN), R, INP, 1024, G, bx, E);
    }
    GSYNC();
    phase_conv(P);
    GSYNC();
    {
        EpiQ EQ{(bf16_t*)(ws + WS_QN), (bf16_t*)(ws + WS_QR), (const float*)(ws + WS_SSQ_CQ), (const f32x2*)(ws + WS_ROPE)};
        run_gemm(lds, (const bf16_t*)(ws + WS_CQ), (const bf16_t*)(ws + WS_WUQ), R, 1536, 256, G, bx, EQ);
        EpiKV EK{(bf16_t*)(ws + WS_KV), (const float*)(ws + WS_SSQ_CKV)};
        run_gemm(lds, (const bf16_t*)(ws + WS_CKVA), (const bf16_t*)(ws + WS_WUKV), KVR, 2048, 256, G, (bx + 224) % G, EK);
        phase_ssd_a(P, lds);
    }
    GSYNC();
    phase_mix(P, lds);
    GSYNC();
    {
        EpiMla EM{(const bf16_t*)P.out, (float*)(ws + WS_ST)};
        run_gemm(lds, (const bf16_t*)(ws + WS_QN), (const bf16_t*)(ws + WS_WOMLA), R, 1024, 1024, G, bx, EM);
        EpiSsd ES{(const bf16_t*)P.out + (size_t)R * 1024, (const float*)(ws + WS_ST), (const float*)(ws + WS_SSQ_Y), (bf16_t*)(ws + WS_MERGED)};
        run_gemm(lds, (const bf16_t*)(ws + WS_Z), (const bf16_t*)(ws + WS_WOSSD), R, 1024, 1024, G, bx, ES);
    }
    GSYNC();
    {
        EpiOut E{P.in[I_XP], P.in[I_XS], (const float*)(ws + WS_MOD), P.in[I_GFFN], P.out, (bf16_t*)(ws + WS_A1), (float*)(ws + WS_SSQ2)};
        run_gemm(lds, (const bf16_t*)(ws + WS_MERGED), (const bf16_t*)(ws + WS_WOUT), R, 1024, 1024, G, bx, E);
    }
    GSYNC();
    {
        EpiUp E{(const float*)(ws + WS_SSQ2), (const float*)(ws + WS_CUP), (bf16_t*)(ws + WS_U)};
        run_gemm(lds, (const bf16_t*)(ws + WS_A1), (const bf16_t*)(ws + WS_WUP), R, UPN, 1024, G, bx, E);
    }
    GSYNC();
    phase_convgate(P);
    GSYNC();
    {
        EpiDown E{(const float*)(ws + WS_MOD), P.out};
        run_gemm(lds, (const bf16_t*)(ws + WS_UG), (const bf16_t*)(ws + WS_WDOWN), R, 1024, DFF, G, bx, E);
    }
    GSYNC();
    phase_final(P);
}

extern "C" void kernel_launch(void* const* d_in, const int* in_sizes, int n_in, void* d_out, int out_size, void* d_ws, size_t ws_size, hipStream_t stream) {
    static int grid = 0;
    if (grid == 0) {
        if (n_in != 30 || ws_size < WS_END || out_size != (int)(O_SSD + (size_t)32 * 2 * 16 * 64 * 64)) {
            fprintf(stderr, "kernel_launch: unexpected shapes: n_in %d out %d ws %zu (need %zu)\n", n_in, out_size, ws_size, (size_t)WS_END); grid = -1; return; }
        int dev = 0, cus = 0, per_cu = 0;
        if (hipGetDevice(&dev) != hipSuccess || hipDeviceGetAttribute(&cus, hipDeviceAttributeMultiprocessorCount, dev) != hipSuccess) { grid = -1; return; }
        if (hipFuncSetAttribute((const void*)mega_fwd, hipFuncAttributeMaxDynamicSharedMemorySize, LDS_BYTES) != hipSuccess) { fprintf(stderr, "kernel_launch: hipFuncSetAttribute failed\n"); grid = -1; return; }
        if (hipOccupancyMaxActiveBlocksPerMultiprocessor(&per_cu, (const void*)mega_fwd, NT, LDS_BYTES) != hipSuccess || per_cu < 1) { fprintf(stderr, "kernel_launch: occupancy query failed (%d)\n", per_cu); (void)hipGetLastError(); grid = -1; return; }
        grid = cus;
    }
    if (grid < 0) return;
    (void)hipMemsetAsync((char*)d_ws + WS_CTL, 0, CTL_ZERO, stream);
    Params p{};
    for (int i = 0; i < 30; ++i) p.in[i] = (const float*)d_in[i];
    p.out = (float*)d_out; p.ws = (unsigned char*)d_ws;
    void* args[] = {&p};
    hipError_t e = hipLaunchCooperativeKernel((const void*)mega_fwd, dim3(grid), dim3(NT), args, LDS_BYTES, stream);
    if (e != hipSuccess) fprintf(stderr, "kernel_launch: cooperative launch failed: %s (grid %d)\n", hipGetErrorString(e), grid);
}
```

```cpp
#include <hip/hip_runtime.h>
#include <hip/hip_cooperative_groups.h>
#include <cstdio>
#include <cstdint>
namespace cg = cooperative_groups;

namespace pg8 {
#define PG8_LAS __attribute__((address_space(3)))
typedef unsigned short bf16_t;
typedef short bf16x8 __attribute__((ext_vector_type(8)));
typedef float f32x4 __attribute__((ext_vector_type(4)));
typedef unsigned u32x4 __attribute__((ext_vector_type(4)));
constexpr int BM = 256, BK = 64, HALF = 128, HTB = HALF * BK * 2  , STAGE_BYTES = 8 * HTB, NXCD = 8, WGM = 8;

__host__ __device__ __forceinline__ int lds_byte(int r, int c) { const int st = (r >> 4) * 2 + (c >> 5), rr = r & 15, cc = c & 31, ob = rr * 64 + cc * 2; return st * 1024 + (ob ^ (((ob >> 9) & 1) << 5)); }
__host__ __device__ __forceinline__ void stage_rc(int b, int& R, int& C) { const int st = b / 1024, sb = b % 1024, swz = sb ^ (((sb >> 9) & 1) << 5); R = (st >> 1) * 16 + swz / 64; C = (st & 1) * 32 + (swz % 64) / 2; }
__host__ __device__ __forceinline__ int perm32(int rho) { const int n = rho >> 4, i = rho & 15; return 8 * (i >> 2) + 4 * n + (i & 3); }

struct Unit { int pm, pn; };
struct Gemm { const bf16_t* A; const bf16_t* Bt; int M, N, K; };

struct StaticOrder {
    int nM, nN, nwg, G, c;
    __host__ __device__ void init(int M, int N, int G_, int c_) { nM = M / BM; nN = N / BM; nwg = nM * nN; G = G_; c = c_; }
    __host__ __device__ bool next(int i, Unit& u) const {
        const long L = (long)i * G + c; if (L >= nwg) return false;
        int wgid = (int)L; { const int q = nwg / NXCD, r = nwg % NXCD, xcd = wgid % NXCD, off = wgid / NXCD; wgid = (xcd < r ? xcd * (q + 1) : r * (q + 1) + (xcd - r) * q) + off; }
        const int nig = WGM * nN, gid = wgid / nig, fm = gid * WGM, gsz = (nM - fm) < WGM ? (nM - fm) : WGM;
        u.pm = fm + ((wgid % nig) % gsz); u.pn = (wgid % nig) / gsz; return true;
    }
    __device__ __forceinline__ void a_ready(const Unit&) const {}
    __device__ __forceinline__ void done(const Unit&) const {}
};


template <class Epi, class Sched, bool ALIGN_EPI = false, bool SP2 = false>
__device__ __forceinline__ void gemm_phase(PG8_LAS unsigned char* lds, const Gemm g, const Sched& S, const Epi& E) {
    int tid_ = threadIdx.x; asm volatile("" : "+v"(tid_));
    const int tid = tid_, wid = __builtin_amdgcn_readfirstlane(tid >> 6), lane = tid & 63, wr = wid >> 2, wc = wid & 3, fr = lane & 15, fq = lane >> 4;
    const int K = g.K, nt = K / BK;
    unsigned voffA[2], voffB[2];
#pragma unroll
    for (int i = 0; i < 2; ++i) { int R, C; stage_rc(tid * 16 + i * 8192, R, C); const int Rb = Epi::PERM ? ((R & ~31) + perm32(R & 31)) : R;
        voffA[i] = (unsigned)(R * K + C) * 2u; voffB[i] = (unsigned)(Rb * K + C) * 2u; }
    const size_t kstep = (size_t)(BK * 2);
    const size_t hstep = (size_t)HALF * K * 2;
    const size_t tstep = 2 * hstep;
    const unsigned ldsw = (unsigned)wid * 1024u;
    const int aoff = lds_byte(wr * 64 + fr, fq * 8), boff = lds_byte(wc * 32 + fr, fq * 8);
#define PG8_SA(b, h) (((b) * 2 + (h)) * HTB)
#define PG8_SB(b, h) ((4 + (b) * 2 + (h)) * HTB)
#define PG8_STAGE(bufoff, gbase, voff) do { _Pragma("unroll") for (int _i = 0; _i < 2; ++_i) \
        __builtin_amdgcn_global_load_lds((const unsigned*)((const char*)(gbase) + (voff)[_i]), (PG8_LAS unsigned*)(lds + (bufoff) + ldsw + _i * 8192), 16, 0, 0); } while (0)
#define PG8_LDA(dst, b, h) do { _Pragma("unroll") for (int m = 0; m < 4; ++m) _Pragma("unroll") for (int k = 0; k < 2; ++k) dst[m][k] = *(const PG8_LAS bf16x8*)(lds + PG8_SA(b, h) + aoff + m * 2048 + k * 1024); } while (0)
#define PG8_LDB(dst, b, h) do { _Pragma("unroll") for (int n = 0; n < 2; ++n) _Pragma("unroll") for (int k = 0; k < 2; ++k) dst[n][k] = *(const PG8_LAS bf16x8*)(lds + PG8_SB(b, h) + boff + n * 2048 + k * 1024); } while (0)
#define PG8_MMA(ai, bj, At, Bt) do { __builtin_amdgcn_s_setprio(1); _Pragma("unroll") for (int m = 0; m < 4; ++m) _Pragma("unroll") for (int n = 0; n < 2; ++n) _Pragma("unroll") for (int k = 0; k < 2; ++k) \
        acc[ai][bj][m][n] = __builtin_amdgcn_mfma_f32_16x16x32_bf16(Bt[n][k], At[m][k], acc[ai][bj][m][n], 0, 0, 0); __builtin_amdgcn_s_setprio(0); } while (0)
#define PG8_WAIT_V(n) asm volatile("s_waitcnt vmcnt(" #n ")" ::: "memory")
#define PG8_WAIT_L(n) asm volatile("s_waitcnt lgkmcnt(" #n ")" ::: "memory")
#define PG8_BAR __builtin_amdgcn_s_barrier()
#define PG8_SCHED __builtin_amdgcn_sched_barrier(0)
    Unit cur, nxt; int ui = 0;
    if (!S.next(0, cur)) return;
    f32x4 acc[2][2][4][2];
#pragma unroll
    for (int a = 0; a < 2; ++a)
#pragma unroll
        for (int b = 0; b < 2; ++b)
#pragma unroll
            for (int m = 0; m < 4; ++m)
#pragma unroll
                for (int n = 0; n < 2; ++n) acc[a][b][m][n] = (f32x4){0.f, 0.f, 0.f, 0.f};
    bf16x8 At[4][2], B0[2][2], B1[2][2];
    const char* cA = (const char*)g.A + (size_t)cur.pm * tstep; const char* cB = (const char*)g.Bt + (size_t)cur.pn * tstep;
    S.a_ready(cur);
    if constexpr (SP2) {
        PG8_STAGE(PG8_SB(0, 0), cB, voffB); PG8_STAGE(PG8_SB(0, 1), cB + hstep, voffB); PG8_STAGE(PG8_SA(0, 0), cA, voffA); PG8_STAGE(PG8_SA(0, 1), cA + hstep, voffA);
        if (wr == 1) PG8_BAR;
        PG8_WAIT_V(2); PG8_BAR;
        PG8_STAGE(PG8_SB(1, 0), cB + kstep, voffB); PG8_STAGE(PG8_SA(1, 0), cA + kstep, voffA); PG8_STAGE(PG8_SB(1, 1), cB + hstep + kstep, voffB);
        PG8_WAIT_V(6); PG8_BAR;
    } else {
        PG8_STAGE(PG8_SB(0, 0), cB, voffB); PG8_STAGE(PG8_SA(0, 0), cA, voffA); PG8_STAGE(PG8_SB(0, 1), cB + hstep, voffB); PG8_STAGE(PG8_SA(0, 1), cA + hstep, voffA);
        if (wr == 1) PG8_BAR;
        PG8_WAIT_V(4); PG8_BAR;
        PG8_STAGE(PG8_SB(1, 0), cB + kstep, voffB); PG8_STAGE(PG8_SA(1, 0), cA + kstep, voffA); PG8_STAGE(PG8_SB(1, 1), cB + hstep + kstep, voffB);
        PG8_WAIT_V(6); PG8_BAR;
    }
    for (;;) {
        const bool has_next = S.next(ui + 1, nxt);
        const char* nA = has_next ? (const char*)g.A + (size_t)nxt.pm * tstep : cA; const char* nB = has_next ? (const char*)g.Bt + (size_t)nxt.pn * tstep : cB;
        for (int t = 0; t < nt; t += 2) {
            const bool last = (t == nt - 2);
            const char* a1 = cA + (size_t)(t + 1) * kstep;
            const char* a2 = last ? nA : cA + (size_t)(t + 2) * kstep; const char* b2 = last ? nB : cB + (size_t)(t + 2) * kstep;
            const char* a3 = a2 + kstep; const char* b3 = b2 + kstep;
            if (last && has_next) S.a_ready(nxt);
            if constexpr (SP2) {
            PG8_LDB(B0, 0, 0); PG8_LDB(B1, 0, 1); PG8_SCHED; PG8_LDA(At, 0, 0); PG8_STAGE(PG8_SA(1, 1), a1 + hstep, voffA);
            PG8_WAIT_V(8); PG8_WAIT_L(0); PG8_BAR; PG8_MMA(0, 0, At, B0); PG8_MMA(0, 1, At, B1); PG8_BAR; PG8_SCHED;
            PG8_LDA(At, 0, 1); PG8_STAGE(PG8_SB(0, 0), b2, voffB); PG8_STAGE(PG8_SB(0, 1), b2 + hstep, voffB); PG8_STAGE(PG8_SA(0, 0), a2, voffA);
            PG8_WAIT_V(8); PG8_WAIT_L(0); PG8_BAR; PG8_MMA(1, 0, At, B0); PG8_MMA(1, 1, At, B1); PG8_BAR; PG8_SCHED;
            PG8_LDB(B0, 1, 0); PG8_LDB(B1, 1, 1); PG8_SCHED; PG8_LDA(At, 1, 0); PG8_STAGE(PG8_SA(0, 1), a2 + hstep, voffA);
            PG8_WAIT_V(8); PG8_WAIT_L(0); PG8_BAR; PG8_MMA(0, 0, At, B0); PG8_MMA(0, 1, At, B1); PG8_BAR; PG8_SCHED;
            PG8_LDA(At, 1, 1); PG8_STAGE(PG8_SB(1, 0), b3, voffB); PG8_STAGE(PG8_SB(1, 1), b3 + hstep, voffB); PG8_STAGE(PG8_SA(1, 0), a3, voffA);
            PG8_WAIT_V(8); PG8_WAIT_L(0); PG8_BAR; PG8_MMA(1, 0, At, B0); PG8_MMA(1, 1, At, B1); PG8_BAR; PG8_SCHED;
            } else {
            PG8_LDB(B0, 0, 0); PG8_SCHED; PG8_LDA(At, 0, 0); PG8_STAGE(PG8_SA(1, 1), a1 + hstep, voffA);
            PG8_WAIT_L(8); PG8_BAR; PG8_WAIT_L(0); PG8_MMA(0, 0, At, B0); PG8_BAR; PG8_SCHED;
            PG8_LDB(B1, 0, 1); PG8_STAGE(PG8_SB(0, 0), b2, voffB);
            PG8_BAR; PG8_WAIT_L(0); PG8_MMA(0, 1, At, B1); PG8_BAR;
            PG8_LDA(At, 0, 1); PG8_STAGE(PG8_SA(0, 0), a2, voffA);
            PG8_BAR; PG8_WAIT_L(0); PG8_MMA(1, 0, At, B0); PG8_BAR; PG8_SCHED;
            PG8_STAGE(PG8_SB(0, 1), b2 + hstep, voffB);
            PG8_WAIT_V(6); PG8_BAR; PG8_MMA(1, 1, At, B1); PG8_BAR;
            PG8_LDB(B0, 1, 0); PG8_SCHED; PG8_LDA(At, 1, 0); PG8_STAGE(PG8_SA(0, 1), a2 + hstep, voffA);
            PG8_WAIT_L(8); PG8_BAR; PG8_WAIT_L(0); PG8_MMA(0, 0, At, B0); PG8_BAR; PG8_SCHED;
            PG8_LDB(B1, 1, 1); PG8_STAGE(PG8_SB(1, 0), b3, voffB);
            PG8_BAR; PG8_WAIT_L(0); PG8_MMA(0, 1, At, B1); PG8_BAR;
            PG8_LDA(At, 1, 1); PG8_STAGE(PG8_SA(1, 0), a3, voffA);
            PG8_BAR; PG8_WAIT_L(0); PG8_MMA(1, 0, At, B0); PG8_BAR; PG8_SCHED;
            PG8_STAGE(PG8_SB(1, 1), b3 + hstep, voffB);
            PG8_WAIT_V(6); PG8_BAR; PG8_MMA(1, 1, At, B1); PG8_BAR;
            }
        }
        if constexpr (ALIGN_EPI) { if (wr == 0) PG8_BAR; }
        if constexpr (!Epi::AFTER_DRAIN) { E(acc, cur, wr, wc, fr, fq); S.done(cur); }
        if (!has_next) break;
#pragma unroll
        for (int a = 0; a < 2; ++a)
#pragma unroll
            for (int b = 0; b < 2; ++b)
#pragma unroll
                for (int m = 0; m < 4; ++m)
#pragma unroll
                    for (int n = 0; n < 2; ++n) acc[a][b][m][n] = (f32x4){0.f, 0.f, 0.f, 0.f};
        cur = nxt; cA = nA; cB = nB; ++ui;
        if constexpr (ALIGN_EPI) { if (wr == 1) PG8_BAR; }
    }
    PG8_WAIT_V(0);
    if constexpr (!ALIGN_EPI) { if (wr == 0) PG8_BAR; }
    PG8_BAR;
    if constexpr (Epi::AFTER_DRAIN) { E.fused(acc, cur, wr, wc, fr, fq, lds, wid, lane); S.done(cur); }
#undef PG8_SA
#undef PG8_SB
#undef PG8_STAGE
#undef PG8_LDA
#undef PG8_LDB
#undef PG8_MMA
#undef PG8_WAIT_V
#undef PG8_WAIT_L
#undef PG8_BAR
#undef PG8_SCHED
}
}

#ifndef PG8_SP2
#define PG8_SP2 true
#endif
#ifndef PG8_ALIGN
#define PG8_ALIGN true
#endif

#define LAS __attribute__((address_space(3)))
using pg8::bf16_t; using pg8::f32x4; using pg8::bf16x8; using pg8::u32x4;
typedef unsigned u32x2 __attribute__((ext_vector_type(2)));
typedef float f32x2 __attribute__((ext_vector_type(2)));

constexpr int DM = 1024;
constexpr int RP = 8192, RS = 4096, R = 12288;
constexpr int SEQP = 256, SEQS = 2048, PAST = 512, KVS = PAST + SEQS;
constexpr int KVR = RP + 2 * KVS;
constexpr int NH = 8;
constexpr int INC = 5216, INP = 5376;
constexpr int DFF = 2816, UPN = 5632;
constexpr float EPS = 1e-6f;
constexpr float ATT_SCALE = 0.07216878364870322f;

enum { I_XP = 0, I_XS, I_C, I_CKV, I_CKR, I_SSD, I_CCTX, I_WADA, I_BADA, I_GATTN, I_WIN, I_GQ, I_GKV, I_WUQ, I_WUKV, I_WOMLA,
       I_CONVW, I_CONVB, I_DTB, I_ALOG, I_SSDD, I_GSSD, I_WOSSD, I_WOUT, I_GFFN, I_WUP, I_FCW, I_FCB, I_WDOWN, I_GFIN };

constexpr size_t O_Y = 0, O_CKV = (size_t)R * DM, O_KR = O_CKV + (size_t)RP * 256, O_SSD = O_KR + (size_t)RP * 64;

constexpr size_t MiB = 1u << 20;
constexpr size_t WS_CTL = 0, CTL_ZERO = 65536;
constexpr size_t WS_MOD = 64 * 1024;
constexpr size_t WS_CUP = 160 * 1024;
constexpr size_t WS_ROPE = 256 * 1024;
constexpr size_t WS_SSQ_CQ = 1 * MiB;
constexpr size_t WS_SSQ_CKV = 1 * MiB + 204800;
constexpr size_t WS_SSQ_Y = 1 * MiB + 430080;
constexpr size_t WS_SSQ2 = 1 * MiB + 1216512;
constexpr size_t WS_DT = 3 * MiB;
constexpr size_t WS_DEC = 3 * MiB + 1572864;
constexpr size_t WS_WIN = 5 * MiB;
constexpr size_t WS_WUQ = WS_WIN + (size_t)INP * 1024 * 2;
constexpr size_t WS_WUKV = WS_WUQ + 1536 * 256 * 2;
constexpr size_t WS_WOMLA = WS_WUKV + 2048 * 256 * 2;
constexpr size_t WS_WOSSD = WS_WOMLA + 2 * MiB;
constexpr size_t WS_WOUT = WS_WOSSD + 2 * MiB;
constexpr size_t WS_WUP = WS_WOUT + 2 * MiB;
constexpr size_t WS_WDOWN = WS_WUP + (size_t)UPN * 1024 * 2;
static_assert(WS_WDOWN + (size_t)1024 * DFF * 2 <= 40 * MiB, "weights");
constexpr size_t WS_CQ = 40 * MiB;
constexpr size_t WS_CKVA = 46 * MiB;
constexpr size_t WS_KROPE = 46 * MiB + (size_t)KVR * 256 * 2;
constexpr size_t WS_Z = 55 * MiB;
constexpr size_t WS_XBC = 79 * MiB;
constexpr size_t WS_H = 115 * MiB;
constexpr size_t WS_XC = 115 * MiB;
constexpr size_t WS_QN = 79 * MiB;
constexpr size_t WS_QR = 103 * MiB;
constexpr size_t WS_KV = 151 * MiB;
constexpr size_t WS_YF = 151 * MiB;
constexpr size_t WS_ST = 203 * MiB;
constexpr size_t WS_MERGED = 151 * MiB;
constexpr size_t WS_A1 = 55 * MiB;
constexpr size_t WS_U = 115 * MiB;
constexpr size_t WS_UG = 40 * MiB;
constexpr size_t WS_END = 251 * MiB;
static_assert(WS_KROPE + (size_t)KVR * 64 * 2 <= WS_Z && WS_KV + (size_t)KVR * 2048 * 2 <= WS_ST && WS_ST + (size_t)R * 1024 * 4 <= WS_END, "map");
static_assert(WS_U + (size_t)R * UPN * 2 <= WS_END && WS_UG + (size_t)R * DFF * 2 <= WS_U, "map2");

constexpr int LDS_BYTES = 147456;
constexpr int NT = 512;

struct Params { const float* in[30]; float* out; unsigned char* ws; };
#define PHASE_IDS int tid = threadIdx.x; asm volatile("" : "+v"(tid)); const int lane = tid & 63, wave = __builtin_amdgcn_readfirstlane(tid >> 6), G = gridDim.x; (void)lane; (void)wave; (void)G;

#define LDS_WAIT() asm volatile("s_waitcnt lgkmcnt(0)" ::: "memory")
__device__ __forceinline__ unsigned f2bf(float f) { unsigned u = __builtin_bit_cast(unsigned, f); return (u + 0x7fffu + ((u >> 16) & 1u)) >> 16; }
__device__ __forceinline__ float bf2f(unsigned short b) { return __builtin_bit_cast(float, (unsigned)b << 16); }
__device__ __forceinline__ unsigned pk2(float lo, float hi) { return f2bf(lo) | (f2bf(hi) << 16); }
__device__ __forceinline__ float bflo(unsigned w) { return __builtin_bit_cast(float, w << 16); }
__device__ __forceinline__ float bfhi(unsigned w) { return __builtin_bit_cast(float, w & 0xffff0000u); }
__device__ __forceinline__ float wave_sum(float v) {
#pragma unroll
    for (int o = 1; o < 64; o <<= 1) v += __shfl_xor(v, o);
    return v;
}
__device__ __forceinline__ float wave_max(float v) {
#pragma unroll
    for (int o = 1; o < 64; o <<= 1) v = fmaxf(v, __shfl_xor(v, o));
    return v;
}
__device__ __forceinline__ float siluf(float x) { return x / (1.f + __expf(-x)); }
__device__ __forceinline__ float sigm(float x) { return 1.f / (1.f + __expf(-x)); }
__device__ __forceinline__ float softplusf(float x) { return x > 20.f ? x : log1pf(__expf(x)); }
__device__ __forceinline__ int grp_of_row(int row) { return row < RP ? 0 : 1 + ((row - RP) >> 11); }
__device__ __forceinline__ int kvrow_of_row(int row) { return row < RP ? row : RP + ((row - RP) >> 11) * KVS + PAST + ((row - RP) & 2047); }
__device__ __forceinline__ const float* xrow_ptr(const Params& P, int row) { return row < RP ? P.in[I_XP] + (size_t)row * DM : P.in[I_XS] + (size_t)(row - RP) * DM; }

__device__ __forceinline__ void transpose_item(const float* W, int K, int N, bf16_t* WT, int k0, int n0, int drow0, const float* kscale, LAS float* scr, int lane) {
#pragma unroll 8
    for (int i = 0; i < 32; ++i) { const int kk = 2 * i + (lane >> 5); float w = W[(size_t)(k0 + kk) * N + n0 + (lane & 31)]; if (kscale) w *= kscale[k0 + kk]; scr[kk * 33 + (lane & 31)] = w; }
    LDS_WAIT(); asm volatile("" ::: "memory");
    const int c = lane & 7;
#pragma unroll
    for (int j = 0; j < 4; ++j) { const int n = (lane >> 3) + 8 * j; const LAS float* s = scr + (8 * c) * 33 + n;
        u32x4 o; o.x = pk2(s[0 * 33], s[1 * 33]); o.y = pk2(s[2 * 33], s[3 * 33]); o.z = pk2(s[4 * 33], s[5 * 33]); o.w = pk2(s[6 * 33], s[7 * 33]);
        *(u32x4*)(WT + (size_t)(drow0 + n) * K + k0 + 8 * c) = o; }
    LDS_WAIT(); asm volatile("" ::: "memory");
}
__device__ __forceinline__ int win_dst(int n0) {
    if (n0 < 512) return n0;
    if (n0 < 576) return 5120 + (n0 - 512);
    if (n0 < 1600) return 512 + (n0 - 576);
    if (n0 < 2624) return 1536 + (n0 - 1600);
    if (n0 < 2880) return 2560 + (n0 - 2624);
    if (n0 < 3136) return 2816 + (n0 - 2880);
    if (n0 < 3168) return 5184 + (n0 - 3136);
    if (n0 < 4192) return 3072 + (n0 - 3168);
    return 4096 + (n0 - 4192);
}
__device__ __forceinline__ int wuq_dst(int n0) { const int h = n0 / 192, d0 = n0 - h * 192; return d0 < 128 ? h * 128 + d0 : 1024 + h * 64 + (d0 - 128); }

template <int CW>
__device__ __forceinline__ void gemv3_block(const LAS float* vec  , const float* W, int N, int col0, const float* bias, float* out, int ldo, LAS float* red, int tid) {
    const int j = tid & 31, kq = tid >> 5;
    float a0 = 0.f, a1 = 0.f, a2 = 0.f;
    if (j < CW) {
        const float* wp = W + (size_t)(kq * 64) * N + col0 + j;
#pragma unroll 8
        for (int k = 0; k < 64; ++k) { const float w = wp[(size_t)k * N]; const int kk = kq * 64 + k; a0 += vec[kk] * w; a1 += vec[1024 + kk] * w; a2 += vec[2048 + kk] * w; }
    }
    red[(kq * 3 + 0) * 32 + j] = a0; red[(kq * 3 + 1) * 32 + j] = a1; red[(kq * 3 + 2) * 32 + j] = a2;
    __syncthreads();
    if (tid < 96) { const int g = tid >> 5, jj = tid & 31;
        if (jj < CW) { float s = 0.f;
#pragma unroll
            for (int q = 0; q < 16; ++q) s += red[(q * 3 + g) * 32 + jj];
            out[(size_t)g * ldo + col0 + jj] = s + (bias ? bias[col0 + jj] : 0.f); } }
    __syncthreads();
}

__device__ __forceinline__ void phase_p0(const Params& P, LAS unsigned char* lds) {
    PHASE_IDS unsigned char* ws = P.ws;
    {
        LAS float* sc = (LAS float*)lds; LAS float* red = sc + 3072;
        for (int i = tid; i < 3072; i += NT) { const int g = i >> 10, k = i & 1023; const float c = (g == 0) ? P.in[I_CCTX][k] : P.in[I_C][(g - 1) * 1024 + k]; sc[i] = siluf(c); }
        __syncthreads();
        for (int cb = blockIdx.x; cb < 256; cb += G) gemv3_block<24>(sc, P.in[I_WADA], 6144, cb * 24, P.in[I_BADA], (float*)(ws + WS_MOD), 6144, red, tid);
    }
    {
        LAS float* scr = (LAS float*)(lds + wave * 16384);
        const int gw = blockIdx.x * 8 + wave, NGW = G * 8;
        constexpr int I_IN = 16 * 163, I_UQ = 4 * 48, I_UKV = 4 * 64, I_SQ = 16 * 32, I_UP = 16 * 176, I_DN = 44 * 32;
        constexpr int NITEMS = I_IN + I_UQ + I_UKV + 3 * I_SQ + I_UP + I_DN;
        for (int it = gw; it < NITEMS; it += NGW) {
            int r = it;
            if (r < I_IN) { const int kb = r / 163, nb = r % 163; transpose_item(P.in[I_WIN], 1024, INC, (bf16_t*)(ws + WS_WIN), kb * 64, nb * 32, win_dst(nb * 32), nullptr, scr, lane); continue; } r -= I_IN;
            if (r < I_UQ) { const int kb = r / 48, nb = r % 48; transpose_item(P.in[I_WUQ], 256, 1536, (bf16_t*)(ws + WS_WUQ), kb * 64, nb * 32, wuq_dst(nb * 32), P.in[I_GQ], scr, lane); continue; } r -= I_UQ;
            if (r < I_UKV) { const int kb = r / 64, nb = r % 64; transpose_item(P.in[I_WUKV], 256, 2048, (bf16_t*)(ws + WS_WUKV), kb * 64, nb * 32, nb * 32, P.in[I_GKV], scr, lane); continue; } r -= I_UKV;
            if (r < I_SQ) { const int kb = r / 32, nb = r % 32; transpose_item(P.in[I_WOMLA], 1024, 1024, (bf16_t*)(ws + WS_WOMLA), kb * 64, nb * 32, nb * 32, nullptr, scr, lane); continue; } r -= I_SQ;
            if (r < I_SQ) { const int kb = r / 32, nb = r % 32; transpose_item(P.in[I_WOSSD], 1024, 1024, (bf16_t*)(ws + WS_WOSSD), kb * 64, nb * 32, nb * 32, P.in[I_GSSD], scr, lane); continue; } r -= I_SQ;
            if (r < I_SQ) { const int kb = r / 32, nb = r % 32; transpose_item(P.in[I_WOUT], 1024, 1024, (bf16_t*)(ws + WS_WOUT), kb * 64, nb * 32, nb * 32, nullptr, scr, lane); continue; } r -= I_SQ;
            if (r < I_UP) { const int kb = r / 176, nb = r % 176; transpose_item(P.in[I_WUP], 1024, UPN, (bf16_t*)(ws + WS_WUP), kb * 64, nb * 32, nb * 32, nullptr, scr, lane); continue; } r -= I_UP;
            { const int kb = r / 32, nb = r % 32; transpose_item(P.in[I_WDOWN], DFF, 1024, (bf16_t*)(ws + WS_WDOWN), kb * 64, nb * 32, nb * 32, nullptr, scr, lane); }
        }
    }
    {
        const int gt = blockIdx.x * NT + tid, GT = G * NT;
        for (int i = gt; i < 160 * 1024 / 8; i += GT) *(u32x4*)((bf16_t*)(ws + WS_WIN) + (size_t)5216 * 1024 + (size_t)i * 8) = (u32x4){0u, 0u, 0u, 0u};
        for (int i = gt; i < 2048 * 32; i += GT) { const int t = i >> 5, a = (i >> 4) & 1, fi = i & 15; const float pos = (float)(a ? (t & 63) : (t >> 6));
            const float inv = exp2f(-(float)fi * 0.8304820237218406f); const float ang = pos * inv;
            ((f32x2*)(ws + WS_ROPE))[i] = (f32x2){__cosf(ang), __sinf(ang)}; }
        for (int i = gt; i < 2 * PAST * 256; i += GT) { const int k = i & 255, s = (i >> 8) & 511, b = i >> 17;
            ((bf16_t*)(ws + WS_CKVA))[(size_t)(RP + b * KVS + s) * 256 + k] = (bf16_t)f2bf(P.in[I_CKV][i] / P.in[I_GKV][k]); }
        for (int i = gt; i < 2 * PAST * 64; i += GT) { const int j = i & 63, s = (i >> 6) & 511, b = i >> 15;
            ((bf16_t*)(ws + WS_KROPE))[(size_t)(RP + b * KVS + s) * 64 + j] = (bf16_t)f2bf(P.in[I_CKR][i]); }
        for (int i = gt; i < 2 * PAST; i += GT) { const int s = i & 511, b = i >> 9;
            *(f32x4*)((float*)(ws + WS_SSQ_CKV) + (size_t)(RP + b * KVS + s) * 4) = (f32x4){256.f * (1.f - EPS), 0.f, 0.f, 0.f}; }
    }
}

__device__ __forceinline__ void phase_p1(const Params& P, LAS unsigned char* lds) {
    PHASE_IDS unsigned char* ws = P.ws; const float* mod = (const float*)(ws + WS_MOD);
    {
        LAS float* sh = (LAS float*)lds; LAS float* red = sh + 3072;
        for (int i = tid; i < 3072; i += NT) { const int g = i >> 10, k = i & 1023; sh[i] = mod[g * 6144 + 3072 + k]; }
        __syncthreads();
        for (int cb = blockIdx.x; cb < 256; cb += G) gemv3_block<22>(sh, P.in[I_WUP], UPN, cb * 22, nullptr, (float*)(ws + WS_CUP), UPN, red, tid);
    }
    const int gw = blockIdx.x * 8 + wave, NGW = G * 8;
    const float* gat = P.in[I_GATTN];
    for (int row = gw; row < R; row += NGW) {
        const f32x4* xr = (const f32x4*)xrow_ptr(P, row) + lane; const int g = grp_of_row(row);
        f32x4 v[4]; float s = 0.f;
#pragma unroll
        for (int j = 0; j < 4; ++j) { v[j] = xr[64 * j]; s += (v[j].x * v[j].x + v[j].y * v[j].y) + (v[j].z * v[j].z + v[j].w * v[j].w); }
        const float rs = rsqrtf(wave_sum(s) * (1.f / DM) + EPS);
        u32x2* o8 = (u32x2*)((bf16_t*)(ws + WS_H) + (size_t)row * DM) + lane;
#pragma unroll
        for (int j = 0; j < 4; ++j) { const int c = 4 * lane + 256 * j;
            const f32x4 gg = *(const f32x4*)(gat + c), sc = *(const f32x4*)(mod + g * 6144 + 1024 + c), sh = *(const f32x4*)(mod + g * 6144 + c);
            const f32x4 h = v[j] * rs * gg * (sc + 1.f) + sh;
            o8[64 * j] = (u32x2){pk2(h.x, h.y), pk2(h.z, h.w)}; }
    }
}

typedef const f32x4 (&AccRef)[2][2][4][2];
#define EPI_ROWS(pm) _Pragma("unroll") for (int ai = 0; ai < 2; ++ai) _Pragma("unroll") for (int m = 0; m < 4; ++m) { const int row = (pm) * 256 + ai * 128 + wr * 64 + m * 16 + fr;
#define EPI_COLS _Pragma("unroll") for (int bj = 0; bj < 2; ++bj) _Pragma("unroll") for (int n = 0; n < 2; ++n) { const int col = bj * 128 + wc * 32 + n * 16 + fq * 4; const f32x4 v = acc[ai][bj][m][n];
#define EPI_END }
__device__ __forceinline__ void st_bf4(bf16_t* p, f32x4 v) { *(u32x2*)p = (u32x2){pk2(v.x, v.y), pk2(v.z, v.w)}; }
__device__ __forceinline__ f32x4 ld_bf4(const bf16_t* p) { const u32x2 w = *(const u32x2*)p; return (f32x4){bflo(w.x), bfhi(w.x), bflo(w.y), bfhi(w.y)}; }
__device__ __forceinline__ float quad_sum16(float s) { s += __shfl_xor(s, 16); s += __shfl_xor(s, 32); return s; }

struct EpiIn {
    static constexpr bool PERM = false, AFTER_DRAIN = false;
    bf16_t *cq, *ckv, *z, *xbc, *sgm, *sgs, *krope; float *ssq_cq, *ssq_ckv, *dt, *new_ckv, *new_krope; const float* dt_bias; const f32x2* rope;
    __device__ __forceinline__ void operator()(AccRef acc, const pg8::Unit& u, int wr, int wc, int fr, int fq) const {
        const int pn = u.pn;
        if (pn < 2) {
            EPI_ROWS(u.pm)
                const int orow = pn == 0 ? row : kvrow_of_row(row); bf16_t* dst = (pn == 0 ? cq : ckv) + (size_t)orow * 256; float s = 0.f;
                EPI_COLS
                    st_bf4(dst + col, v); s += (v.x * v.x + v.y * v.y) + (v.z * v.z + v.w * v.w);
                    if (pn == 1 && row < RP) *(f32x4*)(new_ckv + (size_t)row * 256 + col) = v;
                EPI_END
                s = quad_sum16(s);
                if (fq == 0) (pn == 0 ? ssq_cq : ssq_ckv)[(size_t)orow * 4 + wc] = s;
            EPI_END
        } else if (pn < 12) {
            bf16_t* base = pn < 6 ? z : xbc; const int ld = pn < 6 ? 1024 : 1536, c0 = pn < 6 ? (pn - 2) * 256 : (pn - 6) * 256;
            EPI_ROWS(u.pm)
                bf16_t* dst = base + (size_t)row * ld + c0;
                EPI_COLS st_bf4(dst + col, v); EPI_END
            EPI_END
        } else if (pn < 20) {
            bf16_t* base = pn < 16 ? sgm : sgs; const int c0 = (pn & 3) * 256;
            EPI_ROWS(u.pm)
                bf16_t* dst = base + (size_t)row * 1024 + c0;
                EPI_COLS st_bf4(dst + col, (f32x4){sigm(v.x), sigm(v.y), sigm(v.z), sigm(v.w)}); EPI_END
            EPI_END
        } else {
            if (wc < 2) {
                EPI_ROWS(u.pm)
                    const f32x4 x0 = acc[ai][0][m][0], x1 = acc[ai][0][m][1]; const int i0 = fq * 4;
                    if (row < RP) {
                        st_bf4(krope + (size_t)row * 64 + wc * 32 + i0, x0); st_bf4(krope + (size_t)row * 64 + wc * 32 + 16 + i0, x1);
                        *(f32x4*)(new_krope + (size_t)row * 64 + wc * 32 + i0) = x0; *(f32x4*)(new_krope + (size_t)row * 64 + wc * 32 + 16 + i0) = x1;
                    } else {
                        const int t = (row - RP) & 2047; const f32x2* rp = rope + t * 32 + wc * 16 + i0; f32x4 o0, o1;
#pragma unroll
                        for (int e = 0; e < 4; ++e) { const f32x2 cs = rp[e]; o0[e] = x0[e] * cs.x - x1[e] * cs.y; o1[e] = x0[e] * cs.y + x1[e] * cs.x; }
                        bf16_t* dst = krope + (size_t)kvrow_of_row(row) * 64 + wc * 32 + i0; st_bf4(dst, o0); st_bf4(dst + 16, o1);
                    }
                EPI_END
            } else if (wc == 2) {
                EPI_ROWS(u.pm)
#pragma unroll
                    for (int n = 0; n < 2; ++n) { const int j = n * 16 + fq * 4; const f32x4 v = acc[ai][0][m][n]; const f32x4 b = *(const f32x4*)(dt_bias + j);
                        *(f32x4*)(dt + (size_t)row * 32 + j) = (f32x4){softplusf(v.x + b.x), softplusf(v.y + b.y), softplusf(v.z + b.z), softplusf(v.w + b.w)}; }
                EPI_END
            }
        }
    }
};

struct EpiQ {
    static constexpr bool PERM = false, AFTER_DRAIN = false;
    bf16_t *qn, *qr; const float* ssq; const f32x2* rope;
    __device__ __forceinline__ void operator()(AccRef acc, const pg8::Unit& u, int wr, int wc, int fr, int fq) const {
        const int pn = u.pn;
        EPI_ROWS(u.pm)
            const f32x4 sq = *(const f32x4*)(ssq + (size_t)row * 4); const float rs = rsqrtf(((sq.x + sq.y) + (sq.z + sq.w)) * (1.f / 256.f) + EPS);
            if (pn < 4) {
                bf16_t* dst = qn + (size_t)row * 1024 + pn * 256;
                EPI_COLS st_bf4(dst + col, v * rs); EPI_END
            } else {
                bf16_t* dst = qr + (size_t)row * 512 + (pn - 4) * 256;
#pragma unroll
                for (int bj = 0; bj < 2; ++bj) { const int cb = bj * 128 + wc * 32, i0 = fq * 4; const f32x4 x0 = acc[ai][bj][m][0] * rs, x1 = acc[ai][bj][m][1] * rs;
                    if (row < RP) { st_bf4(dst + cb + i0, x0); st_bf4(dst + cb + 16 + i0, x1); }
                    else { const int t = (row - RP) & 2047; const f32x2* rp = rope + t * 32 + (wc & 1) * 16 + i0; f32x4 o0, o1;
#pragma unroll
                        for (int e = 0; e < 4; ++e) { const f32x2 cs = rp[e]; o0[e] = x0[e] * cs.x - x1[e] * cs.y; o1[e] = x0[e] * cs.y + x1[e] * cs.x; }
                        st_bf4(dst + cb + i0, o0); st_bf4(dst + cb + 16 + i0, o1); } }
            }
        EPI_END
    }
};
struct EpiKV {
    static constexpr bool PERM = false, AFTER_DRAIN = false;
    bf16_t* kv; const float* ssq;
    __device__ __forceinline__ void operator()(AccRef acc, const pg8::Unit& u, int wr, int wc, int fr, int fq) const {
        EPI_ROWS(u.pm)
            const f32x4 sq = *(const f32x4*)(ssq + (size_t)row * 4); const float rs = rsqrtf(((sq.x + sq.y) + (sq.z + sq.w)) * (1.f / 256.f) + EPS);
            bf16_t* dst = kv + (size_t)row * 2048 + u.pn * 256;
            EPI_COLS st_bf4(dst + col, v * rs); EPI_END
        EPI_END
    }
};
struct EpiMla {
    static constexpr bool PERM = false, AFTER_DRAIN = false;
    const bf16_t* sgm; float* t;
    __device__ __forceinline__ void operator()(AccRef acc, const pg8::Unit& u, int wr, int wc, int fr, int fq) const {
        EPI_ROWS(u.pm)
            const size_t off = (size_t)row * 1024 + u.pn * 256;
            EPI_COLS *(f32x4*)(t + off + col) = ld_bf4(sgm + off + col) * v; EPI_END
        EPI_END
    }
};
struct EpiSsd {
    static constexpr bool PERM = false, AFTER_DRAIN = false;
    const bf16_t* sgs; const float* t; const float* ssq_y; bf16_t* merged;
    __device__ __forceinline__ void operator()(AccRef acc, const pg8::Unit& u, int wr, int wc, int fr, int fq) const {
        EPI_ROWS(u.pm)
            float s = 0.f;
#pragma unroll
            for (int q = 0; q < 4; ++q) { const f32x4 a = *(const f32x4*)(ssq_y + (size_t)row * 16 + q * 4); s += (a.x + a.y) + (a.z + a.w); }
            const float rs = rsqrtf(s * (1.f / 1024.f) + EPS); const size_t off = (size_t)row * 1024 + u.pn * 256;
            EPI_COLS st_bf4(merged + off + col, *(const f32x4*)(t + off + col) + ld_bf4(sgs + off + col) * (v * rs)); EPI_END
        EPI_END
    }
};
struct EpiOut {
    static constexpr bool PERM = false, AFTER_DRAIN = false;
    const float *xp, *xs, *mod, *gffn; float* x1; bf16_t* a1; float* ssq2;
    __device__ __forceinline__ void operator()(AccRef acc, const pg8::Unit& u, int wr, int wc, int fr, int fq) const {
        const int g = u.pm < 32 ? 0 : 1 + ((u.pm - 32) >> 3); const float* md = mod + g * 6144;
        EPI_ROWS(u.pm)
            const float* xr = row < RP ? xp + (size_t)row * DM : xs + (size_t)(row - RP) * DM; const size_t off = (size_t)row * 1024; float s = 0.f;
            EPI_COLS
                const int c = u.pn * 256 + col; const f32x4 x1v = *(const f32x4*)(xr + c) + *(const f32x4*)(md + 2048 + c) * v;
                *(f32x4*)(x1 + off + c) = x1v; s += (x1v.x * x1v.x + x1v.y * x1v.y) + (x1v.z * x1v.z + x1v.w * x1v.w);
                st_bf4(a1 + off + c, x1v * *(const f32x4*)(gffn + c) * (*(const f32x4*)(md + 4096 + c) + 1.f));
            EPI_END
            s = quad_sum16(s);
            if (fq == 0) ssq2[(size_t)row * 16 + u.pn * 4 + wc] = s;
        EPI_END
    }
};
struct EpiUp {
    static constexpr bool PERM = false, AFTER_DRAIN = false;
    const float *ssq2, *cup; bf16_t* uo;
    __device__ __forceinline__ void operator()(AccRef acc, const pg8::Unit& u, int wr, int wc, int fr, int fq) const {
        const int g = u.pm < 32 ? 0 : 1 + ((u.pm - 32) >> 3); const float* cu = cup + g * UPN + u.pn * 256;
        EPI_ROWS(u.pm)
            float s = 0.f;
#pragma unroll
            for (int q = 0; q < 4; ++q) { const f32x4 a = *(const f32x4*)(ssq2 + (size_t)row * 16 + q * 4); s += (a.x + a.y) + (a.z + a.w); }
            const float rs = rsqrtf(s * (1.f / 1024.f) + EPS); bf16_t* dst = uo + (size_t)row * UPN + u.pn * 256;
            EPI_COLS st_bf4(dst + col, v * rs + *(const f32x4*)(cu + col)); EPI_END
        EPI_END
    }
};
struct EpiDown {
    static constexpr bool PERM = false, AFTER_DRAIN = false;
    const float* mod; float* x;
    __device__ __forceinline__ void operator()(AccRef acc, const pg8::Unit& u, int wr, int wc, int fr, int fq) const {
        const int g = u.pm < 32 ? 0 : 1 + ((u.pm - 32) >> 3); const float* g2 = mod + g * 6144 + 5120 + u.pn * 256;
        EPI_ROWS(u.pm)
            float* xr = x + (size_t)row * 1024 + u.pn * 256;
            EPI_COLS *(f32x4*)(xr + col) = *(const f32x4*)(xr + col) + *(const f32x4*)(g2 + col) * v; EPI_END
        EPI_END
    }
};

template <class Epi>
__device__ __forceinline__ void run_gemm(LAS unsigned char* lds, const bf16_t* A, const bf16_t* Bt, int M, int N, int K, int G, int c, const Epi& E) {
    pg8::Gemm g{A, Bt, M, N, K}; pg8::StaticOrder S; S.init(M, N, G, c);
    pg8::gemm_phase<Epi, pg8::StaticOrder, PG8_ALIGN, PG8_SP2>(lds, g, S, E);
}

__device__ __forceinline__ void phase_conv(const Params& P) {
    PHASE_IDS unsigned char* ws = P.ws; const bf16_t* xbc = (const bf16_t*)(ws + WS_XBC); bf16_t* xc = (bf16_t*)(ws + WS_XC);
    const float* cw = P.in[I_CONVW]; const float* cb = P.in[I_CONVB];
    const int gt = blockIdx.x * NT + tid, GT = G * NT;
    for (int i = gt; i < R * (1536 / 4); i += GT) {
        const int row = i / 384, c = (i % 384) * 4; const int t = row < RP ? (row & 255) : ((row - RP) & 2047), L = row < RP ? SEQP : SEQS;
        f32x4 a = *(const f32x4*)(cb + c);
        if (t > 0) a += ld_bf4(xbc + (size_t)(row - 1) * 1536 + c) * *(const f32x4*)(cw + c);
        a += ld_bf4(xbc + (size_t)row * 1536 + c) * *(const f32x4*)(cw + 1536 + c);
        if (t < L - 1) a += ld_bf4(xbc + (size_t)(row + 1) * 1536 + c) * *(const f32x4*)(cw + 3072 + c);
        st_bf4(xc + (size_t)row * 1536 + c, (f32x4){siluf(a.x), siluf(a.y), siluf(a.z), siluf(a.w)});
    }
    const int gw = blockIdx.x * 8 + wave, NGW = G * 8;
    float* nck = P.out + O_CKV; const float* ssq = (const float*)(ws + WS_SSQ_CKV); const float* gk = P.in[I_GKV];
    for (int row = gw; row < RP; row += NGW) {
        const f32x4 sq = *(const f32x4*)(ssq + (size_t)row * 4); const float rs = rsqrtf(((sq.x + sq.y) + (sq.z + sq.w)) * (1.f / 256.f) + EPS);
        f32x4* p = (f32x4*)(nck + (size_t)row * 256) + lane; *p = *p * rs * *(const f32x4*)(gk + 4 * lane);
    }
}
__device__ __forceinline__ void phase_ssd_naive(const Params& P) {
    PHASE_IDS unsigned char* ws = P.ws; const bf16_t* xc = (const bf16_t*)(ws + WS_XC); const float* dt = (const float*)(ws + WS_DT);
    const int gw = blockIdx.x * 8 + wave, NGW = G * 8;
    for (int task = gw; task < 64 + 1024; task += NGW) {
        int b, dir, h, L, row0; bool smp = task < 64;
        if (smp) { b = task >> 5; dir = (task >> 4) & 1; h = task & 15; L = SEQS; row0 = RP + b * SEQS; }
        else { const int q = task - 64; b = q >> 5; dir = (q >> 4) & 1; h = q & 15; L = SEQP; row0 = b * SEQP; }
        const float A = -__expf(P.in[I_ALOG][dir * 16 + h]); const int g = h >> 2;
        float hs[64];
#pragma unroll
        for (int n = 0; n < 64; ++n) hs[n] = smp ? P.in[I_SSD][((((size_t)b * 2 + dir) * 16 + h) * 64 + lane) * 64 + n] : 0.f;
        float* yo = (float*)(ws + (dir ? WS_ST : WS_YF));
        for (int step = 0; step < L; ++step) {
            const int row = row0 + (dir ? L - 1 - step : step);
            const float dtv = dt[(size_t)row * 32 + dir * 16 + h]; const float a = __expf(dtv * A);
            const float xd = bf2f(xc[(size_t)row * 1536 + h * 64 + lane]) * dtv;
            const u32x4* Bp = (const u32x4*)(xc + (size_t)row * 1536 + 1024 + g * 64); const u32x4* Cp = (const u32x4*)(xc + (size_t)row * 1536 + 1280 + g * 64);
            float y = 0.f;
#pragma unroll
            for (int q = 0; q < 8; ++q) { const u32x4 bw = Bp[q], cw = Cp[q];
#pragma unroll
                for (int e = 0; e < 4; ++e) { const int n = q * 8 + e * 2;
                    hs[n] = hs[n] * a + xd * bflo(bw[e]); y += bflo(cw[e]) * hs[n];
                    hs[n + 1] = hs[n + 1] * a + xd * bfhi(bw[e]); y += bfhi(cw[e]) * hs[n + 1]; } }
            yo[(size_t)row * 1024 + h * 64 + lane] = y;
        }
        if (!smp) { float* so = P.out + O_SSD + ((((size_t)b * 2 + dir) * 16 + h) * 64 + lane) * 64;
#pragma unroll
            for (int n = 0; n < 64; n += 4) *(f32x4*)(so + n) = (f32x4){hs[n], hs[n + 1], hs[n + 2], hs[n + 3]}; }
    }
}
__device__ __forceinline__ void phase_gate(const Params& P) {
    PHASE_IDS unsigned char* ws = P.ws; const float* yf = (const float*)(ws + WS_YF); const float* yb = (const float*)(ws + WS_ST);
    const bf16_t* xc = (const bf16_t*)(ws + WS_XC); bf16_t* z = (bf16_t*)(ws + WS_Z); float* ssq = (float*)(ws + WS_SSQ_Y);
    const int gw = blockIdx.x * 8 + wave, NGW = G * 8;
    for (int row = gw; row < R; row += NGW) {
#pragma unroll
        for (int j = 0; j < 4; ++j) { const int c = 4 * lane + 256 * j, h = c >> 6; const float Dh = P.in[I_SSDD][h];
            const f32x4 zz = ld_bf4(z + (size_t)row * 1024 + c), xx = ld_bf4(xc + (size_t)row * 1536 + c);
            f32x4 v = *(const f32x4*)(yf + (size_t)row * 1024 + c) + *(const f32x4*)(yb + (size_t)row * 1024 + c) + xx * Dh;
            v = v * (f32x4){siluf(zz.x), siluf(zz.y), siluf(zz.z), siluf(zz.w)};
            float s = (v.x * v.x + v.y * v.y) + (v.z * v.z + v.w * v.w);
            s += __shfl_xor(s, 1); s += __shfl_xor(s, 2); s += __shfl_xor(s, 4); s += __shfl_xor(s, 8);
            st_bf4(z + (size_t)row * 1024 + c, v);
            if ((lane & 15) == 0) ssq[(size_t)row * 16 + h] = s; }
    }
}
__device__ __forceinline__ void phase_attn_naive(const Params& P, LAS unsigned char* lds) {
    PHASE_IDS unsigned char* ws = P.ws; bf16_t* qn = (bf16_t*)(ws + WS_QN); const bf16_t* qr = (const bf16_t*)(ws + WS_QR);
    const bf16_t* kv = (const bf16_t*)(ws + WS_KV); const bf16_t* kr = (const bf16_t*)(ws + WS_KROPE);
    LAS float* qs = (LAS float*)lds + wave * 192;
    const int gw = blockIdx.x * 8 + wave, NGW = G * 8;
    for (int task = gw; task < R * NH; task += NGW) {
        const int rr = task >> 3, h = task & 7; const int row = rr < RS ? RP + rr : rr - RS;
        int kv0, nk; if (row < RP) { kv0 = (row >> 8) * SEQP; nk = SEQP; } else { kv0 = RP + ((row - RP) >> 11) * KVS; nk = KVS; }
        qs[lane] = bf2f(qn[(size_t)row * 1024 + h * 128 + lane]); qs[64 + lane] = bf2f(qn[(size_t)row * 1024 + h * 128 + 64 + lane]);
        qs[128 + lane] = bf2f(qr[(size_t)row * 512 + h * 64 + lane]);
        LDS_WAIT(); asm volatile("" ::: "memory");
        float m = -1e30f, l = 0.f, o0 = 0.f, o1 = 0.f;
        for (int k0 = 0; k0 < nk; k0 += 64) {
            const size_t krow = (size_t)(kv0 + k0 + lane);
            const u32x4* kp = (const u32x4*)(kv + krow * 2048 + h * 256); const u32x4* rp = (const u32x4*)(kr + krow * 64);
            float s = 0.f;
#pragma unroll 4
            for (int q = 0; q < 16; ++q) { const u32x4 w = kp[q];
#pragma unroll
                for (int e = 0; e < 4; ++e) s += qs[q * 8 + e * 2] * bflo(w[e]) + qs[q * 8 + e * 2 + 1] * bfhi(w[e]); }
#pragma unroll 4
            for (int q = 0; q < 8; ++q) { const u32x4 w = rp[q];
#pragma unroll
                for (int e = 0; e < 4; ++e) s += qs[128 + q * 8 + e * 2] * bflo(w[e]) + qs[128 + q * 8 + e * 2 + 1] * bfhi(w[e]); }
            s *= ATT_SCALE;
            const float mn = fmaxf(m, wave_max(s)); const float p = __expf(s - mn), al = __expf(m - mn);
            l = l * al + wave_sum(p); o0 *= al; o1 *= al; m = mn;
            const bf16_t* vp = kv + (size_t)(kv0 + k0) * 2048 + h * 256 + 128;
#pragma unroll 8
            for (int j = 0; j < 64; ++j) { const float pj = __shfl(p, j); o0 += pj * bf2f(vp[(size_t)j * 2048 + lane]); o1 += pj * bf2f(vp[(size_t)j * 2048 + 64 + lane]); }
        }
        const float il = 1.f / l;
        qn[(size_t)row * 1024 + h * 128 + lane] = (bf16_t)f2bf(o0 * il); qn[(size_t)row * 1024 + h * 128 + 64 + lane] = (bf16_t)f2bf(o1 * il);
        asm volatile("" ::: "memory");
    }
}
namespace att {
using s16x4 = __attribute__((ext_vector_type(4))) short;
using f32x16 = __attribute__((ext_vector_type(16))) float;
constexpr int QBLK = 32, KVBLK = 64;
constexpr float SCALE = ATT_SCALE, THR = 8.f;
constexpr int SHM_V = 16384, SHM_K = 16384, SHM_KR = 8192;
constexpr int L_V = 0, L_K = 2 * SHM_V, L_KR = L_K + 2 * SHM_K, L_WS = L_KR + 2 * SHM_KR, L_QR = L_WS + 8 * 64 * 4, L_END = L_QR + 8 * 4096;
#define KSWZ(row, colB) ((row) * 256 + ((colB) ^ (((row) & 7) << 4)))
#define KRSWZ(row, colB) ((row) * 128 + ((colB) ^ ((((row) >> 1) & 7) << 4)))
#define SBAR() __builtin_amdgcn_sched_barrier(0)
__device__ __forceinline__ int crow(int r, int hi) { return (r & 3) + 8 * (r >> 2) + 4 * hi; }
__device__ __forceinline__ unsigned cvtpk(float lo, float hi) { unsigned r; asm volatile("v_cvt_pk_bf16_f32 %0, %1, %2" : "=v"(r) : "v"(lo), "v"(hi)); return r; }
__device__ __forceinline__ void partialSM(f32x16& p0, f32x16& p1, float& m_reg, float& mn, float& alpha) {
  constexpr float C = SCALE * 1.4426950408889634f;
  float pmax = p0[0];
#pragma unroll
  for (int r = 1; r < 16; ++r) pmax = fmaxf(pmax, p0[r]);
#pragma unroll
  for (int r = 0; r < 16; ++r) pmax = fmaxf(pmax, p1[r]);
  { auto rr = __builtin_amdgcn_permlane32_swap(__float_as_uint(pmax), __float_as_uint(pmax), false, false);
    pmax = fmaxf(__uint_as_float(rr[0]), __uint_as_float(rr[1])); }
  if (__builtin_expect(__all(pmax - m_reg <= THR / SCALE), 1)) { mn = m_reg; alpha = 1.f; }
  else { mn = fmaxf(m_reg, pmax); alpha = __builtin_amdgcn_exp2f((m_reg - mn) * C); m_reg = mn; }
  float mnC = -mn * C;
#pragma unroll
  for (int r = 0; r < 16; ++r) p0[r] = fmaf(p0[r], C, mnC);
#pragma unroll
  for (int r = 0; r < 16; ++r) p1[r] = fmaf(p1[r], C, mnC);
#pragma unroll
  for (int r = 0; r < 16; ++r) p0[r] = __builtin_amdgcn_exp2f(p0[r]);
}
__device__ __forceinline__ void finishSM(f32x16& p0, f32x16& p1, float alpha, float& l_reg, bf16x8& pa0, bf16x8& pa1, bf16x8& pa2, bf16x8& pa3) {
#pragma unroll
  for (int r = 0; r < 16; ++r) p1[r] = __builtin_amdgcn_exp2f(p1[r]);
  float ps = 0;
#pragma unroll
  for (int r = 0; r < 16; ++r) ps += p0[r];
#pragma unroll
  for (int r = 0; r < 16; ++r) ps += p1[r];
  { auto rr = __builtin_amdgcn_permlane32_swap(__float_as_uint(ps), __float_as_uint(ps), false, false);
    ps = __uint_as_float(rr[0]) + __uint_as_float(rr[1]); }
  l_reg = l_reg * alpha + ps;
#define PK4(P, BASE, OUT) do { unsigned a0 = cvtpk(P[BASE + 0], P[BASE + 1]), a1 = cvtpk(P[BASE + 2], P[BASE + 3]);   \
    unsigned b0 = cvtpk(P[BASE + 4], P[BASE + 5]), b1 = cvtpk(P[BASE + 6], P[BASE + 7]);                              \
    auto r0 = __builtin_amdgcn_permlane32_swap(a0, b0, false, false); auto r1 = __builtin_amdgcn_permlane32_swap(a1, b1, false, false); \
    u32x4 w = {r0[0], r1[0], r0[1], r1[1]}; OUT = *reinterpret_cast<bf16x8*>(&w); } while (0)
  PK4(p0, 0, pa0); PK4(p0, 8, pa1); PK4(p1, 0, pa2); PK4(p1, 8, pa3);
#undef PK4
}
__device__ __forceinline__ void qkt(f32x16& p0, f32x16& p1, const LAS char* Ks, const LAS char* Krs, const bf16x8* qr, const LAS char* qrl, int r32, int hi) {
  p0 = f32x16{}; p1 = f32x16{};
#pragma unroll
  for (int d0 = 0; d0 < 8; ++d0) { const int cb = (d0 * 16 + hi * 8) * 2;
    const bf16x8 b0 = *reinterpret_cast<const LAS bf16x8*>(Ks + KSWZ(r32, cb));
    const bf16x8 b1 = *reinterpret_cast<const LAS bf16x8*>(Ks + KSWZ(32 + r32, cb));
    p0 = __builtin_amdgcn_mfma_f32_32x32x16_bf16(b0, qr[d0], p0, 0, 0, 0);
    p1 = __builtin_amdgcn_mfma_f32_32x32x16_bf16(b1, qr[d0], p1, 0, 0, 0); }
#pragma unroll
  for (int d0 = 0; d0 < 4; ++d0) { const int cb = (d0 * 16 + hi * 8) * 2;
    const bf16x8 b0 = *reinterpret_cast<const LAS bf16x8*>(Krs + KRSWZ(r32, cb));
    const bf16x8 b1 = *reinterpret_cast<const LAS bf16x8*>(Krs + KRSWZ(32 + r32, cb));
    const bf16x8 qq = *reinterpret_cast<const LAS bf16x8*>(qrl + d0 * 1024);
    p0 = __builtin_amdgcn_mfma_f32_32x32x16_bf16(b0, qq, p0, 0, 0, 0);
    p1 = __builtin_amdgcn_mfma_f32_32x32x16_bf16(b1, qq, p1, 0, 0, 0); }
}
__device__ __forceinline__ int v_st(int k, int c) { const int kk = (k & ~0xC) | ((k & 4) << 1) | ((k & 8) >> 1); return ((kk >> 3) * 4 + (c >> 5)) * 512 + ((kk & 7) * 32 + (c & 31)) * 2; }
__device__ __forceinline__ int v_rd_base(int lane) { return ((lane & 3) << 3) | (((lane >> 2) & 3) << 6) | (((lane >> 4) & 1) << 5) | (((lane >> 5) & 1) << 8); }
constexpr int v_rd_off(int d0, int ks, int half) { return d0 * 512 + ks * 4096 + half * 2048; }
template <int OFF> __device__ __forceinline__ s16x4 tr_read(int vb) {
  s16x4 r; asm volatile("ds_read_b64_tr_b16 %0, %1 offset:%2" : "=&v"(r) : "v"(vb), "i"(OFF) : "memory"); return r;
}
template <int D0> __device__ __forceinline__ void pv_one(f32x16& od, int vb, bf16x8 pa0, bf16x8 pa1, bf16x8 pa2, bf16x8 pa3) {
  const s16x4 l0 = tr_read<v_rd_off(D0, 0, 0)>(vb), h0 = tr_read<v_rd_off(D0, 0, 1)>(vb), l1 = tr_read<v_rd_off(D0, 1, 0)>(vb), h1 = tr_read<v_rd_off(D0, 1, 1)>(vb);
  const s16x4 l2 = tr_read<v_rd_off(D0, 2, 0)>(vb), h2 = tr_read<v_rd_off(D0, 2, 1)>(vb), l3 = tr_read<v_rd_off(D0, 3, 0)>(vb), h3 = tr_read<v_rd_off(D0, 3, 1)>(vb);
  asm volatile("s_waitcnt lgkmcnt(0)" ::: "memory"); SBAR();
#define PK(L, H) (bf16x8){L[0], L[1], L[2], L[3], H[0], H[1], H[2], H[3]}
  od = __builtin_amdgcn_mfma_f32_32x32x16_bf16(pa0, PK(l0, h0), od, 0, 0, 0);
  od = __builtin_amdgcn_mfma_f32_32x32x16_bf16(pa1, PK(l1, h1), od, 0, 0, 0);
  od = __builtin_amdgcn_mfma_f32_32x32x16_bf16(pa2, PK(l2, h2), od, 0, 0, 0);
  od = __builtin_amdgcn_mfma_f32_32x32x16_bf16(pa3, PK(l3, h3), od, 0, 0, 0);
#undef PK
}
__device__ __forceinline__ void pv_d0(f32x16* o, int vb, bf16x8 pa0, bf16x8 pa1, bf16x8 pa2, bf16x8 pa3) {
  pv_one<0>(o[0], vb, pa0, pa1, pa2, pa3); pv_one<1>(o[1], vb, pa0, pa1, pa2, pa3); pv_one<2>(o[2], vb, pa0, pa1, pa2, pa3); pv_one<3>(o[3], vb, pa0, pa1, pa2, pa3);
}
__device__ __forceinline__ void attn_unit(const bf16_t* __restrict__ Qn, const bf16_t* __restrict__ Qr, const bf16_t* __restrict__ Kh, const bf16_t* __restrict__ Vh,
                                          const bf16_t* __restrict__ Krh, bf16_t* Ob, int seq, LAS char* lds, int tid) {
  constexpr int LDQ = 1024, LDQR = 512, LDK = 2048, LDKR = 64, LDO = 1024;
  const int wid = tid >> 6, lane = tid & 63, r32 = lane & 31, hi = lane >> 5;
  LAS char* V_lds = lds + L_V; LAS char* K_lds = lds + L_K; LAS char* KR_lds = lds + L_KR;
  LAS float* wsf = (LAS float*)(lds + L_WS) + wid * 64; LAS float* li_l = wsf; LAS float* al_l = wsf + 32;
  float m_reg = -1e30f, l_reg = 0; f32x16 o[4] = {}; bf16x8 qr[8];
  LAS char* qrl = lds + L_QR + wid * 4096 + lane * 16;
  { const unsigned qo = (unsigned)((wid * QBLK + r32) * LDQ + hi * 8);
#pragma unroll
    for (int d0 = 0; d0 < 8; ++d0) qr[d0] = *reinterpret_cast<const bf16x8*>(Qn + (qo + d0 * 16));
    const unsigned qo2 = (unsigned)((wid * QBLK + r32) * LDQR + hi * 8);
#pragma unroll
    for (int d0 = 0; d0 < 4; ++d0) *reinterpret_cast<LAS bf16x8*>(qrl + d0 * 1024) = *reinterpret_cast<const bf16x8*>(Qr + (qo2 + d0 * 16)); }
  const int sr = tid >> 4, sc = (tid & 15) * 8, vst0 = v_st(sr, sc), vst1 = v_st(32 + sr, sc);
  const int rr_ = tid >> 3, rc_ = (tid & 7) * 8, krst = KRSWZ(rr_, rc_ * 2);
  const int vb0 = (int)(unsigned)(uintptr_t)V_lds + v_rd_base(lane);
  constexpr int SDEPTH = 1;
  struct { bf16x8 vs0, vs1, ks0, ks1, kr; } sr_[SDEPTH];
  const unsigned kvo = (unsigned)(sr * LDK + sc), kro = (unsigned)(rr_ * LDKR + rc_);
#define SLOAD(i, k0) do { const bf16_t* vp_ = Vh + (size_t)(k0) * LDK; const bf16_t* kp_ = Kh + (size_t)(k0) * LDK; const bf16_t* rp_ = Krh + (size_t)(k0) * LDKR; \
    sr_[i].vs0 = *reinterpret_cast<const bf16x8*>(vp_ + kvo); sr_[i].vs1 = *reinterpret_cast<const bf16x8*>(vp_ + (kvo + 32u * LDK)); \
    sr_[i].ks0 = *reinterpret_cast<const bf16x8*>(kp_ + kvo); sr_[i].ks1 = *reinterpret_cast<const bf16x8*>(kp_ + (kvo + 32u * LDK)); \
    sr_[i].kr = *reinterpret_cast<const bf16x8*>(rp_ + kro); } while (0)
#define SWRITE(b, i) do { *(LAS bf16x8*)(V_lds + (b) * SHM_V + vst0) = sr_[i].vs0; *(LAS bf16x8*)(V_lds + (b) * SHM_V + vst1) = sr_[i].vs1; const int kc = sc * 2; \
    *(LAS bf16x8*)(K_lds + (b) * SHM_K + KSWZ(sr, kc)) = sr_[i].ks0; *(LAS bf16x8*)(K_lds + (b) * SHM_K + KSWZ(32 + sr, kc)) = sr_[i].ks1; \
    *(LAS bf16x8*)(KR_lds + (b) * SHM_KR + krst) = sr_[i].kr; } while (0)
#define SWAIT() do { if constexpr (SDEPTH == 2) asm volatile("s_waitcnt vmcnt(5)" ::: "memory"); else asm volatile("s_waitcnt vmcnt(0)" ::: "memory"); } while (0)
#define RESC(a) do { if (__any((a) < 1.f)) { if (hi == 0) al_l[r32] = (a); asm volatile("s_waitcnt lgkmcnt(0)" ::: "memory"); \
    _Pragma("unroll") for (int d = 0; d < 4; ++d) _Pragma("unroll") for (int r = 0; r < 16; ++r) o[d][r] *= al_l[crow(r, hi)]; } } while (0)
  f32x16 pA0, pA1, pB0, pB1; float mnA, mnB, alA, alB; bf16x8 pa0, pa1, pa2, pa3; const int NTL = seq / KVBLK;
  constexpr int SE = 0, SO = SDEPTH - 1;
  SLOAD(SE, 0); asm volatile("s_waitcnt vmcnt(0)" ::: "memory"); SWRITE(0, SE); __syncthreads();
  qkt(pA0, pA1, K_lds, KR_lds, qr, qrl, r32, hi); partialSM(pA0, pA1, m_reg, mnA, alA);
  SLOAD(SO, KVBLK); if constexpr (SDEPTH == 2) { if (2 < NTL) SLOAD(SE, 2 * KVBLK); }
  SWAIT(); SWRITE(1, SO); __syncthreads();
  for (int j = 1; j + 1 < NTL; j += 2) {
    SBAR(); qkt(pB0, pB1, K_lds + SHM_K, KR_lds + SHM_KR, qr, qrl, r32, hi);
    finishSM(pA0, pA1, alA, l_reg, pa0, pa1, pa2, pa3); SBAR();
    SLOAD(SO, (j + SDEPTH) * KVBLK); SBAR();
    pv_d0(o, vb0, pa0, pa1, pa2, pa3); partialSM(pB0, pB1, m_reg, mnB, alB);
    __syncthreads(); SWAIT(); SWRITE(0, SE);
    RESC(alB); __syncthreads();
    SBAR(); qkt(pA0, pA1, K_lds, KR_lds, qr, qrl, r32, hi);
    finishSM(pB0, pB1, alB, l_reg, pa0, pa1, pa2, pa3); SBAR();
    if (SDEPTH == 1 || j + 3 < NTL) SLOAD(SE, (j + 1 + SDEPTH) * KVBLK); SBAR();
    pv_d0(o, vb0 + SHM_V, pa0, pa1, pa2, pa3); partialSM(pA0, pA1, m_reg, mnA, alA);
    __syncthreads(); SWAIT(); SWRITE(1, SO);
    RESC(alA); __syncthreads();
  }
  SBAR(); qkt(pB0, pB1, K_lds + SHM_K, KR_lds + SHM_KR, qr, qrl, r32, hi);
  finishSM(pA0, pA1, alA, l_reg, pa0, pa1, pa2, pa3); SBAR();
  pv_d0(o, vb0, pa0, pa1, pa2, pa3); partialSM(pB0, pB1, m_reg, mnB, alB);
  __syncthreads(); RESC(alB);
  finishSM(pB0, pB1, alB, l_reg, pa0, pa1, pa2, pa3); SBAR();
  pv_d0(o, vb0 + SHM_V, pa0, pa1, pa2, pa3);
  if (hi == 0) li_l[r32] = l_reg; asm volatile("s_waitcnt lgkmcnt(0)" ::: "memory");
  float rli[16];
#pragma unroll
  for (int r = 0; r < 16; ++r) rli[r] = __builtin_amdgcn_rcpf(li_l[crow(r, hi)]);
#pragma unroll
  for (int r = 0; r < 16; ++r) { const unsigned oo = (unsigned)((wid * QBLK + crow(r, hi)) * LDO + r32);
#pragma unroll
    for (int d0 = 0; d0 < 4; ++d0) Ob[oo + d0 * 32] = (bf16_t)f2bf(o[d0][r] * rli[r]); }
  __syncthreads();
#undef SLOAD
#undef SWRITE
#undef SWAIT
#undef RESC
}
}

__device__ __forceinline__ void phase_attn(const Params& P, LAS unsigned char* lds) {
    PHASE_IDS unsigned char* ws = P.ws; bf16_t* qn = (bf16_t*)(ws + WS_QN); const bf16_t* qr = (const bf16_t*)(ws + WS_QR);
    const bf16_t* kv = (const bf16_t*)(ws + WS_KV); const bf16_t* kr = (const bf16_t*)(ws + WS_KROPE);
    for (int u = blockIdx.x; u < 384; u += G) {
        int row0, kv0, h, seq;
        if (u < 128) { const int x = u & 7, k = u >> 3, bh = x + 8 * (k >> 3), qb = k & 7, b = bh >> 3; h = bh & 7; row0 = RP + b * SEQS + qb * 256; kv0 = RP + b * KVS; seq = KVS; }
        else { const int q = u - 128, b = q >> 3; h = q & 7; row0 = b * SEQP; kv0 = row0; seq = SEQP; }
        int t2 = tid; asm volatile("" : "+v"(t2));
        att::attn_unit(qn + (size_t)row0 * 1024 + h * 128, qr + (size_t)row0 * 512 + h * 64, kv + (size_t)kv0 * 2048 + h * 256, kv + (size_t)kv0 * 2048 + h * 256 + 128,
                       kr + (size_t)kv0 * 64, qn + (size_t)row0 * 1024 + h * 128, seq, (LAS char*)lds, t2);
    }
}
namespace ssd {
typedef short v4i16_t __attribute__((ext_vector_type(4)));
constexpr int RSB = 144;
constexpr int TB = 128 * RSB;
constexpr int L_X = 0, L_B = TB, L_C = 2 * TB, L_HF = 3 * TB, L_HB = 3 * TB + 64 * RSB, L_ARR = 3 * TB + 128 * RSB, L_SC = L_ARR + 2048, L_END = L_SC + 64;
struct UnitInfo { int b, c, h, nc, row0; bool smp; };
__device__ __forceinline__ UnitInfo decode(int u) { UnitInfo I; if (u < 512) { I.smp = true; I.b = u >> 8; I.c = (u >> 4) & 15; I.h = u & 15; I.nc = 16; I.row0 = RP + I.b * SEQS + I.c * 128; }
    else { const int q = u - 512; I.smp = false; I.b = q >> 5; I.c = (q >> 4) & 1; I.h = q & 15; I.nc = 2; I.row0 = I.b * SEQP + I.c * 128; } return I; }
__device__ __forceinline__ int unit_id(bool smp, int b, int c, int h) { return smp ? ((b * 16 + c) * 16 + h) : 512 + ((b * 2 + c) * 16 + h); }
__device__ __forceinline__ bf16x8 tr2(const LAS char* p0, const LAS char* p1) {
    const v4i16_t a = __builtin_amdgcn_ds_read_tr16_b64_v4i16((LAS v4i16_t*)p0), b = __builtin_amdgcn_ds_read_tr16_b64_v4i16((LAS v4i16_t*)p1);
    return (bf16x8){a[0], a[1], a[2], a[3], b[0], b[1], b[2], b[3]};
}
__device__ __forceinline__ float wave_incl_scan(float v, int lane) {
#pragma unroll
    for (int o = 1; o < 64; o <<= 1) { const float t = __shfl_up(v, o); if (lane >= o) v += t; }
    return v;
}
__device__ __forceinline__ void chunk_scalars(const float* dt, int row0, int h, float Af, float Ab, LAS f32x4* arr, LAS float* sc, int lane) {
    const float df0 = dt[(size_t)(row0 + lane) * 32 + h], df1 = dt[(size_t)(row0 + 64 + lane) * 32 + h];
    const float db0 = dt[(size_t)(row0 + lane) * 32 + 16 + h], db1 = dt[(size_t)(row0 + 64 + lane) * 32 + 16 + h];
    const float af0 = df0 * Af, af1 = df1 * Af, ab0 = db0 * Ab, ab1 = db1 * Ab;
    const float s0 = wave_incl_scan(af0, lane), t0 = __shfl(s0, 63), s1 = wave_incl_scan(af1, lane) + t0;
    const float r0 = wave_incl_scan(ab0, lane), u0 = __shfl(r0, 63), r1 = wave_incl_scan(ab1, lane) + u0, tot = __shfl(r1, 63);
    arr[lane] = (f32x4){s0, tot - (r0 - ab0), df0, db0};
    arr[64 + lane] = (f32x4){s1, tot - (r1 - ab1), df1, db1};
    if (lane == 63) { sc[0] = s1; sc[1] = tot; }
}
__device__ __forceinline__ void pass_a_unit(const Params& P, int u, LAS char* lds, int tid) {
    unsigned char* ws = P.ws; const bf16_t* xc = (const bf16_t*)(ws + WS_XC); const float* dt = (const float*)(ws + WS_DT);
    const int lane = tid & 63, wave = tid >> 6; const UnitInfo I = decode(u); const int g = I.h >> 2;
    LAS f32x4* arr = (LAS f32x4*)(lds + L_ARR); LAS float* sc = (LAS float*)(lds + L_SC);
    const float Af = -__expf(P.in[I_ALOG][I.h]), Ab = -__expf(P.in[I_ALOG][16 + I.h]);
    if (wave == 0) chunk_scalars(dt, I.row0, I.h, Af, Ab, arr, sc, lane);
    __syncthreads();
    { const int r = tid >> 2, c0 = (tid & 3) * 16; const f32x4 a = arr[r]; const float totf = sc[0], totb = sc[1];
      const float wf = a.z * __expf(totf - a.x), wb = a.w * __expf(totb - a.y);
      const bf16_t* xr = xc + (size_t)(I.row0 + r) * 1536;
#pragma unroll
      for (int q = 0; q < 2; ++q) { const int cc = c0 + q * 8;
          const u32x4 xv = *(const u32x4*)(xr + I.h * 64 + cc); const u32x4 bv = *(const u32x4*)(xr + 1024 + g * 64 + cc);
          u32x4 of, ob;
#pragma unroll
          for (int e = 0; e < 4; ++e) { const float lo = bflo(xv[e]), hi = bfhi(xv[e]); of[e] = pk2(lo * wf, hi * wf); ob[e] = pk2(lo * wb, hi * wb); }
          *(LAS u32x4*)(lds + L_X + r * RSB + cc * 2) = of; *(LAS u32x4*)(lds + L_C + r * RSB + cc * 2) = ob; *(LAS u32x4*)(lds + L_B + r * RSB + cc * 2) = bv; } }
    __syncthreads();
    { const int d = wave >> 2, pt = wave & 3, gq = lane >> 4, q4 = (lane >> 2) & 3, p4 = lane & 3;
      const LAS char* xb = lds + (d ? L_C : L_X) + (8 * gq + q4) * RSB + (16 * pt + 4 * p4) * 2;
      const LAS char* bb = lds + L_B + (8 * gq + q4) * RSB + (4 * p4) * 2;
      f32x4 acc[4] = {};
#pragma unroll
      for (int s4 = 0; s4 < 4; ++s4) { const bf16x8 af = tr2(xb + s4 * 32 * RSB, xb + s4 * 32 * RSB + 4 * RSB);
#pragma unroll
          for (int nt = 0; nt < 4; ++nt) { const bf16x8 bf = tr2(bb + s4 * 32 * RSB + nt * 32, bb + s4 * 32 * RSB + 4 * RSB + nt * 32);
              acc[nt] = __builtin_amdgcn_mfma_f32_16x16x32_bf16(af, bf, acc[nt], 0, 0, 0); } }
      float* So = (float*)(ws + WS_ST) + ((size_t)u * 2 + d) * 4096;
#pragma unroll
      for (int nt = 0; nt < 4; ++nt)
#pragma unroll
          for (int r = 0; r < 4; ++r) So[(16 * pt + 4 * gq + r) * 64 + nt * 16 + (lane & 15)] = acc[nt][r];
    }
    if (tid == 0) { float* dec = (float*)(ws + WS_DEC) + (size_t)u * 2; dec[0] = __expf(sc[0]); dec[1] = __expf(sc[1]); }
    __syncthreads();
}
__device__ __forceinline__ void pass_b_unit(const Params& P, int u, LAS char* lds, int tid) {
    unsigned char* ws = P.ws; const bf16_t* xc = (const bf16_t*)(ws + WS_XC); const float* dt = (const float*)(ws + WS_DT);
    const float* ST = (const float*)(ws + WS_ST); const float* DEC = (const float*)(ws + WS_DEC);
    const int lane = tid & 63, wave = tid >> 6; const UnitInfo I = decode(u); const int g = I.h >> 2;
    LAS f32x4* arr = (LAS f32x4*)(lds + L_ARR); LAS float* sc = (LAS float*)(lds + L_SC);
    const float Af = -__expf(P.in[I_ALOG][I.h]), Ab = -__expf(P.in[I_ALOG][16 + I.h]);
    if (wave == 0) chunk_scalars(dt, I.row0, I.h, Af, Ab, arr, sc, lane);
    { const int r = tid >> 2, c0 = (tid & 3) * 16; const bf16_t* xr = xc + (size_t)(I.row0 + r) * 1536;
#pragma unroll
      for (int q = 0; q < 2; ++q) { const int cc = c0 + q * 8;
          *(LAS u32x4*)(lds + L_X + r * RSB + cc * 2) = *(const u32x4*)(xr + I.h * 64 + cc);
          *(LAS u32x4*)(lds + L_B + r * RSB + cc * 2) = *(const u32x4*)(xr + 1024 + g * 64 + cc);
          *(LAS u32x4*)(lds + L_C + r * RSB + cc * 2) = *(const u32x4*)(xr + 1280 + g * 64 + cc); } }
    { const int p = tid >> 3, n0 = (tid & 7) * 8; const size_t eo = (size_t)p * 64 + n0;
      f32x4 hf0, hf1, hb0, hb1;
      if (I.smp) { const float* h0 = P.in[I_SSD] + (((size_t)I.b * 2 + 0) * 16 + I.h) * 4096 + eo; hf0 = *(const f32x4*)h0; hf1 = *(const f32x4*)(h0 + 4);
                   const float* h1 = P.in[I_SSD] + (((size_t)I.b * 2 + 1) * 16 + I.h) * 4096 + eo; hb0 = *(const f32x4*)h1; hb1 = *(const f32x4*)(h1 + 4); }
      else { hf0 = hf1 = hb0 = hb1 = (f32x4){0.f, 0.f, 0.f, 0.f}; }
      for (int cc = 0; cc < I.c; ++cc) { const int uu = unit_id(I.smp, I.b, cc, I.h); const float d = DEC[(size_t)uu * 2]; const float* sp = ST + ((size_t)uu * 2) * 4096 + eo;
          hf0 = hf0 * d + *(const f32x4*)sp; hf1 = hf1 * d + *(const f32x4*)(sp + 4); }
      for (int cc = I.nc - 1; cc > I.c; --cc) { const int uu = unit_id(I.smp, I.b, cc, I.h); const float d = DEC[(size_t)uu * 2 + 1]; const float* sp = ST + ((size_t)uu * 2 + 1) * 4096 + eo;
          hb0 = hb0 * d + *(const f32x4*)sp; hb1 = hb1 * d + *(const f32x4*)(sp + 4); }
      *(LAS u32x4*)(lds + L_HF + p * RSB + n0 * 2) = (u32x4){pk2(hf0.x, hf0.y), pk2(hf0.z, hf0.w), pk2(hf1.x, hf1.y), pk2(hf1.z, hf1.w)};
      *(LAS u32x4*)(lds + L_HB + p * RSB + n0 * 2) = (u32x4){pk2(hb0.x, hb0.y), pk2(hb0.z, hb0.w), pk2(hb1.x, hb1.y), pk2(hb1.z, hb1.w)};
      if (!I.smp) {
          if (I.c == I.nc - 1) { const float d = DEC[(size_t)u * 2]; const float* sp = ST + ((size_t)u * 2) * 4096 + eo; float* o = P.out + O_SSD + (((size_t)I.b * 2 + 0) * 16 + I.h) * 4096 + eo;
              *(f32x4*)o = hf0 * d + *(const f32x4*)sp; *(f32x4*)(o + 4) = hf1 * d + *(const f32x4*)(sp + 4); }
          if (I.c == 0) { const float d = DEC[(size_t)u * 2 + 1]; const float* sp = ST + ((size_t)u * 2 + 1) * 4096 + eo; float* o = P.out + O_SSD + (((size_t)I.b * 2 + 1) * 16 + I.h) * 4096 + eo;
              *(f32x4*)o = hb0 * d + *(const f32x4*)sp; *(f32x4*)(o + 4) = hb1 * d + *(const f32x4*)(sp + 4); } } }
    __syncthreads();
    const int i0 = 16 * wave, li = lane & 15, gq = lane >> 4, q4 = (lane >> 2) & 3, p4 = lane & 3, ii = i0 + li;
    bf16x8 cf[2];
#pragma unroll
    for (int ks = 0; ks < 2; ++ks) cf[ks] = *(const LAS bf16x8*)(lds + L_C + ii * RSB + (8 * gq + 32 * ks) * 2);
    const f32x4 ai = arr[ii];
    bf16x8 pf[4];
#pragma unroll
    for (int s4 = 0; s4 < 4; ++s4) {
        unsigned pk[4];
#pragma unroll
        for (int half = 0; half < 2; ++half) { const int t = 2 * s4 + half, jb = 16 * t + 4 * gq;
            f32x4 sacc = {0.f, 0.f, 0.f, 0.f};
#pragma unroll
            for (int ks = 0; ks < 2; ++ks) { const bf16x8 bfr = *(const LAS bf16x8*)(lds + L_B + (16 * t + li) * RSB + (8 * gq + 32 * ks) * 2);
                sacc = __builtin_amdgcn_mfma_f32_16x16x32_bf16(bfr, cf[ks], sacc, 0, 0, 0); }
            float m[4];
#pragma unroll
            for (int r = 0; r < 4; ++r) { const int j = jb + r; const f32x4 aj = arr[j];
                const bool lower = j < ii; const float arg = lower ? ai.x - aj.x : ai.y - aj.y; const float w = lower ? aj.z : aj.w;
                float mm = __expf(arg) * w; if (j == ii) mm = ai.z + ai.w; m[r] = sacc[r] * mm; }
            pk[half * 2 + 0] = pk2(m[0], m[1]); pk[half * 2 + 1] = pk2(m[2], m[3]); }
        const u32x4 w4 = {pk[0], pk[1], pk[2], pk[3]}; pf[s4] = *reinterpret_cast<const bf16x8*>(&w4);
    }
    const float ef = __expf(ai.x), eb = __expf(ai.y), Dh = P.in[I_SSDD][I.h];
    bf16_t* zrow = (bf16_t*)(ws + WS_Z) + (size_t)(I.row0 + ii) * 1024 + I.h * 64;
    float ssq = 0.f;
#pragma unroll
    for (int pt = 0; pt < 4; ++pt) {
        f32x4 yd = {0.f, 0.f, 0.f, 0.f}, yf = {0.f, 0.f, 0.f, 0.f}, yb = {0.f, 0.f, 0.f, 0.f};
#pragma unroll
        for (int s4 = 0; s4 < 4; ++s4) { const LAS char* xb = lds + L_X + (32 * s4 + 4 * gq + q4) * RSB + (16 * pt + 4 * p4) * 2;
            const bf16x8 xf = tr2(xb, xb + 16 * RSB);
            yd = __builtin_amdgcn_mfma_f32_16x16x32_bf16(xf, pf[s4], yd, 0, 0, 0); }
#pragma unroll
        for (int ks = 0; ks < 2; ++ks) { const bf16x8 hfr = *(const LAS bf16x8*)(lds + L_HF + (16 * pt + li) * RSB + (8 * gq + 32 * ks) * 2);
            const bf16x8 hbr = *(const LAS bf16x8*)(lds + L_HB + (16 * pt + li) * RSB + (8 * gq + 32 * ks) * 2);
            yf = __builtin_amdgcn_mfma_f32_16x16x32_bf16(hfr, cf[ks], yf, 0, 0, 0);
            yb = __builtin_amdgcn_mfma_f32_16x16x32_bf16(hbr, cf[ks], yb, 0, 0, 0); }
        const int pc = 16 * pt + 4 * gq;
        const u32x2 xw = *(const LAS u32x2*)(lds + L_X + ii * RSB + pc * 2);
        const f32x4 xx = {bflo(xw.x), bfhi(xw.x), bflo(xw.y), bfhi(xw.y)};
        const f32x4 zz = ld_bf4(zrow + pc);
        f32x4 y = yd + yf * ef + yb * eb + xx * Dh;
        y = y * (f32x4){siluf(zz.x), siluf(zz.y), siluf(zz.z), siluf(zz.w)};
        ssq += (y.x * y.x + y.y * y.y) + (y.z * y.z + y.w * y.w);
        st_bf4(zrow + pc, y);
    }
    ssq += __shfl_xor(ssq, 16); ssq += __shfl_xor(ssq, 32);
    if (gq == 0) ((float*)(ws + WS_SSQ_Y))[(size_t)(I.row0 + ii) * 16 + I.h] = ssq;
    __syncthreads();
}
}

__device__ __forceinline__ f32x4 conv3_at(const bf16_t* u, int row, int t, int L, int c, const float* fw, const float* fb) {
    f32x4 a = *(const f32x4*)(fb + c);
    if (t > 0) a += ld_bf4(u + (size_t)(row - 1) * UPN + c) * *(const f32x4*)(fw + c);
    a += ld_bf4(u + (size_t)row * UPN + c) * *(const f32x4*)(fw + UPN + c);
    if (t < L - 1) a += ld_bf4(u + (size_t)(row + 1) * UPN + c) * *(const f32x4*)(fw + 2 * UPN + c);
    return a;
}
__device__ __forceinline__ void phase_convgate(const Params& P) {
    PHASE_IDS unsigned char* ws = P.ws; const bf16_t* u = (const bf16_t*)(ws + WS_U); bf16_t* ug = (bf16_t*)(ws + WS_UG);
    const float* fw = P.in[I_FCW]; const float* fb = P.in[I_FCB];
    const int gt = blockIdx.x * NT + tid, GT = G * NT;
    for (int i = gt; i < R * (DFF / 4); i += GT) {
        const int row = i / (DFF / 4), c = (i % (DFF / 4)) * 4; const int t = row < RP ? (row & 255) : ((row - RP) & 2047), L = row < RP ? SEQP : SEQS;
        const f32x4 a = conv3_at(u, row, t, L, c, fw, fb), b = conv3_at(u, row, t, L, DFF + c, fw, fb);
        st_bf4(ug + (size_t)row * DFF + c, (f32x4){siluf(a.x), siluf(a.y), siluf(a.z), siluf(a.w)} * b);
    }
}
__device__ __forceinline__ void phase_final(const Params& P) {
    PHASE_IDS const int gw = blockIdx.x * 8 + wave, NGW = G * 8; const float* gf = P.in[I_GFIN];
    for (int row = gw; row < R; row += NGW) {
        f32x4* xr = (f32x4*)(P.out + (size_t)row * DM) + lane; f32x4 v[4]; float s = 0.f;
#pragma unroll
        for (int j = 0; j < 4; ++j) { v[j] = xr[64 * j]; s += (v[j].x * v[j].x + v[j].y * v[j].y) + (v[j].z * v[j].z + v[j].w * v[j].w); }
        const float rs = rsqrtf(wave_sum(s) * (1.f / DM) + EPS);
#pragma unroll
        for (int j = 0; j < 4; ++j) xr[64 * j] = v[j] * rs * *(const f32x4*)(gf + 4 * lane + 256 * j);
    }
}

__device__ __forceinline__ void phase_ssd_a(const Params& P, LAS unsigned char* lds) {
    PHASE_IDS
    for (int u = blockIdx.x; u < 1536; u += G) { int t2 = tid; asm volatile("" : "+v"(t2)); ssd::pass_a_unit(P, u, (LAS char*)lds, t2); }
}
__device__ __forceinline__ void phase_mix(const Params& P, LAS unsigned char* lds) {
    PHASE_IDS unsigned char* ws = P.ws; bf16_t* qn = (bf16_t*)(ws + WS_QN); const bf16_t* qr = (const bf16_t*)(ws + WS_QR);
    const bf16_t* kv = (const bf16_t*)(ws + WS_KV); const bf16_t* kr = (const bf16_t*)(ws + WS_KROPE);
    const int nbA = G / 2, bx = blockIdx.x;
    if (bx < nbA) {
        for (int u = bx; u < 128; u += nbA) {
            const int x = u & 7, k = u >> 3, bh = x + 8 * (k >> 3), qb = k & 7, b = bh >> 3, h = bh & 7, row0 = RP + b * SEQS + qb * 256, kv0 = RP + b * KVS;
            int t2 = tid; asm volatile("" : "+v"(t2));
            att::attn_unit(qn + (size_t)row0 * 1024 + h * 128, qr + (size_t)row0 * 512 + h * 64, kv + (size_t)kv0 * 2048 + h * 256, kv + (size_t)kv0 * 2048 + h * 256 + 128,
                           kr + (size_t)kv0 * 64, qn + (size_t)row0 * 1024 + h * 128, KVS, (LAS char*)lds, t2);
        }
    } else {
        const int k0 = bx - nbA, nb2 = G - nbA;
        for (int q = k0; q < 256; q += nb2) {
            const int b = q >> 3, h = q & 7, row0 = b * SEQP;
            int t2 = tid; asm volatile("" : "+v"(t2));
            att::attn_unit(qn + (size_t)row0 * 1024 + h * 128, qr + (size_t)row0 * 512 + h * 64, kv + (size_t)row0 * 2048 + h * 256, kv + (size_t)row0 * 2048 + h * 256 + 128,
                           kr + (size_t)row0 * 64, qn + (size_t)row0 * 1024 + h * 128, SEQP, (LAS char*)lds, t2);
        }
        for (int u = k0; u < 1536; u += nb2) { int t2 = tid; asm volatile("" : "+v"(t2)); ssd::pass_b_unit(P, u, (LAS char*)lds, t2); }
    }
}
#define XB_TMO      128
#define XB_XCNT(j)  (256  + 64 * (j))
#define XB_XSUB(j)  (1280 + 64 * (j))
#define XB_XGEN(j)  (2304 + 64 * (j))
#define XB_TOP      3328
#define XB_TOPGEN   3392
#define XCD_BAR_WORDS 3456
#define XB_SPIN_CAP (1u << 18)

__device__ __forceinline__ unsigned xb_ld(unsigned* p)              { return __hip_atomic_load(p, __ATOMIC_RELAXED, __HIP_MEMORY_SCOPE_AGENT); }
__device__ __forceinline__ unsigned xb_add(unsigned* p, unsigned v) { return __hip_atomic_fetch_add(p, v, __ATOMIC_RELAXED, __HIP_MEMORY_SCOPE_AGENT); }
__device__ __forceinline__ unsigned xb_xcc_id() { return (unsigned)__builtin_amdgcn_s_getreg((3 << 11) | 20) & 0xFu; }
#define XB_SPIN(cond, bar) do { unsigned _sp = 0; while (cond) { __builtin_amdgcn_s_sleep(1); \
    if ((++_sp & 255u) == 0u) { if (xb_ld(&(bar)[XB_TMO])) break; if (_sp > XB_SPIN_CAP) { atomicAdd(&(bar)[XB_TMO], 1u); break; } } } } while (0)

struct XcdBarrier {
    unsigned* bar; unsigned x;
    volatile LAS unsigned* st;
};

__device__ __forceinline__ XcdBarrier xcd_barrier_post(unsigned* bar, volatile LAS unsigned* st) {
    XcdBarrier b; b.bar = bar; b.x = xb_xcc_id(); b.st = st;
    if (threadIdx.x == 0) (void)xb_add(&bar[XB_XCNT(b.x)], 1u);
    return b;
}
__device__ __forceinline__ void xcd_barrier_complete(unsigned* bar, unsigned x, unsigned& nloc, unsigned& nx) {
    const unsigned G = gridDim.x * gridDim.y * gridDim.z;
    unsigned sum, cnt, mine, sp = 0u;
    for (;;) {
        sum = 0u; cnt = 0u; mine = 0u;
#pragma unroll
        for (unsigned j = 0; j < 16; ++j) { const unsigned c = xb_ld(&bar[XB_XCNT(j)]); sum += c; cnt += (c > 0u) ? 1u : 0u; mine = (j == x) ? c : mine; }
        if (sum == G) break;
        __builtin_amdgcn_s_sleep(1);
        if ((++sp & 255u) == 0u) { if (xb_ld(&bar[XB_TMO])) break; if (sp > XB_SPIN_CAP) { atomicAdd(&bar[XB_TMO], 1u); break; } }
    }
    nloc = mine > 0u ? mine : 1u; nx = cnt > 0u ? cnt : 1u;
}

__device__ __forceinline__ void xcd_barrier(const XcdBarrier& b) {
    asm volatile("s_waitcnt vmcnt(0)" ::: "memory");
    __syncthreads();
    if (threadIdx.x == 0) {
        unsigned* bar = b.bar;
        __builtin_amdgcn_s_waitcnt(0);
        unsigned nloc = b.st[0], nx = b.st[1];
        if (nloc == 0u) { xcd_barrier_complete(bar, b.x, nloc, nx); b.st[0] = nloc; b.st[1] = nx; }
        const unsigned old = xb_add(&bar[XB_XSUB(b.x)], 1u);
        const unsigned gen = old / nloc;
        if (old + 1u == (gen + 1u) * nloc) {
            __builtin_amdgcn_fence(__ATOMIC_RELEASE, "agent");
            asm volatile("s_waitcnt vmcnt(0)" ::: "memory");
            const unsigned og = xb_add(&bar[XB_TOP], 1u);
            const unsigned tg = og / nx;
            if (og + 1u == (tg + 1u) * nx) xb_add(&bar[XB_TOPGEN], 1u);
            else XB_SPIN(xb_ld(&bar[XB_TOPGEN]) == tg, bar);
            __builtin_amdgcn_fence(__ATOMIC_ACQUIRE, "agent");
            xb_add(&bar[XB_XGEN(b.x)], 1u);
            asm volatile("s_waitcnt vmcnt(0)" ::: "memory");
        } else {
            XB_SPIN(xb_ld(&bar[XB_XGEN(b.x)]) == gen, bar);
            __builtin_amdgcn_fence(__ATOMIC_ACQUIRE, "agent");
            asm volatile("s_waitcnt vmcnt(0)" ::: "memory");
        }
    }
    __syncthreads();
}

__global__ void __launch_bounds__(NT, 2) mega_fwd(Params P) {
    extern __shared__ __attribute__((aligned(16))) unsigned char lds_raw[];
    LAS unsigned char* lds = (LAS unsigned char*)lds_raw;
    cg::grid_group grid = cg::this_grid();
    const int G = gridDim.x, bx = blockIdx.x;
    unsigned char* ws = P.ws;
    volatile LAS unsigned* misc = (volatile LAS unsigned*)(lds + 131072);
    if (threadIdx.x < 4) misc[threadIdx.x] = 0u;
    __syncthreads();
    const XcdBarrier xbar = xcd_barrier_post((unsigned*)(ws + WS_CTL) + 1024, misc);
#define GSYNC() xcd_barrier(xbar)

#ifdef ONLY_ATT
    phase_attn(P, lds);
    return;
#endif
    phase_p0(P, lds);
    grid.sync();
    phase_p1(P, lds);
    GSYNC();
    {
        EpiIn E{(bf16_t*)(ws + WS_CQ), (bf16_t*)(ws + WS_CKVA), (bf16_t*)(ws + WS_Z), (bf16_t*)(ws + WS_XBC), (bf16_t*)P.out, (bf16_t*)P.out + (size_t)R * 1024, (bf16_t*)(ws + WS_KROPE),
                (float*)(ws + WS_SSQ_CQ), (float*)(ws + WS_SSQ_CKV), (float*)(ws + WS_DT), P.out + O_CKV, P.out + O_KR, P.in[I_DTB], (const f32x2*)(ws + WS_ROPE)};
        run_gemm(lds, (const bf16_t*)(ws + WS_H), (const bf16_t*)(ws + WS_WIN), R, INP, 1024, G, bx, E);
    }
    GSYNC();
    phase_conv(P);
    GSYNC();
    {
        EpiQ EQ{(bf16_t*)(ws + WS_QN), (bf16_t*)(ws + WS_QR), (const float*)(ws + WS_SSQ_CQ), (const f32x2*)(ws + WS_ROPE)};
        run_gemm(lds, (const bf16_t*)(ws + WS_CQ), (const bf16_t*)(ws + WS_WUQ), R, 1536, 256, G, bx, EQ);
        EpiKV EK{(bf16_t*)(ws + WS_KV), (const float*)(ws + WS_SSQ_CKV)};
        run_gemm(lds, (const bf16_t*)(ws + WS_CKVA), (const bf16_t*)(ws + WS_WUKV), KVR, 2048, 256, G, (bx + 224) % G, EK);
        phase_ssd_a(P, lds);
    }
    GSYNC();
    phase_mix(P, lds);
    GSYNC();
    {
        EpiMla EM{(const bf16_t*)P.out, (float*)(ws + WS_ST)};
        run_gemm(lds, (const bf16_t*)(ws + WS_QN), (const bf16_t*)(ws + WS_WOMLA), R, 1024, 1024, G, bx, EM);
        EpiSsd ES{(const bf16_t*)P.out + (size_t)R * 1024, (const float*)(ws + WS_ST), (const float*)(ws + WS_SSQ_Y), (bf16_t*)(ws + WS_MERGED)};
        run_gemm(lds, (const bf16_t*)(ws + WS_Z), (const bf16_t*)(ws + WS_WOSSD), R, 1024, 1024, G, bx, ES);
    }
    GSYNC();
    {
        EpiOut E{P.in[I_XP], P.in[I_XS], (const float*)(ws + WS_MOD), P.in[I_GFFN], P.out, (bf16_t*)(ws + WS_A1), (float*)(ws + WS_SSQ2)};
        run_gemm(lds, (const bf16_t*)(ws + WS_MERGED), (const bf16_t*)(ws + WS_WOUT), R, 1024, 1024, G, bx, E);
    }
    GSYNC();
    {
        EpiUp E{(const float*)(ws + WS_SSQ2), (const float*)(ws + WS_CUP), (bf16_t*)(ws + WS_U)};
        run_gemm(lds, (const bf16_t*)(ws + WS_A1), (const bf16_t*)(ws + WS_WUP), R, UPN, 1024, G, bx, E);
    }
    GSYNC();
    phase_convgate(P);
    GSYNC();
    {
        EpiDown E{(const float*)(ws + WS_MOD), P.out};
        run_gemm(lds, (const bf16_t*)(ws + WS_UG), (const bf16_t*)(ws + WS_WDOWN), R, 1024, DFF, G, bx, E);
    }
    GSYNC();
    phase_final(P);
}

extern "C" void kernel_launch(void* const* d_in, const int* in_sizes, int n_in, void* d_out, int out_size, void* d_ws, size_t ws_size, hipStream_t stream) {
    static int grid = 0;
    if (grid == 0) {
        if (n_in != 30 || ws_size < WS_END || out_size != (int)(O_SSD + (size_t)32 * 2 * 16 * 64 * 64)) {
            fprintf(stderr, "kernel_launch: unexpected shapes: n_in %d out %d ws %zu (need %zu)\n", n_in, out_size, ws_size, (size_t)WS_END); grid = -1; return; }
        int dev = 0, cus = 0, per_cu = 0;
        if (hipGetDevice(&dev) != hipSuccess || hipDeviceGetAttribute(&cus, hipDeviceAttributeMultiprocessorCount, dev) != hipSuccess) { grid = -1; return; }
        if (hipFuncSetAttribute((const void*)mega_fwd, hipFuncAttributeMaxDynamicSharedMemorySize, LDS_BYTES) != hipSuccess) { fprintf(stderr, "kernel_launch: hipFuncSetAttribute failed\n"); grid = -1; return; }
        if (hipOccupancyMaxActiveBlocksPerMultiprocessor(&per_cu, (const void*)mega_fwd, NT, LDS_BYTES) != hipSuccess || per_cu < 1) { fprintf(stderr, "kernel_launch: occupancy query failed (%d)\n", per_cu); (void)hipGetLastError(); grid = -1; return; }
        grid = cus;
    }
    if (grid < 0) return;
    (void)hipMemsetAsync((char*)d_ws + WS_CTL, 0, CTL_ZERO, stream);
    Params p{};
    for (int i = 0; i < 30; ++i) p.in[i] = (const float*)d_in[i];
    p.out = (float*)d_out; p.ws = (unsigned char*)d_ws;
    void* args[] = {&p};
    hipError_t e = hipLaunchCooperativeKernel((const void*)mega_fwd, dim3(grid), dim3(NT), args, LDS_BYTES, stream);
    if (e != hipSuccess) fprintf(stderr, "kernel_launch: cooperative launch failed: %s (grid %d)\n", hipGetErrorString(e), grid);
}
```

```cpp
#include <hip/hip_runtime.h>
#include <hip/hip_cooperative_groups.h>
#include <cstdio>
#include <cstdint>
#include <type_traits>
namespace cg = cooperative_groups;

namespace pg8 {
#define PG8_LAS __attribute__((address_space(3)))
typedef unsigned short bf16_t;
typedef short bf16x8 __attribute__((ext_vector_type(8)));
typedef float f32x4 __attribute__((ext_vector_type(4)));
typedef unsigned u32x4 __attribute__((ext_vector_type(4)));
constexpr int BM = 256, BK = 64, HALF = 128, HTB = HALF * BK * 2  , STAGE_BYTES = 8 * HTB, NXCD = 8, WGM = 8;

__host__ __device__ __forceinline__ int lds_byte(int r, int c) { const int st = (r >> 4) * 2 + (c >> 5), rr = r & 15, cc = c & 31, ob = rr * 64 + cc * 2; return st * 1024 + (ob ^ (((ob >> 9) & 1) << 5)); }
__host__ __device__ __forceinline__ void stage_rc(int b, int& R, int& C) { const int st = b / 1024, sb = b % 1024, swz = sb ^ (((sb >> 9) & 1) << 5); R = (st >> 1) * 16 + swz / 64; C = (st & 1) * 32 + (swz % 64) / 2; }
__host__ __device__ __forceinline__ int perm32(int rho) { const int n = rho >> 4, i = rho & 15; return 8 * (i >> 2) + 4 * n + (i & 3); }

struct Unit { int pm, pn; };
#ifdef PG8_TIME
__device__ unsigned long long pg8_tacc[2];
#endif
struct Gemm { const bf16_t* A; const bf16_t* Bt; int M, N, K; };

struct StaticOrder {
    int nM, nN, nwg, G, c;
    __host__ __device__ void init(int M, int N, int G_, int c_, int bm = BM) { nM = M / bm; nN = N / BM; nwg = nM * nN; G = G_; c = c_; }
    __host__ __device__ __forceinline__ bool next(int i, Unit& u) const {
        const long L = (long)i * G + c; if (L >= nwg) return false;
        int wgid = (int)L; { const int q = nwg / NXCD, r = nwg % NXCD, xcd = wgid % NXCD, off = wgid / NXCD; wgid = (xcd < r ? xcd * (q + 1) : r * (q + 1) + (xcd - r) * q) + off; }
        const int nig = WGM * nN, gid = wgid / nig, fm = gid * WGM, gsz = (nM - fm) < WGM ? (nM - fm) : WGM;
        u.pm = fm + ((wgid % nig) % gsz); u.pn = (wgid % nig) / gsz; return true;
    }
    __device__ __forceinline__ void a_ready(const Unit&) const {}
    __device__ __forceinline__ void done(const Unit&) const {}
};


template <class E, class = void> struct epi_state { struct type {}; static constexpr bool value = false; };
template <class E> struct epi_state<E, std::void_t<typename E::State>> { using type = typename E::State; static constexpr bool value = true; };
template <class E, class = void> struct epi_pre : std::false_type {};
template <class E> struct epi_pre<E, std::void_t<decltype(E::PRE_SLOT)>> : std::true_type {};
template <class E, class = void> struct epi_timed : std::false_type {};
template <class E> struct epi_timed<E, std::void_t<decltype(E::TIMED)>> : std::true_type {};
template <class Epi, class Sched, bool ALIGN_EPI = false, bool SP2 = false, int MFR = 4  >
__device__ __forceinline__ void gemm_phase(PG8_LAS unsigned char* lds, const Gemm g, const Sched& S, const Epi& E) {
    int tid_ = threadIdx.x; asm volatile("" : "+v"(tid_));
    const int tid = tid_, wid = __builtin_amdgcn_readfirstlane(tid >> 6), lane = tid & 63, wr = wid >> 2, wc = wid & 3, fr = lane & 15, fq = lane >> 4;
    static_assert(SP2 || MFR == 4, "192-row tiles need the two-super-phase loop");
    const bool shortA = (MFR == 3) && (wr == 1);
    const int K = g.K, nt = K / BK;
    unsigned voffA[2], voffB[2];
#pragma unroll
    for (int i = 0; i < 2; ++i) { int R, C; stage_rc(tid * 16 + i * 8192, R, C); const int Rb = Epi::PERM ? ((R & ~31) + perm32(R & 31)) : R;
        voffA[i] = (unsigned)(R * K + C) * 2u; voffB[i] = (unsigned)(Rb * K + C) * 2u; }
    const size_t kstep = (size_t)(BK * 2);
    const size_t hstep = (size_t)HALF * K * 2;
    const size_t tstep = 2 * hstep;
    const size_t hstepA = (size_t)(32 * MFR) * K * 2, tstepA = 2 * hstepA;
    const unsigned ldsw = (unsigned)wid * 1024u;
    const int aoff = lds_byte(wr * (16 * MFR) + fr, fq * 8), boff = lds_byte(wc * 32 + fr, fq * 8);
#define PG8_SA(b, h) (((b) * 2 + (h)) * HTB)
#define PG8_SB(b, h) ((4 + (b) * 2 + (h)) * HTB)
#define PG8_STAGE(bufoff, gbase, voff) do { _Pragma("unroll") for (int _i = 0; _i < 2; ++_i) \
        __builtin_amdgcn_global_load_lds((const unsigned*)((const char*)(gbase) + (voff)[_i]), (PG8_LAS unsigned*)(lds + (bufoff) + ldsw + _i * 8192), 16, 0, 0); } while (0)
#define PG8_LDA(dst, b, h) do { _Pragma("unroll") for (int m = 0; m < MFR; ++m) _Pragma("unroll") for (int k = 0; k < 2; ++k) dst[m][k] = *(const PG8_LAS bf16x8*)(lds + PG8_SA(b, h) + aoff + m * 2048 + k * 1024); } while (0)
#define PG8_LDB(dst, b, h) do { _Pragma("unroll") for (int n = 0; n < 2; ++n) _Pragma("unroll") for (int k = 0; k < 2; ++k) dst[n][k] = *(const PG8_LAS bf16x8*)(lds + PG8_SB(b, h) + boff + n * 2048 + k * 1024); } while (0)
#define PG8_MMA(ai, bj, At, Bt) do { __builtin_amdgcn_s_setprio(1); _Pragma("unroll") for (int m = 0; m < MFR; ++m) _Pragma("unroll") for (int n = 0; n < 2; ++n) _Pragma("unroll") for (int k = 0; k < 2; ++k) \
        acc[ai][bj][m][n] = __builtin_amdgcn_mfma_f32_16x16x32_bf16(Bt[n][k], At[m][k], acc[ai][bj][m][n], 0, 0, 0); __builtin_amdgcn_s_setprio(0); } while (0)
#define PG8_WAIT_V(n) asm volatile("s_waitcnt vmcnt(" #n ")" ::: "memory")
#define PG8_WAIT_VS(nf, ns) do { if (shortA) PG8_WAIT_V(ns); else PG8_WAIT_V(nf); } while (0)
#define PG8_STAGE_A(bufoff, gbase) do { __builtin_amdgcn_global_load_lds((const unsigned*)((const char*)(gbase) + voffA[0]), (PG8_LAS unsigned*)(lds + (bufoff) + ldsw), 16, 0, 0); \
        if (!shortA) __builtin_amdgcn_global_load_lds((const unsigned*)((const char*)(gbase) + voffA[1]), (PG8_LAS unsigned*)(lds + (bufoff) + ldsw + 8192), 16, 0, 0); } while (0)
#define PG8_WAIT_L(n) asm volatile("s_waitcnt lgkmcnt(" #n ")" ::: "memory")
#define PG8_BAR __builtin_amdgcn_s_barrier()
#define PG8_SCHED __builtin_amdgcn_sched_barrier(0)
    Unit cur, nxt; int ui = 0;
    if (!S.next(0, cur)) return;
#ifdef PG8_TIME
    const bool tme = epi_timed<Epi>::value && (wid == 0 && blockIdx.x == 0); unsigned long long tk0 = 0;
#endif
    typename epi_state<Epi>::type est; (void)est;
    f32x4 acc[2][2][MFR][2];
#pragma unroll
    for (int a = 0; a < 2; ++a)
#pragma unroll
        for (int b = 0; b < 2; ++b)
#pragma unroll
            for (int m = 0; m < MFR; ++m)
#pragma unroll
                for (int n = 0; n < 2; ++n) acc[a][b][m][n] = (f32x4){0.f, 0.f, 0.f, 0.f};
    bf16x8 At[MFR][2], B0[2][2], B1[2][2];
    const char* cA = (const char*)g.A + (size_t)cur.pm * tstepA; const char* cB = (const char*)g.Bt + (size_t)cur.pn * tstep;
    S.a_ready(cur);
    if constexpr (epi_pre<Epi>::value) E.pre(cur, lds + STAGE_BYTES + Epi::PRE_SLOT, wr, wc, lane);
    if constexpr (SP2) {
        PG8_STAGE(PG8_SB(0, 0), cB, voffB); PG8_STAGE(PG8_SB(0, 1), cB + hstep, voffB); PG8_STAGE_A(PG8_SA(0, 0), cA); PG8_STAGE_A(PG8_SA(0, 1), cA + hstepA);
        if (wr == 1) PG8_BAR;
        PG8_WAIT_VS(2, 1); PG8_BAR;
        PG8_STAGE(PG8_SB(1, 0), cB + kstep, voffB); PG8_STAGE_A(PG8_SA(1, 0), cA + kstep); PG8_STAGE(PG8_SB(1, 1), cB + hstep + kstep, voffB);
        PG8_WAIT_VS(6, 5); PG8_BAR;
    } else {
        PG8_STAGE(PG8_SB(0, 0), cB, voffB); PG8_STAGE_A(PG8_SA(0, 0), cA); PG8_STAGE(PG8_SB(0, 1), cB + hstep, voffB); PG8_STAGE_A(PG8_SA(0, 1), cA + hstepA);
        if (wr == 1) PG8_BAR;
        PG8_WAIT_V(4); PG8_BAR;
        PG8_STAGE(PG8_SB(1, 0), cB + kstep, voffB); PG8_STAGE_A(PG8_SA(1, 0), cA + kstep); PG8_STAGE(PG8_SB(1, 1), cB + hstep + kstep, voffB);
        PG8_WAIT_V(6); PG8_BAR;
    }
    for (;;) {
        const bool has_next = S.next(ui + 1, nxt);
        const char* nA = has_next ? (const char*)g.A + (size_t)nxt.pm * tstepA : cA; const char* nB = has_next ? (const char*)g.Bt + (size_t)nxt.pn * tstep : cB;
#ifdef PG8_TIME
        if (tme) tk0 = __builtin_amdgcn_s_memrealtime();
#endif
        for (int t = 0; t < nt; t += 2) {
            const bool last = (t == nt - 2);
            const char* a1 = cA + (size_t)(t + 1) * kstep;
            const char* a2 = last ? nA : cA + (size_t)(t + 2) * kstep; const char* b2 = last ? nB : cB + (size_t)(t + 2) * kstep;
            const char* a3 = a2 + kstep; const char* b3 = b2 + kstep;
            if (last && has_next) S.a_ready(nxt);
            if constexpr (SP2) {
            PG8_LDB(B0, 0, 0); PG8_LDB(B1, 0, 1); PG8_SCHED; PG8_LDA(At, 0, 0); PG8_STAGE_A(PG8_SA(1, 1), a1 + hstepA);
            PG8_WAIT_VS(8, 6); PG8_WAIT_L(0); PG8_BAR; PG8_MMA(0, 0, At, B0); PG8_MMA(0, 1, At, B1); PG8_BAR; PG8_SCHED;
            PG8_LDA(At, 0, 1); PG8_STAGE(PG8_SB(0, 0), b2, voffB); PG8_STAGE(PG8_SB(0, 1), b2 + hstep, voffB); PG8_STAGE_A(PG8_SA(0, 0), a2);
            PG8_WAIT_VS(8, 6); PG8_WAIT_L(0); PG8_BAR; PG8_MMA(1, 0, At, B0); PG8_MMA(1, 1, At, B1); PG8_BAR; PG8_SCHED;
            PG8_LDB(B0, 1, 0); PG8_LDB(B1, 1, 1); PG8_SCHED; PG8_LDA(At, 1, 0); PG8_STAGE_A(PG8_SA(0, 1), a2 + hstepA);
            PG8_WAIT_VS(8, 6); PG8_WAIT_L(0); PG8_BAR; PG8_MMA(0, 0, At, B0); PG8_MMA(0, 1, At, B1); PG8_BAR; PG8_SCHED;
            PG8_LDA(At, 1, 1); PG8_STAGE(PG8_SB(1, 0), b3, voffB); PG8_STAGE(PG8_SB(1, 1), b3 + hstep, voffB); PG8_STAGE_A(PG8_SA(1, 0), a3);
            PG8_WAIT_VS(8, 6); PG8_WAIT_L(0); PG8_BAR; PG8_MMA(1, 0, At, B0); PG8_MMA(1, 1, At, B1); PG8_BAR; PG8_SCHED;
            } else {
            PG8_LDB(B0, 0, 0); PG8_SCHED; PG8_LDA(At, 0, 0); PG8_STAGE_A(PG8_SA(1, 1), a1 + hstepA);
            PG8_WAIT_L(8); PG8_BAR; PG8_WAIT_L(0); PG8_MMA(0, 0, At, B0); PG8_BAR; PG8_SCHED;
            PG8_LDB(B1, 0, 1); PG8_STAGE(PG8_SB(0, 0), b2, voffB);
            PG8_BAR; PG8_WAIT_L(0); PG8_MMA(0, 1, At, B1); PG8_BAR;
            PG8_LDA(At, 0, 1); PG8_STAGE_A(PG8_SA(0, 0), a2);
            PG8_BAR; PG8_WAIT_L(0); PG8_MMA(1, 0, At, B0); PG8_BAR; PG8_SCHED;
            PG8_STAGE(PG8_SB(0, 1), b2 + hstep, voffB);
            PG8_WAIT_V(6); PG8_BAR; PG8_MMA(1, 1, At, B1); PG8_BAR;
            PG8_LDB(B0, 1, 0); PG8_SCHED; PG8_LDA(At, 1, 0); PG8_STAGE_A(PG8_SA(0, 1), a2 + hstepA);
            PG8_WAIT_L(8); PG8_BAR; PG8_WAIT_L(0); PG8_MMA(0, 0, At, B0); PG8_BAR; PG8_SCHED;
            PG8_LDB(B1, 1, 1); PG8_STAGE(PG8_SB(1, 0), b3, voffB);
            PG8_BAR; PG8_WAIT_L(0); PG8_MMA(0, 1, At, B1); PG8_BAR;
            PG8_LDA(At, 1, 1); PG8_STAGE_A(PG8_SA(1, 0), a3);
            PG8_BAR; PG8_WAIT_L(0); PG8_MMA(1, 0, At, B0); PG8_BAR; PG8_SCHED;
            PG8_STAGE(PG8_SB(1, 1), b3 + hstep, voffB);
            PG8_WAIT_V(6); PG8_BAR; PG8_MMA(1, 1, At, B1); PG8_BAR;
            }
        }
#ifdef PG8_TIME
        if (tme) { const unsigned long long t1 = __builtin_amdgcn_s_memrealtime(); pg8_tacc[0] += t1 - tk0; tk0 = t1; }
#endif
        if constexpr (ALIGN_EPI) { if (wr == 0) PG8_BAR; }
        if constexpr (!Epi::AFTER_DRAIN) { if constexpr (epi_state<Epi>::value) E(acc, cur, wr, wc, fr, fq, est); else if constexpr (epi_pre<Epi>::value) E(acc, cur, wr, wc, fr, fq, lds + STAGE_BYTES + Epi::PRE_SLOT + (ui & 1) * Epi::PRE_BYTES);
            else E(acc, cur, wr, wc, fr, fq); S.done(cur);
            if constexpr (epi_pre<Epi>::value) { if (has_next) E.pre(nxt, lds + STAGE_BYTES + Epi::PRE_SLOT + ((ui + 1) & 1) * Epi::PRE_BYTES, wr, wc, lane); } }
#ifdef PG8_TIME
        if (tme) { const unsigned long long t1 = __builtin_amdgcn_s_memrealtime(); pg8_tacc[1] += t1 - tk0; }
#endif
        if (!has_next) break;
#pragma unroll
        for (int a = 0; a < 2; ++a)
#pragma unroll
            for (int b = 0; b < 2; ++b)
#pragma unroll
                for (int m = 0; m < MFR; ++m)
#pragma unroll
                    for (int n = 0; n < 2; ++n) acc[a][b][m][n] = (f32x4){0.f, 0.f, 0.f, 0.f};
        cur = nxt; cA = nA; cB = nB; ++ui;
        if constexpr (ALIGN_EPI) { if (wr == 1) PG8_BAR; }
    }
    PG8_WAIT_V(0);
    if constexpr (!ALIGN_EPI) { if (wr == 0) PG8_BAR; }
    PG8_BAR;
    if constexpr (Epi::AFTER_DRAIN) { E.fused(acc, cur, wr, wc, fr, fq, lds, wid, lane); S.done(cur); }
#undef PG8_SA
#undef PG8_SB
#undef PG8_STAGE
#undef PG8_LDA
#undef PG8_LDB
#undef PG8_MMA
#undef PG8_WAIT_V
#undef PG8_WAIT_VS
#undef PG8_STAGE_A
#undef PG8_WAIT_L
#undef PG8_BAR
#undef PG8_SCHED
}
}

#ifndef PROBE_MASK
#define PROBE_MASK 0
#endif
#define PROBE_MULT 8
#ifndef PB_DUP1
#define PB_DUP1 1
#endif
#ifndef PG8_SP2
#define PG8_SP2 true
#endif
#ifndef PG8_ALIGN
#define PG8_ALIGN true
#endif

#define LAS __attribute__((address_space(3)))
using pg8::bf16_t; using pg8::f32x4; using pg8::bf16x8; using pg8::u32x4;
typedef unsigned u32x2 __attribute__((ext_vector_type(2)));
typedef float f32x2 __attribute__((ext_vector_type(2)));

constexpr int DM = 1024;
constexpr int RP = 8192, RS = 4096, R = 12288;
constexpr int SEQP = 256, SEQS = 2048, PAST = 512, KVS = PAST + SEQS;
constexpr int KVR = RP + 2 * KVS;
constexpr int NH = 8;
constexpr int INC = 5216, INP = 5376;
constexpr int DFF = 2816, UPN = 5632;
constexpr float EPS = 1e-6f;
constexpr float ATT_SCALE = 0.07216878364870322f;

enum { I_XP = 0, I_XS, I_C, I_CKV, I_CKR, I_SSD, I_CCTX, I_WADA, I_BADA, I_GATTN, I_WIN, I_GQ, I_GKV, I_WUQ, I_WUKV, I_WOMLA,
       I_CONVW, I_CONVB, I_DTB, I_ALOG, I_SSDD, I_GSSD, I_WOSSD, I_WOUT, I_GFFN, I_WUP, I_FCW, I_FCB, I_WDOWN, I_GFIN };

constexpr size_t O_Y = 0, O_CKV = (size_t)R * DM, O_KR = O_CKV + (size_t)RP * 256, O_SSD = O_KR + (size_t)RP * 64;

constexpr size_t MiB = 1u << 20;
constexpr size_t WS_CTL = 0, CTL_ZERO = 65536;
constexpr size_t WS_MOD = 64 * 1024;
constexpr size_t WS_CUP = 160 * 1024;
constexpr size_t WS_ROPE = 256 * 1024;
constexpr size_t WS_CST = 800 * 1024;
constexpr size_t WS_SSQ_CQ = 1 * MiB;
constexpr size_t WS_SSQ_CKV = 1 * MiB + 204800;
constexpr size_t WS_SSQ_Y = 1 * MiB + 430080;
constexpr size_t WS_SSQ2 = 1 * MiB + 1216512;
constexpr size_t WS_DT = 3 * MiB;
constexpr size_t WS_DEC = 3 * MiB + 1572864;
constexpr size_t WS_ZERO = WS_DEC + 16384;
constexpr size_t WS_WIN = 5 * MiB;
constexpr size_t WS_WUQ = WS_WIN + (size_t)INP * 1024 * 2;
constexpr size_t WS_WUKV = WS_WUQ + 1536 * 256 * 2;
constexpr size_t WS_WOMLA = WS_WUKV + 2048 * 256 * 2;
constexpr size_t WS_WOSSD = WS_WOMLA + 2 * MiB;
constexpr size_t WS_WOUT = WS_WOSSD + 2 * MiB;
constexpr size_t WS_WUP = WS_WOUT + 2 * MiB;
constexpr size_t WS_WDOWN = WS_WUP + (size_t)UPN * 1024 * 2;
static_assert(WS_WDOWN + (size_t)1024 * DFF * 2 <= 40 * MiB, "weights");
constexpr size_t WS_CQ = 40 * MiB;
constexpr size_t WS_CKVA = 46 * MiB;
constexpr size_t WS_KROPE = 46 * MiB + (size_t)KVR * 256 * 2;
constexpr size_t WS_Z = 55 * MiB;
constexpr size_t WS_XBC = 79 * MiB;
constexpr size_t WS_H = 115 * MiB;
constexpr size_t WS_QN = 115 * MiB;
constexpr size_t WS_QR = 139 * MiB;
constexpr size_t WS_KV = 151 * MiB;
constexpr size_t WS_ST = 203 * MiB;
constexpr size_t WS_MERGED = 151 * MiB;
constexpr size_t WS_A1 = 203 * MiB;
constexpr size_t WS_U = 115 * MiB;
constexpr size_t WS_UG = 115 * MiB;
constexpr size_t WS_HALO = 182 * MiB;
constexpr size_t WS_END = 251 * MiB;
static_assert(WS_KROPE + (size_t)KVR * 64 * 2 <= WS_Z && WS_KV + (size_t)KVR * 2048 * 2 <= WS_ST && WS_ST + (size_t)R * 1024 * 4 <= WS_END, "map");
static_assert(WS_UG + (size_t)R * DFF * 2 <= WS_HALO && WS_HALO + (size_t)192 * 4 * UPN * 2 <= WS_END, "map2");
static_assert(WS_A1 >= WS_HALO + (size_t)192 * 4 * UPN * 2 && WS_A1 + (size_t)R * 1024 * 2 <= WS_END, "a1 clear of ug / halo");

constexpr int LDS_BYTES = 147456;
constexpr int NT = 512;

struct Params { const float* in[30]; float* out; unsigned char* ws; };
#define PHASE_IDS int tid = threadIdx.x; asm volatile("" : "+v"(tid)); const int lane = tid & 63, wave = __builtin_amdgcn_readfirstlane(tid >> 6), G = gridDim.x; (void)lane; (void)wave; (void)G;

#define LDS_WAIT() asm volatile("s_waitcnt lgkmcnt(0)" ::: "memory")
__device__ __forceinline__ unsigned f2bf(float f) { unsigned u = __builtin_bit_cast(unsigned, f); return (u + 0x7fffu + ((u >> 16) & 1u)) >> 16; }
__device__ __forceinline__ float bf2f(unsigned short b) { return __builtin_bit_cast(float, (unsigned)b << 16); }
typedef __bf16 bf16x2_t __attribute__((ext_vector_type(2)));
__device__ __forceinline__ unsigned pk2(float lo, float hi) { const f32x2 v = {lo, hi}; const bf16x2_t b = __builtin_convertvector(v, bf16x2_t); return __builtin_bit_cast(unsigned, b); }
__device__ __forceinline__ float bflo(unsigned w) { return __builtin_bit_cast(float, w << 16); }
__device__ __forceinline__ float bfhi(unsigned w) { return __builtin_bit_cast(float, w & 0xffff0000u); }
__device__ __forceinline__ float wave_sum(float v) {
#pragma unroll
    for (int o = 1; o < 64; o <<= 1) v += __shfl_xor(v, o);
    return v;
}
__device__ __forceinline__ float wave_max(float v) {
#pragma unroll
    for (int o = 1; o < 64; o <<= 1) v = fmaxf(v, __shfl_xor(v, o));
    return v;
}
__device__ __forceinline__ void unpack8(const u32x4 w, float* f) {
#pragma unroll
    for (int e = 0; e < 4; ++e) { f[2 * e] = bflo(w[e]); f[2 * e + 1] = bfhi(w[e]); }
}
__device__ __forceinline__ float sigm(float x) { return __builtin_amdgcn_rcpf(1.f + __expf(-x)); }
__device__ __forceinline__ float siluf(float x) { return x * sigm(x); }
__device__ __forceinline__ float softplusf(float x) { return x > 20.f ? x : log1pf(__expf(x)); }
__device__ __forceinline__ int grp_of_row(int row) { return row < RP ? 0 : 1 + ((row - RP) >> 11); }
__device__ __forceinline__ int kvrow_of_row(int row) { return row < RP ? row : RP + ((row - RP) >> 11) * KVS + PAST + ((row - RP) & 2047); }
__device__ __forceinline__ const float* xrow_ptr(const Params& P, int row) { return row < RP ? P.in[I_XP] + (size_t)row * DM : P.in[I_XS] + (size_t)(row - RP) * DM; }

__device__ __forceinline__ void transpose_item(const float* W, int K, int N, bf16_t* WT, int k0, int n0, int drow0, const float* kscale, LAS float* scr, int lane) {
    float wv[32];
#pragma unroll
    for (int i = 0; i < 32; ++i) wv[i] = __builtin_nontemporal_load(W + (size_t)(k0 + 2 * i + (lane >> 5)) * N + n0 + (lane & 31));
#pragma unroll
    for (int i = 0; i < 32; ++i) { const int kk = 2 * i + (lane >> 5); float w = wv[i]; if (kscale) w *= kscale[k0 + kk]; scr[kk * 33 + (lane & 31)] = w; }
    LDS_WAIT(); asm volatile("" ::: "memory");
    const int c = lane & 7;
#pragma unroll
    for (int j = 0; j < 4; ++j) { const int n = (lane >> 3) + 8 * j; const LAS float* s = scr + (8 * c) * 33 + n;
        u32x4 o; o.x = pk2(s[0 * 33], s[1 * 33]); o.y = pk2(s[2 * 33], s[3 * 33]); o.z = pk2(s[4 * 33], s[5 * 33]); o.w = pk2(s[6 * 33], s[7 * 33]);
        *(u32x4*)(WT + (size_t)(drow0 + n) * K + k0 + 8 * c) = o; }
    LDS_WAIT(); asm volatile("" ::: "memory");
}
__device__ __forceinline__ int win_dst(int n0) {
    if (n0 < 512) return n0;
    if (n0 < 576) return 5120 + (n0 - 512);
    if (n0 < 1600) return 512 + (n0 - 576);
    if (n0 < 2624) return 1536 + (n0 - 1600);
    if (n0 < 2880) return 2560 + (n0 - 2624);
    if (n0 < 3136) return 2816 + (n0 - 2880);
    if (n0 < 3168) return 5184 + (n0 - 3136);
    if (n0 < 4192) return 3072 + (n0 - 3168);
    return 4096 + (n0 - 4192);
}
__device__ __forceinline__ int wup_dst(int n0) { const bool isv = n0 >= DFF; const int j = isv ? n0 - DFF : n0; return (j >> 7) * 256 + (isv ? 128 : 0) + (j & 127); }
__device__ __forceinline__ int wuq_dst(int n0) { const int h = n0 / 192, d0 = n0 - h * 192; return d0 < 128 ? h * 128 + d0 : 1024 + h * 64 + (d0 - 128); }

template <int CW>
__device__ __forceinline__ void gemv3_block(const LAS float* vec  , const float* W, int N, int col0, const float* bias, float* out, int ldo, LAS float* red, int tid) {
    const int j = tid & 31, kq = tid >> 5;
    float a0 = 0.f, a1 = 0.f, a2 = 0.f;
    if (j < CW) {
        const float* wp = W + (size_t)(kq * 64) * N + col0 + j;
#pragma unroll 32
        for (int k = 0; k < 64; ++k) { const float w = __builtin_nontemporal_load(wp + (size_t)k * N); const int kk = kq * 64 + k; a0 += vec[kk] * w; a1 += vec[1024 + kk] * w; a2 += vec[2048 + kk] * w; }
    }
    red[(kq * 3 + 0) * 32 + j] = a0; red[(kq * 3 + 1) * 32 + j] = a1; red[(kq * 3 + 2) * 32 + j] = a2;
    __syncthreads();
    if (tid < 96) { const int g = tid >> 5, jj = tid & 31;
        if (jj < CW) { float s = 0.f;
#pragma unroll
            for (int q = 0; q < 16; ++q) s += red[(q * 3 + g) * 32 + jj];
            out[(size_t)g * ldo + col0 + jj] = s + (bias ? bias[col0 + jj] : 0.f); } }
    __syncthreads();
}

__device__ __forceinline__ void phase_p0(const Params& P, LAS unsigned char* lds) {
    PHASE_IDS unsigned char* ws = P.ws;
    {
        LAS float* sc = (LAS float*)lds; LAS float* red = sc + 3072;
        for (int i = tid; i < 3072; i += NT) { const int g = i >> 10, k = i & 1023; const float c = (g == 0) ? P.in[I_CCTX][k] : P.in[I_C][(g - 1) * 1024 + k]; sc[i] = siluf(c); }
        __syncthreads();
        for (int cb = blockIdx.x; cb < 256; cb += G) gemv3_block<24>(sc, P.in[I_WADA], 6144, cb * 24, P.in[I_BADA], (float*)(ws + WS_MOD), 6144, red, tid);
    }
    {
        LAS float* scr = (LAS float*)(lds + wave * 16384);
        const int gw = blockIdx.x * 8 + wave, NGW = G * 8;
        constexpr int I_IN = 16 * 163, I_UQ = 4 * 48, I_UKV = 4 * 64, I_SQ = 16 * 32, I_UP = 16 * 176, I_DN = 44 * 32;
        constexpr int NITEMS = I_IN + I_UQ + I_UKV + 3 * I_SQ + I_UP + I_DN;
        for (int it = gw; it < NITEMS; it += NGW) {
            int r = it;
            if (r < I_IN) { const int kb = r / 163, nb = r % 163; transpose_item(P.in[I_WIN], 1024, INC, (bf16_t*)(ws + WS_WIN), kb * 64, nb * 32, win_dst(nb * 32), nullptr, scr, lane); continue; } r -= I_IN;
            if (r < I_UQ) { const int kb = r / 48, nb = r % 48; transpose_item(P.in[I_WUQ], 256, 1536, (bf16_t*)(ws + WS_WUQ), kb * 64, nb * 32, wuq_dst(nb * 32), P.in[I_GQ], scr, lane); continue; } r -= I_UQ;
            if (r < I_UKV) { const int kb = r / 64, nb = r % 64; transpose_item(P.in[I_WUKV], 256, 2048, (bf16_t*)(ws + WS_WUKV), kb * 64, nb * 32, nb * 32, P.in[I_GKV], scr, lane); continue; } r -= I_UKV;
            if (r < I_SQ) { const int kb = r / 32, nb = r % 32; transpose_item(P.in[I_WOMLA], 1024, 1024, (bf16_t*)(ws + WS_WOMLA), kb * 64, nb * 32, nb * 32, nullptr, scr, lane); continue; } r -= I_SQ;
            if (r < I_SQ) { const int kb = r / 32, nb = r % 32; transpose_item(P.in[I_WOSSD], 1024, 1024, (bf16_t*)(ws + WS_WOSSD), kb * 64, nb * 32, nb * 32, P.in[I_GSSD], scr, lane); continue; } r -= I_SQ;
            if (r < I_SQ) { const int kb = r / 32, nb = r % 32; transpose_item(P.in[I_WOUT], 1024, 1024, (bf16_t*)(ws + WS_WOUT), kb * 64, nb * 32, nb * 32, nullptr, scr, lane); continue; } r -= I_SQ;
            if (r < I_UP) { const int kb = r / 176, nb = r % 176; transpose_item(P.in[I_WUP], 1024, UPN, (bf16_t*)(ws + WS_WUP), kb * 64, nb * 32, wup_dst(nb * 32), nullptr, scr, lane); continue; } r -= I_UP;
            { const int kb = r / 32, nb = r % 32; transpose_item(P.in[I_WDOWN], DFF, 1024, (bf16_t*)(ws + WS_WDOWN), kb * 64, nb * 32, nb * 32, nullptr, scr, lane); }
        }
    }
    {
        const int gt = blockIdx.x * NT + tid, GT = G * NT;
        for (int i = gt; i < 8192 / 16; i += GT) *(u32x4*)(ws + WS_ZERO + (size_t)i * 16) = (u32x4){0u, 0u, 0u, 0u};
        for (int i = gt; i < 160 * 1024 / 8; i += GT) *(u32x4*)((bf16_t*)(ws + WS_WIN) + (size_t)5216 * 1024 + (size_t)i * 8) = (u32x4){0u, 0u, 0u, 0u};
        for (int i = gt; i < 2048 * 32; i += GT) { const int t = i >> 5, a = (i >> 4) & 1, fi = i & 15; const float pos = (float)(a ? (t & 63) : (t >> 6));
            const float inv = exp2f(-(float)fi * 0.8304820237218406f); const float ang = pos * inv;
            ((f32x2*)(ws + WS_ROPE))[i] = (f32x2){__cosf(ang), __sinf(ang)}; }
        for (int i = gt; i < 2 * PAST * 256; i += GT) { const int k = i & 255, s = (i >> 8) & 511, b = i >> 17;
            ((bf16_t*)(ws + WS_CKVA))[(size_t)(RP + b * KVS + s) * 256 + k] = (bf16_t)f2bf(P.in[I_CKV][i] / P.in[I_GKV][k]); }
        for (int i = gt; i < 2 * PAST * 64; i += GT) { const int j = i & 63, s = (i >> 6) & 511, b = i >> 15;
            ((bf16_t*)(ws + WS_KROPE))[(size_t)(RP + b * KVS + s) * 64 + j] = (bf16_t)f2bf(P.in[I_CKR][i]); }
        for (int i = gt; i < 2 * PAST; i += GT) { const int s = i & 511, b = i >> 9;
            *(f32x4*)((float*)(ws + WS_SSQ_CKV) + (size_t)(RP + b * KVS + s) * 4) = (f32x4){256.f * (1.f - EPS), 0.f, 0.f, 0.f}; }
    }
}

__device__ __forceinline__ void phase_p1(const Params& P, LAS unsigned char* lds) {
    PHASE_IDS unsigned char* ws = P.ws; const float* mod = (const float*)(ws + WS_MOD);
    const int gw = blockIdx.x * 8 + wave, NGW = G * 8;
    {
        float s2[3][16];
#pragma unroll
        for (int g = 0; g < 3; ++g)
#pragma unroll
            for (int q = 0; q < 4; ++q) { const f32x4 a = *(const f32x4*)(mod + g * 6144 + 3072 + (q >> 1) * 512 + 8 * lane + 4 * (q & 1));
#pragma unroll
                for (int e = 0; e < 4; ++e) s2[g][4 * q + e] = a[e]; }
        const bf16_t* wt = (const bf16_t*)(ws + WS_WUP);
        for (int j = gw; j < UPN; j += NGW) {
            const size_t jr = (size_t)(wup_dst(j & ~31) + (j & 31)) * 1024;
            float wf[16]; unpack8(*(const u32x4*)(wt + jr + 8 * lane), wf); unpack8(*(const u32x4*)(wt + jr + 512 + 8 * lane), wf + 8);
            float a0 = 0.f, a1 = 0.f, a2 = 0.f;
#pragma unroll
            for (int e = 0; e < 16; ++e) { a0 += s2[0][e] * wf[e]; a1 += s2[1][e] * wf[e]; a2 += s2[2][e] * wf[e]; }
            a0 = wave_sum(a0); a1 = wave_sum(a1); a2 = wave_sum(a2);
            if (lane == 0) { float* cu = (float*)(ws + WS_CUP); cu[j] = a0; cu[UPN + j] = a1; cu[2 * UPN + j] = a2;
                const float* fw = P.in[I_FCW]; const float wsum = (fw[j] + fw[UPN + j]) + fw[2 * UPN + j], bb = P.in[I_FCB][j]; float* cs = (float*)(ws + WS_CST);
                cs[j] = a0 * wsum + bb; cs[UPN + j] = a1 * wsum + bb; cs[2 * UPN + j] = a2 * wsum + bb; }
        }
    }
    const float* gat = P.in[I_GATTN];
    for (int row0 = gw * 2; row0 < R; row0 += NGW * 2) {
        const int g = grp_of_row(row0);
        f32x4 v[2][4]; float s[2] = {0.f, 0.f};
#pragma unroll
        for (int q = 0; q < 2; ++q) { const f32x4* xr = (const f32x4*)xrow_ptr(P, row0 + q) + lane;
#pragma unroll
            for (int j = 0; j < 4; ++j) v[q][j] = __builtin_nontemporal_load(xr + 64 * j); }
#pragma unroll
        for (int q = 0; q < 2; ++q)
#pragma unroll
            for (int j = 0; j < 4; ++j) s[q] += (v[q][j].x * v[q][j].x + v[q][j].y * v[q][j].y) + (v[q][j].z * v[q][j].z + v[q][j].w * v[q][j].w);
        const float rs0 = rsqrtf(wave_sum(s[0]) * (1.f / DM) + EPS), rs1 = rsqrtf(wave_sum(s[1]) * (1.f / DM) + EPS);
#pragma unroll
        for (int j = 0; j < 4; ++j) { const int c = 4 * lane + 256 * j;
            const f32x4 gg = *(const f32x4*)(gat + c), sc = *(const f32x4*)(mod + g * 6144 + 1024 + c), sh = *(const f32x4*)(mod + g * 6144 + c);
            const f32x4 gs = gg * (sc + 1.f);
            const f32x4 h0 = v[0][j] * rs0 * gs + sh, h1 = v[1][j] * rs1 * gs + sh;
            ((u32x2*)((bf16_t*)(ws + WS_H) + (size_t)row0 * DM) + lane)[64 * j] = (u32x2){pk2(h0.x, h0.y), pk2(h0.z, h0.w)};
            ((u32x2*)((bf16_t*)(ws + WS_H) + (size_t)(row0 + 1) * DM) + lane)[64 * j] = (u32x2){pk2(h1.x, h1.y), pk2(h1.z, h1.w)}; }
    }
}

typedef const f32x4 (&AccRef)[2][2][4][2];
typedef const f32x4 (&AccRef3)[2][2][3][2];
#define EPI_ROWS_M(pm, MFR) _Pragma("unroll") for (int ai = 0; ai < 2; ++ai) _Pragma("unroll") for (int m = 0; m < (MFR); ++m) { const int row = (pm) * (64 * (MFR)) + ai * (32 * (MFR)) + wr * (16 * (MFR)) + m * 16 + fr;
#define EPI_ROWS(pm) _Pragma("unroll") for (int ai = 0; ai < 2; ++ai) _Pragma("unroll") for (int m = 0; m < 4; ++m) { const int row = (pm) * 256 + ai * 128 + wr * 64 + m * 16 + fr;
#define EPI_COLS _Pragma("unroll") for (int bj = 0; bj < 2; ++bj) _Pragma("unroll") for (int n = 0; n < 2; ++n) { const int col = bj * 128 + wc * 32 + n * 16 + fq * 4; const f32x4 v = acc[ai][bj][m][n];
#define EPI_END }
#define EPI_COLS8 _Pragma("unroll") for (int bj = 0; bj < 2; ++bj) { const int col = bj * 128 + wc * 32 + fq * 8; const f32x4 v0 = acc[ai][bj][m][0], v1 = acc[ai][bj][m][1];
__device__ __forceinline__ void st_bf8(bf16_t* p, f32x4 a, f32x4 b) { *(u32x4*)p = (u32x4){pk2(a.x, a.y), pk2(a.z, a.w), pk2(b.x, b.y), pk2(b.z, b.w)}; }
__device__ __forceinline__ void st_bf4(bf16_t* p, f32x4 v) { *(u32x2*)p = (u32x2){pk2(v.x, v.y), pk2(v.z, v.w)}; }
__device__ __forceinline__ f32x4 ld_bf4(const bf16_t* p) { const u32x2 w = *(const u32x2*)p; return (f32x4){bflo(w.x), bfhi(w.x), bflo(w.y), bfhi(w.y)}; }
__device__ __forceinline__ float quad_sum16(float s) { s += __shfl_xor(s, 16); s += __shfl_xor(s, 32); return s; }

struct EpiInMain {
    static constexpr bool PERM = true, AFTER_DRAIN = false;
#if defined(PG8_TIME) && PG8_TPH == 1
    static constexpr bool TIMED = true;
#endif
    bf16_t *cq, *ckv, *z, *xbc, *sgm, *sgs; float *ssq_cq, *ssq_ckv, *new_ckv;
    __device__ __forceinline__ void operator()(AccRef acc, const pg8::Unit& u, int wr, int wc, int fr, int fq) const {
        const int pn = u.pn;
        if (pn < 2) {
            EPI_ROWS(u.pm)
                const int orow = pn == 0 ? row : kvrow_of_row(row); bf16_t* dst = (pn == 0 ? cq : ckv) + (size_t)orow * 256; float s = 0.f;
                EPI_COLS8
                    st_bf8(dst + col, v0, v1); s += ((v0.x * v0.x + v0.y * v0.y) + (v0.z * v0.z + v0.w * v0.w)) + ((v1.x * v1.x + v1.y * v1.y) + (v1.z * v1.z + v1.w * v1.w));
                    if (pn == 1 && row < RP) { *(f32x4*)(new_ckv + (size_t)row * 256 + col) = v0; *(f32x4*)(new_ckv + (size_t)row * 256 + col + 4) = v1; }
                EPI_END
                s = quad_sum16(s);
                if (fq == 0) (pn == 0 ? ssq_cq : ssq_ckv)[(size_t)orow * 4 + wc] = s;
            EPI_END
        } else if (pn < 12) {
            bf16_t* base = pn < 6 ? z : xbc; const int ld = pn < 6 ? 1024 : 1536, c0 = pn < 6 ? (pn - 2) * 256 : (pn - 6) * 256;
            EPI_ROWS(u.pm)
                bf16_t* dst = base + (size_t)row * ld + c0;
                EPI_COLS8 st_bf8(dst + col, v0, v1); EPI_END
            EPI_END
        } else {
            bf16_t* base = pn < 16 ? sgm : sgs; const int c0 = (pn & 3) * 256;
            EPI_ROWS(u.pm)
                bf16_t* dst = base + (size_t)row * 1024 + c0;
                EPI_COLS8 __builtin_nontemporal_store((u32x4){pk2(sigm(v0.x), sigm(v0.y)), pk2(sigm(v0.z), sigm(v0.w)), pk2(sigm(v1.x), sigm(v1.y)), pk2(sigm(v1.z), sigm(v1.w))}, (u32x4*)(dst + col)); EPI_END
            EPI_END
        }
    }
};
struct EpiInTail {
    static constexpr bool PERM = false, AFTER_DRAIN = false;
    bf16_t* krope; float *dt, *new_krope; const float* dt_bias; const f32x2* rope;
    __device__ __forceinline__ void operator()(AccRef acc, const pg8::Unit& u, int wr, int wc, int fr, int fq) const {
        if (wc < 2) {
            EPI_ROWS(u.pm)
                const f32x4 x0 = acc[ai][0][m][0], x1 = acc[ai][0][m][1]; const int i0 = fq * 4;
                if (row < RP) {
                    st_bf4(krope + (size_t)row * 64 + wc * 32 + i0, x0); st_bf4(krope + (size_t)row * 64 + wc * 32 + 16 + i0, x1);
                    *(f32x4*)(new_krope + (size_t)row * 64 + wc * 32 + i0) = x0; *(f32x4*)(new_krope + (size_t)row * 64 + wc * 32 + 16 + i0) = x1;
                } else {
                    const int t = (row - RP) & 2047; const f32x2* rp = rope + t * 32 + wc * 16 + i0; f32x4 o0, o1;
#pragma unroll
                    for (int e = 0; e < 4; ++e) { const f32x2 cs = rp[e]; o0[e] = x0[e] * cs.x - x1[e] * cs.y; o1[e] = x0[e] * cs.y + x1[e] * cs.x; }
                    bf16_t* dst = krope + (size_t)kvrow_of_row(row) * 64 + wc * 32 + i0; st_bf4(dst, o0); st_bf4(dst + 16, o1);
                }
            EPI_END
        } else if (wc == 2) {
            EPI_ROWS(u.pm)
#pragma unroll
                for (int n = 0; n < 2; ++n) { const int j = n * 16 + fq * 4; const f32x4 v = acc[ai][0][m][n]; const f32x4 b = *(const f32x4*)(dt_bias + j);
                    *(f32x4*)(dt + (size_t)row * 32 + j) = (f32x4){softplusf(v.x + b.x), softplusf(v.y + b.y), softplusf(v.z + b.z), softplusf(v.w + b.w)}; }
            EPI_END
        }
    }
};

struct EpiQR {
    static constexpr bool PERM = false, AFTER_DRAIN = false;
    bf16_t* qr; const float* ssq; const f32x2* rope;
    __device__ __forceinline__ void operator()(AccRef acc, const pg8::Unit& u, int wr, int wc, int fr, int fq) const {
        EPI_ROWS(u.pm)
            const f32x4 sq = *(const f32x4*)(ssq + (size_t)row * 4); const float rs = rsqrtf(((sq.x + sq.y) + (sq.z + sq.w)) * (1.f / 256.f) + EPS);
            bf16_t* dst = qr + (size_t)row * 512 + u.pn * 256;
#pragma unroll
            for (int bj = 0; bj < 2; ++bj) { const int cb = bj * 128 + wc * 32, i0 = fq * 4; const f32x4 x0 = acc[ai][bj][m][0] * rs, x1 = acc[ai][bj][m][1] * rs;
                if (row < RP) { st_bf4(dst + cb + i0, x0); st_bf4(dst + cb + 16 + i0, x1); }
                else { const int t = (row - RP) & 2047; const f32x2* rp = rope + t * 32 + (wc & 1) * 16 + i0; f32x4 o0, o1;
#pragma unroll
                    for (int e = 0; e < 4; ++e) { const f32x2 cs = rp[e]; o0[e] = x0[e] * cs.x - x1[e] * cs.y; o1[e] = x0[e] * cs.y + x1[e] * cs.x; }
                    st_bf4(dst + cb + i0, o0); st_bf4(dst + cb + 16 + i0, o1); } }
        EPI_END
    }
};
template <int MFR> struct EpiMla {
    static constexpr bool PERM = true, AFTER_DRAIN = false;
    const bf16_t* sgm; float* t;
    __device__ __forceinline__ void operator()(const f32x4 (&acc)[2][2][MFR][2], const pg8::Unit& u, int wr, int wc, int fr, int fq) const {
        EPI_ROWS_M(u.pm, MFR)
            const size_t off = (size_t)row * 1024 + u.pn * 256;
            EPI_COLS8 const u32x4 gw = *(const u32x4*)(sgm + off + col);
                *(f32x4*)(t + off + col) = (f32x4){bflo(gw.x), bfhi(gw.x), bflo(gw.y), bfhi(gw.y)} * v0; *(f32x4*)(t + off + col + 4) = (f32x4){bflo(gw.z), bfhi(gw.z), bflo(gw.w), bfhi(gw.w)} * v1; EPI_END
        EPI_END
    }
};
template <int MFR> struct EpiSsd {
    static constexpr bool PERM = true, AFTER_DRAIN = false;
    const bf16_t* sgs; const float* t; const float* ssq_y; bf16_t* merged;
    __device__ __forceinline__ void operator()(const f32x4 (&acc)[2][2][MFR][2], const pg8::Unit& u, int wr, int wc, int fr, int fq) const {
        EPI_ROWS_M(u.pm, MFR)
            float s = 0.f;
#pragma unroll
            for (int q = 0; q < 4; ++q) { const f32x4 a = *(const f32x4*)(ssq_y + (size_t)row * 16 + q * 4); s += (a.x + a.y) + (a.z + a.w); }
            const float rs = rsqrtf(s * (1.f / 1024.f) + EPS); const size_t off = (size_t)row * 1024 + u.pn * 256;
            EPI_COLS8 const u32x4 gw = *(const u32x4*)(sgs + off + col);
                st_bf8(merged + off + col, *(const f32x4*)(t + off + col) + (f32x4){bflo(gw.x), bfhi(gw.x), bflo(gw.y), bfhi(gw.y)} * (v0 * rs),
                       *(const f32x4*)(t + off + col + 4) + (f32x4){bflo(gw.z), bfhi(gw.z), bflo(gw.w), bfhi(gw.w)} * (v1 * rs)); EPI_END
        EPI_END
    }
};
template <int MFR> struct EpiOut {
    static constexpr bool PERM = true, AFTER_DRAIN = false;
    const float *xp, *xs, *mod, *gffn; float* x1; bf16_t* a1; float* ssq2;
    __device__ __forceinline__ void operator()(const f32x4 (&acc)[2][2][MFR][2], const pg8::Unit& u, int wr, int wc, int fr, int fq) const {
        EPI_ROWS_M(u.pm, MFR)
            const float* md = mod + grp_of_row(row) * 6144;
            const float* xr = row < RP ? xp + (size_t)row * DM : xs + (size_t)(row - RP) * DM; const size_t off = (size_t)row * 1024; float s = 0.f;
            EPI_COLS8
                const int c = u.pn * 256 + col;
                const f32x4 xa = __builtin_nontemporal_load((const f32x4*)(xr + c)) + *(const f32x4*)(md + 2048 + c) * v0, xb = __builtin_nontemporal_load((const f32x4*)(xr + c + 4)) + *(const f32x4*)(md + 2048 + c + 4) * v1;
                *(f32x4*)(x1 + off + c) = xa; *(f32x4*)(x1 + off + c + 4) = xb;
                s += ((xa.x * xa.x + xa.y * xa.y) + (xa.z * xa.z + xa.w * xa.w)) + ((xb.x * xb.x + xb.y * xb.y) + (xb.z * xb.z + xb.w * xb.w));
                st_bf8(a1 + off + c, xa * *(const f32x4*)(gffn + c) * (*(const f32x4*)(md + 4096 + c) + 1.f), xb * *(const f32x4*)(gffn + c + 4) * (*(const f32x4*)(md + 4096 + c + 4) + 1.f));
            EPI_END
            s = quad_sum16(s);
            if (fq == 0) ssq2[(size_t)row * 16 + u.pn * 4 + wc] = s;
        EPI_END
    }
};
struct EpiUp {
    static constexpr bool PERM = true, AFTER_DRAIN = false;
    const float *ssq2, *cup; bf16_t* uo; int pm_off;
    __device__ __forceinline__ void operator()(AccRef acc, const pg8::Unit& u, int wr, int wc, int fr, int fq) const {
        const int pmo = u.pm + pm_off; const int g = pmo < 32 ? 0 : 1 + ((pmo - 32) >> 3); const float* cu = cup + g * UPN + u.pn * 256;
        EPI_ROWS(pmo)
            float s = 0.f;
#pragma unroll
            for (int q = 0; q < 4; ++q) { const f32x4 a = *(const f32x4*)(ssq2 + (size_t)row * 16 + q * 4); s += (a.x + a.y) + (a.z + a.w); }
            const float rs = rsqrtf(s * (1.f / 1024.f) + EPS); bf16_t* dst = uo + (size_t)row * UPN + u.pn * 256;
            EPI_COLS8 st_bf8(dst + col, v0 * rs + *(const f32x4*)(cu + col), v1 * rs + *(const f32x4*)(cu + col + 4)); EPI_END
        EPI_END
    }
};
constexpr int CG_RB = 16;
struct CgW { float wg[3][8], wv[3][8], bg[8], bv[8]; };
__device__ __forceinline__ void cg_load_w(CgW& W, const float* fw, const float* fb, int c) {
#pragma unroll
    for (int k = 0; k < 3; ++k)
#pragma unroll
        for (int q = 0; q < 2; ++q) { const f32x4 a = *(const f32x4*)(fw + k * UPN + c + 4 * q), b = *(const f32x4*)(fw + k * UPN + DFF + c + 4 * q);
#pragma unroll
            for (int e = 0; e < 4; ++e) { W.wg[k][4 * q + e] = a[e]; W.wv[k][4 * q + e] = b[e]; } }
#pragma unroll
    for (int q = 0; q < 2; ++q) { const f32x4 a = *(const f32x4*)(fb + c + 4 * q), b = *(const f32x4*)(fb + DFF + c + 4 * q);
#pragma unroll
        for (int e = 0; e < 4; ++e) { W.bg[4 * q + e] = a[e]; W.bv[4 * q + e] = b[e]; } }
}
__device__ __forceinline__ float dpp_row_prev(float cur, float prv) {
    const int o = __builtin_amdgcn_update_dpp(0, __float_as_int(prv), 0x121, 0xf, 0xf, true);
    return __int_as_float(__builtin_amdgcn_update_dpp(o, __float_as_int(cur), 0x111, 0xf, 0xf, false)); }
__device__ __forceinline__ float dpp_row_next(float cur, float nxt) {
    const int o = __builtin_amdgcn_update_dpp(0, __float_as_int(nxt), 0x12F, 0xf, 0xf, true);
    return __int_as_float(__builtin_amdgcn_update_dpp(o, __float_as_int(cur), 0x101, 0xf, 0xf, false)); }
__device__ __forceinline__ void conv4_rows(float (&c)[4], float a0, float a1, float a2, float a3, float r0, float r1, float r2, float r3,
                                           float w0, float w1, float w2, float cs) {
    float t0, t1, t2, t3, z; const unsigned long long mlo = 0x0001000100010001ull, mhi = 0x8000800080008000ull;
    asm volatile(
        "v_cndmask_b32_e64 %[z], 0, %[w0], %[mlo]\n\t"
        "v_mul_f32 %[t0], %[a0], %[r0]\n\t" "v_mul_f32 %[t1], %[a1], %[r1]\n\t" "v_mul_f32 %[t2], %[a2], %[r2]\n\t" "v_mul_f32 %[t3], %[a3], %[r3]\n\t"
        "v_fma_f32 %[c0], %[w1], %[t0], %[cs]\n\t" "v_fma_f32 %[c1], %[w1], %[t1], %[cs]\n\t" "v_fma_f32 %[c2], %[w1], %[t2], %[cs]\n\t" "v_fma_f32 %[c3], %[w1], %[t3], %[cs]\n\t"
        "v_fmac_f32_dpp %[c0], %[t0], %[w0] row_shr:1 row_mask:0xf bank_mask:0xf bound_ctrl:1\n\t"
        "v_fmac_f32_dpp %[c1], %[t1], %[w0] row_shr:1 row_mask:0xf bank_mask:0xf bound_ctrl:1\n\t"
        "v_fmac_f32_dpp %[c2], %[t2], %[w0] row_shr:1 row_mask:0xf bank_mask:0xf bound_ctrl:1\n\t"
        "v_fmac_f32_dpp %[c3], %[t3], %[w0] row_shr:1 row_mask:0xf bank_mask:0xf bound_ctrl:1\n\t"
        "v_fmac_f32_dpp %[c0], %[t0], %[w2] row_shl:1 row_mask:0xf bank_mask:0xf bound_ctrl:1\n\t"
        "v_fmac_f32_dpp %[c1], %[t1], %[w2] row_shl:1 row_mask:0xf bank_mask:0xf bound_ctrl:1\n\t"
        "v_fmac_f32_dpp %[c2], %[t2], %[w2] row_shl:1 row_mask:0xf bank_mask:0xf bound_ctrl:1\n\t"
        "v_fmac_f32_dpp %[c3], %[t3], %[w2] row_shl:1 row_mask:0xf bank_mask:0xf bound_ctrl:1\n\t"
        "v_fmac_f32_dpp %[c1], %[t0], %[z] row_ror:1 row_mask:0xf bank_mask:0xf\n\t"
        "v_fmac_f32_dpp %[c2], %[t1], %[z] row_ror:1 row_mask:0xf bank_mask:0xf\n\t"
        "v_fmac_f32_dpp %[c3], %[t2], %[z] row_ror:1 row_mask:0xf bank_mask:0xf\n\t"
        "v_cndmask_b32_e64 %[z], 0, %[w2], %[mhi]\n\t"
        "v_fmac_f32_dpp %[c0], %[t1], %[z] row_ror:15 row_mask:0xf bank_mask:0xf\n\t"
        "v_fmac_f32_dpp %[c1], %[t2], %[z] row_ror:15 row_mask:0xf bank_mask:0xf\n\t"
        "v_fmac_f32_dpp %[c2], %[t3], %[z] row_ror:15 row_mask:0xf bank_mask:0xf"
        : [c0] "=&v"(c[0]), [c1] "=&v"(c[1]), [c2] "=&v"(c[2]), [c3] "=&v"(c[3]), [t0] "=&v"(t0), [t1] "=&v"(t1), [t2] "=&v"(t2), [t3] "=&v"(t3), [z] "=&v"(z)
        : [a0] "v"(a0), [a1] "v"(a1), [a2] "v"(a2), [a3] "v"(a3), [r0] "v"(r0), [r1] "v"(r1), [r2] "v"(r2), [r3] "v"(r3),
          [w0] "v"(w0), [w1] "v"(w1), [w2] "v"(w2), [cs] "v"(cs), [mlo] "s"(mlo), [mhi] "s"(mhi));
}
struct EpiUpGate {
    static constexpr bool PERM = true, AFTER_DRAIN = false;
#if defined(PG8_TIME) && PG8_TPH == 5
    static constexpr bool TIMED = true;
#endif
    static constexpr int PRE_SLOT = 1024, PRE_BYTES = 5120;
    const float *ssq2, *cup, *fcw, *cstp; bf16_t *ug, *halo;
    __device__ __forceinline__ void pre(const pg8::Unit& u, LAS unsigned char* slot, int wr, int wc, int lane) const {
        if (wr != 0) return;
        const int g = u.pm < 32 ? 0 : 1 + ((u.pm - 32) >> 3); const int cb = u.pn * 128 + wc * 32; const int a = lane >> 4, hv = (lane >> 3) & 1, c4 = lane & 7;
        const float* src = (a < 3 ? fcw + a * UPN : cstp + g * UPN) + hv * DFF + cb + c4 * 4;
        __builtin_amdgcn_global_load_lds((const unsigned*)src, (LAS unsigned*)(slot + wc * 1280), 16, 0, 0);
        if (lane < 16) __builtin_amdgcn_global_load_lds((const unsigned*)(cup + g * UPN + hv * DFF + cb + c4 * 4), (LAS unsigned*)(slot + wc * 1280 + 1024), 16, 0, 0);
    }
    __device__ __forceinline__ void operator()(const f32x4 (&acc)[2][2][4][2], const pg8::Unit& u, int wr, int wc, int fr, int fq, LAS unsigned char* slot) const {
        asm volatile("" : "+v"(fr), "+v"(fq));
        const int cb = u.pn * 128 + wc * 32;
        LAS const unsigned char* cl = slot + wc * 1280 + fq * 32;
        const char* sb = (const char*)(ssq2 + (size_t)(u.pm * 256 + wr * 64) * 16); const size_t slo = (unsigned)fr * 64u + (unsigned)fq * 16u;
        f32x4 raw[4];
#pragma unroll
        for (int m = 0; m < 4; ++m) raw[m] = *(const f32x4*)(sb + m * 1024 + slo);
#pragma unroll
        for (int ai = 0; ai < 2; ++ai) {
            const int row0 = u.pm * 256 + ai * 128 + wr * 64;
            float rsv[4];
#pragma unroll
            for (int m = 0; m < 4; ++m) rsv[m] = rsqrtf(quad_sum16((raw[m].x + raw[m].y) + (raw[m].z + raw[m].w)) * (1.f / 1024.f) + EPS);
            if (ai == 0) {
#pragma unroll
                for (int m = 0; m < 4; ++m) raw[m] = *(const f32x4*)(sb + 128 * 64 + m * 1024 + slo); }
            unsigned pk[4][4];
#ifdef CG_REP
            for (int rep = 0; rep < CG_REP; ++rep)
#endif
#pragma unroll
            for (int h = 0; h < 4; ++h) {
                f32x2 w0[2], w1[2], w2[2], cst[2];
#pragma unroll
                for (int hv = 0; hv < 2; ++hv) { const int co = hv * 128 + h * 8;
                    w0[hv] = *(LAS const f32x2*)(cl + co); w1[hv] = *(LAS const f32x2*)(cl + 256 + co); w2[hv] = *(LAS const f32x2*)(cl + 512 + co); cst[hv] = *(LAS const f32x2*)(cl + 768 + co); }
                float o[4][2];
#pragma unroll
                for (int e2 = 0; e2 < 2; ++e2) { const int n = h >> 1, e = (h & 1) * 2 + e2;
                    float cv[2][4];
#pragma unroll
                    for (int hv = 0; hv < 2; ++hv)
                        conv4_rows(cv[hv], acc[ai][hv][0][n][e], acc[ai][hv][1][n][e], acc[ai][hv][2][n][e], acc[ai][hv][3][n][e], rsv[0], rsv[1], rsv[2], rsv[3],
                                   w0[hv][e2], w1[hv][e2], w2[hv][e2], cst[hv][e2]);
#pragma unroll
                    for (int m = 0; m < 4; ++m) o[m][e2] = siluf(cv[0][m]) * cv[1][m];
                }
#pragma unroll
                for (int m = 0; m < 4; ++m) pk[m][h] = pk2(o[m][0], o[m][1]);
                __builtin_amdgcn_sched_barrier(0);
            }
            { char* ub = (char*)(ug + (size_t)row0 * DFF + cb); const size_t lo = (unsigned)fr * (unsigned)(DFF * 2) + (unsigned)fq * 16u;
#pragma unroll
                for (int m = 0; m < 4; ++m) { const bool edge = (m == 0 && fr == 0) || (m == 3 && fr == 15);
                    if (!edge) *(u32x4*)(ub + (size_t)m * 16 * DFF * 2 + lo) = (u32x4){pk[m][0], pk[m][1], pk[m][2], pk[m][3]}; } }
            const int slab = u.pm * 4 + ai * 2 + wr; char* hb = (char*)(halo + (size_t)slab * 4 * UPN + cb);
#pragma unroll
            for (int mm = 0; mm < 2; ++mm) { const int m = mm * 3; const bool act = mm == 0 ? (fr < 2) : (fr >= 14); const unsigned r4 = mm == 0 ? fr : fr - 12;
                if (act) { const size_t ho = r4 * (unsigned)(UPN * 2) + (unsigned)fq * 16u;
#pragma unroll
                    for (int hv = 0; hv < 2; ++hv) { const f32x4 c0 = *(LAS const f32x4*)(cl + 1024 + hv * 128), c1 = *(LAS const f32x4*)(cl + 1024 + hv * 128 + 16);
                        st_bf8((bf16_t*)(hb + hv * DFF * 2 + ho), acc[ai][hv][m][0] * rsv[m] + c0, acc[ai][hv][m][1] * rsv[m] + c1); } } }
        }
    }
};
__device__ __forceinline__ void fixup_rows(const Params& P, int row_lo, int row_hi, int tid) {
    if (tid >= DFF / 8) return;
    unsigned char* ws = P.ws; const bf16_t* halo = (const bf16_t*)(ws + WS_HALO); bf16_t* ug = (bf16_t*)(ws + WS_UG); const int c = tid * 8;
    CgW W; cg_load_w(W, P.in[I_FCW], P.in[I_FCB], c);
    const u32x4 zero = {0u, 0u, 0u, 0u};
    for (int k = row_lo / 64; k < row_hi / 64; ++k)
#pragma unroll
        for (int wh = 0; wh < 2; ++wh) {
            const int row = 64 * k + (wh ? 63 : 0); const int t = row < RP ? (row & 255) : ((row - RP) & 2047), L = row < RP ? SEQP : SEQS;
            const bf16_t* hp = nullptr; const bf16_t* hc; const bf16_t* hn = nullptr;
            if (wh == 0) { hc = halo + ((size_t)k * 4 + 0) * UPN; hn = halo + ((size_t)k * 4 + 1) * UPN; if (t > 0) hp = halo + ((size_t)(k - 1) * 4 + 3) * UPN; }
            else { hp = halo + ((size_t)k * 4 + 2) * UPN; hc = halo + ((size_t)k * 4 + 3) * UPN; if (t < L - 1) hn = halo + ((size_t)(k + 1) * 4 + 0) * UPN; }
            const u32x4 gp = hp ? *(const u32x4*)(hp + c) : zero, vp = hp ? *(const u32x4*)(hp + DFF + c) : zero;
            const u32x4 gc = *(const u32x4*)(hc + c), vc = *(const u32x4*)(hc + DFF + c);
            const u32x4 gn = hn ? *(const u32x4*)(hn + c) : zero, vn = hn ? *(const u32x4*)(hn + DFF + c) : zero;
            float a[8], b[8], x[8];
#pragma unroll
            for (int e = 0; e < 8; ++e) { a[e] = W.bg[e]; b[e] = W.bv[e]; }
            unpack8(gp, x);
#pragma unroll
            for (int e = 0; e < 8; ++e) a[e] += x[e] * W.wg[0][e];
            unpack8(gc, x);
#pragma unroll
            for (int e = 0; e < 8; ++e) a[e] += x[e] * W.wg[1][e];
            unpack8(gn, x);
#pragma unroll
            for (int e = 0; e < 8; ++e) a[e] += x[e] * W.wg[2][e];
            unpack8(vp, x);
#pragma unroll
            for (int e = 0; e < 8; ++e) b[e] += x[e] * W.wv[0][e];
            unpack8(vc, x);
#pragma unroll
            for (int e = 0; e < 8; ++e) b[e] += x[e] * W.wv[1][e];
            unpack8(vn, x);
#pragma unroll
            for (int e = 0; e < 8; ++e) b[e] += x[e] * W.wv[2][e];
            u32x4 o;
#pragma unroll
            for (int e = 0; e < 4; ++e) o[e] = pk2(siluf(a[2 * e]) * b[2 * e], siluf(a[2 * e + 1]) * b[2 * e + 1]);
            *(u32x4*)(ug + (size_t)row * DFF + c) = o;
        }
}

template <int MFR> struct EpiDown {
    static constexpr bool PERM = true, AFTER_DRAIN = false;
    const float* mod; float* x;
    __device__ __forceinline__ void operator()(const f32x4 (&acc)[2][2][MFR][2], const pg8::Unit& u, int wr, int wc, int fr, int fq) const {
        EPI_ROWS_M(u.pm, MFR)
            const float* g2 = mod + grp_of_row(row) * 6144 + 5120 + u.pn * 256;
            float* xr = x + (size_t)row * 1024 + u.pn * 256;
            EPI_COLS8 *(f32x4*)(xr + col) = *(const f32x4*)(xr + col) + *(const f32x4*)(g2 + col) * v0; *(f32x4*)(xr + col + 4) = *(const f32x4*)(xr + col + 4) + *(const f32x4*)(g2 + col + 4) * v1; EPI_END
        EPI_END
    }
};

struct EpiDownNorm {
    static constexpr bool PERM = true, AFTER_DRAIN = true;
    const float* mod; float* x; const float* gfin; float* xbuf; unsigned* cnt;
    __device__ __forceinline__ void fused(f32x4 (&acc)[2][2][3][2], const pg8::Unit& u, int wr, int wc, int fr, int fq, LAS unsigned char* lds, int wid, int lane) const {
        LAS float* Pt = (LAS float*)lds;
        LAS float* St = (LAS float*)(lds + 4096);
        EPI_ROWS_M(u.pm, 3)
            const float* g2 = mod + grp_of_row(row) * 6144 + 5120 + u.pn * 256; const float* xr = x + (size_t)row * 1024 + u.pn * 256; float s = 0.f;
#pragma unroll
            for (int bj = 0; bj < 2; ++bj) { const int col = bj * 128 + wc * 32 + fq * 8;
                const f32x4 a = *(const f32x4*)(xr + col) + *(const f32x4*)(g2 + col) * acc[ai][bj][m][0], b = *(const f32x4*)(xr + col + 4) + *(const f32x4*)(g2 + col + 4) * acc[ai][bj][m][1];
                acc[ai][bj][m][0] = a; acc[ai][bj][m][1] = b;
                s += ((a.x * a.x + a.y * a.y) + (a.z * a.z + a.w * a.w)) + ((b.x * b.x + b.y * b.y) + (b.z * b.z + b.w * b.w)); }
            s = quad_sum16(s);
            if (fq == 0) Pt[(ai * 96 + wr * 48 + m * 16 + fr) * 4 + wc] = s;
        EPI_END
        asm volatile("s_waitcnt lgkmcnt(0)" ::: "memory"); __builtin_amdgcn_s_barrier(); asm volatile("" ::: "memory");
        const int rloc = wid * 32 + (lane & 31);
        if (lane < 32 && rloc < 192) { const float tot = (Pt[rloc * 4 + 0] + Pt[rloc * 4 + 1]) + (Pt[rloc * 4 + 2] + Pt[rloc * 4 + 3]);
            __hip_atomic_store(xbuf + ((size_t)(u.pm * 192 + rloc) * 4 + u.pn), tot, __ATOMIC_RELAXED, __HIP_MEMORY_SCOPE_AGENT); }
        asm volatile("s_waitcnt vmcnt(0)" ::: "memory");
        if (lane == 0) __hip_atomic_fetch_add(cnt + 16 * u.pm, 1u, __ATOMIC_RELAXED, __HIP_MEMORY_SCOPE_AGENT);
        if (wid == 0) { unsigned sp = 0;
            while ((unsigned)__builtin_amdgcn_readfirstlane(__hip_atomic_load(cnt + 16 * u.pm, __ATOMIC_RELAXED, __HIP_MEMORY_SCOPE_AGENT)) < 32u) { __builtin_amdgcn_s_sleep(2); if (++sp > (1u << 22)) break; }
            __builtin_amdgcn_fence(__ATOMIC_ACQUIRE, "agent"); }
        asm volatile("s_waitcnt vmcnt(0) lgkmcnt(0)" ::: "memory"); __builtin_amdgcn_s_barrier(); asm volatile("" ::: "memory");
        if (lane < 32 && rloc < 192) { const float* sl = xbuf + (size_t)(u.pm * 192 + rloc) * 4; float tot = 0.f;
#pragma unroll
            for (int t = 0; t < 4; ++t) tot += __hip_atomic_load(sl + t, __ATOMIC_RELAXED, __HIP_MEMORY_SCOPE_AGENT);
            St[rloc] = rsqrtf(tot * (1.f / 1024.f) + EPS); }
        asm volatile("s_waitcnt lgkmcnt(0)" ::: "memory"); __builtin_amdgcn_s_barrier(); asm volatile("" ::: "memory");
        EPI_ROWS_M(u.pm, 3)
            const float rs = St[ai * 96 + wr * 48 + m * 16 + fr]; float* xr = x + (size_t)row * 1024 + u.pn * 256; const float* gf = gfin + u.pn * 256;
#pragma unroll
            for (int bj = 0; bj < 2; ++bj) { const int col = bj * 128 + wc * 32 + fq * 8;
                *(f32x4*)(xr + col) = acc[ai][bj][m][0] * rs * *(const f32x4*)(gf + col); *(f32x4*)(xr + col + 4) = acc[ai][bj][m][1] * rs * *(const f32x4*)(gf + col + 4); }
        EPI_END
    }
};

struct Gemm2Order {
    int G, c;
    __device__ void init(int G_, int c_) { G = G_; c = c_; }
    __device__ bool next(int i, pg8::Unit& u) const {
        const int L = i * G + c; if (L >= 608) return false;
        if (L < 416) { u.pm = 48 + L % 52; u.pn = 6 + L / 52; } else { const int l = L - 416; u.pm = l % 48; u.pn = l / 48; }
        return true;
    }
    __device__ __forceinline__ void a_ready(const pg8::Unit&) const {}
    __device__ __forceinline__ void done(const pg8::Unit&) const {}
};
struct EpiG2 {
    static constexpr bool PERM = true, AFTER_DRAIN = false;
    bf16_t *qn, *kv; const float *ssq_cq, *ssq_ckv;
    __device__ __forceinline__ void operator()(AccRef acc, const pg8::Unit& u, int wr, int wc, int fr, int fq) const {
        if (u.pn >= 6) {
            const int pm = u.pm - 48, pn = u.pn - 6;
            EPI_ROWS(pm)
                const f32x4 sq = *(const f32x4*)(ssq_ckv + (size_t)row * 4); const float rs = rsqrtf(((sq.x + sq.y) + (sq.z + sq.w)) * (1.f / 256.f) + EPS);
                bf16_t* dst = kv + (size_t)row * 2048 + pn * 256;
                EPI_COLS8 st_bf8(dst + col, v0 * rs, v1 * rs); EPI_END
            EPI_END
        } else {
            EPI_ROWS(u.pm)
                const f32x4 sq = *(const f32x4*)(ssq_cq + (size_t)row * 4); const float rs = rsqrtf(((sq.x + sq.y) + (sq.z + sq.w)) * (1.f / 256.f) + EPS);
                bf16_t* dst = qn + (size_t)row * 1024 + u.pn * 256;
                EPI_COLS8 st_bf8(dst + col, v0 * rs, v1 * rs); EPI_END
            EPI_END
        }
    }
};
static_assert(WS_CKVA - WS_CQ == (size_t)48 * 256 * 256 * 2 && WS_WUKV - WS_WUQ == (size_t)6 * 256 * 256 * 2, "GEMM2 addressing");

struct PairOrder {
    int nwg, G, c;
    __device__ void init(int G_, int c_) { nwg = 256; G = G_; c = c_; }
    __device__ bool next(int i, pg8::Unit& u) const {
        const int k = i >> 1; const long L = (long)k * G + c; if (L >= nwg) return false;
        int wgid = (int)L; { const int q = nwg / 8, xcd = wgid % 8, off = wgid / 8; wgid = xcd * q + off; }
        const int nig = 8 * 4, gid = wgid / nig, fm = gid * 8; const int pm = fm + ((wgid % nig) % 8), pn = (wgid % nig) / 8;
        if ((i & 1) == 0) { u.pm = pm + 160; u.pn = pn; } else { u.pm = pm; u.pn = pn + 4; }
        return true;
    }
    __device__ __forceinline__ void a_ready(const pg8::Unit&) const {}
    __device__ __forceinline__ void done(const pg8::Unit&) const {}
};
struct EpiMerged {
    static constexpr bool PERM = true, AFTER_DRAIN = false;
    struct State { u32x4 t[2][3][2]; };
    const bf16_t *sgm, *sgs; const float* ssq_y; bf16_t* merged;
    __device__ __forceinline__ void operator()(const f32x4 (&acc)[2][2][3][2], const pg8::Unit& u, int wr, int wc, int fr, int fq, State& st) const {
        if (u.pn < 4) {
            const int pm = u.pm - 160;
            EPI_ROWS_M(pm, 3)
                const size_t off = (size_t)row * 1024 + u.pn * 256;
                EPI_COLS8 const u32x4 gw = __builtin_nontemporal_load((const u32x4*)(sgm + off + col));
                    const f32x4 a = (f32x4){bflo(gw.x), bfhi(gw.x), bflo(gw.y), bfhi(gw.y)} * v0, b = (f32x4){bflo(gw.z), bfhi(gw.z), bflo(gw.w), bfhi(gw.w)} * v1;
                    st.t[ai][m][bj] = (u32x4){pk2(a.x, a.y), pk2(a.z, a.w), pk2(b.x, b.y), pk2(b.z, b.w)}; EPI_END
            EPI_END
        } else {
            const int pn = u.pn - 4;
            EPI_ROWS_M(u.pm, 3)
                float s = 0.f;
#pragma unroll
                for (int q = 0; q < 4; ++q) { const f32x4 a = *(const f32x4*)(ssq_y + (size_t)row * 16 + q * 4); s += (a.x + a.y) + (a.z + a.w); }
                const float rs = rsqrtf(s * (1.f / 1024.f) + EPS); const size_t off = (size_t)row * 1024 + pn * 256;
                EPI_COLS8 const u32x4 gw = __builtin_nontemporal_load((const u32x4*)(sgs + off + col)); const u32x4 tw = st.t[ai][m][bj];
                    st_bf8(merged + off + col, (f32x4){bflo(tw.x), bfhi(tw.x), bflo(tw.y), bfhi(tw.y)} + (f32x4){bflo(gw.x), bfhi(gw.x), bflo(gw.y), bfhi(gw.y)} * (v0 * rs),
                           (f32x4){bflo(tw.z), bfhi(tw.z), bflo(tw.w), bfhi(tw.w)} + (f32x4){bflo(gw.z), bfhi(gw.z), bflo(gw.w), bfhi(gw.w)} * (v1 * rs)); EPI_END
            EPI_END
        }
    }
};
static_assert(WS_QN - WS_Z == (size_t)160 * 192 * 1024 * 2 && WS_WOSSD - WS_WOMLA == (size_t)4 * 256 * 1024 * 2, "GEMM3 pair addressing");

template <class Epi>
__device__ __forceinline__ void run_gemm(LAS unsigned char* lds, const bf16_t* A, const bf16_t* Bt, int M, int N, int K, int G, int c, const Epi& E) {
    pg8::Gemm g{A, Bt, M, N, K}; pg8::StaticOrder S; S.init(M, N, G, c);
    pg8::gemm_phase<Epi, pg8::StaticOrder, PG8_ALIGN, PG8_SP2>(lds, g, S, E);
}
template <class Epi>
__device__ __forceinline__ void run_gemm192(LAS unsigned char* lds, const bf16_t* A, const bf16_t* Bt, int M, int N, int K, int G, int c, const Epi& E) {
    pg8::Gemm g{A, Bt, M, N, K}; pg8::StaticOrder S; S.init(M, N, G, c, 192);
    pg8::gemm_phase<Epi, pg8::StaticOrder, PG8_ALIGN, PG8_SP2, 3>(lds, g, S, E);
}

__device__ __forceinline__ void norm_new_ckv(const Params& P, int lane, int wave, int G) {
    const int gw = blockIdx.x * 8 + wave, NGW = G * 8;
    float* nck = P.out + O_CKV; const float* ssq = (const float*)(P.ws + WS_SSQ_CKV); const float* gk = P.in[I_GKV];
    for (int row = gw; row < RP; row += NGW) {
        const f32x4 sq = *(const f32x4*)(ssq + (size_t)row * 4); const float rs = rsqrtf(((sq.x + sq.y) + (sq.z + sq.w)) * (1.f / 256.f) + EPS);
        f32x4* p = (f32x4*)(nck + (size_t)row * 256) + lane; *p = *p * rs * *(const f32x4*)(gk + 4 * lane);
    }
}
namespace att {
using s16x4 = __attribute__((ext_vector_type(4))) short;
using f32x16 = __attribute__((ext_vector_type(16))) float;
constexpr int QBLK = 32, KVBLK = 64;
constexpr float SCALE = ATT_SCALE, THR = 8.f;
constexpr int SHM_V = 16384, SHM_K = 16384, SHM_KR = 8192;
constexpr int L_V = 0, L_K = 2 * SHM_V, L_KR = L_K + 2 * SHM_K, L_WS = L_KR + 2 * SHM_KR, L_QR = L_WS + 8 * 64 * 4, L_END = L_QR + 8 * 4096;
#define KSWZ(row, colB) ((row) * 256 + ((colB) ^ (((row) & 7) << 4)))
#define KRSWZ(row, colB) ((row) * 128 + ((colB) ^ ((((row) >> 1) & 7) << 4)))
#define SBAR() __builtin_amdgcn_sched_barrier(0)
__device__ __forceinline__ int crow(int r, int hi) { return (r & 3) + 8 * (r >> 2) + 4 * hi; }
__device__ __forceinline__ unsigned cvtpk(float lo, float hi) { unsigned r; asm volatile("v_cvt_pk_bf16_f32 %0, %1, %2" : "=v"(r) : "v"(lo), "v"(hi)); return r; }
__device__ __forceinline__ void partialSM(f32x16& p0, f32x16& p1, float& m_reg, float& mn, float& alpha) {
  constexpr float C = SCALE * 1.4426950408889634f;
  float pmax = p0[0];
#pragma unroll
  for (int r = 1; r < 16; ++r) pmax = fmaxf(pmax, p0[r]);
#pragma unroll
  for (int r = 0; r < 16; ++r) pmax = fmaxf(pmax, p1[r]);
  { auto rr = __builtin_amdgcn_permlane32_swap(__float_as_uint(pmax), __float_as_uint(pmax), false, false);
    pmax = fmaxf(__uint_as_float(rr[0]), __uint_as_float(rr[1])); }
  if (__builtin_expect(__all(pmax - m_reg <= THR / SCALE), 1)) { mn = m_reg; alpha = 1.f; }
  else { mn = fmaxf(m_reg, pmax); alpha = __builtin_amdgcn_exp2f((m_reg - mn) * C); m_reg = mn; }
  float mnC = -mn * C;
#pragma unroll
  for (int r = 0; r < 16; ++r) p0[r] = fmaf(p0[r], C, mnC);
#pragma unroll
  for (int r = 0; r < 16; ++r) p1[r] = fmaf(p1[r], C, mnC);
#pragma unroll
  for (int r = 0; r < 16; ++r) p0[r] = __builtin_amdgcn_exp2f(p0[r]);
}
__device__ __forceinline__ void finishSM(f32x16& p0, f32x16& p1, float alpha, float& l_reg, bf16x8& pa0, bf16x8& pa1, bf16x8& pa2, bf16x8& pa3) {
#pragma unroll
  for (int r = 0; r < 16; ++r) p1[r] = __builtin_amdgcn_exp2f(p1[r]);
  float ps = 0;
#pragma unroll
  for (int r = 0; r < 16; ++r) ps += p0[r];
#pragma unroll
  for (int r = 0; r < 16; ++r) ps += p1[r];
  { auto rr = __builtin_amdgcn_permlane32_swap(__float_as_uint(ps), __float_as_uint(ps), false, false);
    ps = __uint_as_float(rr[0]) + __uint_as_float(rr[1]); }
  l_reg = l_reg * alpha + ps;
#define PK4(P, BASE, OUT) do { unsigned a0 = cvtpk(P[BASE + 0], P[BASE + 1]), a1 = cvtpk(P[BASE + 2], P[BASE + 3]);   \
    unsigned b0 = cvtpk(P[BASE + 4], P[BASE + 5]), b1 = cvtpk(P[BASE + 6], P[BASE + 7]);                              \
    auto r0 = __builtin_amdgcn_permlane32_swap(a0, b0, false, false); auto r1 = __builtin_amdgcn_permlane32_swap(a1, b1, false, false); \
    u32x4 w = {r0[0], r1[0], r0[1], r1[1]}; OUT = *reinterpret_cast<bf16x8*>(&w); } while (0)
  PK4(p0, 0, pa0); PK4(p0, 8, pa1); PK4(p1, 0, pa2); PK4(p1, 8, pa3);
#undef PK4
}
__device__ __forceinline__ void qkt(f32x16& p0, f32x16& p1, const LAS char* Ks, const LAS char* Krs, const bf16x8* qr, const LAS char* qrl, int r32, int hi) {
  p0 = f32x16{}; p1 = f32x16{};
#pragma unroll
  for (int d0 = 0; d0 < 8; ++d0) { const int cb = (d0 * 16 + hi * 8) * 2;
    const bf16x8 b0 = *reinterpret_cast<const LAS bf16x8*>(Ks + KSWZ(r32, cb));
    const bf16x8 b1 = *reinterpret_cast<const LAS bf16x8*>(Ks + KSWZ(32 + r32, cb));
    p0 = __builtin_amdgcn_mfma_f32_32x32x16_bf16(b0, qr[d0], p0, 0, 0, 0);
    p1 = __builtin_amdgcn_mfma_f32_32x32x16_bf16(b1, qr[d0], p1, 0, 0, 0); }
#pragma unroll
  for (int d0 = 0; d0 < 4; ++d0) { const int cb = (d0 * 16 + hi * 8) * 2;
    const bf16x8 b0 = *reinterpret_cast<const LAS bf16x8*>(Krs + KRSWZ(r32, cb));
    const bf16x8 b1 = *reinterpret_cast<const LAS bf16x8*>(Krs + KRSWZ(32 + r32, cb));
    const bf16x8 qq = *reinterpret_cast<const LAS bf16x8*>(qrl + d0 * 1024);
    p0 = __builtin_amdgcn_mfma_f32_32x32x16_bf16(b0, qq, p0, 0, 0, 0);
    p1 = __builtin_amdgcn_mfma_f32_32x32x16_bf16(b1, qq, p1, 0, 0, 0); }
}
__device__ __forceinline__ int v_st(int k, int c) { const int kk = (k & ~0xC) | ((k & 4) << 1) | ((k & 8) >> 1); return ((kk >> 3) * 4 + (c >> 5)) * 512 + ((kk & 7) * 32 + (c & 31)) * 2; }
__device__ __forceinline__ int v_rd_base(int lane) { return ((lane & 3) << 3) | (((lane >> 2) & 3) << 6) | (((lane >> 4) & 1) << 5) | (((lane >> 5) & 1) << 8); }
constexpr int v_rd_off(int d0, int ks, int half) { return d0 * 512 + ks * 4096 + half * 2048; }
template <int OFF> __device__ __forceinline__ s16x4 tr_read(int vb) {
  s16x4 r; asm volatile("ds_read_b64_tr_b16 %0, %1 offset:%2" : "=&v"(r) : "v"(vb), "i"(OFF) : "memory"); return r;
}
template <int D0> __device__ __forceinline__ void pv_one(f32x16& od, int vb, bf16x8 pa0, bf16x8 pa1, bf16x8 pa2, bf16x8 pa3) {
  const s16x4 l0 = tr_read<v_rd_off(D0, 0, 0)>(vb), h0 = tr_read<v_rd_off(D0, 0, 1)>(vb), l1 = tr_read<v_rd_off(D0, 1, 0)>(vb), h1 = tr_read<v_rd_off(D0, 1, 1)>(vb);
  const s16x4 l2 = tr_read<v_rd_off(D0, 2, 0)>(vb), h2 = tr_read<v_rd_off(D0, 2, 1)>(vb), l3 = tr_read<v_rd_off(D0, 3, 0)>(vb), h3 = tr_read<v_rd_off(D0, 3, 1)>(vb);
  asm volatile("s_waitcnt lgkmcnt(0)" ::: "memory"); SBAR();
#define PK(L, H) (bf16x8){L[0], L[1], L[2], L[3], H[0], H[1], H[2], H[3]}
  od = __builtin_amdgcn_mfma_f32_32x32x16_bf16(pa0, PK(l0, h0), od, 0, 0, 0);
  od = __builtin_amdgcn_mfma_f32_32x32x16_bf16(pa1, PK(l1, h1), od, 0, 0, 0);
  od = __builtin_amdgcn_mfma_f32_32x32x16_bf16(pa2, PK(l2, h2), od, 0, 0, 0);
  od = __builtin_amdgcn_mfma_f32_32x32x16_bf16(pa3, PK(l3, h3), od, 0, 0, 0);
#undef PK
}
__device__ __forceinline__ void pv_d0(f32x16* o, int vb, bf16x8 pa0, bf16x8 pa1, bf16x8 pa2, bf16x8 pa3) {
  pv_one<0>(o[0], vb, pa0, pa1, pa2, pa3); pv_one<1>(o[1], vb, pa0, pa1, pa2, pa3); pv_one<2>(o[2], vb, pa0, pa1, pa2, pa3); pv_one<3>(o[3], vb, pa0, pa1, pa2, pa3);
}
__device__ __forceinline__ void attn_unit(const bf16_t* __restrict__ Qn, const bf16_t* __restrict__ Qr, const bf16_t* __restrict__ Kh, const bf16_t* __restrict__ Vh,
                                          const bf16_t* __restrict__ Krh, bf16_t* Ob, int seq, LAS char* lds, int tid) {
  constexpr int LDQ = 1024, LDQR = 512, LDK = 2048, LDKR = 64, LDO = 1024;
  const int wid = tid >> 6, lane = tid & 63, r32 = lane & 31, hi = lane >> 5;
  LAS char* V_lds = lds + L_V; LAS char* K_lds = lds + L_K; LAS char* KR_lds = lds + L_KR;
  LAS float* wsf = (LAS float*)(lds + L_WS) + wid * 64; LAS float* li_l = wsf; LAS float* al_l = wsf + 32;
  float m_reg = -1e30f, l_reg = 0; f32x16 o[4] = {}; bf16x8 qr[8];
  LAS char* qrl = lds + L_QR + wid * 4096 + lane * 16;
  { const unsigned qo = (unsigned)((wid * QBLK + r32) * LDQ + hi * 8);
#pragma unroll
    for (int d0 = 0; d0 < 8; ++d0) qr[d0] = *reinterpret_cast<const bf16x8*>(Qn + (qo + d0 * 16));
    const unsigned qo2 = (unsigned)((wid * QBLK + r32) * LDQR + hi * 8);
#pragma unroll
    for (int d0 = 0; d0 < 4; ++d0) *reinterpret_cast<LAS bf16x8*>(qrl + d0 * 1024) = *reinterpret_cast<const bf16x8*>(Qr + (qo2 + d0 * 16)); }
  const int sr = tid >> 4, sc = (tid & 15) * 8, vst0 = v_st(sr, sc), vst1 = v_st(32 + sr, sc);
  const int rr_ = tid >> 3, rc_ = (tid & 7) * 8, krst = KRSWZ(rr_, rc_ * 2);
  const int vb0 = (int)(unsigned)(uintptr_t)V_lds + v_rd_base(lane);
  constexpr int SDEPTH = 1;
  struct { bf16x8 vs0, vs1, ks0, ks1, kr; } sr_[SDEPTH];
  const unsigned kvo = (unsigned)(sr * LDK + sc), kro = (unsigned)(rr_ * LDKR + rc_);
#define SLOAD(i, k0) do { const bf16_t* vp_ = Vh + (size_t)(k0) * LDK; const bf16_t* kp_ = Kh + (size_t)(k0) * LDK; const bf16_t* rp_ = Krh + (size_t)(k0) * LDKR; \
    sr_[i].vs0 = *reinterpret_cast<const bf16x8*>(vp_ + kvo); sr_[i].vs1 = *reinterpret_cast<const bf16x8*>(vp_ + (kvo + 32u * LDK)); \
    sr_[i].ks0 = *reinterpret_cast<const bf16x8*>(kp_ + kvo); sr_[i].ks1 = *reinterpret_cast<const bf16x8*>(kp_ + (kvo + 32u * LDK)); \
    sr_[i].kr = *reinterpret_cast<const bf16x8*>(rp_ + kro); } while (0)
#define SWRITE(b, i) do { *(LAS bf16x8*)(V_lds + (b) * SHM_V + vst0) = sr_[i].vs0; *(LAS bf16x8*)(V_lds + (b) * SHM_V + vst1) = sr_[i].vs1; const int kc = sc * 2; \
    *(LAS bf16x8*)(K_lds + (b) * SHM_K + KSWZ(sr, kc)) = sr_[i].ks0; *(LAS bf16x8*)(K_lds + (b) * SHM_K + KSWZ(32 + sr, kc)) = sr_[i].ks1; \
    *(LAS bf16x8*)(KR_lds + (b) * SHM_KR + krst) = sr_[i].kr; } while (0)
#define SWAIT() do { if constexpr (SDEPTH == 2) asm volatile("s_waitcnt vmcnt(5)" ::: "memory"); else asm volatile("s_waitcnt vmcnt(0)" ::: "memory"); } while (0)
#define RESC(a) do { if (__any((a) < 1.f)) { if (hi == 0) al_l[r32] = (a); asm volatile("s_waitcnt lgkmcnt(0)" ::: "memory"); \
    _Pragma("unroll") for (int d = 0; d < 4; ++d) _Pragma("unroll") for (int r = 0; r < 16; ++r) o[d][r] *= al_l[crow(r, hi)]; } } while (0)
  f32x16 pA0, pA1, pB0, pB1; float mnA, mnB, alA, alB; bf16x8 pa0, pa1, pa2, pa3; const int NTL = seq / KVBLK;
  constexpr int SE = 0, SO = SDEPTH - 1;
  SLOAD(SE, 0); asm volatile("s_waitcnt vmcnt(0)" ::: "memory"); SWRITE(0, SE); __syncthreads();
  qkt(pA0, pA1, K_lds, KR_lds, qr, qrl, r32, hi); partialSM(pA0, pA1, m_reg, mnA, alA);
  SLOAD(SO, KVBLK); if constexpr (SDEPTH == 2) { if (2 < NTL) SLOAD(SE, 2 * KVBLK); }
  SWAIT(); SWRITE(1, SO); __syncthreads();
  for (int j = 1; j + 1 < NTL; j += 2) {
    SBAR(); qkt(pB0, pB1, K_lds + SHM_K, KR_lds + SHM_KR, qr, qrl, r32, hi);
    finishSM(pA0, pA1, alA, l_reg, pa0, pa1, pa2, pa3); SBAR();
    SLOAD(SO, (j + SDEPTH) * KVBLK); SBAR();
    pv_d0(o, vb0, pa0, pa1, pa2, pa3); partialSM(pB0, pB1, m_reg, mnB, alB);
    __syncthreads(); SWAIT(); SWRITE(0, SE);
    RESC(alB); __syncthreads();
    SBAR(); qkt(pA0, pA1, K_lds, KR_lds, qr, qrl, r32, hi);
    finishSM(pB0, pB1, alB, l_reg, pa0, pa1, pa2, pa3); SBAR();
    if (SDEPTH == 1 || j + 3 < NTL) SLOAD(SE, (j + 1 + SDEPTH) * KVBLK); SBAR();
    pv_d0(o, vb0 + SHM_V, pa0, pa1, pa2, pa3); partialSM(pA0, pA1, m_reg, mnA, alA);
    __syncthreads(); SWAIT(); SWRITE(1, SO);
    RESC(alA); __syncthreads();
  }
  SBAR(); qkt(pB0, pB1, K_lds + SHM_K, KR_lds + SHM_KR, qr, qrl, r32, hi);
  finishSM(pA0, pA1, alA, l_reg, pa0, pa1, pa2, pa3); SBAR();
  pv_d0(o, vb0, pa0, pa1, pa2, pa3); partialSM(pB0, pB1, m_reg, mnB, alB);
  __syncthreads(); RESC(alB);
  finishSM(pB0, pB1, alB, l_reg, pa0, pa1, pa2, pa3); SBAR();
  pv_d0(o, vb0 + SHM_V, pa0, pa1, pa2, pa3);
  if (hi == 0) li_l[r32] = l_reg; asm volatile("s_waitcnt lgkmcnt(0)" ::: "memory");
  float rli[16];
#pragma unroll
  for (int r = 0; r < 16; ++r) rli[r] = __builtin_amdgcn_rcpf(li_l[crow(r, hi)]);
#pragma unroll
  for (int r = 0; r < 16; ++r) { const unsigned oo = (unsigned)((wid * QBLK + crow(r, hi)) * LDO + r32);
#pragma unroll
    for (int d0 = 0; d0 < 4; ++d0) Ob[oo + d0 * 32] = (bf16_t)f2bf(o[d0][r] * rli[r]); }
  __syncthreads();
#undef SLOAD
#undef SWRITE
#undef SWAIT
#undef RESC
}
}

namespace ssd {
typedef short v4i16_t __attribute__((ext_vector_type(4)));
constexpr int RSB = 144;
constexpr int TB = 128 * RSB;
constexpr int L_X = 0, L_B = TB, L_C = 2 * TB, L_HF = 3 * TB, L_HB = 3 * TB + 64 * RSB, L_ARR = 3 * TB + 128 * RSB, L_SC = L_ARR + 2048, L_END = L_SC + 64;
struct UnitInfo { int b, c, h, nc, row0; bool smp; };
__device__ __forceinline__ UnitInfo decode(int u) { UnitInfo I; if (u < 512) { I.smp = true; I.b = u >> 8; I.c = (u >> 4) & 15; I.h = u & 15; I.nc = 16; I.row0 = RP + I.b * SEQS + I.c * 128; }
    else { const int q = u - 512; I.smp = false; I.b = q >> 5; I.c = (q >> 4) & 1; I.h = q & 15; I.nc = 2; I.row0 = I.b * SEQP + I.c * 128; } return I; }
__device__ __forceinline__ int unit_id(bool smp, int b, int c, int h) { return smp ? ((b * 16 + c) * 16 + h) : 512 + ((b * 2 + c) * 16 + h); }
__device__ __forceinline__ bf16x8 tr2(const LAS char* p0, const LAS char* p1) {
    const v4i16_t a = __builtin_amdgcn_ds_read_tr16_b64_v4i16((LAS v4i16_t*)p0), b = __builtin_amdgcn_ds_read_tr16_b64_v4i16((LAS v4i16_t*)p1);
    return (bf16x8){a[0], a[1], a[2], a[3], b[0], b[1], b[2], b[3]};
}
__device__ __forceinline__ float wave_incl_scan(float v, int lane) {
#pragma unroll
    for (int o = 1; o < 64; o <<= 1) { const float t = __shfl_up(v, o); if (lane >= o) v += t; }
    return v;
}
__device__ __forceinline__ void chunk_scalars(const float* dt, int row0, int h, float Af, float Ab, LAS f32x4* arr, LAS float* sc, int lane) {
    const float df0 = dt[(size_t)(row0 + lane) * 32 + h], df1 = dt[(size_t)(row0 + 64 + lane) * 32 + h];
    const float db0 = dt[(size_t)(row0 + lane) * 32 + 16 + h], db1 = dt[(size_t)(row0 + 64 + lane) * 32 + 16 + h];
    const float af0 = df0 * Af, af1 = df1 * Af, ab0 = db0 * Ab, ab1 = db1 * Ab;
    const float s0 = wave_incl_scan(af0, lane), t0 = __shfl(s0, 63), s1 = wave_incl_scan(af1, lane) + t0;
    const float r0 = wave_incl_scan(ab0, lane), u0 = __shfl(r0, 63), r1 = wave_incl_scan(ab1, lane) + u0, tot = __shfl(r1, 63);
    arr[lane] = (f32x4){s0, tot - (r0 - ab0), df0, db0};
    arr[64 + lane] = (f32x4){s1, tot - (r1 - ab1), df1, db1};
    if (lane == 63) { sc[0] = s1; sc[1] = tot; }
}
constexpr int G_B = 0, G_C = TB, G_X = 2 * TB, G_ARR = 6 * TB, G_SC = G_ARR + 4 * 2048, G_END = G_SC + 64;
struct GInfo { int b, c, g, nc, row0; bool smp; };
__device__ __forceinline__ GInfo gdecode(int gu) { GInfo I; if (gu < 128) { I.smp = true; I.b = gu >> 6; I.c = (gu >> 2) & 15; I.g = gu & 3; I.nc = 16; I.row0 = RP + I.b * SEQS + I.c * 128; }
    else { const int q = gu - 128; I.smp = false; I.b = q >> 3; I.c = (q >> 2) & 1; I.g = q & 3; I.nc = 2; I.row0 = I.b * SEQP + I.c * 128; } return I; }
template <bool WITH_C>
__device__ __forceinline__ void stage_group(const Params& P, const GInfo& I, LAS char* lds, int tid) {
    const bf16_t* xbc = (const bf16_t*)(P.ws + WS_XBC); const int lane = tid & 63, wave = tid >> 6;
    if (wave >= 6) {
        const float* dt = (const float*)(P.ws + WS_DT);
#pragma unroll 1
        for (int q = 0; q < 2; ++q) { const int hl = 2 * (wave - 6) + q, h = 4 * I.g + hl;
            chunk_scalars(dt, I.row0, h, -__expf(P.in[I_ALOG][h]), -__expf(P.in[I_ALOG][16 + h]), (LAS f32x4*)(lds + G_ARR + hl * 2048), (LAS float*)(lds + G_SC + hl * 16), lane); }
        return;
    }
    if (!WITH_C && wave == 5) return;
    const int p8 = lane & 7, rs = lane >> 3;
    const int cbase = (wave == 0 ? 1024 + I.g * 64 : wave == 5 ? 1280 + I.g * 64 : (4 * I.g + wave - 1) * 64) + p8 * 8;
    const int lbase = (wave == 0 ? G_B : wave == 5 ? G_C : G_X + (wave - 1) * TB) + p8 * 16;
    const float* cw = P.in[I_CONVW]; const float* cb = P.in[I_CONVB];
    float w[3][8], bb[8];
#pragma unroll
    for (int q = 0; q < 2; ++q) { const f32x4 b4 = *(const f32x4*)(cb + cbase + 4 * q);
#pragma unroll
        for (int e = 0; e < 4; ++e) bb[4 * q + e] = b4[e];
#pragma unroll
        for (int k = 0; k < 3; ++k) { const f32x4 a = *(const f32x4*)(cw + k * 1536 + cbase + 4 * q);
#pragma unroll
            for (int e = 0; e < 4; ++e) w[k][4 * q + e] = a[e]; } }
    const int r0 = rs * 16; const bf16_t* xr = xbc + (size_t)(I.row0 + r0) * 1536 + cbase;
    const bool first = (I.c == 0 && rs == 0), last = (I.c == I.nc - 1 && rs == 7);
    const u32x4 zero = {0u, 0u, 0u, 0u};
    u32x4 rows[18];
    rows[0] = first ? zero : *(const u32x4*)(xr - 1536);
#pragma unroll
    for (int i = 0; i < 16; ++i) rows[1 + i] = *(const u32x4*)(xr + (size_t)i * 1536);
    rows[17] = last ? zero : *(const u32x4*)(xr + (size_t)16 * 1536);
#pragma unroll
    for (int i = 0; i < 16; ++i) {
        float a[8], x[8];
        unpack8(rows[i], x);
#pragma unroll
        for (int e = 0; e < 8; ++e) a[e] = bb[e] + x[e] * w[0][e];
        unpack8(rows[i + 1], x);
#pragma unroll
        for (int e = 0; e < 8; ++e) a[e] += x[e] * w[1][e];
        unpack8(rows[i + 2], x);
#pragma unroll
        for (int e = 0; e < 8; ++e) a[e] += x[e] * w[2][e];
        u32x4 o;
#pragma unroll
        for (int e = 0; e < 4; ++e) o[e] = pk2(siluf(a[2 * e]), siluf(a[2 * e + 1]));
        *(LAS u32x4*)(lds + lbase + (r0 + i) * RSB) = o;
    }
}
__device__ __forceinline__ void pass_a_group(const Params& P, int gu, LAS char* lds, int tid) {
    unsigned char* ws = P.ws;
    const int lane = tid & 63, wave = tid >> 6; const GInfo I = gdecode(gu);
    stage_group<false>(P, I, lds, tid);
    __syncthreads();
    { const int hl = wave >> 1, d = wave & 1, h = 4 * I.g + hl, gq = lane >> 4, q4 = (lane >> 2) & 3, p4 = lane & 3, li = lane & 15;
      const LAS f32x4* arr = (const LAS f32x4*)(lds + G_ARR + hl * 2048); const float tot = ((const LAS float*)(lds + G_SC + hl * 16))[d];
      const LAS char* xb = lds + G_X + hl * TB + (8 * gq + q4) * RSB + (4 * p4) * 2;
      const LAS char* bb = lds + G_B + (8 * gq + q4) * RSB + (4 * p4) * 2;
      f32x4 acc[4][4] = {};
#pragma unroll
      for (int s4 = 0; s4 < 4; ++s4) {
          float wj[8];
#pragma unroll
          for (int jj = 0; jj < 8; ++jj) { const f32x4 a = arr[32 * s4 + 8 * gq + jj]; wj[jj] = d ? a.w * __expf(tot - a.y) : a.z * __expf(tot - a.x); }
          bf16x8 bfr[4];
#pragma unroll
          for (int nt = 0; nt < 4; ++nt) bfr[nt] = tr2(bb + s4 * 32 * RSB + nt * 32, bb + s4 * 32 * RSB + 4 * RSB + nt * 32);
#pragma unroll
          for (int pt = 0; pt < 4; ++pt) { const bf16x8 xr_ = tr2(xb + s4 * 32 * RSB + pt * 32, xb + s4 * 32 * RSB + 4 * RSB + pt * 32);
              const u32x4 xw = *reinterpret_cast<const u32x4*>(&xr_); u32x4 sw;
#pragma unroll
              for (int e = 0; e < 4; ++e) sw[e] = pk2(bflo(xw[e]) * wj[2 * e], bfhi(xw[e]) * wj[2 * e + 1]);
              const bf16x8 xf = *reinterpret_cast<const bf16x8*>(&sw);
#pragma unroll
              for (int nt = 0; nt < 4; ++nt) acc[pt][nt] = __builtin_amdgcn_mfma_f32_16x16x32_bf16(bfr[nt], xf, acc[pt][nt], 0, 0, 0); } }
      const int u = unit_id(I.smp, I.b, I.c, h);
      bf16_t* So = (bf16_t*)(ws + WS_ST) + ((size_t)u * 2 + d) * 4096;
#pragma unroll
      for (int pt = 0; pt < 4; ++pt)
#pragma unroll
          for (int nt = 0; nt < 4; ++nt) st_bf4(So + (16 * pt + li) * 64 + nt * 16 + 4 * gq, acc[pt][nt]);
      if (lane == 0) ((float*)(ws + WS_DEC))[(size_t)u * 2 + d] = __expf(tot);
    }
    __syncthreads();
}
__device__ __forceinline__ bf16x8 ld_h_frag(const bf16_t* H, int p, int n) { return *(const bf16x8*)(H + p * 64 + n); }
__device__ __forceinline__ void pass_b_group(const Params& P, int gu, LAS char* lds, int tid) {
    unsigned char* ws = P.ws;
    const bf16_t* ST = (const bf16_t*)(ws + WS_ST);
    const int lane = tid & 63, wave = tid >> 6; const GInfo I = gdecode(gu);
    stage_group<true>(P, I, lds, tid);
    const int hl = wave >> 1, half = wave & 1, h = 4 * I.g + hl, li = lane & 15, gq = lane >> 4, q4 = (lane >> 2) & 3, p4 = lane & 3;
    const bf16_t *Hf, *Hb;
    if (I.smp) { const int u = unit_id(true, I.b, I.c, h); Hf = ST + ((size_t)u * 2) * 4096; Hb = ST + ((size_t)u * 2 + 1) * 4096; }
    else { const bf16_t* zp = (const bf16_t*)(ws + WS_ZERO); Hf = I.c == 1 ? ST + ((size_t)unit_id(false, I.b, 0, h) * 2) * 4096 : zp; Hb = I.c == 0 ? ST + ((size_t)unit_id(false, I.b, 1, h) * 2 + 1) * 4096 : zp; }
    __syncthreads();
    const LAS f32x4* arr = (const LAS f32x4*)(lds + G_ARR + hl * 2048); const LAS char* Xl = lds + G_X + hl * TB;
    const float Dh = P.in[I_SSDD][h];
#pragma unroll 1
    for (int st = 0; st < 4; st += 2) {
        int ii[2], tdiag[2]; bf16x8 cf[2][2]; f32x4 ai[2]; bf16_t* zrow[2]; u32x2 zw[2][4]; bf16x8 pf[2][4];
#pragma unroll
        for (int u = 0; u < 2; ++u) { ii[u] = 64 * half + 16 * (st + u) + li; tdiag[u] = __builtin_amdgcn_readfirstlane(4 * half + st + u);
#pragma unroll
            for (int ks = 0; ks < 2; ++ks) cf[u][ks] = *(const LAS bf16x8*)(lds + G_C + ii[u] * RSB + (8 * gq + 32 * ks) * 2);
            ai[u] = arr[ii[u]];
            zrow[u] = (bf16_t*)(ws + WS_Z) + (size_t)(I.row0 + ii[u]) * 1024 + h * 64;
#pragma unroll
            for (int pt = 0; pt < 4; ++pt) zw[u][pt] = *(const u32x2*)(zrow[u] + 16 * pt + 4 * gq); }
#pragma unroll
        for (int s4 = 0; s4 < 4; ++s4) {
            unsigned pk[2][4];
#pragma unroll
            for (int hf2 = 0; hf2 < 2; ++hf2) { const int t = 2 * s4 + hf2, jb = 16 * t + 4 * gq;
                f32x4 sacc[2] = {{0.f, 0.f, 0.f, 0.f}, {0.f, 0.f, 0.f, 0.f}};
#pragma unroll
                for (int ks = 0; ks < 2; ++ks) { const bf16x8 bfr = *(const LAS bf16x8*)(lds + G_B + (16 * t + li) * RSB + (8 * gq + 32 * ks) * 2);
                    sacc[0] = __builtin_amdgcn_mfma_f32_16x16x32_bf16(bfr, cf[0][ks], sacc[0], 0, 0, 0);
                    sacc[1] = __builtin_amdgcn_mfma_f32_16x16x32_bf16(bfr, cf[1][ks], sacc[1], 0, 0, 0); }
                f32x4 aj[4];
#pragma unroll
                for (int r = 0; r < 4; ++r) aj[r] = arr[jb + r];
#pragma unroll
                for (int u = 0; u < 2; ++u) {
                    float m[4];
                    if (t < tdiag[u]) {
#pragma unroll
                        for (int r = 0; r < 4; ++r) m[r] = sacc[u][r] * (__expf(ai[u].x - aj[r].x) * aj[r].z);
                    } else if (t > tdiag[u]) {
#pragma unroll
                        for (int r = 0; r < 4; ++r) m[r] = sacc[u][r] * (__expf(ai[u].y - aj[r].y) * aj[r].w);
                    } else {
#pragma unroll
                        for (int r = 0; r < 4; ++r) { const int j = jb + r;
                            const bool lower = j < ii[u]; const float arg = lower ? ai[u].x - aj[r].x : ai[u].y - aj[r].y; const float w = lower ? aj[r].z : aj[r].w;
                            float mm = __expf(arg) * w; if (j == ii[u]) mm = ai[u].z + ai[u].w; m[r] = sacc[u][r] * mm; }
                    }
                    pk[u][hf2 * 2 + 0] = pk2(m[0], m[1]); pk[u][hf2 * 2 + 1] = pk2(m[2], m[3]); } }
#pragma unroll
            for (int u = 0; u < 2; ++u) { const u32x4 w4 = {pk[u][0], pk[u][1], pk[u][2], pk[u][3]}; pf[u][s4] = *reinterpret_cast<const bf16x8*>(&w4); }
            __builtin_amdgcn_sched_barrier(0);
        }
        float ef[2], eb[2], ssq[2] = {0.f, 0.f};
#pragma unroll
        for (int u = 0; u < 2; ++u) { ef[u] = __expf(ai[u].x); eb[u] = __expf(ai[u].y); }
        bf16x8 hfc[2], hbc[2], hfn[2], hbn[2];
#pragma unroll
        for (int ks = 0; ks < 2; ++ks) { hfc[ks] = ld_h_frag(Hf, li, 8 * gq + 32 * ks); hbc[ks] = ld_h_frag(Hb, li, 8 * gq + 32 * ks); }
#pragma unroll
        for (int pt = 0; pt < 4; ++pt) {
            if (pt < 3) {
#pragma unroll
                for (int ks = 0; ks < 2; ++ks) { hfn[ks] = ld_h_frag(Hf, 16 * (pt + 1) + li, 8 * gq + 32 * ks); hbn[ks] = ld_h_frag(Hb, 16 * (pt + 1) + li, 8 * gq + 32 * ks); } }
            f32x4 yd[2] = {{0.f, 0.f, 0.f, 0.f}, {0.f, 0.f, 0.f, 0.f}}, yf[2] = {{0.f, 0.f, 0.f, 0.f}, {0.f, 0.f, 0.f, 0.f}}, yb[2] = {{0.f, 0.f, 0.f, 0.f}, {0.f, 0.f, 0.f, 0.f}};
#pragma unroll
            for (int s4 = 0; s4 < 4; ++s4) { const LAS char* xb = Xl + (32 * s4 + 4 * gq + q4) * RSB + (16 * pt + 4 * p4) * 2; const bf16x8 xf = tr2(xb, xb + 16 * RSB);
                yd[0] = __builtin_amdgcn_mfma_f32_16x16x32_bf16(xf, pf[0][s4], yd[0], 0, 0, 0);
                yd[1] = __builtin_amdgcn_mfma_f32_16x16x32_bf16(xf, pf[1][s4], yd[1], 0, 0, 0); }
#pragma unroll
            for (int ks = 0; ks < 2; ++ks)
#pragma unroll
                for (int u = 0; u < 2; ++u) { yf[u] = __builtin_amdgcn_mfma_f32_16x16x32_bf16(hfc[ks], cf[u][ks], yf[u], 0, 0, 0);
                    yb[u] = __builtin_amdgcn_mfma_f32_16x16x32_bf16(hbc[ks], cf[u][ks], yb[u], 0, 0, 0); }
            const int pc = 16 * pt + 4 * gq;
#pragma unroll
            for (int u = 0; u < 2; ++u) {
                const u32x2 xw = *(const LAS u32x2*)(Xl + ii[u] * RSB + pc * 2);
                const f32x4 xx = {bflo(xw.x), bfhi(xw.x), bflo(xw.y), bfhi(xw.y)};
                const f32x4 zz = {bflo(zw[u][pt].x), bfhi(zw[u][pt].x), bflo(zw[u][pt].y), bfhi(zw[u][pt].y)};
                f32x4 y = yd[u] + yf[u] * ef[u] + yb[u] * eb[u] + xx * Dh;
                y = y * (f32x4){siluf(zz.x), siluf(zz.y), siluf(zz.z), siluf(zz.w)};
                ssq[u] += (y.x * y.x + y.y * y.y) + (y.z * y.z + y.w * y.w);
                st_bf4(zrow[u] + pc, y); }
#pragma unroll
            for (int ks = 0; ks < 2; ++ks) { hfc[ks] = hfn[ks]; hbc[ks] = hbn[ks]; }
            __builtin_amdgcn_sched_barrier(0);
        }
#pragma unroll
        for (int u = 0; u < 2; ++u) { float sq = ssq[u]; sq += __shfl_xor(sq, 16); sq += __shfl_xor(sq, 32);
            if (gq == 0) ((float*)(ws + WS_SSQ_Y))[(size_t)(I.row0 + ii[u]) * 16 + h] = sq; }
    }
    __syncthreads();
}
}

__device__ __forceinline__ void cg_rowblock(const bf16_t* u, bf16_t* ug, const CgW& W, int rb, int c) {
    const int r0 = rb * CG_RB; const int t0 = r0 < RP ? (r0 & 255) : ((r0 - RP) & 2047), L = r0 < RP ? SEQP : SEQS;
    const u32x4 zero = {0u, 0u, 0u, 0u};
    u32x4 gp = zero, vp = zero, gc, vc, gn, vn;
    if (t0 > 0) { gp = *(const u32x4*)(u + (size_t)(r0 - 1) * UPN + c); vp = *(const u32x4*)(u + (size_t)(r0 - 1) * UPN + DFF + c); }
    gc = *(const u32x4*)(u + (size_t)r0 * UPN + c); vc = *(const u32x4*)(u + (size_t)r0 * UPN + DFF + c);
#pragma unroll 16
    for (int i = 0; i < CG_RB; ++i) {
        const int row = r0 + i;
        if (t0 + i + 1 < L) { gn = *(const u32x4*)(u + (size_t)(row + 1) * UPN + c); vn = *(const u32x4*)(u + (size_t)(row + 1) * UPN + DFF + c); } else { gn = zero; vn = zero; }
        float a[8], b[8], x[8];
#pragma unroll
        for (int e = 0; e < 8; ++e) { a[e] = W.bg[e]; b[e] = W.bv[e]; }
        unpack8(gp, x);
#pragma unroll
        for (int e = 0; e < 8; ++e) a[e] += x[e] * W.wg[0][e];
        unpack8(gc, x);
#pragma unroll
        for (int e = 0; e < 8; ++e) a[e] += x[e] * W.wg[1][e];
        unpack8(gn, x);
#pragma unroll
        for (int e = 0; e < 8; ++e) a[e] += x[e] * W.wg[2][e];
        unpack8(vp, x);
#pragma unroll
        for (int e = 0; e < 8; ++e) b[e] += x[e] * W.wv[0][e];
        unpack8(vc, x);
#pragma unroll
        for (int e = 0; e < 8; ++e) b[e] += x[e] * W.wv[1][e];
        unpack8(vn, x);
#pragma unroll
        for (int e = 0; e < 8; ++e) b[e] += x[e] * W.wv[2][e];
        u32x4 o;
#pragma unroll
        for (int e = 0; e < 4; ++e) o[e] = pk2(siluf(a[2 * e]) * b[2 * e], siluf(a[2 * e + 1]) * b[2 * e + 1]);
        *(u32x4*)(ug + (size_t)row * DFF + c) = o;
        gp = gc; vp = vc; gc = gn; vc = vn;
    }
}
__device__ __forceinline__ void cnt_arrive(unsigned* cnt) {
    asm volatile("s_waitcnt vmcnt(0)" ::: "memory");
    __syncthreads();
    if (threadIdx.x == 0) { __builtin_amdgcn_fence(__ATOMIC_RELEASE, "agent"); asm volatile("s_waitcnt vmcnt(0)" ::: "memory");
        __hip_atomic_fetch_add(cnt, 1u, __ATOMIC_RELAXED, __HIP_MEMORY_SCOPE_AGENT); }
}
__device__ __forceinline__ void cnt_wait(unsigned* cnt, unsigned target) {
    if (threadIdx.x == 0) { unsigned sp = 0;
        while (__hip_atomic_load(cnt, __ATOMIC_RELAXED, __HIP_MEMORY_SCOPE_AGENT) < target) { __builtin_amdgcn_s_sleep(4); if (++sp > (1u << 22)) break; }
        __builtin_amdgcn_fence(__ATOMIC_ACQUIRE, "agent"); asm volatile("s_waitcnt vmcnt(0)" ::: "memory"); }
    __syncthreads();
}
constexpr int CG_ROWS1 = 46 * 256, CG_SPLIT = CG_ROWS1 / CG_RB - 1, CG_ITEMS = R / CG_RB;
__device__ __forceinline__ void phase_convgate_queue(const Params& P, LAS unsigned char* lds, unsigned* c1, unsigned* c2, unsigned* q) {
    PHASE_IDS unsigned char* ws = P.ws; const bf16_t* u = (const bf16_t*)(ws + WS_U); bf16_t* ug = (bf16_t*)(ws + WS_UG);
    volatile LAS int* slot = (volatile LAS int*)(lds + 1024);
    const int c = tid * 8; const bool act = tid < DFF / 8;
    CgW W; if (act) cg_load_w(W, P.in[I_FCW], P.in[I_FCB], c);
    bool w1 = false, w2 = false;
    for (;;) {
        if (tid == 0) *slot = (int)__hip_atomic_fetch_add(q, 1u, __ATOMIC_RELAXED, __HIP_MEMORY_SCOPE_AGENT);
        __syncthreads();
        const int rb = *slot;
        __syncthreads();
        if (rb >= CG_ITEMS) break;
        if (!w1) { cnt_wait(c1, (unsigned)G); w1 = true; }
        if (rb >= CG_SPLIT && !w2) { cnt_wait(c2, (unsigned)G); w2 = true; }
        if (act) cg_rowblock(u, ug, W, rb, c);
    }
}
__device__ __forceinline__ void phase_final(const Params& P) {
    PHASE_IDS const int gw = blockIdx.x * 8 + wave, NGW = G * 8; const float* gf = P.in[I_GFIN];
    for (int row = gw; row < R; row += NGW) {
        f32x4* xr = (f32x4*)(P.out + (size_t)row * DM) + lane; f32x4 v[4]; float s = 0.f;
#pragma unroll
        for (int j = 0; j < 4; ++j) { v[j] = xr[64 * j]; s += (v[j].x * v[j].x + v[j].y * v[j].y) + (v[j].z * v[j].z + v[j].w * v[j].w); }
        const float rs = rsqrtf(wave_sum(s) * (1.f / DM) + EPS);
#pragma unroll
        for (int j = 0; j < 4; ++j) xr[64 * j] = v[j] * rs * *(const f32x4*)(gf + 4 * lane + 256 * j);
    }
}

constexpr int G_SLOT_OFF = 126 * 1024;
__device__ __forceinline__ void phase_ssd_a(const Params& P, LAS unsigned char* lds) {
    PHASE_IDS
    norm_new_ckv(P, lane, wave, G);
    unsigned* qa = (unsigned*)(P.ws + WS_CTL) + 8192 + 256; volatile LAS int* slot = (volatile LAS int*)(lds + G_SLOT_OFF);
    for (;;) {
        if (tid == 0) *slot = (int)__hip_atomic_fetch_add(qa, 1u, __ATOMIC_RELAXED, __HIP_MEMORY_SCOPE_AGENT);
        __syncthreads();
        const int gu = *slot;
        __syncthreads();
        if (gu >= 384) break;
        int t2 = tid; asm volatile("" : "+v"(t2)); ssd::pass_a_group(P, gu, (LAS char*)lds, t2);
    }
}
__device__ __forceinline__ void phase_ssd_scan(const Params& P) {
    PHASE_IDS unsigned char* ws = P.ws; bf16_t* ST = (bf16_t*)(ws + WS_ST); const float* DEC = (const float*)(ws + WS_DEC);
    const int gt = blockIdx.x * NT + tid, GT = G * NT;
    for (int it = gt; it < 64 * 512; it += GT) {
        const int chain = it >> 9, e = (it & 511) * 8, b = chain >> 5, h = (chain >> 1) & 15, d = chain & 1;
        float H[8];
        { const float* h0 = P.in[I_SSD] + (((size_t)b * 2 + d) * 16 + h) * 4096 + e; const f32x4 a = *(const f32x4*)h0, c4 = *(const f32x4*)(h0 + 4);
#pragma unroll
          for (int q = 0; q < 4; ++q) { H[q] = a[q]; H[4 + q] = c4[q]; } }
        u32x4 S[16]; float dc[16];
#pragma unroll
        for (int c = 0; c < 16; ++c) { const int u = ssd::unit_id(true, b, c, h); S[c] = *(const u32x4*)(ST + ((size_t)u * 2 + d) * 4096 + e); dc[c] = DEC[(size_t)u * 2 + d]; }
#define SCAN_STEP(c) { const int u = ssd::unit_id(true, b, (c), h); \
            *(u32x4*)(ST + ((size_t)u * 2 + d) * 4096 + e) = (u32x4){pk2(H[0], H[1]), pk2(H[2], H[3]), pk2(H[4], H[5]), pk2(H[6], H[7])}; \
            float sv[8]; unpack8(S[(c)], sv); _Pragma("unroll") for (int q = 0; q < 8; ++q) H[q] = H[q] * dc[(c)] + sv[q]; }
        if (d == 0) {
#pragma unroll
            for (int c = 0; c < 16; ++c) SCAN_STEP(c)
        } else {
#pragma unroll
            for (int c = 15; c >= 0; --c) SCAN_STEP(c)
        }
#undef SCAN_STEP
    }
    for (int it = gt; it < 1024 * 512; it += GT) {
        const int bhd = it >> 9, e = (it & 511) * 8, b = bhd >> 5, d = (bhd >> 4) & 1, h = bhd & 15;
        const int ufirst = ssd::unit_id(false, b, d ? 1 : 0, h), ulast = ssd::unit_id(false, b, d ? 0 : 1, h);
        float f[8], l[8]; unpack8(*(const u32x4*)(ST + ((size_t)ufirst * 2 + d) * 4096 + e), f); unpack8(*(const u32x4*)(ST + ((size_t)ulast * 2 + d) * 4096 + e), l);
        const float dl = DEC[(size_t)ulast * 2 + d]; float* o = P.out + O_SSD + (((size_t)b * 2 + d) * 16 + h) * 4096 + e;
        *(f32x4*)o = (f32x4){f[0] * dl + l[0], f[1] * dl + l[1], f[2] * dl + l[2], f[3] * dl + l[3]};
        *(f32x4*)(o + 4) = (f32x4){f[4] * dl + l[4], f[5] * dl + l[5], f[6] * dl + l[6], f[7] * dl + l[7]};
    }
}
template <int PART>
__device__ __forceinline__ void phase_mix(const Params& P, LAS unsigned char* lds) {
    PHASE_IDS unsigned char* ws = P.ws; bf16_t* qn = (bf16_t*)(ws + WS_QN); const bf16_t* qr = (const bf16_t*)(ws + WS_QR);
    const bf16_t* kv = (const bf16_t*)(ws + WS_KV); const bf16_t* kr = (const bf16_t*)(ws + WS_KROPE);
    const int nbA = G / 2, bx = blockIdx.x;
    if (bx < nbA) {
        if (PART != 2) for (int u = bx; u < 128; u += nbA) {
            const int x = u & 7, k = u >> 3, bh = x + 8 * (k >> 3), qb = k & 7, b = bh >> 3, h = bh & 7, row0 = RP + b * SEQS + qb * 256, kv0 = RP + b * KVS;
            int t2 = tid; asm volatile("" : "+v"(t2));
            att::attn_unit(qn + (size_t)row0 * 1024 + h * 128, qr + (size_t)row0 * 512 + h * 64, kv + (size_t)kv0 * 2048 + h * 256, kv + (size_t)kv0 * 2048 + h * 256 + 128,
                           kr + (size_t)kv0 * 64, qn + (size_t)row0 * 1024 + h * 128, KVS, (LAS char*)lds, t2);
        }
    } else {
        const int k0 = bx - nbA, nb2 = G - nbA;
        if (PART != 2) for (int q = k0; q < 256; q += nb2) {
            const int b = q >> 3, h = q & 7, row0 = b * SEQP;
            int t2 = tid; asm volatile("" : "+v"(t2));
            att::attn_unit(qn + (size_t)row0 * 1024 + h * 128, qr + (size_t)row0 * 512 + h * 64, kv + (size_t)row0 * 2048 + h * 256, kv + (size_t)row0 * 2048 + h * 256 + 128,
                           kr + (size_t)row0 * 64, qn + (size_t)row0 * 1024 + h * 128, SEQP, (LAS char*)lds, t2);
        }
        if (PART != 1) for (int gu = k0; gu < 384; gu += nb2) { int t2 = tid; asm volatile("" : "+v"(t2)); ssd::pass_b_group(P, gu, (LAS char*)lds, t2); }
    }
}
#define XB_TMO      128
#define XB_XCNT(j)  (256  + 64 * (j))
#define XB_XSUB(j)  (1280 + 64 * (j))
#define XB_XGEN(j)  (2304 + 64 * (j))
#define XB_TOP      3328
#define XB_TOPGEN   3392
#define XCD_BAR_WORDS 3456
#define XB_SPIN_CAP (1u << 18)

__device__ __forceinline__ unsigned xb_ld(unsigned* p)              { return __hip_atomic_load(p, __ATOMIC_RELAXED, __HIP_MEMORY_SCOPE_AGENT); }
__device__ __forceinline__ unsigned xb_add(unsigned* p, unsigned v) { return __hip_atomic_fetch_add(p, v, __ATOMIC_RELAXED, __HIP_MEMORY_SCOPE_AGENT); }
__device__ __forceinline__ unsigned xb_xcc_id() { return (unsigned)__builtin_amdgcn_s_getreg((3 << 11) | 20) & 0xFu; }
#define XB_SPIN(cond, bar) do { unsigned _sp = 0; while (cond) { __builtin_amdgcn_s_sleep(1); \
    if ((++_sp & 255u) == 0u) { if (xb_ld(&(bar)[XB_TMO])) break; if (_sp > XB_SPIN_CAP) { atomicAdd(&(bar)[XB_TMO], 1u); break; } } } } while (0)

struct XcdBarrier {
    unsigned* bar; unsigned x;
    volatile LAS unsigned* st;
};

__device__ __forceinline__ XcdBarrier xcd_barrier_post(unsigned* bar, volatile LAS unsigned* st) {
    XcdBarrier b; b.bar = bar; b.x = xb_xcc_id(); b.st = st;
    if (threadIdx.x == 0) (void)xb_add(&bar[XB_XCNT(b.x)], 1u);
    return b;
}
__device__ __forceinline__ void xcd_barrier_complete(unsigned* bar, unsigned x, unsigned& nloc, unsigned& nx) {
    const unsigned G = gridDim.x * gridDim.y * gridDim.z;
    unsigned sum, cnt, mine, sp = 0u;
    for (;;) {
        sum = 0u; cnt = 0u; mine = 0u;
#pragma unroll
        for (unsigned j = 0; j < 16; ++j) { const unsigned c = xb_ld(&bar[XB_XCNT(j)]); sum += c; cnt += (c > 0u) ? 1u : 0u; mine = (j == x) ? c : mine; }
        if (sum == G) break;
        __builtin_amdgcn_s_sleep(1);
        if ((++sp & 255u) == 0u) { if (xb_ld(&bar[XB_TMO])) break; if (sp > XB_SPIN_CAP) { atomicAdd(&bar[XB_TMO], 1u); break; } }
    }
    nloc = mine > 0u ? mine : 1u; nx = cnt > 0u ? cnt : 1u;
}

__device__ __forceinline__ void xcd_barrier(const XcdBarrier& b) {
    asm volatile("s_waitcnt vmcnt(0)" ::: "memory");
    __syncthreads();
    if (threadIdx.x == 0) {
        unsigned* bar = b.bar;
        __builtin_amdgcn_s_waitcnt(0);
        unsigned nloc = b.st[0], nx = b.st[1];
        if (nloc == 0u) { xcd_barrier_complete(bar, b.x, nloc, nx); b.st[0] = nloc; b.st[1] = nx; }
        const unsigned old = xb_add(&bar[XB_XSUB(b.x)], 1u);
        const unsigned gen = old / nloc;
        if (old + 1u == (gen + 1u) * nloc) {
            __builtin_amdgcn_fence(__ATOMIC_RELEASE, "agent");
            asm volatile("s_waitcnt vmcnt(0)" ::: "memory");
            const unsigned og = xb_add(&bar[XB_TOP], 1u);
            const unsigned tg = og / nx;
            if (og + 1u == (tg + 1u) * nx) xb_add(&bar[XB_TOPGEN], 1u);
            else XB_SPIN(xb_ld(&bar[XB_TOPGEN]) == tg, bar);
            __builtin_amdgcn_fence(__ATOMIC_ACQUIRE, "agent");
            xb_add(&bar[XB_XGEN(b.x)], 1u);
            asm volatile("s_waitcnt vmcnt(0)" ::: "memory");
        } else {
            XB_SPIN(xb_ld(&bar[XB_XGEN(b.x)]) == gen, bar);
            __builtin_amdgcn_fence(__ATOMIC_ACQUIRE, "agent");
            asm volatile("s_waitcnt vmcnt(0)" ::: "memory");
        }
    }
    __syncthreads();
}

__global__ void __launch_bounds__(NT, 2) mega_fwd(Params P) {
    extern __shared__ __attribute__((aligned(16))) unsigned char lds_raw[];
    LAS unsigned char* lds = (LAS unsigned char*)lds_raw;
    const int G = gridDim.x, bx = blockIdx.x;
    unsigned char* ws = P.ws;
    volatile LAS unsigned* misc = (volatile LAS unsigned*)(lds + 131072);
    if (threadIdx.x < 4) misc[threadIdx.x] = 0u;
    __syncthreads();
    const XcdBarrier xbar = xcd_barrier_post((unsigned*)(ws + WS_CTL) + 1024, misc);
#define GSYNC() xcd_barrier(xbar)
    unsigned long long pt0 = 0, pacc = 0; (void)pt0; (void)pacc;
#define PB(k) do { if ((PROBE_MASK >> (k)) & 1) pt0 = __builtin_amdgcn_s_memrealtime(); } while (0)
#define PE(k) do { if ((PROBE_MASK >> (k)) & 1) pacc += __builtin_amdgcn_s_memrealtime() - pt0; } while (0)

#ifdef PG8_TIME
    if (blockIdx.x == 0 && threadIdx.x == 0) { pg8::pg8_tacc[0] = 0; pg8::pg8_tacc[1] = 0; }
#endif
    PB(0); phase_p0(P, lds);
    GSYNC(); PE(0);
    PB(1); phase_p1(P, lds);
    GSYNC(); PE(1);
    PB(2);
    {
        EpiInMain E{(bf16_t*)(ws + WS_CQ), (bf16_t*)(ws + WS_CKVA), (bf16_t*)(ws + WS_Z), (bf16_t*)(ws + WS_XBC), (bf16_t*)P.out, (bf16_t*)P.out + (size_t)R * 1024,
                    (float*)(ws + WS_SSQ_CQ), (float*)(ws + WS_SSQ_CKV), P.out + O_CKV};
        run_gemm(lds, (const bf16_t*)(ws + WS_H), (const bf16_t*)(ws + WS_WIN), R, 5120, 1024, G, bx, E);
        EpiInTail ET{(bf16_t*)(ws + WS_KROPE), (float*)(ws + WS_DT), P.out + O_KR, P.in[I_DTB], (const f32x2*)(ws + WS_ROPE)};
        run_gemm(lds, (const bf16_t*)(ws + WS_H), (const bf16_t*)(ws + WS_WIN) + (size_t)5120 * 1024, R, 256, 1024, G, (bx + 64) % G, ET);
    }
    GSYNC(); PE(2);
    PB(4);
    {
        EpiG2 E{(bf16_t*)(ws + WS_QN), (bf16_t*)(ws + WS_KV), (const float*)(ws + WS_SSQ_CQ), (const float*)(ws + WS_SSQ_CKV)};
        pg8::Gemm g{(const bf16_t*)(ws + WS_CQ), (const bf16_t*)(ws + WS_WUQ), R + KVR, 3584, 256}; Gemm2Order S; S.init(G, bx);
        pg8::gemm_phase<EpiG2, Gemm2Order, PG8_ALIGN, PG8_SP2>(lds, g, S, E);
        EpiQR EQR{(bf16_t*)(ws + WS_QR), (const float*)(ws + WS_SSQ_CQ), (const f32x2*)(ws + WS_ROPE)};
        run_gemm(lds, (const bf16_t*)(ws + WS_CQ), (const bf16_t*)(ws + WS_WUQ) + (size_t)1024 * 256, R, 512, 256, G, (bx + 160) % G, EQR);
        phase_ssd_a(P, lds);
    }
    GSYNC();
    PB(14); phase_ssd_scan(P); PE(14);
    GSYNC(); PE(4);
    PB(5); PB(12); PB(13); PB(18); phase_mix<1>(P, lds); PE(18); PB(19); phase_mix<2>(P, lds); PE(19); PE(12); PE(13);
    GSYNC(); PE(5);
    PB(6);
    {
        EpiMerged E{(const bf16_t*)P.out, (const bf16_t*)P.out + (size_t)R * 1024, (const float*)(ws + WS_SSQ_Y), (bf16_t*)(ws + WS_MERGED)};
        pg8::Gemm g{(const bf16_t*)(ws + WS_Z), (const bf16_t*)(ws + WS_WOMLA), R, 1024, 1024}; PairOrder S; S.init(G, bx);
        pg8::gemm_phase<EpiMerged, PairOrder, PG8_ALIGN, PG8_SP2, 3>(lds, g, S, E);
    }
    GSYNC(); PE(6);
    PB(7);
    {
        EpiOut<3> E{P.in[I_XP], P.in[I_XS], (const float*)(ws + WS_MOD), P.in[I_GFFN], P.out, (bf16_t*)(ws + WS_A1), (float*)(ws + WS_SSQ2)};
        run_gemm192(lds, (const bf16_t*)(ws + WS_MERGED), (const bf16_t*)(ws + WS_WOUT), R, 1024, 1024, G, bx, E);
    }
    GSYNC(); PE(7);
    PB(8);
    {
        EpiUpGate E{(const float*)(ws + WS_SSQ2), (const float*)(ws + WS_CUP), P.in[I_FCW], (const float*)(ws + WS_CST), (bf16_t*)(ws + WS_UG), (bf16_t*)(ws + WS_HALO)};
        run_gemm(lds, (const bf16_t*)(ws + WS_A1), (const bf16_t*)(ws + WS_WUP), R, UPN, 1024, G, bx, E);
    }
    GSYNC(); PE(8);
    PB(9); PE(9);
    PB(10);
    const bool fuse_final = (G == 256);
    if (fuse_final) {
        { pg8::StaticOrder S0; S0.init(R, 1024, G, bx, 192); pg8::Unit u0; if (S0.next(0, u0)) fixup_rows(P, u0.pm * 192, u0.pm * 192 + 192, threadIdx.x);
          asm volatile("s_waitcnt vmcnt(0)" ::: "memory"); __syncthreads(); }
        EpiDownNorm E{(const float*)(ws + WS_MOD), P.out, P.in[I_GFIN], (float*)(ws + WS_SSQ_CQ), (unsigned*)(ws + WS_CTL) + 4608};
        pg8::Gemm g{(const bf16_t*)(ws + WS_UG), (const bf16_t*)(ws + WS_WDOWN), R, 1024, DFF}; pg8::StaticOrder S; S.init(R, 1024, G, bx, 192);
        pg8::gemm_phase<EpiDownNorm, pg8::StaticOrder, false, PG8_SP2, 3>(lds, g, S, E);
        PE(10);
#ifdef PG8_TIME
        if (blockIdx.x == 0 && threadIdx.x == 0) pacc += pg8::pg8_tacc[PG8_TIME];
#endif
        if (PROBE_MASK != 0 && blockIdx.x == (((PROBE_MASK >> 13) & 0x61) ? gridDim.x / 2 : 0) && threadIdx.x == 0) { const unsigned long long te = __builtin_amdgcn_s_memrealtime() + (unsigned long long)PROBE_MULT * pacc; while (__builtin_amdgcn_s_memrealtime() < te) __builtin_amdgcn_s_sleep(32); }
        return;
    }
    for (int k = bx; k < R / 64; k += G) fixup_rows(P, 64 * k, 64 * k + 64, threadIdx.x);
    GSYNC();
    {
        EpiDown<3> E{(const float*)(ws + WS_MOD), P.out};
        run_gemm192(lds, (const bf16_t*)(ws + WS_UG), (const bf16_t*)(ws + WS_WDOWN), R, 1024, DFF, G, bx, E);
    }
    GSYNC(); PE(10);
    PB(11); phase_final(P); PE(11);
    if (PROBE_MASK != 0 && blockIdx.x == (((PROBE_MASK >> 13) & 0x61) ? gridDim.x / 2 : 0) && threadIdx.x == 0) { const unsigned long long te = __builtin_amdgcn_s_memrealtime() + (unsigned long long)PROBE_MULT * pacc; while (__builtin_amdgcn_s_memrealtime() < te) __builtin_amdgcn_s_sleep(32); }
}

extern "C" void kernel_launch(void* const* d_in, const int* in_sizes, int n_in, void* d_out, int out_size, void* d_ws, size_t ws_size, hipStream_t stream) {
    static int grid = 0;
    if (grid == 0) {
        if (n_in != 30 || ws_size < WS_END || out_size != (int)(O_SSD + (size_t)32 * 2 * 16 * 64 * 64)) {
            fprintf(stderr, "kernel_launch: unexpected shapes: n_in %d out %d ws %zu (need %zu)\n", n_in, out_size, ws_size, (size_t)WS_END); grid = -1; return; }
        int dev = 0, cus = 0, per_cu = 0;
        if (hipGetDevice(&dev) != hipSuccess || hipDeviceGetAttribute(&cus, hipDeviceAttributeMultiprocessorCount, dev) != hipSuccess) { grid = -1; return; }
        if (hipFuncSetAttribute((const void*)mega_fwd, hipFuncAttributeMaxDynamicSharedMemorySize, LDS_BYTES) != hipSuccess) { fprintf(stderr, "kernel_launch: hipFuncSetAttribute failed\n"); grid = -1; return; }
        if (hipOccupancyMaxActiveBlocksPerMultiprocessor(&per_cu, (const void*)mega_fwd, NT, LDS_BYTES) != hipSuccess || per_cu < 1) { fprintf(stderr, "kernel_launch: occupancy query failed (%d)\n", per_cu); (void)hipGetLastError(); grid = -1; return; }
        grid = cus;
    }
    if (grid < 0) return;
    (void)hipMemsetAsync((char*)d_ws + WS_CTL, 0, CTL_ZERO, stream);
    Params p{};
    for (int i = 0; i < 30; ++i) p.in[i] = (const float*)d_in[i];
    p.out = (float*)d_out; p.ws = (unsigned char*)d_ws;
    void* args[] = {&p};
    hipError_t e = hipLaunchCooperativeKernel((const void*)mega_fwd, dim3(grid), dim3(NT), args, LDS_BYTES, stream);
    if (e != hipSuccess) fprintf(stderr, "kernel_launch: cooperative launch failed: %s (grid %d)\n", hipGetErrorString(e), grid);
}
```

```cpp
#include <hip/hip_runtime.h>
#include <hip/hip_cooperative_groups.h>
#include <cstdio>
#include <cstdint>
#include <type_traits>
namespace cg = cooperative_groups;

namespace pg8 {
#define PG8_LAS __attribute__((address_space(3)))
typedef unsigned short bf16_t;
typedef short bf16x8 __attribute__((ext_vector_type(8)));
typedef float f32x4 __attribute__((ext_vector_type(4)));
typedef unsigned u32x4 __attribute__((ext_vector_type(4)));
constexpr int BM = 256, BK = 64, HALF = 128, HTB = HALF * BK * 2  , STAGE_BYTES = 8 * HTB, NXCD = 8, WGM = 8;

__host__ __device__ __forceinline__ int lds_byte(int r, int c) { const int st = (r >> 4) * 2 + (c >> 5), rr = r & 15, cc = c & 31, ob = rr * 64 + cc * 2; return st * 1024 + (ob ^ (((ob >> 9) & 1) << 5)); }
__host__ __device__ __forceinline__ void stage_rc(int b, int& R, int& C) { const int st = b / 1024, sb = b % 1024, swz = sb ^ (((sb >> 9) & 1) << 5); R = (st >> 1) * 16 + swz / 64; C = (st & 1) * 32 + (swz % 64) / 2; }
__host__ __device__ __forceinline__ int perm32(int rho) { const int n = rho >> 4, i = rho & 15; return 8 * (i >> 2) + 4 * n + (i & 3); }

struct Unit { int pm, pn; };
#ifdef PG8_TIME
#ifndef PG8_TBLK
#define PG8_TBLK 0
#endif
__device__ unsigned long long pg8_tacc[2];
#endif
struct Gemm { const bf16_t* A; const bf16_t* Bt; int M, N, K; };

struct StaticOrder {
    int nM, nN, nwg, G, c;
    __host__ __device__ void init(int M, int N, int G_, int c_, int bm = BM) { nM = M / bm; nN = N / BM; nwg = nM * nN; G = G_; c = c_; }
    __host__ __device__ __forceinline__ bool next(int i, Unit& u) const {
        const long L = (long)i * G + c; if (L >= nwg) return false;
        int wgid = (int)L; { const int q = nwg / NXCD, r = nwg % NXCD, xcd = wgid % NXCD, off = wgid / NXCD; wgid = (xcd < r ? xcd * (q + 1) : r * (q + 1) + (xcd - r) * q) + off; }
        const int nig = WGM * nN, gid = wgid / nig, fm = gid * WGM, gsz = (nM - fm) < WGM ? (nM - fm) : WGM;
        u.pm = fm + ((wgid % nig) % gsz); u.pn = (wgid % nig) / gsz; return true;
    }
    __device__ __forceinline__ void a_ready(const Unit&) const {}
    __device__ __forceinline__ void done(const Unit&) const {}
};


template <class E, class = void> struct epi_state { struct type {}; static constexpr bool value = false; };
template <class E> struct epi_state<E, std::void_t<typename E::State>> { using type = typename E::State; static constexpr bool value = true; };
template <class E, class = void> struct epi_pre : std::false_type {};
template <class E> struct epi_pre<E, std::void_t<decltype(E::PRE_SLOT)>> : std::true_type {};
template <class E, class = void> struct epi_timed : std::false_type {};
template <class E> struct epi_timed<E, std::void_t<decltype(E::TIMED)>> : std::true_type {};
template <class Epi, class Sched, bool ALIGN_EPI = false, bool SP2 = false, int MFR = 4  >
__device__ __forceinline__ void gemm_phase(PG8_LAS unsigned char* lds, const Gemm g, const Sched& S, const Epi& E) {
    int tid_ = threadIdx.x; asm volatile("" : "+v"(tid_));
    const int tid = tid_, wid = __builtin_amdgcn_readfirstlane(tid >> 6), lane = tid & 63, wr = wid >> 2, wc = wid & 3, fr = lane & 15, fq = lane >> 4;
    static_assert(SP2 || MFR == 4, "192-row tiles need the two-super-phase loop");
    const bool shortA = (MFR == 3) && (wr == 1);
    const int K = g.K, nt = K / BK;
    unsigned voffA[2], voffB[2];
#pragma unroll
    for (int i = 0; i < 2; ++i) { int R, C; stage_rc(tid * 16 + i * 8192, R, C); const int Rb = Epi::PERM ? ((R & ~31) + perm32(R & 31)) : R;
        voffA[i] = (unsigned)(R * K + C) * 2u; voffB[i] = (unsigned)(Rb * K + C) * 2u; }
    const size_t kstep = (size_t)(BK * 2);
    const size_t hstep = (size_t)HALF * K * 2;
    const size_t tstep = 2 * hstep;
    const size_t hstepA = (size_t)(32 * MFR) * K * 2, tstepA = 2 * hstepA;
    const unsigned ldsw = (unsigned)wid * 1024u;
    const int aoff = lds_byte(wr * (16 * MFR) + fr, fq * 8), boff = lds_byte(wc * 32 + fr, fq * 8);
#define PG8_SA(b, h) (((b) * 2 + (h)) * HTB)
#define PG8_SB(b, h) ((4 + (b) * 2 + (h)) * HTB)
#define PG8_STAGE(bufoff, gbase, voff) do { _Pragma("unroll") for (int _i = 0; _i < 2; ++_i) \
        __builtin_amdgcn_global_load_lds((const unsigned*)((const char*)(gbase) + (voff)[_i]), (PG8_LAS unsigned*)(lds + (bufoff) + ldsw + _i * 8192), 16, 0, 0); } while (0)
#define PG8_LDA(dst, b, h) do { _Pragma("unroll") for (int m = 0; m < MFR; ++m) _Pragma("unroll") for (int k = 0; k < 2; ++k) dst[m][k] = *(const PG8_LAS bf16x8*)(lds + PG8_SA(b, h) + aoff + m * 2048 + k * 1024); } while (0)
#define PG8_LDB(dst, b, h) do { _Pragma("unroll") for (int n = 0; n < 2; ++n) _Pragma("unroll") for (int k = 0; k < 2; ++k) dst[n][k] = *(const PG8_LAS bf16x8*)(lds + PG8_SB(b, h) + boff + n * 2048 + k * 1024); } while (0)
#define PG8_MMA(ai, bj, At, Bt) do { __builtin_amdgcn_s_setprio(1); _Pragma("unroll") for (int m = 0; m < MFR; ++m) _Pragma("unroll") for (int n = 0; n < 2; ++n) _Pragma("unroll") for (int k = 0; k < 2; ++k) \
        acc[ai][bj][m][n] = __builtin_amdgcn_mfma_f32_16x16x32_bf16(Bt[n][k], At[m][k], acc[ai][bj][m][n], 0, 0, 0); __builtin_amdgcn_s_setprio(0); } while (0)
#define PG8_WAIT_V(n) asm volatile("s_waitcnt vmcnt(" #n ")" ::: "memory")
#define PG8_WAIT_VS(nf, ns) do { if (shortA) PG8_WAIT_V(ns); else PG8_WAIT_V(nf); } while (0)
#define PG8_STAGE_A(bufoff, gbase) do { __builtin_amdgcn_global_load_lds((const unsigned*)((const char*)(gbase) + voffA[0]), (PG8_LAS unsigned*)(lds + (bufoff) + ldsw), 16, 0, 0); \
        if (!shortA) __builtin_amdgcn_global_load_lds((const unsigned*)((const char*)(gbase) + voffA[1]), (PG8_LAS unsigned*)(lds + (bufoff) + ldsw + 8192), 16, 0, 0); } while (0)
#define PG8_WAIT_L(n) asm volatile("s_waitcnt lgkmcnt(" #n ")" ::: "memory")
#define PG8_BAR __builtin_amdgcn_s_barrier()
#define PG8_SCHED __builtin_amdgcn_sched_barrier(0)
    Unit cur, nxt; int ui = 0;
    if (!S.next(0, cur)) return;
#ifdef PG8_TIME
    const bool tme = epi_timed<Epi>::value && (wid == 0 && blockIdx.x == PG8_TBLK); unsigned long long tk0 = 0;
#endif
    typename epi_state<Epi>::type est; (void)est;
    f32x4 acc[2][2][MFR][2];
#pragma unroll
    for (int a = 0; a < 2; ++a)
#pragma unroll
        for (int b = 0; b < 2; ++b)
#pragma unroll
            for (int m = 0; m < MFR; ++m)
#pragma unroll
                for (int n = 0; n < 2; ++n) acc[a][b][m][n] = (f32x4){0.f, 0.f, 0.f, 0.f};
    bf16x8 At[MFR][2], B0[2][2], B1[2][2];
    const char* cA = (const char*)g.A + (size_t)cur.pm * tstepA; const char* cB = (const char*)g.Bt + (size_t)cur.pn * tstep;
    S.a_ready(cur);
    if constexpr (epi_pre<Epi>::value) E.pre(cur, lds + STAGE_BYTES + Epi::PRE_SLOT, wr, wc, lane);
    if constexpr (SP2) {
        PG8_STAGE(PG8_SB(0, 0), cB, voffB); PG8_STAGE(PG8_SB(0, 1), cB + hstep, voffB); PG8_STAGE_A(PG8_SA(0, 0), cA); PG8_STAGE_A(PG8_SA(0, 1), cA + hstepA);
        if (wr == 1) PG8_BAR;
        PG8_WAIT_VS(2, 1); PG8_BAR;
        PG8_STAGE(PG8_SB(1, 0), cB + kstep, voffB); PG8_STAGE_A(PG8_SA(1, 0), cA + kstep); PG8_STAGE(PG8_SB(1, 1), cB + hstep + kstep, voffB);
        PG8_WAIT_VS(6, 5); PG8_BAR;
    } else {
        PG8_STAGE(PG8_SB(0, 0), cB, voffB); PG8_STAGE_A(PG8_SA(0, 0), cA); PG8_STAGE(PG8_SB(0, 1), cB + hstep, voffB); PG8_STAGE_A(PG8_SA(0, 1), cA + hstepA);
        if (wr == 1) PG8_BAR;
        PG8_WAIT_V(4); PG8_BAR;
        PG8_STAGE(PG8_SB(1, 0), cB + kstep, voffB); PG8_STAGE_A(PG8_SA(1, 0), cA + kstep); PG8_STAGE(PG8_SB(1, 1), cB + hstep + kstep, voffB);
        PG8_WAIT_V(6); PG8_BAR;
    }
    for (;;) {
        const bool has_next = S.next(ui + 1, nxt);
        const char* nA = has_next ? (const char*)g.A + (size_t)nxt.pm * tstepA : cA; const char* nB = has_next ? (const char*)g.Bt + (size_t)nxt.pn * tstep : cB;
#ifdef PG8_TIME
        if (tme) tk0 = __builtin_amdgcn_s_memrealtime();
#endif
        for (int t = 0; t < nt; t += 2) {
            const bool last = (t == nt - 2);
            const char* a1 = cA + (size_t)(t + 1) * kstep;
            const char* a2 = last ? nA : cA + (size_t)(t + 2) * kstep; const char* b2 = last ? nB : cB + (size_t)(t + 2) * kstep;
            const char* a3 = a2 + kstep; const char* b3 = b2 + kstep;
            if (last && has_next) S.a_ready(nxt);
            if constexpr (SP2) {
            PG8_LDB(B0, 0, 0); PG8_LDB(B1, 0, 1); PG8_SCHED; PG8_LDA(At, 0, 0); PG8_STAGE_A(PG8_SA(1, 1), a1 + hstepA);
            PG8_WAIT_VS(8, 6); PG8_WAIT_L(0); PG8_BAR; PG8_MMA(0, 0, At, B0); PG8_MMA(0, 1, At, B1); PG8_BAR; PG8_SCHED;
            PG8_LDA(At, 0, 1); PG8_STAGE(PG8_SB(0, 0), b2, voffB); PG8_STAGE(PG8_SB(0, 1), b2 + hstep, voffB); PG8_STAGE_A(PG8_SA(0, 0), a2);
            PG8_WAIT_VS(8, 6); PG8_WAIT_L(0); PG8_BAR; PG8_MMA(1, 0, At, B0); PG8_MMA(1, 1, At, B1); PG8_BAR; PG8_SCHED;
            PG8_LDB(B0, 1, 0); PG8_LDB(B1, 1, 1); PG8_SCHED; PG8_LDA(At, 1, 0); PG8_STAGE_A(PG8_SA(0, 1), a2 + hstepA);
            PG8_WAIT_VS(8, 6); PG8_WAIT_L(0); PG8_BAR; PG8_MMA(0, 0, At, B0); PG8_MMA(0, 1, At, B1); PG8_BAR; PG8_SCHED;
            PG8_LDA(At, 1, 1); PG8_STAGE(PG8_SB(1, 0), b3, voffB); PG8_STAGE(PG8_SB(1, 1), b3 + hstep, voffB); PG8_STAGE_A(PG8_SA(1, 0), a3);
            PG8_WAIT_VS(8, 6); PG8_WAIT_L(0); PG8_BAR; PG8_MMA(1, 0, At, B0); PG8_MMA(1, 1, At, B1); PG8_BAR; PG8_SCHED;
            } else {
            PG8_LDB(B0, 0, 0); PG8_SCHED; PG8_LDA(At, 0, 0); PG8_STAGE_A(PG8_SA(1, 1), a1 + hstepA);
            PG8_WAIT_L(8); PG8_BAR; PG8_WAIT_L(0); PG8_MMA(0, 0, At, B0); PG8_BAR; PG8_SCHED;
            PG8_LDB(B1, 0, 1); PG8_STAGE(PG8_SB(0, 0), b2, voffB);
            PG8_BAR; PG8_WAIT_L(0); PG8_MMA(0, 1, At, B1); PG8_BAR;
            PG8_LDA(At, 0, 1); PG8_STAGE_A(PG8_SA(0, 0), a2);
            PG8_BAR; PG8_WAIT_L(0); PG8_MMA(1, 0, At, B0); PG8_BAR; PG8_SCHED;
            PG8_STAGE(PG8_SB(0, 1), b2 + hstep, voffB);
            PG8_WAIT_V(6); PG8_BAR; PG8_MMA(1, 1, At, B1); PG8_BAR;
            PG8_LDB(B0, 1, 0); PG8_SCHED; PG8_LDA(At, 1, 0); PG8_STAGE_A(PG8_SA(0, 1), a2 + hstepA);
            PG8_WAIT_L(8); PG8_BAR; PG8_WAIT_L(0); PG8_MMA(0, 0, At, B0); PG8_BAR; PG8_SCHED;
            PG8_LDB(B1, 1, 1); PG8_STAGE(PG8_SB(1, 0), b3, voffB);
            PG8_BAR; PG8_WAIT_L(0); PG8_MMA(0, 1, At, B1); PG8_BAR;
            PG8_LDA(At, 1, 1); PG8_STAGE_A(PG8_SA(1, 0), a3);
            PG8_BAR; PG8_WAIT_L(0); PG8_MMA(1, 0, At, B0); PG8_BAR; PG8_SCHED;
            PG8_STAGE(PG8_SB(1, 1), b3 + hstep, voffB);
            PG8_WAIT_V(6); PG8_BAR; PG8_MMA(1, 1, At, B1); PG8_BAR;
            }
        }
#ifdef PG8_TIME
        if (tme) { const unsigned long long t1 = __builtin_amdgcn_s_memrealtime(); pg8_tacc[0] += t1 - tk0; tk0 = t1; }
#endif
        if constexpr (ALIGN_EPI) { if (wr == 0) PG8_BAR; }
        if constexpr (!Epi::AFTER_DRAIN) { if constexpr (epi_state<Epi>::value) E(acc, cur, wr, wc, fr, fq, est); else if constexpr (epi_pre<Epi>::value) E(acc, cur, wr, wc, fr, fq, lds + STAGE_BYTES + Epi::PRE_SLOT + (ui & 1) * Epi::PRE_BYTES);
            else E(acc, cur, wr, wc, fr, fq); S.done(cur);
            if constexpr (epi_pre<Epi>::value) { if (has_next) E.pre(nxt, lds + STAGE_BYTES + Epi::PRE_SLOT + ((ui + 1) & 1) * Epi::PRE_BYTES, wr, wc, lane); } }
#ifdef PG8_TIME
        if (tme) { const unsigned long long t1 = __builtin_amdgcn_s_memrealtime(); pg8_tacc[1] += t1 - tk0; }
#endif
        if (!has_next) break;
#pragma unroll
        for (int a = 0; a < 2; ++a)
#pragma unroll
            for (int b = 0; b < 2; ++b)
#pragma unroll
                for (int m = 0; m < MFR; ++m)
#pragma unroll
                    for (int n = 0; n < 2; ++n) acc[a][b][m][n] = (f32x4){0.f, 0.f, 0.f, 0.f};
        cur = nxt; cA = nA; cB = nB; ++ui;
        if constexpr (ALIGN_EPI) { if (wr == 1) PG8_BAR; }
    }
    PG8_WAIT_V(0);
    if constexpr (!ALIGN_EPI) { if (wr == 0) PG8_BAR; }
    PG8_BAR;
    if constexpr (Epi::AFTER_DRAIN) { E.fused(acc, cur, wr, wc, fr, fq, lds, wid, lane); S.done(cur); }
#undef PG8_SA
#undef PG8_SB
#undef PG8_STAGE
#undef PG8_LDA
#undef PG8_LDB
#undef PG8_MMA
#undef PG8_WAIT_V
#undef PG8_WAIT_VS
#undef PG8_STAGE_A
#undef PG8_WAIT_L
#undef PG8_BAR
#undef PG8_SCHED
}
}

#ifndef PROBE_MASK
#define PROBE_MASK 0
#endif
#define PROBE_MULT 8
#ifndef PROBE_BLK
#define PROBE_BLK (((PROBE_MASK >> 13) & 0x61) ? gridDim.x / 2 : 0)
#endif
#ifndef PB_DUP1
#define PB_DUP1 1
#endif
#ifndef PG8_SP2
#define PG8_SP2 true
#endif
#ifndef PG8_ALIGN
#define PG8_ALIGN true
#endif

#define LAS __attribute__((address_space(3)))
using pg8::bf16_t; using pg8::f32x4; using pg8::bf16x8; using pg8::u32x4;
typedef unsigned u32x2 __attribute__((ext_vector_type(2)));
typedef float f32x2 __attribute__((ext_vector_type(2)));

constexpr int DM = 1024;
constexpr int RP = 8192, RS = 4096, R = 12288;
constexpr int SEQP = 256, SEQS = 2048, PAST = 512, KVS = PAST + SEQS;
constexpr int KVR = RP + 2 * KVS;
constexpr int NH = 8;
constexpr int INC = 5216, INP = 5376;
constexpr int DFF = 2816, UPN = 5632;
constexpr float EPS = 1e-6f;
constexpr float ATT_SCALE = 0.07216878364870322f;

enum { I_XP = 0, I_XS, I_C, I_CKV, I_CKR, I_SSD, I_CCTX, I_WADA, I_BADA, I_GATTN, I_WIN, I_GQ, I_GKV, I_WUQ, I_WUKV, I_WOMLA,
       I_CONVW, I_CONVB, I_DTB, I_ALOG, I_SSDD, I_GSSD, I_WOSSD, I_WOUT, I_GFFN, I_WUP, I_FCW, I_FCB, I_WDOWN, I_GFIN };

constexpr size_t O_Y = 0, O_CKV = (size_t)R * DM, O_KR = O_CKV + (size_t)RP * 256, O_SSD = O_KR + (size_t)RP * 64;

constexpr size_t MiB = 1u << 20;
constexpr size_t WS_CTL = 0, CTL_ZERO = 65536;
constexpr size_t WS_MOD = 64 * 1024;
constexpr size_t WS_CUP = 160 * 1024;
constexpr size_t WS_ROPE = 256 * 1024;
constexpr size_t WS_CST = 800 * 1024;
constexpr size_t WS_SSQ_CQ = 1 * MiB;
constexpr size_t WS_SSQ_CKV = 1 * MiB + 204800;
constexpr size_t WS_SSQ_Y = 1 * MiB + 430080;
constexpr size_t WS_SSQ2 = 1 * MiB + 1216512;
constexpr size_t WS_DT = 3 * MiB;
constexpr size_t WS_DEC = 3 * MiB + 1572864;
constexpr size_t WS_ZERO = WS_DEC + 16384;
constexpr size_t WS_WIN = 5 * MiB;
constexpr size_t WS_WUQ = WS_WIN + (size_t)INP * 1024 * 2;
constexpr size_t WS_WUKV = WS_WUQ + 1536 * 256 * 2;
constexpr size_t WS_WOMLA = WS_WUKV + 2048 * 256 * 2;
constexpr size_t WS_WOSSD = WS_WOMLA + 2 * MiB;
constexpr size_t WS_WOUT = WS_WOSSD + 2 * MiB;
constexpr size_t WS_WUP = WS_WOUT + 2 * MiB;
constexpr size_t WS_WDOWN = WS_WUP + (size_t)UPN * 1024 * 2;
static_assert(WS_WDOWN + (size_t)1024 * DFF * 2 <= 40 * MiB, "weights");
constexpr size_t WS_CQ = 40 * MiB;
constexpr size_t WS_CKVA = 46 * MiB;
constexpr size_t WS_KROPE = 46 * MiB + (size_t)KVR * 256 * 2;
constexpr size_t WS_Z = 55 * MiB;
constexpr size_t WS_XBC = 79 * MiB;
constexpr size_t WS_H = 115 * MiB;
constexpr size_t WS_QN = 115 * MiB;
constexpr size_t WS_QR = 139 * MiB;
constexpr size_t WS_KV = 151 * MiB;
constexpr size_t WS_ST = 203 * MiB;
constexpr size_t WS_MERGED = 151 * MiB;
constexpr size_t WS_A1 = 83 * MiB;
constexpr size_t WS_U = 115 * MiB;
constexpr size_t WS_UG = 115 * MiB;
constexpr size_t WS_HALO = 182 * MiB;
constexpr size_t WS_END = 251 * MiB;
static_assert(WS_KROPE + (size_t)KVR * 64 * 2 <= WS_Z && WS_KV + (size_t)KVR * 2048 * 2 <= WS_ST && WS_ST + (size_t)R * 1024 * 4 <= WS_END, "map");
static_assert(WS_UG + (size_t)R * DFF * 2 <= WS_HALO && WS_HALO + (size_t)192 * 4 * UPN * 2 <= WS_END, "map2");
static_assert(WS_A1 + (size_t)R * 1024 * 2 <= WS_UG, "a1 clear of ug");

constexpr int LDS_BYTES = 147456;
constexpr int NT = 512;

struct Params { const float* in[30]; float* out; unsigned char* ws; };
#define PHASE_IDS int tid = threadIdx.x; asm volatile("" : "+v"(tid)); const int lane = tid & 63, wave = __builtin_amdgcn_readfirstlane(tid >> 6), G = gridDim.x; (void)lane; (void)wave; (void)G;

#define LDS_WAIT() asm volatile("s_waitcnt lgkmcnt(0)" ::: "memory")
__device__ __forceinline__ unsigned f2bf(float f) { unsigned u = __builtin_bit_cast(unsigned, f); return (u + 0x7fffu + ((u >> 16) & 1u)) >> 16; }
__device__ __forceinline__ float bf2f(unsigned short b) { return __builtin_bit_cast(float, (unsigned)b << 16); }
typedef __bf16 bf16x2_t __attribute__((ext_vector_type(2)));
__device__ __forceinline__ unsigned pk2(float lo, float hi) { const f32x2 v = {lo, hi}; const bf16x2_t b = __builtin_convertvector(v, bf16x2_t); return __builtin_bit_cast(unsigned, b); }
__device__ __forceinline__ float bflo(unsigned w) { return __builtin_bit_cast(float, w << 16); }
__device__ __forceinline__ float bfhi(unsigned w) { return __builtin_bit_cast(float, w & 0xffff0000u); }
__device__ __forceinline__ float wave_sum(float v) {
#pragma unroll
    for (int o = 1; o < 64; o <<= 1) v += __shfl_xor(v, o);
    return v;
}
__device__ __forceinline__ float wave_max(float v) {
#pragma unroll
    for (int o = 1; o < 64; o <<= 1) v = fmaxf(v, __shfl_xor(v, o));
    return v;
}
__device__ __forceinline__ void unpack8(const u32x4 w, float* f) {
#pragma unroll
    for (int e = 0; e < 4; ++e) { f[2 * e] = bflo(w[e]); f[2 * e + 1] = bfhi(w[e]); }
}
__device__ __forceinline__ float sigm(float x) { return __builtin_amdgcn_rcpf(1.f + __expf(-x)); }
__device__ __forceinline__ float siluf(float x) { return x * sigm(x); }
__device__ __forceinline__ float softplusf(float x) { return x > 20.f ? x : log1pf(__expf(x)); }
__device__ __forceinline__ int grp_of_row(int row) { return row < RP ? 0 : 1 + ((row - RP) >> 11); }
__device__ __forceinline__ int kvrow_of_row(int row) { return row < RP ? row : RP + ((row - RP) >> 11) * KVS + PAST + ((row - RP) & 2047); }
__device__ __forceinline__ const float* xrow_ptr(const Params& P, int row) { return row < RP ? P.in[I_XP] + (size_t)row * DM : P.in[I_XS] + (size_t)(row - RP) * DM; }

__device__ __forceinline__ int pair_pos(int i) { return 8 * ((i & 15) >> 2) + (i & 3) + (i >= 16 ? 4 : 0); }
__device__ __forceinline__ void transpose_item(const float* W, int K, int N, bf16_t* WT, int k0, int n0, int drow0, const float* kscale, LAS float* scr, int lane, bool pairs = false) {
    float wv[32];
#pragma unroll
    for (int i = 0; i < 32; ++i) wv[i] = __builtin_nontemporal_load(W + (size_t)(k0 + 2 * i + (lane >> 5)) * N + n0 + (lane & 31));
#pragma unroll
    for (int i = 0; i < 32; ++i) { const int kk = 2 * i + (lane >> 5); float w = wv[i]; if (kscale) w *= kscale[k0 + kk]; scr[kk * 33 + (lane & 31)] = w; }
    LDS_WAIT(); asm volatile("" ::: "memory");
    const int c = lane & 7;
#pragma unroll
    for (int j = 0; j < 4; ++j) { const int n = (lane >> 3) + 8 * j; const LAS float* s = scr + (8 * c) * 33 + n;
        u32x4 o; o.x = pk2(s[0 * 33], s[1 * 33]); o.y = pk2(s[2 * 33], s[3 * 33]); o.z = pk2(s[4 * 33], s[5 * 33]); o.w = pk2(s[6 * 33], s[7 * 33]);
        *(u32x4*)(WT + (size_t)(drow0 + (pairs ? pair_pos(n) : n)) * K + k0 + 8 * c) = o; }
    LDS_WAIT(); asm volatile("" ::: "memory");
}
__device__ __forceinline__ int win_dst(int n0) {
    if (n0 < 512) return n0;
    if (n0 < 576) return 5120 + (n0 - 512);
    if (n0 < 1600) return 512 + (n0 - 576);
    if (n0 < 2624) return 1536 + (n0 - 1600);
    if (n0 < 2880) return 2560 + (n0 - 2624);
    if (n0 < 3136) return 2816 + (n0 - 2880);
    if (n0 < 3168) return 5184 + (n0 - 3136);
    if (n0 < 4192) return 3072 + (n0 - 3168);
    return 4096 + (n0 - 4192);
}
__device__ __forceinline__ int wup_dst(int n0) { const bool isv = n0 >= DFF; const int j = isv ? n0 - DFF : n0; return (j >> 7) * 256 + (isv ? 128 : 0) + (j & 127); }
__device__ __forceinline__ int wuq_dst(int n0) { const int h = n0 / 192, d0 = n0 - h * 192; return d0 < 128 ? h * 128 + d0 : 1024 + h * 64 + (d0 - 128); }

template <int CW>
__device__ __forceinline__ void gemv3_block(const LAS float* vec  , const float* W, int N, int col0, const float* bias, float* out, int ldo, LAS float* red, int tid) {
    const int j = tid & 31, kq = tid >> 5;
    float a0 = 0.f, a1 = 0.f, a2 = 0.f;
    if (j < CW) {
        const float* wp = W + (size_t)(kq * 64) * N + col0 + j;
#pragma unroll 32
        for (int k = 0; k < 64; ++k) { const float w = __builtin_nontemporal_load(wp + (size_t)k * N); const int kk = kq * 64 + k; a0 += vec[kk] * w; a1 += vec[1024 + kk] * w; a2 += vec[2048 + kk] * w; }
    }
    red[(kq * 3 + 0) * 32 + j] = a0; red[(kq * 3 + 1) * 32 + j] = a1; red[(kq * 3 + 2) * 32 + j] = a2;
    __syncthreads();
    if (tid < 96) { const int g = tid >> 5, jj = tid & 31;
        if (jj < CW) { float s = 0.f;
#pragma unroll
            for (int q = 0; q < 16; ++q) s += red[(q * 3 + g) * 32 + jj];
            out[(size_t)g * ldo + col0 + jj] = s + (bias ? bias[col0 + jj] : 0.f); } }
    __syncthreads();
}

__device__ __forceinline__ void phase_p0(const Params& P, LAS unsigned char* lds) {
    PHASE_IDS unsigned char* ws = P.ws;
    {
        LAS float* sc = (LAS float*)lds; LAS float* red = sc + 3072;
        for (int i = tid; i < 3072; i += NT) { const int g = i >> 10, k = i & 1023; const float c = (g == 0) ? P.in[I_CCTX][k] : P.in[I_C][(g - 1) * 1024 + k]; sc[i] = siluf(c); }
        __syncthreads();
        for (int cb = blockIdx.x; cb < 256; cb += G) gemv3_block<24>(sc, P.in[I_WADA], 6144, cb * 24, P.in[I_BADA], (float*)(ws + WS_MOD), 6144, red, tid);
    }
    {
        LAS float* scr = (LAS float*)(lds + wave * 16384);
        const int gw = blockIdx.x * 8 + wave, NGW = G * 8;
        constexpr int I_IN = 16 * 163, I_UQ = 4 * 48, I_UKV = 4 * 64, I_SQ = 16 * 32, I_UP = 16 * 176, I_DN = 44 * 32;
        constexpr int NITEMS = I_IN + I_UQ + I_UKV + 3 * I_SQ + I_UP + I_DN;
        for (int it = gw; it < NITEMS; it += NGW) {
            int r = it;
            if (r < I_IN) { const int kb = r / 163, nb = r % 163; transpose_item(P.in[I_WIN], 1024, INC, (bf16_t*)(ws + WS_WIN), kb * 64, nb * 32, win_dst(nb * 32), nullptr, scr, lane, win_dst(nb * 32) >= 5120); continue; } r -= I_IN;
            if (r < I_UQ) { const int kb = r / 48, nb = r % 48; transpose_item(P.in[I_WUQ], 256, 1536, (bf16_t*)(ws + WS_WUQ), kb * 64, nb * 32, wuq_dst(nb * 32), P.in[I_GQ], scr, lane); continue; } r -= I_UQ;
            if (r < I_UKV) { const int kb = r / 64, nb = r % 64; transpose_item(P.in[I_WUKV], 256, 2048, (bf16_t*)(ws + WS_WUKV), kb * 64, nb * 32, nb * 32, P.in[I_GKV], scr, lane); continue; } r -= I_UKV;
            if (r < I_SQ) { const int kb = r / 32, nb = r % 32; transpose_item(P.in[I_WOMLA], 1024, 1024, (bf16_t*)(ws + WS_WOMLA), kb * 64, nb * 32, nb * 32, nullptr, scr, lane); continue; } r -= I_SQ;
            if (r < I_SQ) { const int kb = r / 32, nb = r % 32; transpose_item(P.in[I_WOSSD], 1024, 1024, (bf16_t*)(ws + WS_WOSSD), kb * 64, nb * 32, nb * 32, P.in[I_GSSD], scr, lane); continue; } r -= I_SQ;
            if (r < I_SQ) { const int kb = r / 32, nb = r % 32; transpose_item(P.in[I_WOUT], 1024, 1024, (bf16_t*)(ws + WS_WOUT), kb * 64, nb * 32, nb * 32, nullptr, scr, lane); continue; } r -= I_SQ;
            if (r < I_UP) { const int kb = r / 176, nb = r % 176; transpose_item(P.in[I_WUP], 1024, UPN, (bf16_t*)(ws + WS_WUP), kb * 64, nb * 32, wup_dst(nb * 32), nullptr, scr, lane); continue; } r -= I_UP;
            { const int kb = r / 32, nb = r % 32; transpose_item(P.in[I_WDOWN], DFF, 1024, (bf16_t*)(ws + WS_WDOWN), kb * 64, nb * 32, nb * 32, nullptr, scr, lane); }
        }
    }
    {
        const int gt = blockIdx.x * NT + tid, GT = G * NT;
        for (int i = gt; i < 8192 / 16; i += GT) *(u32x4*)(ws + WS_ZERO + (size_t)i * 16) = (u32x4){0u, 0u, 0u, 0u};
        for (int i = gt; i < 160 * 1024 / 8; i += GT) *(u32x4*)((bf16_t*)(ws + WS_WIN) + (size_t)5216 * 1024 + (size_t)i * 8) = (u32x4){0u, 0u, 0u, 0u};
        for (int i = gt; i < 2048 * 32; i += GT) { const int t = i >> 5, a = (i >> 4) & 1, fi = i & 15; const float pos = (float)(a ? (t & 63) : (t >> 6));
            const float inv = exp2f(-(float)fi * 0.8304820237218406f); const float ang = pos * inv;
            ((f32x2*)(ws + WS_ROPE))[i] = (f32x2){__cosf(ang), __sinf(ang)}; }
        for (int i = gt; i < 2 * PAST * 256; i += GT) { const int k = i & 255, s = (i >> 8) & 511, b = i >> 17;
            ((bf16_t*)(ws + WS_CKVA))[(size_t)(RP + b * KVS + s) * 256 + k] = (bf16_t)f2bf(P.in[I_CKV][i] / P.in[I_GKV][k]); }
        for (int i = gt; i < 2 * PAST * 64; i += GT) { const int j = i & 63, s = (i >> 6) & 511, b = i >> 15;
            ((bf16_t*)(ws + WS_KROPE))[(size_t)(RP + b * KVS + s) * 64 + j] = (bf16_t)f2bf(P.in[I_CKR][i]); }
        for (int i = gt; i < 2 * PAST; i += GT) { const int s = i & 511, b = i >> 9;
            *(f32x4*)((float*)(ws + WS_SSQ_CKV) + (size_t)(RP + b * KVS + s) * 4) = (f32x4){256.f * (1.f - EPS), 0.f, 0.f, 0.f}; }
    }
}

__device__ __forceinline__ void phase_p1(const Params& P, LAS unsigned char* lds) {
    PHASE_IDS unsigned char* ws = P.ws; const float* mod = (const float*)(ws + WS_MOD);
    const int gw = blockIdx.x * 8 + wave, NGW = G * 8;
    {
        float s2[3][16];
#pragma unroll
        for (int g = 0; g < 3; ++g)
#pragma unroll
            for (int q = 0; q < 4; ++q) { const f32x4 a = *(const f32x4*)(mod + g * 6144 + 3072 + (q >> 1) * 512 + 8 * lane + 4 * (q & 1));
#pragma unroll
                for (int e = 0; e < 4; ++e) s2[g][4 * q + e] = a[e]; }
        const bf16_t* wt = (const bf16_t*)(ws + WS_WUP);
        for (int j = gw; j < UPN; j += NGW) {
            const size_t jr = (size_t)(wup_dst(j & ~31) + (j & 31)) * 1024;
            float wf[16]; unpack8(*(const u32x4*)(wt + jr + 8 * lane), wf); unpack8(*(const u32x4*)(wt + jr + 512 + 8 * lane), wf + 8);
            float a0 = 0.f, a1 = 0.f, a2 = 0.f;
#pragma unroll
            for (int e = 0; e < 16; ++e) { a0 += s2[0][e] * wf[e]; a1 += s2[1][e] * wf[e]; a2 += s2[2][e] * wf[e]; }
            a0 = wave_sum(a0); a1 = wave_sum(a1); a2 = wave_sum(a2);
            if (lane == 0) { float* cu = (float*)(ws + WS_CUP); cu[j] = a0; cu[UPN + j] = a1; cu[2 * UPN + j] = a2;
                const float* fw = P.in[I_FCW]; const float wsum = (fw[j] + fw[UPN + j]) + fw[2 * UPN + j], bb = P.in[I_FCB][j]; float* cs = (float*)(ws + WS_CST);
                cs[j] = a0 * wsum + bb; cs[UPN + j] = a1 * wsum + bb; cs[2 * UPN + j] = a2 * wsum + bb; }
        }
    }
    const float* gat = P.in[I_GATTN];
    for (int row0 = gw * 2; row0 < R; row0 += NGW * 2) {
        const int g = grp_of_row(row0);
        f32x4 v[2][4]; float s[2] = {0.f, 0.f};
#pragma unroll
        for (int q = 0; q < 2; ++q) { const f32x4* xr = (const f32x4*)xrow_ptr(P, row0 + q) + lane;
#pragma unroll
            for (int j = 0; j < 4; ++j) v[q][j] = __builtin_nontemporal_load(xr + 64 * j); }
#pragma unroll
        for (int q = 0; q < 2; ++q)
#pragma unroll
            for (int j = 0; j < 4; ++j) s[q] += (v[q][j].x * v[q][j].x + v[q][j].y * v[q][j].y) + (v[q][j].z * v[q][j].z + v[q][j].w * v[q][j].w);
        const float rs0 = rsqrtf(wave_sum(s[0]) * (1.f / DM) + EPS), rs1 = rsqrtf(wave_sum(s[1]) * (1.f / DM) + EPS);
#pragma unroll
        for (int j = 0; j < 4; ++j) { const int c = 4 * lane + 256 * j;
            const f32x4 gg = *(const f32x4*)(gat + c), sc = *(const f32x4*)(mod + g * 6144 + 1024 + c), sh = *(const f32x4*)(mod + g * 6144 + c);
            const f32x4 gs = gg * (sc + 1.f);
            const f32x4 h0 = v[0][j] * rs0 * gs + sh, h1 = v[1][j] * rs1 * gs + sh;
            ((u32x2*)((bf16_t*)(ws + WS_H) + (size_t)row0 * DM) + lane)[64 * j] = (u32x2){pk2(h0.x, h0.y), pk2(h0.z, h0.w)};
            ((u32x2*)((bf16_t*)(ws + WS_H) + (size_t)(row0 + 1) * DM) + lane)[64 * j] = (u32x2){pk2(h1.x, h1.y), pk2(h1.z, h1.w)}; }
    }
}

typedef const f32x4 (&AccRef)[2][2][4][2];
typedef const f32x4 (&AccRef3)[2][2][3][2];
#define EPI_ROWS_M(pm, MFR) _Pragma("unroll") for (int ai = 0; ai < 2; ++ai) _Pragma("unroll") for (int m = 0; m < (MFR); ++m) { const int row = (pm) * (64 * (MFR)) + ai * (32 * (MFR)) + wr * (16 * (MFR)) + m * 16 + fr;
#define EPI_ROWS(pm) _Pragma("unroll") for (int ai = 0; ai < 2; ++ai) _Pragma("unroll") for (int m = 0; m < 4; ++m) { const int row = (pm) * 256 + ai * 128 + wr * 64 + m * 16 + fr;
#define EPI_COLS _Pragma("unroll") for (int bj = 0; bj < 2; ++bj) _Pragma("unroll") for (int n = 0; n < 2; ++n) { const int col = bj * 128 + wc * 32 + n * 16 + fq * 4; const f32x4 v = acc[ai][bj][m][n];
#define EPI_END }
#define EPI_COLS8 _Pragma("unroll") for (int bj = 0; bj < 2; ++bj) { const int col = bj * 128 + wc * 32 + fq * 8; const f32x4 v0 = acc[ai][bj][m][0], v1 = acc[ai][bj][m][1];
__device__ __forceinline__ void st_bf8(bf16_t* p, f32x4 a, f32x4 b) { *(u32x4*)p = (u32x4){pk2(a.x, a.y), pk2(a.z, a.w), pk2(b.x, b.y), pk2(b.z, b.w)}; }
__device__ __forceinline__ void st_bf4(bf16_t* p, f32x4 v) { *(u32x2*)p = (u32x2){pk2(v.x, v.y), pk2(v.z, v.w)}; }
__device__ __forceinline__ f32x4 ld_bf4(const bf16_t* p) { const u32x2 w = *(const u32x2*)p; return (f32x4){bflo(w.x), bfhi(w.x), bflo(w.y), bfhi(w.y)}; }
__device__ __forceinline__ float quad_sum16(float s) { s += __shfl_xor(s, 16); s += __shfl_xor(s, 32); return s; }

struct EpiInMain {
    static constexpr bool PERM = true, AFTER_DRAIN = false;
#if defined(PG8_TIME) && PG8_TPH == 1
    static constexpr bool TIMED = true;
#endif
    bf16_t *cq, *ckv, *z, *xbc, *sgm, *sgs; float *ssq_cq, *ssq_ckv, *new_ckv;
    bf16_t* krope; float *dt, *new_krope; const float* dt_bias; const f32x2* rope;
    __device__ __forceinline__ void operator()(AccRef acc, const pg8::Unit& u, int wr, int wc, int fr, int fq) const {
        const int pn = u.pn;
        if (pn == 20) {
            if (wc < 2) {
                EPI_ROWS(u.pm)
                    const f32x4 x0 = acc[ai][0][m][0], x1 = acc[ai][0][m][1]; const int i0 = fq * 4;
                    if (row < RP) {
                        st_bf4(krope + (size_t)row * 64 + wc * 32 + i0, x0); st_bf4(krope + (size_t)row * 64 + wc * 32 + 16 + i0, x1);
                        *(f32x4*)(new_krope + (size_t)row * 64 + wc * 32 + i0) = x0; *(f32x4*)(new_krope + (size_t)row * 64 + wc * 32 + 16 + i0) = x1;
                    } else {
                        const int t = (row - RP) & 2047; const f32x2* rp = rope + t * 32 + wc * 16 + i0; f32x4 o0, o1;
#pragma unroll
                        for (int e = 0; e < 4; ++e) { const f32x2 cs = rp[e]; o0[e] = x0[e] * cs.x - x1[e] * cs.y; o1[e] = x0[e] * cs.y + x1[e] * cs.x; }
                        bf16_t* dst = krope + (size_t)kvrow_of_row(row) * 64 + wc * 32 + i0; st_bf4(dst, o0); st_bf4(dst + 16, o1);
                    }
                EPI_END
            } else if (wc == 2) {
                EPI_ROWS(u.pm)
#pragma unroll
                    for (int n = 0; n < 2; ++n) { const int j = n * 16 + fq * 4; const f32x4 v = acc[ai][0][m][n]; const f32x4 b = *(const f32x4*)(dt_bias + j);
                        *(f32x4*)(dt + (size_t)row * 32 + j) = (f32x4){softplusf(v.x + b.x), softplusf(v.y + b.y), softplusf(v.z + b.z), softplusf(v.w + b.w)}; }
                EPI_END
            }
        } else if (pn < 2) {
            EPI_ROWS(u.pm)
                const int orow = pn == 0 ? row : kvrow_of_row(row); bf16_t* dst = (pn == 0 ? cq : ckv) + (size_t)orow * 256; float s = 0.f;
                EPI_COLS8
                    st_bf8(dst + col, v0, v1); s += ((v0.x * v0.x + v0.y * v0.y) + (v0.z * v0.z + v0.w * v0.w)) + ((v1.x * v1.x + v1.y * v1.y) + (v1.z * v1.z + v1.w * v1.w));
                    if (pn == 1 && row < RP) { *(f32x4*)(new_ckv + (size_t)row * 256 + col) = v0; *(f32x4*)(new_ckv + (size_t)row * 256 + col + 4) = v1; }
                EPI_END
                s = quad_sum16(s);
                if (fq == 0) (pn == 0 ? ssq_cq : ssq_ckv)[(size_t)orow * 4 + wc] = s;
            EPI_END
        } else if (pn < 12) {
            bf16_t* base = pn < 6 ? z : xbc; const int ld = pn < 6 ? 1024 : 1536, c0 = pn < 6 ? (pn - 2) * 256 : (pn - 6) * 256;
            EPI_ROWS(u.pm)
                bf16_t* dst = base + (size_t)row * ld + c0;
                EPI_COLS8 st_bf8(dst + col, v0, v1); EPI_END
            EPI_END
        } else {
            bf16_t* base = pn < 16 ? sgm : sgs; const int c0 = (pn & 3) * 256;
            EPI_ROWS(u.pm)
                bf16_t* dst = base + (size_t)row * 1024 + c0;
                EPI_COLS8 __builtin_nontemporal_store((u32x4){pk2(sigm(v0.x), sigm(v0.y)), pk2(sigm(v0.z), sigm(v0.w)), pk2(sigm(v1.x), sigm(v1.y)), pk2(sigm(v1.z), sigm(v1.w))}, (u32x4*)(dst + col)); EPI_END
            EPI_END
        }
    }
};
struct EpiInTail {
    static constexpr bool PERM = false, AFTER_DRAIN = false;
    bf16_t* krope; float *dt, *new_krope; const float* dt_bias; const f32x2* rope;
    __device__ __forceinline__ void operator()(AccRef acc, const pg8::Unit& u, int wr, int wc, int fr, int fq) const {
        if (wc < 2) {
            EPI_ROWS(u.pm)
                const f32x4 x0 = acc[ai][0][m][0], x1 = acc[ai][0][m][1]; const int i0 = fq * 4;
                if (row < RP) {
                    st_bf4(krope + (size_t)row * 64 + wc * 32 + i0, x0); st_bf4(krope + (size_t)row * 64 + wc * 32 + 16 + i0, x1);
                    *(f32x4*)(new_krope + (size_t)row * 64 + wc * 32 + i0) = x0; *(f32x4*)(new_krope + (size_t)row * 64 + wc * 32 + 16 + i0) = x1;
                } else {
                    const int t = (row - RP) & 2047; const f32x2* rp = rope + t * 32 + wc * 16 + i0; f32x4 o0, o1;
#pragma unroll
                    for (int e = 0; e < 4; ++e) { const f32x2 cs = rp[e]; o0[e] = x0[e] * cs.x - x1[e] * cs.y; o1[e] = x0[e] * cs.y + x1[e] * cs.x; }
                    bf16_t* dst = krope + (size_t)kvrow_of_row(row) * 64 + wc * 32 + i0; st_bf4(dst, o0); st_bf4(dst + 16, o1);
                }
            EPI_END
        } else if (wc == 2) {
            EPI_ROWS(u.pm)
#pragma unroll
                for (int n = 0; n < 2; ++n) { const int j = n * 16 + fq * 4; const f32x4 v = acc[ai][0][m][n]; const f32x4 b = *(const f32x4*)(dt_bias + j);
                    *(f32x4*)(dt + (size_t)row * 32 + j) = (f32x4){softplusf(v.x + b.x), softplusf(v.y + b.y), softplusf(v.z + b.z), softplusf(v.w + b.w)}; }
            EPI_END
        }
    }
};

struct EpiQR {
    static constexpr bool PERM = false, AFTER_DRAIN = false;
    bf16_t* qr; const float* ssq; const f32x2* rope;
    __device__ __forceinline__ void operator()(AccRef acc, const pg8::Unit& u, int wr, int wc, int fr, int fq) const {
        EPI_ROWS(u.pm)
            const f32x4 sq = *(const f32x4*)(ssq + (size_t)row * 4); const float rs = rsqrtf(((sq.x + sq.y) + (sq.z + sq.w)) * (1.f / 256.f) + EPS);
            bf16_t* dst = qr + (size_t)row * 512 + u.pn * 256;
#pragma unroll
            for (int bj = 0; bj < 2; ++bj) { const int cb = bj * 128 + wc * 32, i0 = fq * 4; const f32x4 x0 = acc[ai][bj][m][0] * rs, x1 = acc[ai][bj][m][1] * rs;
                if (row < RP) { st_bf4(dst + cb + i0, x0); st_bf4(dst + cb + 16 + i0, x1); }
                else { const int t = (row - RP) & 2047; const f32x2* rp = rope + t * 32 + (wc & 1) * 16 + i0; f32x4 o0, o1;
#pragma unroll
                    for (int e = 0; e < 4; ++e) { const f32x2 cs = rp[e]; o0[e] = x0[e] * cs.x - x1[e] * cs.y; o1[e] = x0[e] * cs.y + x1[e] * cs.x; }
                    st_bf4(dst + cb + i0, o0); st_bf4(dst + cb + 16 + i0, o1); } }
        EPI_END
    }
};
template <int MFR> struct EpiMla {
    static constexpr bool PERM = true, AFTER_DRAIN = false;
    const bf16_t* sgm; float* t;
    __device__ __forceinline__ void operator()(const f32x4 (&acc)[2][2][MFR][2], const pg8::Unit& u, int wr, int wc, int fr, int fq) const {
        EPI_ROWS_M(u.pm, MFR)
            const size_t off = (size_t)row * 1024 + u.pn * 256;
            EPI_COLS8 const u32x4 gw = *(const u32x4*)(sgm + off + col);
                *(f32x4*)(t + off + col) = (f32x4){bflo(gw.x), bfhi(gw.x), bflo(gw.y), bfhi(gw.y)} * v0; *(f32x4*)(t + off + col + 4) = (f32x4){bflo(gw.z), bfhi(gw.z), bflo(gw.w), bfhi(gw.w)} * v1; EPI_END
        EPI_END
    }
};
template <int MFR> struct EpiSsd {
    static constexpr bool PERM = true, AFTER_DRAIN = false;
    const bf16_t* sgs; const float* t; const float* ssq_y; bf16_t* merged;
    __device__ __forceinline__ void operator()(const f32x4 (&acc)[2][2][MFR][2], const pg8::Unit& u, int wr, int wc, int fr, int fq) const {
        EPI_ROWS_M(u.pm, MFR)
            float s = 0.f;
#pragma unroll
            for (int q = 0; q < 4; ++q) { const f32x4 a = *(const f32x4*)(ssq_y + (size_t)row * 16 + q * 4); s += (a.x + a.y) + (a.z + a.w); }
            const float rs = rsqrtf(s * (1.f / 1024.f) + EPS); const size_t off = (size_t)row * 1024 + u.pn * 256;
            EPI_COLS8 const u32x4 gw = *(const u32x4*)(sgs + off + col);
                st_bf8(merged + off + col, *(const f32x4*)(t + off + col) + (f32x4){bflo(gw.x), bfhi(gw.x), bflo(gw.y), bfhi(gw.y)} * (v0 * rs),
                       *(const f32x4*)(t + off + col + 4) + (f32x4){bflo(gw.z), bfhi(gw.z), bflo(gw.w), bfhi(gw.w)} * (v1 * rs)); EPI_END
        EPI_END
    }
};
template <int MFR> struct EpiOut {
    static constexpr bool PERM = true, AFTER_DRAIN = false;
    const float *xp, *xs, *mod, *gffn; float* x1; bf16_t* a1; float* ssq2;
    __device__ __forceinline__ void operator()(const f32x4 (&acc)[2][2][MFR][2], const pg8::Unit& u, int wr, int wc, int fr, int fq) const {
        EPI_ROWS_M(u.pm, MFR)
            const float* md = mod + grp_of_row(row) * 6144;
            const float* xr = row < RP ? xp + (size_t)row * DM : xs + (size_t)(row - RP) * DM; const size_t off = (size_t)row * 1024; float s = 0.f;
            EPI_COLS8
                const int c = u.pn * 256 + col;
                const f32x4 xa = __builtin_nontemporal_load((const f32x4*)(xr + c)) + *(const f32x4*)(md + 2048 + c) * v0, xb = __builtin_nontemporal_load((const f32x4*)(xr + c + 4)) + *(const f32x4*)(md + 2048 + c + 4) * v1;
                *(f32x4*)(x1 + off + c) = xa; *(f32x4*)(x1 + off + c + 4) = xb;
                s += ((xa.x * xa.x + xa.y * xa.y) + (xa.z * xa.z + xa.w * xa.w)) + ((xb.x * xb.x + xb.y * xb.y) + (xb.z * xb.z + xb.w * xb.w));
                st_bf8(a1 + off + c, xa * *(const f32x4*)(gffn + c) * (*(const f32x4*)(md + 4096 + c) + 1.f), xb * *(const f32x4*)(gffn + c + 4) * (*(const f32x4*)(md + 4096 + c + 4) + 1.f));
            EPI_END
            s = quad_sum16(s);
            if (fq == 0) ssq2[(size_t)row * 16 + u.pn * 4 + wc] = s;
        EPI_END
    }
};
struct EpiUp {
    static constexpr bool PERM = true, AFTER_DRAIN = false;
    const float *ssq2, *cup; bf16_t* uo; int pm_off;
    __device__ __forceinline__ void operator()(AccRef acc, const pg8::Unit& u, int wr, int wc, int fr, int fq) const {
        const int pmo = u.pm + pm_off; const int g = pmo < 32 ? 0 : 1 + ((pmo - 32) >> 3); const float* cu = cup + g * UPN + u.pn * 256;
        EPI_ROWS(pmo)
            float s = 0.f;
#pragma unroll
            for (int q = 0; q < 4; ++q) { const f32x4 a = *(const f32x4*)(ssq2 + (size_t)row * 16 + q * 4); s += (a.x + a.y) + (a.z + a.w); }
            const float rs = rsqrtf(s * (1.f / 1024.f) + EPS); bf16_t* dst = uo + (size_t)row * UPN + u.pn * 256;
            EPI_COLS8 st_bf8(dst + col, v0 * rs + *(const f32x4*)(cu + col), v1 * rs + *(const f32x4*)(cu + col + 4)); EPI_END
        EPI_END
    }
};
constexpr int CG_RB = 16;
struct CgW { float wg[3][8], wv[3][8], bg[8], bv[8]; };
__device__ __forceinline__ void cg_load_w(CgW& W, const float* fw, const float* fb, int c) {
#pragma unroll
    for (int k = 0; k < 3; ++k)
#pragma unroll
        for (int q = 0; q < 2; ++q) { const f32x4 a = *(const f32x4*)(fw + k * UPN + c + 4 * q), b = *(const f32x4*)(fw + k * UPN + DFF + c + 4 * q);
#pragma unroll
            for (int e = 0; e < 4; ++e) { W.wg[k][4 * q + e] = a[e]; W.wv[k][4 * q + e] = b[e]; } }
#pragma unroll
    for (int q = 0; q < 2; ++q) { const f32x4 a = *(const f32x4*)(fb + c + 4 * q), b = *(const f32x4*)(fb + DFF + c + 4 * q);
#pragma unroll
        for (int e = 0; e < 4; ++e) { W.bg[4 * q + e] = a[e]; W.bv[4 * q + e] = b[e]; } }
}
__device__ __forceinline__ float dpp_row_prev(float cur, float prv) {
    const int o = __builtin_amdgcn_update_dpp(0, __float_as_int(prv), 0x121, 0xf, 0xf, true);
    return __int_as_float(__builtin_amdgcn_update_dpp(o, __float_as_int(cur), 0x111, 0xf, 0xf, false)); }
__device__ __forceinline__ float dpp_row_next(float cur, float nxt) {
    const int o = __builtin_amdgcn_update_dpp(0, __float_as_int(nxt), 0x12F, 0xf, 0xf, true);
    return __int_as_float(__builtin_amdgcn_update_dpp(o, __float_as_int(cur), 0x101, 0xf, 0xf, false)); }
__device__ __forceinline__ void conv4_rows(float (&c)[4], float a0, float a1, float a2, float a3, float r0, float r1, float r2, float r3,
                                           float w0, float w1, float w2, float cs) {
    float t0, t1, t2, t3, z; const unsigned long long mlo = 0x0001000100010001ull, mhi = 0x8000800080008000ull;
    asm volatile(
        "v_cndmask_b32_e64 %[z], 0, %[w0], %[mlo]\n\t"
        "v_mul_f32 %[t0], %[a0], %[r0]\n\t" "v_mul_f32 %[t1], %[a1], %[r1]\n\t" "v_mul_f32 %[t2], %[a2], %[r2]\n\t" "v_mul_f32 %[t3], %[a3], %[r3]\n\t"
        "v_fma_f32 %[c0], %[w1], %[t0], %[cs]\n\t" "v_fma_f32 %[c1], %[w1], %[t1], %[cs]\n\t" "v_fma_f32 %[c2], %[w1], %[t2], %[cs]\n\t" "v_fma_f32 %[c3], %[w1], %[t3], %[cs]\n\t"
        "v_fmac_f32_dpp %[c0], %[t0], %[w0] row_shr:1 row_mask:0xf bank_mask:0xf bound_ctrl:1\n\t"
        "v_fmac_f32_dpp %[c1], %[t1], %[w0] row_shr:1 row_mask:0xf bank_mask:0xf bound_ctrl:1\n\t"
        "v_fmac_f32_dpp %[c2], %[t2], %[w0] row_shr:1 row_mask:0xf bank_mask:0xf bound_ctrl:1\n\t"
        "v_fmac_f32_dpp %[c3], %[t3], %[w0] row_shr:1 row_mask:0xf bank_mask:0xf bound_ctrl:1\n\t"
        "v_fmac_f32_dpp %[c0], %[t0], %[w2] row_shl:1 row_mask:0xf bank_mask:0xf bound_ctrl:1\n\t"
        "v_fmac_f32_dpp %[c1], %[t1], %[w2] row_shl:1 row_mask:0xf bank_mask:0xf bound_ctrl:1\n\t"
        "v_fmac_f32_dpp %[c2], %[t2], %[w2] row_shl:1 row_mask:0xf bank_mask:0xf bound_ctrl:1\n\t"
        "v_fmac_f32_dpp %[c3], %[t3], %[w2] row_shl:1 row_mask:0xf bank_mask:0xf bound_ctrl:1\n\t"
        "v_fmac_f32_dpp %[c1], %[t0], %[z] row_ror:1 row_mask:0xf bank_mask:0xf\n\t"
        "v_fmac_f32_dpp %[c2], %[t1], %[z] row_ror:1 row_mask:0xf bank_mask:0xf\n\t"
        "v_fmac_f32_dpp %[c3], %[t2], %[z] row_ror:1 row_mask:0xf bank_mask:0xf\n\t"
        "v_cndmask_b32_e64 %[z], 0, %[w2], %[mhi]\n\t"
        "v_fmac_f32_dpp %[c0], %[t1], %[z] row_ror:15 row_mask:0xf bank_mask:0xf\n\t"
        "v_fmac_f32_dpp %[c1], %[t2], %[z] row_ror:15 row_mask:0xf bank_mask:0xf\n\t"
        "v_fmac_f32_dpp %[c2], %[t3], %[z] row_ror:15 row_mask:0xf bank_mask:0xf"
        : [c0] "=&v"(c[0]), [c1] "=&v"(c[1]), [c2] "=&v"(c[2]), [c3] "=&v"(c[3]), [t0] "=&v"(t0), [t1] "=&v"(t1), [t2] "=&v"(t2), [t3] "=&v"(t3), [z] "=&v"(z)
        : [a0] "v"(a0), [a1] "v"(a1), [a2] "v"(a2), [a3] "v"(a3), [r0] "v"(r0), [r1] "v"(r1), [r2] "v"(r2), [r3] "v"(r3),
          [w0] "v"(w0), [w1] "v"(w1), [w2] "v"(w2), [cs] "v"(cs), [mlo] "s"(mlo), [mhi] "s"(mhi));
}
struct EpiUpGate {
    static constexpr bool PERM = true, AFTER_DRAIN = false;
#if defined(PG8_TIME) && PG8_TPH == 5
    static constexpr bool TIMED = true;
#endif
    static constexpr int PRE_SLOT = 1024, PRE_BYTES = 5120;
    const float *ssq2, *cup, *fcw, *cstp; bf16_t *ug, *halo;
    __device__ __forceinline__ void pre(const pg8::Unit& u, LAS unsigned char* slot, int wr, int wc, int lane) const {
        if (wr != 0) return;
        const int g = u.pm < 32 ? 0 : 1 + ((u.pm - 32) >> 3); const int cb = u.pn * 128 + wc * 32; const int a = lane >> 4, hv = (lane >> 3) & 1, c4 = lane & 7;
        const float* src = (a < 3 ? fcw + a * UPN : cstp + g * UPN) + hv * DFF + cb + c4 * 4;
        __builtin_amdgcn_global_load_lds((const unsigned*)src, (LAS unsigned*)(slot + wc * 1280), 16, 0, 0);
        if (lane < 16) __builtin_amdgcn_global_load_lds((const unsigned*)(cup + g * UPN + hv * DFF + cb + c4 * 4), (LAS unsigned*)(slot + wc * 1280 + 1024), 16, 0, 0);
    }
    __device__ __forceinline__ void operator()(const f32x4 (&acc)[2][2][4][2], const pg8::Unit& u, int wr, int wc, int fr, int fq, LAS unsigned char* slot) const {
        asm volatile("" : "+v"(fr), "+v"(fq));
        const int cb = u.pn * 128 + wc * 32;
        LAS const unsigned char* cl = slot + wc * 1280 + fq * 32;
        const char* sb = (const char*)(ssq2 + (size_t)(u.pm * 256 + wr * 64) * 16); const size_t slo = (unsigned)fr * 64u + (unsigned)fq * 16u;
        f32x4 raw[4];
#pragma unroll
        for (int m = 0; m < 4; ++m) raw[m] = *(const f32x4*)(sb + m * 1024 + slo);
#pragma unroll
        for (int ai = 0; ai < 2; ++ai) {
            const int row0 = u.pm * 256 + ai * 128 + wr * 64;
            float rsv[4];
#pragma unroll
            for (int m = 0; m < 4; ++m) rsv[m] = rsqrtf(quad_sum16((raw[m].x + raw[m].y) + (raw[m].z + raw[m].w)) * (1.f / 1024.f) + EPS);
            if (ai == 0) {
#pragma unroll
                for (int m = 0; m < 4; ++m) raw[m] = *(const f32x4*)(sb + 128 * 64 + m * 1024 + slo); }
            unsigned pk[4][4];
#ifdef CG_REP
            for (int rep = 0; rep < CG_REP; ++rep)
#endif
#pragma unroll
            for (int h = 0; h < 4; ++h) {
                f32x2 w0[2], w1[2], w2[2], cst[2];
#pragma unroll
                for (int hv = 0; hv < 2; ++hv) { const int co = hv * 128 + h * 8;
                    w0[hv] = *(LAS const f32x2*)(cl + co); w1[hv] = *(LAS const f32x2*)(cl + 256 + co); w2[hv] = *(LAS const f32x2*)(cl + 512 + co); cst[hv] = *(LAS const f32x2*)(cl + 768 + co); }
                float o[4][2];
#pragma unroll
                for (int e2 = 0; e2 < 2; ++e2) { const int n = h >> 1, e = (h & 1) * 2 + e2;
                    float cv[2][4];
#pragma unroll
                    for (int hv = 0; hv < 2; ++hv)
                        conv4_rows(cv[hv], acc[ai][hv][0][n][e], acc[ai][hv][1][n][e], acc[ai][hv][2][n][e], acc[ai][hv][3][n][e], rsv[0], rsv[1], rsv[2], rsv[3],
                                   w0[hv][e2], w1[hv][e2], w2[hv][e2], cst[hv][e2]);
#pragma unroll
                    for (int m = 0; m < 4; ++m) o[m][e2] = siluf(cv[0][m]) * cv[1][m];
                }
#pragma unroll
                for (int m = 0; m < 4; ++m) pk[m][h] = pk2(o[m][0], o[m][1]);
                __builtin_amdgcn_sched_barrier(0);
            }
            { char* ub = (char*)(ug + (size_t)row0 * DFF + cb); const size_t lo = (unsigned)fr * (unsigned)(DFF * 2) + (unsigned)fq * 16u;
#pragma unroll
                for (int m = 0; m < 4; ++m) { const bool edge = (m == 0 && fr == 0) || (m == 3 && fr == 15);
                    if (!edge) *(u32x4*)(ub + (size_t)m * 16 * DFF * 2 + lo) = (u32x4){pk[m][0], pk[m][1], pk[m][2], pk[m][3]}; } }
            const int slab = u.pm * 4 + ai * 2 + wr; char* hb = (char*)(halo + (size_t)slab * 4 * UPN + cb);
#pragma unroll
            for (int mm = 0; mm < 2; ++mm) { const int m = mm * 3; const bool act = mm == 0 ? (fr < 2) : (fr >= 14); const unsigned r4 = mm == 0 ? fr : fr - 12;
                if (act) { const size_t ho = r4 * (unsigned)(UPN * 2) + (unsigned)fq * 16u;
#pragma unroll
                    for (int hv = 0; hv < 2; ++hv) { const f32x4 c0 = *(LAS const f32x4*)(cl + 1024 + hv * 128), c1 = *(LAS const f32x4*)(cl + 1024 + hv * 128 + 16);
                        st_bf8((bf16_t*)(hb + hv * DFF * 2 + ho), acc[ai][hv][m][0] * rsv[m] + c0, acc[ai][hv][m][1] * rsv[m] + c1); } } }
        }
    }
};
__device__ __forceinline__ void fixup_rows(const Params& P, int row_lo, int row_hi, int tid) {
    if (tid >= DFF / 8) return;
    unsigned char* ws = P.ws; const bf16_t* halo = (const bf16_t*)(ws + WS_HALO); bf16_t* ug = (bf16_t*)(ws + WS_UG); const int c = tid * 8;
    CgW W; cg_load_w(W, P.in[I_FCW], P.in[I_FCB], c);
    const u32x4 zero = {0u, 0u, 0u, 0u};
    for (int k = row_lo / 64; k < row_hi / 64; ++k)
#pragma unroll
        for (int wh = 0; wh < 2; ++wh) {
            const int row = 64 * k + (wh ? 63 : 0); const int t = row < RP ? (row & 255) : ((row - RP) & 2047), L = row < RP ? SEQP : SEQS;
            const bf16_t* hp = nullptr; const bf16_t* hc; const bf16_t* hn = nullptr;
            if (wh == 0) { hc = halo + ((size_t)k * 4 + 0) * UPN; hn = halo + ((size_t)k * 4 + 1) * UPN; if (t > 0) hp = halo + ((size_t)(k - 1) * 4 + 3) * UPN; }
            else { hp = halo + ((size_t)k * 4 + 2) * UPN; hc = halo + ((size_t)k * 4 + 3) * UPN; if (t < L - 1) hn = halo + ((size_t)(k + 1) * 4 + 0) * UPN; }
            const u32x4 gp = hp ? *(const u32x4*)(hp + c) : zero, vp = hp ? *(const u32x4*)(hp + DFF + c) : zero;
            const u32x4 gc = *(const u32x4*)(hc + c), vc = *(const u32x4*)(hc + DFF + c);
            const u32x4 gn = hn ? *(const u32x4*)(hn + c) : zero, vn = hn ? *(const u32x4*)(hn + DFF + c) : zero;
            float a[8], b[8], x[8];
#pragma unroll
            for (int e = 0; e < 8; ++e) { a[e] = W.bg[e]; b[e] = W.bv[e]; }
            unpack8(gp, x);
#pragma unroll
            for (int e = 0; e < 8; ++e) a[e] += x[e] * W.wg[0][e];
            unpack8(gc, x);
#pragma unroll
            for (int e = 0; e < 8; ++e) a[e] += x[e] * W.wg[1][e];
            unpack8(gn, x);
#pragma unroll
            for (int e = 0; e < 8; ++e) a[e] += x[e] * W.wg[2][e];
            unpack8(vp, x);
#pragma unroll
            for (int e = 0; e < 8; ++e) b[e] += x[e] * W.wv[0][e];
            unpack8(vc, x);
#pragma unroll
            for (int e = 0; e < 8; ++e) b[e] += x[e] * W.wv[1][e];
            unpack8(vn, x);
#pragma unroll
            for (int e = 0; e < 8; ++e) b[e] += x[e] * W.wv[2][e];
            u32x4 o;
#pragma unroll
            for (int e = 0; e < 4; ++e) o[e] = pk2(siluf(a[2 * e]) * b[2 * e], siluf(a[2 * e + 1]) * b[2 * e + 1]);
            *(u32x4*)(ug + (size_t)row * DFF + c) = o;
        }
}

template <int MFR> struct EpiDown {
    static constexpr bool PERM = true, AFTER_DRAIN = false;
    const float* mod; float* x;
    __device__ __forceinline__ void operator()(const f32x4 (&acc)[2][2][MFR][2], const pg8::Unit& u, int wr, int wc, int fr, int fq) const {
        EPI_ROWS_M(u.pm, MFR)
            const float* g2 = mod + grp_of_row(row) * 6144 + 5120 + u.pn * 256;
            float* xr = x + (size_t)row * 1024 + u.pn * 256;
            EPI_COLS8 *(f32x4*)(xr + col) = *(const f32x4*)(xr + col) + *(const f32x4*)(g2 + col) * v0; *(f32x4*)(xr + col + 4) = *(const f32x4*)(xr + col + 4) + *(const f32x4*)(g2 + col + 4) * v1; EPI_END
        EPI_END
    }
};

struct EpiDownNorm {
    static constexpr bool PERM = true, AFTER_DRAIN = true;
    const float* mod; float* x; const float* gfin; float* xbuf; unsigned* cnt;
    __device__ __forceinline__ void fused(f32x4 (&acc)[2][2][3][2], const pg8::Unit& u, int wr, int wc, int fr, int fq, LAS unsigned char* lds, int wid, int lane) const {
        LAS float* Pt = (LAS float*)lds;
        LAS float* St = (LAS float*)(lds + 4096);
        EPI_ROWS_M(u.pm, 3)
            const float* g2 = mod + grp_of_row(row) * 6144 + 5120 + u.pn * 256; const float* xr = x + (size_t)row * 1024 + u.pn * 256; float s = 0.f;
#pragma unroll
            for (int bj = 0; bj < 2; ++bj) { const int col = bj * 128 + wc * 32 + fq * 8;
                const f32x4 a = *(const f32x4*)(xr + col) + *(const f32x4*)(g2 + col) * acc[ai][bj][m][0], b = *(const f32x4*)(xr + col + 4) + *(const f32x4*)(g2 + col + 4) * acc[ai][bj][m][1];
                acc[ai][bj][m][0] = a; acc[ai][bj][m][1] = b;
                s += ((a.x * a.x + a.y * a.y) + (a.z * a.z + a.w * a.w)) + ((b.x * b.x + b.y * b.y) + (b.z * b.z + b.w * b.w)); }
            s = quad_sum16(s);
            if (fq == 0) Pt[(ai * 96 + wr * 48 + m * 16 + fr) * 4 + wc] = s;
        EPI_END
        asm volatile("s_waitcnt lgkmcnt(0)" ::: "memory"); __builtin_amdgcn_s_barrier(); asm volatile("" ::: "memory");
        const int rloc = wid * 32 + (lane & 31);
        if (lane < 32 && rloc < 192) { const float tot = (Pt[rloc * 4 + 0] + Pt[rloc * 4 + 1]) + (Pt[rloc * 4 + 2] + Pt[rloc * 4 + 3]);
            __hip_atomic_store(xbuf + ((size_t)(u.pm * 192 + rloc) * 4 + u.pn), tot, __ATOMIC_RELAXED, __HIP_MEMORY_SCOPE_AGENT); }
        asm volatile("s_waitcnt vmcnt(0)" ::: "memory");
        if (lane == 0) __hip_atomic_fetch_add(cnt + 16 * u.pm, 1u, __ATOMIC_RELAXED, __HIP_MEMORY_SCOPE_AGENT);
        if (wid == 0) { unsigned sp = 0;
            while ((unsigned)__builtin_amdgcn_readfirstlane(__hip_atomic_load(cnt + 16 * u.pm, __ATOMIC_RELAXED, __HIP_MEMORY_SCOPE_AGENT)) < 32u) { __builtin_amdgcn_s_sleep(2); if (++sp > (1u << 22)) break; }
            __builtin_amdgcn_fence(__ATOMIC_ACQUIRE, "agent"); }
        asm volatile("s_waitcnt vmcnt(0) lgkmcnt(0)" ::: "memory"); __builtin_amdgcn_s_barrier(); asm volatile("" ::: "memory");
        if (lane < 32 && rloc < 192) { const float* sl = xbuf + (size_t)(u.pm * 192 + rloc) * 4; float tot = 0.f;
#pragma unroll
            for (int t = 0; t < 4; ++t) tot += __hip_atomic_load(sl + t, __ATOMIC_RELAXED, __HIP_MEMORY_SCOPE_AGENT);
            St[rloc] = rsqrtf(tot * (1.f / 1024.f) + EPS); }
        asm volatile("s_waitcnt lgkmcnt(0)" ::: "memory"); __builtin_amdgcn_s_barrier(); asm volatile("" ::: "memory");
        EPI_ROWS_M(u.pm, 3)
            const float rs = St[ai * 96 + wr * 48 + m * 16 + fr]; float* xr = x + (size_t)row * 1024 + u.pn * 256; const float* gf = gfin + u.pn * 256;
#pragma unroll
            for (int bj = 0; bj < 2; ++bj) { const int col = bj * 128 + wc * 32 + fq * 8;
                *(f32x4*)(xr + col) = acc[ai][bj][m][0] * rs * *(const f32x4*)(gf + col); *(f32x4*)(xr + col + 4) = acc[ai][bj][m][1] * rs * *(const f32x4*)(gf + col + 4); }
        EPI_END
    }
};

struct Gemm2Order {
    int G, c;
    __device__ void init(int G_, int c_) { G = G_; c = c_; }
    __device__ bool next(int i, pg8::Unit& u) const {
        const int L = i * G + c; if (L >= 608) return false;
        if (L < 416) { u.pm = 48 + L % 52; u.pn = 6 + L / 52; } else { const int l = L - 416; u.pm = l % 48; u.pn = l / 48; }
        return true;
    }
    __device__ __forceinline__ void a_ready(const pg8::Unit&) const {}
    __device__ __forceinline__ void done(const pg8::Unit&) const {}
};
struct EpiG2 {
    static constexpr bool PERM = true, AFTER_DRAIN = false;
    bf16_t *qn, *kv; const float *ssq_cq, *ssq_ckv;
    __device__ __forceinline__ void operator()(AccRef acc, const pg8::Unit& u, int wr, int wc, int fr, int fq) const {
        if (u.pn >= 6) {
            const int pm = u.pm - 48, pn = u.pn - 6;
            EPI_ROWS(pm)
                const f32x4 sq = *(const f32x4*)(ssq_ckv + (size_t)row * 4); const float rs = rsqrtf(((sq.x + sq.y) + (sq.z + sq.w)) * (1.f / 256.f) + EPS);
                bf16_t* dst = kv + (size_t)row * 2048 + pn * 256;
                EPI_COLS8 st_bf8(dst + col, v0 * rs, v1 * rs); EPI_END
            EPI_END
        } else {
            EPI_ROWS(u.pm)
                const f32x4 sq = *(const f32x4*)(ssq_cq + (size_t)row * 4); const float rs = rsqrtf(((sq.x + sq.y) + (sq.z + sq.w)) * (1.f / 256.f) + EPS);
                bf16_t* dst = qn + (size_t)row * 1024 + u.pn * 256;
                EPI_COLS8 st_bf8(dst + col, v0 * rs, v1 * rs); EPI_END
            EPI_END
        }
    }
};
static_assert(WS_CKVA - WS_CQ == (size_t)48 * 256 * 256 * 2 && WS_WUKV - WS_WUQ == (size_t)6 * 256 * 256 * 2, "GEMM2 addressing");

struct PairOrder {
    int nwg, G, c;
    __device__ void init(int G_, int c_) { nwg = 256; G = G_; c = c_; }
    __device__ bool next(int i, pg8::Unit& u) const {
        const int k = i >> 1; const long L = (long)k * G + c; if (L >= nwg) return false;
        int wgid = (int)L; { const int q = nwg / 8, xcd = wgid % 8, off = wgid / 8; wgid = xcd * q + off; }
        const int nig = 8 * 4, gid = wgid / nig, fm = gid * 8; const int pm = fm + ((wgid % nig) % 8), pn = (wgid % nig) / 8;
        if ((i & 1) == 0) { u.pm = pm + 160; u.pn = pn; } else { u.pm = pm; u.pn = pn + 4; }
        return true;
    }
    __device__ __forceinline__ void a_ready(const pg8::Unit&) const {}
    __device__ __forceinline__ void done(const pg8::Unit&) const {}
};
struct EpiMerged {
    static constexpr bool PERM = true, AFTER_DRAIN = false;
    struct State { u32x4 t[2][3][2]; };
    const bf16_t *sgm, *sgs; const float* ssq_y; bf16_t* merged;
    __device__ __forceinline__ void operator()(const f32x4 (&acc)[2][2][3][2], const pg8::Unit& u, int wr, int wc, int fr, int fq, State& st) const {
        if (u.pn < 4) {
            const int pm = u.pm - 160;
            EPI_ROWS_M(pm, 3)
                const size_t off = (size_t)row * 1024 + u.pn * 256;
                EPI_COLS8 const u32x4 gw = __builtin_nontemporal_load((const u32x4*)(sgm + off + col));
                    const f32x4 a = (f32x4){bflo(gw.x), bfhi(gw.x), bflo(gw.y), bfhi(gw.y)} * v0, b = (f32x4){bflo(gw.z), bfhi(gw.z), bflo(gw.w), bfhi(gw.w)} * v1;
                    st.t[ai][m][bj] = (u32x4){pk2(a.x, a.y), pk2(a.z, a.w), pk2(b.x, b.y), pk2(b.z, b.w)}; EPI_END
            EPI_END
        } else {
            const int pn = u.pn - 4;
            EPI_ROWS_M(u.pm, 3)
                float s = 0.f;
#pragma unroll
                for (int q = 0; q < 4; ++q) { const f32x4 a = *(const f32x4*)(ssq_y + (size_t)row * 16 + q * 4); s += (a.x + a.y) + (a.z + a.w); }
                const float rs = rsqrtf(s * (1.f / 1024.f) + EPS); const size_t off = (size_t)row * 1024 + pn * 256;
                EPI_COLS8 const u32x4 gw = __builtin_nontemporal_load((const u32x4*)(sgs + off + col)); const u32x4 tw = st.t[ai][m][bj];
                    st_bf8(merged + off + col, (f32x4){bflo(tw.x), bfhi(tw.x), bflo(tw.y), bfhi(tw.y)} + (f32x4){bflo(gw.x), bfhi(gw.x), bflo(gw.y), bfhi(gw.y)} * (v0 * rs),
                           (f32x4){bflo(tw.z), bfhi(tw.z), bflo(tw.w), bfhi(tw.w)} + (f32x4){bflo(gw.z), bfhi(gw.z), bflo(gw.w), bfhi(gw.w)} * (v1 * rs)); EPI_END
            EPI_END
        }
    }
};
static_assert(WS_QN - WS_Z == (size_t)160 * 192 * 1024 * 2 && WS_WOSSD - WS_WOMLA == (size_t)4 * 256 * 1024 * 2, "GEMM3 pair addressing");

template <class Epi>
__device__ __forceinline__ void run_gemm(LAS unsigned char* lds, const bf16_t* A, const bf16_t* Bt, int M, int N, int K, int G, int c, const Epi& E) {
    pg8::Gemm g{A, Bt, M, N, K}; pg8::StaticOrder S; S.init(M, N, G, c);
    pg8::gemm_phase<Epi, pg8::StaticOrder, PG8_ALIGN, PG8_SP2>(lds, g, S, E);
}
template <class Epi>
__device__ __forceinline__ void run_gemm192(LAS unsigned char* lds, const bf16_t* A, const bf16_t* Bt, int M, int N, int K, int G, int c, const Epi& E) {
    pg8::Gemm g{A, Bt, M, N, K}; pg8::StaticOrder S; S.init(M, N, G, c, 192);
    pg8::gemm_phase<Epi, pg8::StaticOrder, PG8_ALIGN, PG8_SP2, 3>(lds, g, S, E);
}

__device__ __forceinline__ void norm_new_ckv(const Params& P, int lane, int wave, int G) {
    const int gw = blockIdx.x * 8 + wave, NGW = G * 8;
    float* nck = P.out + O_CKV; const float* ssq = (const float*)(P.ws + WS_SSQ_CKV); const float* gk = P.in[I_GKV];
    for (int row = gw; row < RP; row += NGW) {
        const f32x4 sq = *(const f32x4*)(ssq + (size_t)row * 4); const float rs = rsqrtf(((sq.x + sq.y) + (sq.z + sq.w)) * (1.f / 256.f) + EPS);
        f32x4* p = (f32x4*)(nck + (size_t)row * 256) + lane; *p = *p * rs * *(const f32x4*)(gk + 4 * lane);
    }
}
namespace att {
using s16x4 = __attribute__((ext_vector_type(4))) short;
using f32x16 = __attribute__((ext_vector_type(16))) float;
constexpr int QBLK = 32, KVBLK = 64;
constexpr float SCALE = ATT_SCALE, THR = 8.f;
constexpr int SHM_V = 16384, SHM_K = 16384, SHM_KR = 8192;
constexpr int L_V = 0, L_K = 2 * SHM_V, L_KR = L_K + 2 * SHM_K, L_WS = L_KR + 2 * SHM_KR, L_QR = L_WS + 8 * 64 * 4, L_END = L_QR + 8 * 4096;
#define KSWZ(row, colB) ((row) * 256 + ((colB) ^ (((row) & 7) << 4)))
#define KRSWZ(row, colB) ((row) * 128 + ((colB) ^ ((((row) >> 1) & 7) << 4)))
#define SBAR() __builtin_amdgcn_sched_barrier(0)
__device__ __forceinline__ int crow(int r, int hi) { return (r & 3) + 8 * (r >> 2) + 4 * hi; }
__device__ __forceinline__ unsigned cvtpk(float lo, float hi) { unsigned r; asm volatile("v_cvt_pk_bf16_f32 %0, %1, %2" : "=v"(r) : "v"(lo), "v"(hi)); return r; }
__device__ __forceinline__ void partialSM(f32x16& p0, f32x16& p1, float& m_reg, float& mn, float& alpha) {
  constexpr float C = SCALE * 1.4426950408889634f;
  float pmax = p0[0];
#pragma unroll
  for (int r = 1; r < 16; ++r) pmax = fmaxf(pmax, p0[r]);
#pragma unroll
  for (int r = 0; r < 16; ++r) pmax = fmaxf(pmax, p1[r]);
  { auto rr = __builtin_amdgcn_permlane32_swap(__float_as_uint(pmax), __float_as_uint(pmax), false, false);
    pmax = fmaxf(__uint_as_float(rr[0]), __uint_as_float(rr[1])); }
  if (__builtin_expect(__all(pmax - m_reg <= THR / SCALE), 1)) { mn = m_reg; alpha = 1.f; }
  else { mn = fmaxf(m_reg, pmax); alpha = __builtin_amdgcn_exp2f((m_reg - mn) * C); m_reg = mn; }
  float mnC = -mn * C;
#pragma unroll
  for (int r = 0; r < 16; ++r) p0[r] = fmaf(p0[r], C, mnC);
#pragma unroll
  for (int r = 0; r < 16; ++r) p1[r] = fmaf(p1[r], C, mnC);
#pragma unroll
  for (int r = 0; r < 16; ++r) p0[r] = __builtin_amdgcn_exp2f(p0[r]);
}
__device__ __forceinline__ void finishSM(f32x16& p0, f32x16& p1, float alpha, float& l_reg, bf16x8& pa0, bf16x8& pa1, bf16x8& pa2, bf16x8& pa3) {
#pragma unroll
  for (int r = 0; r < 16; ++r) p1[r] = __builtin_amdgcn_exp2f(p1[r]);
  float ps = 0;
#pragma unroll
  for (int r = 0; r < 16; ++r) ps += p0[r];
#pragma unroll
  for (int r = 0; r < 16; ++r) ps += p1[r];
  { auto rr = __builtin_amdgcn_permlane32_swap(__float_as_uint(ps), __float_as_uint(ps), false, false);
    ps = __uint_as_float(rr[0]) + __uint_as_float(rr[1]); }
  l_reg = l_reg * alpha + ps;
#define PK4(P, BASE, OUT) do { unsigned a0 = cvtpk(P[BASE + 0], P[BASE + 1]), a1 = cvtpk(P[BASE + 2], P[BASE + 3]);   \
    unsigned b0 = cvtpk(P[BASE + 4], P[BASE + 5]), b1 = cvtpk(P[BASE + 6], P[BASE + 7]);                              \
    auto r0 = __builtin_amdgcn_permlane32_swap(a0, b0, false, false); auto r1 = __builtin_amdgcn_permlane32_swap(a1, b1, false, false); \
    u32x4 w = {r0[0], r1[0], r0[1], r1[1]}; OUT = *reinterpret_cast<bf16x8*>(&w); } while (0)
  PK4(p0, 0, pa0); PK4(p0, 8, pa1); PK4(p1, 0, pa2); PK4(p1, 8, pa3);
#undef PK4
}
__device__ __forceinline__ void qkt(f32x16& p0, f32x16& p1, const LAS char* Ks, const LAS char* Krs, const bf16x8* qr, const LAS char* qrl, int r32, int hi) {
  p0 = f32x16{}; p1 = f32x16{};
#pragma unroll
  for (int d0 = 0; d0 < 8; ++d0) { const int cb = (d0 * 16 + hi * 8) * 2;
    const bf16x8 b0 = *reinterpret_cast<const LAS bf16x8*>(Ks + KSWZ(r32, cb));
    const bf16x8 b1 = *reinterpret_cast<const LAS bf16x8*>(Ks + KSWZ(32 + r32, cb));
    p0 = __builtin_amdgcn_mfma_f32_32x32x16_bf16(b0, qr[d0], p0, 0, 0, 0);
    p1 = __builtin_amdgcn_mfma_f32_32x32x16_bf16(b1, qr[d0], p1, 0, 0, 0); }
#pragma unroll
  for (int d0 = 0; d0 < 4; ++d0) { const int cb = (d0 * 16 + hi * 8) * 2;
    const bf16x8 b0 = *reinterpret_cast<const LAS bf16x8*>(Krs + KRSWZ(r32, cb));
    const bf16x8 b1 = *reinterpret_cast<const LAS bf16x8*>(Krs + KRSWZ(32 + r32, cb));
    const bf16x8 qq = *reinterpret_cast<const LAS bf16x8*>(qrl + d0 * 1024);
    p0 = __builtin_amdgcn_mfma_f32_32x32x16_bf16(b0, qq, p0, 0, 0, 0);
    p1 = __builtin_amdgcn_mfma_f32_32x32x16_bf16(b1, qq, p1, 0, 0, 0); }
}
__device__ __forceinline__ int v_st(int k, int c) { const int kk = (k & ~0xC) | ((k & 4) << 1) | ((k & 8) >> 1); return ((kk >> 3) * 4 + (c >> 5)) * 512 + ((kk & 7) * 32 + (c & 31)) * 2; }
__device__ __forceinline__ int v_rd_base(int lane) { return ((lane & 3) << 3) | (((lane >> 2) & 3) << 6) | (((lane >> 4) & 1) << 5) | (((lane >> 5) & 1) << 8); }
constexpr int v_rd_off(int d0, int ks, int half) { return d0 * 512 + ks * 4096 + half * 2048; }
template <int OFF> __device__ __forceinline__ s16x4 tr_read(int vb) {
  s16x4 r; asm volatile("ds_read_b64_tr_b16 %0, %1 offset:%2" : "=&v"(r) : "v"(vb), "i"(OFF) : "memory"); return r;
}
template <int D0> __device__ __forceinline__ void pv_one(f32x16& od, int vb, bf16x8 pa0, bf16x8 pa1, bf16x8 pa2, bf16x8 pa3) {
  const s16x4 l0 = tr_read<v_rd_off(D0, 0, 0)>(vb), h0 = tr_read<v_rd_off(D0, 0, 1)>(vb), l1 = tr_read<v_rd_off(D0, 1, 0)>(vb), h1 = tr_read<v_rd_off(D0, 1, 1)>(vb);
  const s16x4 l2 = tr_read<v_rd_off(D0, 2, 0)>(vb), h2 = tr_read<v_rd_off(D0, 2, 1)>(vb), l3 = tr_read<v_rd_off(D0, 3, 0)>(vb), h3 = tr_read<v_rd_off(D0, 3, 1)>(vb);
  asm volatile("s_waitcnt lgkmcnt(0)" ::: "memory"); SBAR();
#define PK(L, H) (bf16x8){L[0], L[1], L[2], L[3], H[0], H[1], H[2], H[3]}
  od = __builtin_amdgcn_mfma_f32_32x32x16_bf16(pa0, PK(l0, h0), od, 0, 0, 0);
  od = __builtin_amdgcn_mfma_f32_32x32x16_bf16(pa1, PK(l1, h1), od, 0, 0, 0);
  od = __builtin_amdgcn_mfma_f32_32x32x16_bf16(pa2, PK(l2, h2), od, 0, 0, 0);
  od = __builtin_amdgcn_mfma_f32_32x32x16_bf16(pa3, PK(l3, h3), od, 0, 0, 0);
#undef PK
}
__device__ __forceinline__ void pv_d0(f32x16* o, int vb, bf16x8 pa0, bf16x8 pa1, bf16x8 pa2, bf16x8 pa3) {
  pv_one<0>(o[0], vb, pa0, pa1, pa2, pa3); pv_one<1>(o[1], vb, pa0, pa1, pa2, pa3); pv_one<2>(o[2], vb, pa0, pa1, pa2, pa3); pv_one<3>(o[3], vb, pa0, pa1, pa2, pa3);
}
__device__ __forceinline__ void attn_unit(const bf16_t* __restrict__ Qn, const bf16_t* __restrict__ Qr, const bf16_t* __restrict__ Kh, const bf16_t* __restrict__ Vh,
                                          const bf16_t* __restrict__ Krh, bf16_t* Ob, int seq, LAS char* lds, int tid) {
  constexpr int LDQ = 1024, LDQR = 512, LDK = 2048, LDKR = 64, LDO = 1024;
  const int wid = tid >> 6, lane = tid & 63, r32 = lane & 31, hi = lane >> 5;
  LAS char* V_lds = lds + L_V; LAS char* K_lds = lds + L_K; LAS char* KR_lds = lds + L_KR;
  LAS float* wsf = (LAS float*)(lds + L_WS) + wid * 64; LAS float* li_l = wsf; LAS float* al_l = wsf + 32;
  float m_reg = -1e30f, l_reg = 0; f32x16 o[4] = {}; bf16x8 qr[8];
  LAS char* qrl = lds + L_QR + wid * 4096 + lane * 16;
  { const unsigned qo = (unsigned)((wid * QBLK + r32) * LDQ + hi * 8);
#pragma unroll
    for (int d0 = 0; d0 < 8; ++d0) qr[d0] = *reinterpret_cast<const bf16x8*>(Qn + (qo + d0 * 16));
    const unsigned qo2 = (unsigned)((wid * QBLK + r32) * LDQR + hi * 8);
#pragma unroll
    for (int d0 = 0; d0 < 4; ++d0) *reinterpret_cast<LAS bf16x8*>(qrl + d0 * 1024) = *reinterpret_cast<const bf16x8*>(Qr + (qo2 + d0 * 16)); }
  const int sr = tid >> 4, sc = (tid & 15) * 8, vst0 = v_st(sr, sc), vst1 = v_st(32 + sr, sc);
  const int rr_ = tid >> 3, rc_ = (tid & 7) * 8, krst = KRSWZ(rr_, rc_ * 2);
  const int vb0 = (int)(unsigned)(uintptr_t)V_lds + v_rd_base(lane);
  constexpr int SDEPTH = 1;
  struct { bf16x8 vs0, vs1, ks0, ks1, kr; } sr_[SDEPTH];
  const unsigned kvo = (unsigned)(sr * LDK + sc), kro = (unsigned)(rr_ * LDKR + rc_);
#define SLOAD(i, k0) do { const bf16_t* vp_ = Vh + (size_t)(k0) * LDK; const bf16_t* kp_ = Kh + (size_t)(k0) * LDK; const bf16_t* rp_ = Krh + (size_t)(k0) * LDKR; \
    sr_[i].vs0 = *reinterpret_cast<const bf16x8*>(vp_ + kvo); sr_[i].vs1 = *reinterpret_cast<const bf16x8*>(vp_ + (kvo + 32u * LDK)); \
    sr_[i].ks0 = *reinterpret_cast<const bf16x8*>(kp_ + kvo); sr_[i].ks1 = *reinterpret_cast<const bf16x8*>(kp_ + (kvo + 32u * LDK)); \
    sr_[i].kr = *reinterpret_cast<const bf16x8*>(rp_ + kro); } while (0)
#define SWRITE(b, i) do { *(LAS bf16x8*)(V_lds + (b) * SHM_V + vst0) = sr_[i].vs0; *(LAS bf16x8*)(V_lds + (b) * SHM_V + vst1) = sr_[i].vs1; const int kc = sc * 2; \
    *(LAS bf16x8*)(K_lds + (b) * SHM_K + KSWZ(sr, kc)) = sr_[i].ks0; *(LAS bf16x8*)(K_lds + (b) * SHM_K + KSWZ(32 + sr, kc)) = sr_[i].ks1; \
    *(LAS bf16x8*)(KR_lds + (b) * SHM_KR + krst) = sr_[i].kr; } while (0)
#define SWAIT() do { if constexpr (SDEPTH == 2) asm volatile("s_waitcnt vmcnt(5)" ::: "memory"); else asm volatile("s_waitcnt vmcnt(0)" ::: "memory"); } while (0)
#define RESC(a) do { if (__any((a) < 1.f)) { if (hi == 0) al_l[r32] = (a); asm volatile("s_waitcnt lgkmcnt(0)" ::: "memory"); \
    _Pragma("unroll") for (int d = 0; d < 4; ++d) _Pragma("unroll") for (int r = 0; r < 16; ++r) o[d][r] *= al_l[crow(r, hi)]; } } while (0)
  f32x16 pA0, pA1, pB0, pB1; float mnA, mnB, alA, alB; bf16x8 pa0, pa1, pa2, pa3; const int NTL = seq / KVBLK;
  constexpr int SE = 0, SO = SDEPTH - 1;
  SLOAD(SE, 0); asm volatile("s_waitcnt vmcnt(0)" ::: "memory"); SWRITE(0, SE); __syncthreads();
  qkt(pA0, pA1, K_lds, KR_lds, qr, qrl, r32, hi); partialSM(pA0, pA1, m_reg, mnA, alA);
  SLOAD(SO, KVBLK); if constexpr (SDEPTH == 2) { if (2 < NTL) SLOAD(SE, 2 * KVBLK); }
  SWAIT(); SWRITE(1, SO); __syncthreads();
  for (int j = 1; j + 1 < NTL; j += 2) {
    SBAR(); qkt(pB0, pB1, K_lds + SHM_K, KR_lds + SHM_KR, qr, qrl, r32, hi);
    finishSM(pA0, pA1, alA, l_reg, pa0, pa1, pa2, pa3); SBAR();
    SLOAD(SO, (j + SDEPTH) * KVBLK); SBAR();
    pv_d0(o, vb0, pa0, pa1, pa2, pa3); partialSM(pB0, pB1, m_reg, mnB, alB);
    __syncthreads(); SWAIT(); SWRITE(0, SE);
    RESC(alB); __syncthreads();
    SBAR(); qkt(pA0, pA1, K_lds, KR_lds, qr, qrl, r32, hi);
    finishSM(pB0, pB1, alB, l_reg, pa0, pa1, pa2, pa3); SBAR();
    if (SDEPTH == 1 || j + 3 < NTL) SLOAD(SE, (j + 1 + SDEPTH) * KVBLK); SBAR();
    pv_d0(o, vb0 + SHM_V, pa0, pa1, pa2, pa3); partialSM(pA0, pA1, m_reg, mnA, alA);
    __syncthreads(); SWAIT(); SWRITE(1, SO);
    RESC(alA); __syncthreads();
  }
  SBAR(); qkt(pB0, pB1, K_lds + SHM_K, KR_lds + SHM_KR, qr, qrl, r32, hi);
  finishSM(pA0, pA1, alA, l_reg, pa0, pa1, pa2, pa3); SBAR();
  pv_d0(o, vb0, pa0, pa1, pa2, pa3); partialSM(pB0, pB1, m_reg, mnB, alB);
  __syncthreads(); RESC(alB);
  finishSM(pB0, pB1, alB, l_reg, pa0, pa1, pa2, pa3); SBAR();
  pv_d0(o, vb0 + SHM_V, pa0, pa1, pa2, pa3);
  if (hi == 0) li_l[r32] = l_reg; asm volatile("s_waitcnt lgkmcnt(0)" ::: "memory");
  float rli[16];
#pragma unroll
  for (int r = 0; r < 16; ++r) rli[r] = __builtin_amdgcn_rcpf(li_l[crow(r, hi)]);
#pragma unroll
  for (int r = 0; r < 16; ++r) { const unsigned oo = (unsigned)((wid * QBLK + crow(r, hi)) * LDO + r32);
#pragma unroll
    for (int d0 = 0; d0 < 4; ++d0) Ob[oo + d0 * 32] = (bf16_t)f2bf(o[d0][r] * rli[r]); }
  __syncthreads();
#undef SLOAD
#undef SWRITE
#undef SWAIT
#undef RESC
}
}

namespace ssd {
typedef short v4i16_t __attribute__((ext_vector_type(4)));
constexpr int RSB = 144;
constexpr int TB = 128 * RSB;
constexpr int L_X = 0, L_B = TB, L_C = 2 * TB, L_HF = 3 * TB, L_HB = 3 * TB + 64 * RSB, L_ARR = 3 * TB + 128 * RSB, L_SC = L_ARR + 2048, L_END = L_SC + 64;
struct UnitInfo { int b, c, h, nc, row0; bool smp; };
__device__ __forceinline__ UnitInfo decode(int u) { UnitInfo I; if (u < 512) { I.smp = true; I.b = u >> 8; I.c = (u >> 4) & 15; I.h = u & 15; I.nc = 16; I.row0 = RP + I.b * SEQS + I.c * 128; }
    else { const int q = u - 512; I.smp = false; I.b = q >> 5; I.c = (q >> 4) & 1; I.h = q & 15; I.nc = 2; I.row0 = I.b * SEQP + I.c * 128; } return I; }
__device__ __forceinline__ int unit_id(bool smp, int b, int c, int h) { return smp ? ((b * 16 + c) * 16 + h) : 512 + ((b * 2 + c) * 16 + h); }
__device__ __forceinline__ bf16x8 tr2(const LAS char* p0, const LAS char* p1) {
    const v4i16_t a = __builtin_amdgcn_ds_read_tr16_b64_v4i16((LAS v4i16_t*)p0), b = __builtin_amdgcn_ds_read_tr16_b64_v4i16((LAS v4i16_t*)p1);
    return (bf16x8){a[0], a[1], a[2], a[3], b[0], b[1], b[2], b[3]};
}
__device__ __forceinline__ float wave_incl_scan(float v, int lane) {
#pragma unroll
    for (int o = 1; o < 64; o <<= 1) { const float t = __shfl_up(v, o); if (lane >= o) v += t; }
    return v;
}
__device__ __forceinline__ void chunk_scalars(const float* dt, int row0, int h, float Af, float Ab, LAS f32x4* arr, LAS float* sc, int lane) {
    const float df0 = dt[(size_t)(row0 + lane) * 32 + h], df1 = dt[(size_t)(row0 + 64 + lane) * 32 + h];
    const float db0 = dt[(size_t)(row0 + lane) * 32 + 16 + h], db1 = dt[(size_t)(row0 + 64 + lane) * 32 + 16 + h];
    const float af0 = df0 * Af, af1 = df1 * Af, ab0 = db0 * Ab, ab1 = db1 * Ab;
    const float s0 = wave_incl_scan(af0, lane), t0 = __shfl(s0, 63), s1 = wave_incl_scan(af1, lane) + t0;
    const float r0 = wave_incl_scan(ab0, lane), u0 = __shfl(r0, 63), r1 = wave_incl_scan(ab1, lane) + u0, tot = __shfl(r1, 63);
    arr[lane] = (f32x4){s0, tot - (r0 - ab0), df0, db0};
    arr[64 + lane] = (f32x4){s1, tot - (r1 - ab1), df1, db1};
    if (lane == 63) { sc[0] = s1; sc[1] = tot; }
}
constexpr int G_B = 0, G_C = TB, G_X = 2 * TB, G_ARR = 6 * TB, G_SC = G_ARR + 4 * 2048, G_END = G_SC + 64;
struct GInfo { int b, c, g, nc, row0; bool smp; };
__device__ __forceinline__ GInfo gdecode(int gu) { GInfo I; if (gu < 128) { I.smp = true; I.b = gu >> 6; I.c = (gu >> 2) & 15; I.g = gu & 3; I.nc = 16; I.row0 = RP + I.b * SEQS + I.c * 128; }
    else { const int q = gu - 128; I.smp = false; I.b = q >> 3; I.c = (q >> 2) & 1; I.g = q & 3; I.nc = 2; I.row0 = I.b * SEQP + I.c * 128; } return I; }
template <bool WITH_C>
__device__ __forceinline__ void stage_group(const Params& P, const GInfo& I, LAS char* lds, int tid) {
    const bf16_t* xbc = (const bf16_t*)(P.ws + WS_XBC); const int lane = tid & 63, wave = tid >> 6;
    if (wave >= 6) {
        const float* dt = (const float*)(P.ws + WS_DT);
#pragma unroll 1
        for (int q = 0; q < 2; ++q) { const int hl = 2 * (wave - 6) + q, h = 4 * I.g + hl;
            chunk_scalars(dt, I.row0, h, -__expf(P.in[I_ALOG][h]), -__expf(P.in[I_ALOG][16 + h]), (LAS f32x4*)(lds + G_ARR + hl * 2048), (LAS float*)(lds + G_SC + hl * 16), lane); }
        return;
    }
    if (!WITH_C && wave == 5) return;
    const int p8 = lane & 7, rs = lane >> 3;
    const int cbase = (wave == 0 ? 1024 + I.g * 64 : wave == 5 ? 1280 + I.g * 64 : (4 * I.g + wave - 1) * 64) + p8 * 8;
    const int lbase = (wave == 0 ? G_B : wave == 5 ? G_C : G_X + (wave - 1) * TB) + p8 * 16;
    const float* cw = P.in[I_CONVW]; const float* cb = P.in[I_CONVB];
    float w[3][8], bb[8];
#pragma unroll
    for (int q = 0; q < 2; ++q) { const f32x4 b4 = *(const f32x4*)(cb + cbase + 4 * q);
#pragma unroll
        for (int e = 0; e < 4; ++e) bb[4 * q + e] = b4[e];
#pragma unroll
        for (int k = 0; k < 3; ++k) { const f32x4 a = *(const f32x4*)(cw + k * 1536 + cbase + 4 * q);
#pragma unroll
            for (int e = 0; e < 4; ++e) w[k][4 * q + e] = a[e]; } }
    const int r0 = rs * 16; const bf16_t* xr = xbc + (size_t)(I.row0 + r0) * 1536 + cbase;
    const bool first = (I.c == 0 && rs == 0), last = (I.c == I.nc - 1 && rs == 7);
    const u32x4 zero = {0u, 0u, 0u, 0u};
    u32x4 rows[18];
    rows[0] = first ? zero : *(const u32x4*)(xr - 1536);
#pragma unroll
    for (int i = 0; i < 16; ++i) rows[1 + i] = *(const u32x4*)(xr + (size_t)i * 1536);
    rows[17] = last ? zero : *(const u32x4*)(xr + (size_t)16 * 1536);
#pragma unroll
    for (int i = 0; i < 16; ++i) {
        float a[8], x[8];
        unpack8(rows[i], x);
#pragma unroll
        for (int e = 0; e < 8; ++e) a[e] = bb[e] + x[e] * w[0][e];
        unpack8(rows[i + 1], x);
#pragma unroll
        for (int e = 0; e < 8; ++e) a[e] += x[e] * w[1][e];
        unpack8(rows[i + 2], x);
#pragma unroll
        for (int e = 0; e < 8; ++e) a[e] += x[e] * w[2][e];
        u32x4 o;
#pragma unroll
        for (int e = 0; e < 4; ++e) o[e] = pk2(siluf(a[2 * e]), siluf(a[2 * e + 1]));
        *(LAS u32x4*)(lds + lbase + (r0 + i) * RSB) = o;
    }
}
__device__ __forceinline__ void pass_a_group(const Params& P, int gu, LAS char* lds, int tid) {
    unsigned char* ws = P.ws;
    const int lane = tid & 63, wave = tid >> 6; const GInfo I = gdecode(gu);
    stage_group<false>(P, I, lds, tid);
    __syncthreads();
    { const int hl = wave >> 1, d = wave & 1, h = 4 * I.g + hl, gq = lane >> 4, q4 = (lane >> 2) & 3, p4 = lane & 3, li = lane & 15;
      const LAS f32x4* arr = (const LAS f32x4*)(lds + G_ARR + hl * 2048); const float tot = ((const LAS float*)(lds + G_SC + hl * 16))[d];
      const LAS char* xb = lds + G_X + hl * TB + (8 * gq + q4) * RSB + (4 * p4) * 2;
      const LAS char* bb = lds + G_B + (8 * gq + q4) * RSB + (4 * p4) * 2;
      f32x4 acc[4][4] = {};
#pragma unroll
      for (int s4 = 0; s4 < 4; ++s4) {
          float wj[8];
#pragma unroll
          for (int jj = 0; jj < 8; ++jj) { const f32x4 a = arr[32 * s4 + 8 * gq + jj]; wj[jj] = d ? a.w * __expf(tot - a.y) : a.z * __expf(tot - a.x); }
          bf16x8 bfr[4];
#pragma unroll
          for (int nt = 0; nt < 4; ++nt) bfr[nt] = tr2(bb + s4 * 32 * RSB + nt * 32, bb + s4 * 32 * RSB + 4 * RSB + nt * 32);
#pragma unroll
          for (int pt = 0; pt < 4; ++pt) { const bf16x8 xr_ = tr2(xb + s4 * 32 * RSB + pt * 32, xb + s4 * 32 * RSB + 4 * RSB + pt * 32);
              const u32x4 xw = *reinterpret_cast<const u32x4*>(&xr_); u32x4 sw;
#pragma unroll
              for (int e = 0; e < 4; ++e) sw[e] = pk2(bflo(xw[e]) * wj[2 * e], bfhi(xw[e]) * wj[2 * e + 1]);
              const bf16x8 xf = *reinterpret_cast<const bf16x8*>(&sw);
#pragma unroll
              for (int nt = 0; nt < 4; ++nt) acc[pt][nt] = __builtin_amdgcn_mfma_f32_16x16x32_bf16(bfr[nt], xf, acc[pt][nt], 0, 0, 0); } }
      const int u = unit_id(I.smp, I.b, I.c, h);
      bf16_t* So = (bf16_t*)(ws + WS_ST) + ((size_t)u * 2 + d) * 4096;
#pragma unroll
      for (int pt = 0; pt < 4; ++pt)
#pragma unroll
          for (int nt = 0; nt < 4; ++nt) st_bf4(So + (16 * pt + li) * 64 + nt * 16 + 4 * gq, acc[pt][nt]);
      if (lane == 0) ((float*)(ws + WS_DEC))[(size_t)u * 2 + d] = __expf(tot);
    }
    __syncthreads();
}
__device__ __forceinline__ bf16x8 ld_h_frag(const bf16_t* H, int p, int n) { return *(const bf16x8*)(H + p * 64 + n); }
__device__ __forceinline__ void pass_b_group(const Params& P, int gu, LAS char* lds, int tid) {
    unsigned char* ws = P.ws;
    const bf16_t* ST = (const bf16_t*)(ws + WS_ST);
    const int lane = tid & 63, wave = tid >> 6; const GInfo I = gdecode(gu);
    stage_group<true>(P, I, lds, tid);
    const int hl = wave >> 1, half = wave & 1, h = 4 * I.g + hl, li = lane & 15, gq = lane >> 4, q4 = (lane >> 2) & 3, p4 = lane & 3;
    const bf16_t *Hf, *Hb;
    if (I.smp) { const int u = unit_id(true, I.b, I.c, h); Hf = ST + ((size_t)u * 2) * 4096; Hb = ST + ((size_t)u * 2 + 1) * 4096; }
    else { const bf16_t* zp = (const bf16_t*)(ws + WS_ZERO); Hf = I.c == 1 ? ST + ((size_t)unit_id(false, I.b, 0, h) * 2) * 4096 : zp; Hb = I.c == 0 ? ST + ((size_t)unit_id(false, I.b, 1, h) * 2 + 1) * 4096 : zp; }
    __syncthreads();
    const LAS f32x4* arr = (const LAS f32x4*)(lds + G_ARR + hl * 2048); const LAS char* Xl = lds + G_X + hl * TB;
    const float Dh = P.in[I_SSDD][h];
#pragma unroll 1
    for (int st = 0; st < 4; st += 2) {
        int ii[2], tdiag[2]; bf16x8 cf[2][2]; f32x4 ai[2]; bf16_t* zrow[2]; u32x2 zw[2][4]; bf16x8 pf[2][4];
#pragma unroll
        for (int u = 0; u < 2; ++u) { ii[u] = 64 * half + 16 * (st + u) + li; tdiag[u] = __builtin_amdgcn_readfirstlane(4 * half + st + u);
#pragma unroll
            for (int ks = 0; ks < 2; ++ks) cf[u][ks] = *(const LAS bf16x8*)(lds + G_C + ii[u] * RSB + (8 * gq + 32 * ks) * 2);
            ai[u] = arr[ii[u]];
            zrow[u] = (bf16_t*)(ws + WS_Z) + (size_t)(I.row0 + ii[u]) * 1024 + h * 64;
#pragma unroll
            for (int pt = 0; pt < 4; ++pt) zw[u][pt] = *(const u32x2*)(zrow[u] + 16 * pt + 4 * gq); }
#pragma unroll
        for (int s4 = 0; s4 < 4; ++s4) {
            unsigned pk[2][4];
#pragma unroll
            for (int hf2 = 0; hf2 < 2; ++hf2) { const int t = 2 * s4 + hf2, jb = 16 * t + 4 * gq;
                f32x4 sacc[2] = {{0.f, 0.f, 0.f, 0.f}, {0.f, 0.f, 0.f, 0.f}};
#pragma unroll
                for (int ks = 0; ks < 2; ++ks) { const bf16x8 bfr = *(const LAS bf16x8*)(lds + G_B + (16 * t + li) * RSB + (8 * gq + 32 * ks) * 2);
                    sacc[0] = __builtin_amdgcn_mfma_f32_16x16x32_bf16(bfr, cf[0][ks], sacc[0], 0, 0, 0);
                    sacc[1] = __builtin_amdgcn_mfma_f32_16x16x32_bf16(bfr, cf[1][ks], sacc[1], 0, 0, 0); }
                f32x4 aj[4];
#pragma unroll
                for (int r = 0; r < 4; ++r) aj[r] = arr[jb + r];
#pragma unroll
                for (int u = 0; u < 2; ++u) {
                    float m[4];
                    if (t < tdiag[u]) {
#pragma unroll
                        for (int r = 0; r < 4; ++r) m[r] = sacc[u][r] * (__expf(ai[u].x - aj[r].x) * aj[r].z);
                    } else if (t > tdiag[u]) {
#pragma unroll
                        for (int r = 0; r < 4; ++r) m[r] = sacc[u][r] * (__expf(ai[u].y - aj[r].y) * aj[r].w);
                    } else {
#pragma unroll
                        for (int r = 0; r < 4; ++r) { const int j = jb + r;
                            const bool lower = j < ii[u]; const float arg = lower ? ai[u].x - aj[r].x : ai[u].y - aj[r].y; const float w = lower ? aj[r].z : aj[r].w;
                            float mm = __expf(arg) * w; if (j == ii[u]) mm = ai[u].z + ai[u].w; m[r] = sacc[u][r] * mm; }
                    }
                    pk[u][hf2 * 2 + 0] = pk2(m[0], m[1]); pk[u][hf2 * 2 + 1] = pk2(m[2], m[3]); } }
#pragma unroll
            for (int u = 0; u < 2; ++u) { const u32x4 w4 = {pk[u][0], pk[u][1], pk[u][2], pk[u][3]}; pf[u][s4] = *reinterpret_cast<const bf16x8*>(&w4); }
            __builtin_amdgcn_sched_barrier(0);
        }
        float ef[2], eb[2], ssq[2] = {0.f, 0.f};
#pragma unroll
        for (int u = 0; u < 2; ++u) { ef[u] = __expf(ai[u].x); eb[u] = __expf(ai[u].y); }
        bf16x8 hfc[2], hbc[2], hfn[2], hbn[2];
#pragma unroll
        for (int ks = 0; ks < 2; ++ks) { hfc[ks] = ld_h_frag(Hf, li, 8 * gq + 32 * ks); hbc[ks] = ld_h_frag(Hb, li, 8 * gq + 32 * ks); }
#pragma unroll
        for (int pt = 0; pt < 4; ++pt) {
            if (pt < 3) {
#pragma unroll
                for (int ks = 0; ks < 2; ++ks) { hfn[ks] = ld_h_frag(Hf, 16 * (pt + 1) + li, 8 * gq + 32 * ks); hbn[ks] = ld_h_frag(Hb, 16 * (pt + 1) + li, 8 * gq + 32 * ks); } }
            f32x4 yd[2] = {{0.f, 0.f, 0.f, 0.f}, {0.f, 0.f, 0.f, 0.f}}, yf[2] = {{0.f, 0.f, 0.f, 0.f}, {0.f, 0.f, 0.f, 0.f}}, yb[2] = {{0.f, 0.f, 0.f, 0.f}, {0.f, 0.f, 0.f, 0.f}};
#pragma unroll
            for (int s4 = 0; s4 < 4; ++s4) { const LAS char* xb = Xl + (32 * s4 + 4 * gq + q4) * RSB + (16 * pt + 4 * p4) * 2; const bf16x8 xf = tr2(xb, xb + 16 * RSB);
                yd[0] = __builtin_amdgcn_mfma_f32_16x16x32_bf16(xf, pf[0][s4], yd[0], 0, 0, 0);
                yd[1] = __builtin_amdgcn_mfma_f32_16x16x32_bf16(xf, pf[1][s4], yd[1], 0, 0, 0); }
#pragma unroll
            for (int ks = 0; ks < 2; ++ks)
#pragma unroll
                for (int u = 0; u < 2; ++u) { yf[u] = __builtin_amdgcn_mfma_f32_16x16x32_bf16(hfc[ks], cf[u][ks], yf[u], 0, 0, 0);
                    yb[u] = __builtin_amdgcn_mfma_f32_16x16x32_bf16(hbc[ks], cf[u][ks], yb[u], 0, 0, 0); }
            const int pc = 16 * pt + 4 * gq;
#pragma unroll
            for (int u = 0; u < 2; ++u) {
                const u32x2 xw = *(const LAS u32x2*)(Xl + ii[u] * RSB + pc * 2);
                const f32x4 xx = {bflo(xw.x), bfhi(xw.x), bflo(xw.y), bfhi(xw.y)};
                const f32x4 zz = {bflo(zw[u][pt].x), bfhi(zw[u][pt].x), bflo(zw[u][pt].y), bfhi(zw[u][pt].y)};
                f32x4 y = yd[u] + yf[u] * ef[u] + yb[u] * eb[u] + xx * Dh;
                y = y * (f32x4){siluf(zz.x), siluf(zz.y), siluf(zz.z), siluf(zz.w)};
                ssq[u] += (y.x * y.x + y.y * y.y) + (y.z * y.z + y.w * y.w);
                st_bf4(zrow[u] + pc, y); }
#pragma unroll
            for (int ks = 0; ks < 2; ++ks) { hfc[ks] = hfn[ks]; hbc[ks] = hbn[ks]; }
            __builtin_amdgcn_sched_barrier(0);
        }
#pragma unroll
        for (int u = 0; u < 2; ++u) { float sq = ssq[u]; sq += __shfl_xor(sq, 16); sq += __shfl_xor(sq, 32);
            if (gq == 0) ((float*)(ws + WS_SSQ_Y))[(size_t)(I.row0 + ii[u]) * 16 + h] = sq; }
    }
    __syncthreads();
}
}

__device__ __forceinline__ void cg_rowblock(const bf16_t* u, bf16_t* ug, const CgW& W, int rb, int c) {
    const int r0 = rb * CG_RB; const int t0 = r0 < RP ? (r0 & 255) : ((r0 - RP) & 2047), L = r0 < RP ? SEQP : SEQS;
    const u32x4 zero = {0u, 0u, 0u, 0u};
    u32x4 gp = zero, vp = zero, gc, vc, gn, vn;
    if (t0 > 0) { gp = *(const u32x4*)(u + (size_t)(r0 - 1) * UPN + c); vp = *(const u32x4*)(u + (size_t)(r0 - 1) * UPN + DFF + c); }
    gc = *(const u32x4*)(u + (size_t)r0 * UPN + c); vc = *(const u32x4*)(u + (size_t)r0 * UPN + DFF + c);
#pragma unroll 16
    for (int i = 0; i < CG_RB; ++i) {
        const int row = r0 + i;
        if (t0 + i + 1 < L) { gn = *(const u32x4*)(u + (size_t)(row + 1) * UPN + c); vn = *(const u32x4*)(u + (size_t)(row + 1) * UPN + DFF + c); } else { gn = zero; vn = zero; }
        float a[8], b[8], x[8];
#pragma unroll
        for (int e = 0; e < 8; ++e) { a[e] = W.bg[e]; b[e] = W.bv[e]; }
        unpack8(gp, x);
#pragma unroll
        for (int e = 0; e < 8; ++e) a[e] += x[e] * W.wg[0][e];
        unpack8(gc, x);
#pragma unroll
        for (int e = 0; e < 8; ++e) a[e] += x[e] * W.wg[1][e];
        unpack8(gn, x);
#pragma unroll
        for (int e = 0; e < 8; ++e) a[e] += x[e] * W.wg[2][e];
        unpack8(vp, x);
#pragma unroll
        for (int e = 0; e < 8; ++e) b[e] += x[e] * W.wv[0][e];
        unpack8(vc, x);
#pragma unroll
        for (int e = 0; e < 8; ++e) b[e] += x[e] * W.wv[1][e];
        unpack8(vn, x);
#pragma unroll
        for (int e = 0; e < 8; ++e) b[e] += x[e] * W.wv[2][e];
        u32x4 o;
#pragma unroll
        for (int e = 0; e < 4; ++e) o[e] = pk2(siluf(a[2 * e]) * b[2 * e], siluf(a[2 * e + 1]) * b[2 * e + 1]);
        *(u32x4*)(ug + (size_t)row * DFF + c) = o;
        gp = gc; vp = vc; gc = gn; vc = vn;
    }
}
__device__ __forceinline__ void cnt_arrive(unsigned* cnt) {
    asm volatile("s_waitcnt vmcnt(0)" ::: "memory");
    __syncthreads();
    if (threadIdx.x == 0) { __builtin_amdgcn_fence(__ATOMIC_RELEASE, "agent"); asm volatile("s_waitcnt vmcnt(0)" ::: "memory");
        __hip_atomic_fetch_add(cnt, 1u, __ATOMIC_RELAXED, __HIP_MEMORY_SCOPE_AGENT); }
}
__device__ __forceinline__ void cnt_wait(unsigned* cnt, unsigned target) {
    if (threadIdx.x == 0) { unsigned sp = 0;
        while (__hip_atomic_load(cnt, __ATOMIC_RELAXED, __HIP_MEMORY_SCOPE_AGENT) < target) { __builtin_amdgcn_s_sleep(4); if (++sp > (1u << 22)) break; }
        __builtin_amdgcn_fence(__ATOMIC_ACQUIRE, "agent"); asm volatile("s_waitcnt vmcnt(0)" ::: "memory"); }
    __syncthreads();
}
constexpr int CG_ROWS1 = 46 * 256, CG_SPLIT = CG_ROWS1 / CG_RB - 1, CG_ITEMS = R / CG_RB;
__device__ __forceinline__ void phase_convgate_queue(const Params& P, LAS unsigned char* lds, unsigned* c1, unsigned* c2, unsigned* q) {
    PHASE_IDS unsigned char* ws = P.ws; const bf16_t* u = (const bf16_t*)(ws + WS_U); bf16_t* ug = (bf16_t*)(ws + WS_UG);
    volatile LAS int* slot = (volatile LAS int*)(lds + 1024);
    const int c = tid * 8; const bool act = tid < DFF / 8;
    CgW W; if (act) cg_load_w(W, P.in[I_FCW], P.in[I_FCB], c);
    bool w1 = false, w2 = false;
    for (;;) {
        if (tid == 0) *slot = (int)__hip_atomic_fetch_add(q, 1u, __ATOMIC_RELAXED, __HIP_MEMORY_SCOPE_AGENT);
        __syncthreads();
        const int rb = *slot;
        __syncthreads();
        if (rb >= CG_ITEMS) break;
        if (!w1) { cnt_wait(c1, (unsigned)G); w1 = true; }
        if (rb >= CG_SPLIT && !w2) { cnt_wait(c2, (unsigned)G); w2 = true; }
        if (act) cg_rowblock(u, ug, W, rb, c);
    }
}
__device__ __forceinline__ void phase_final(const Params& P) {
    PHASE_IDS const int gw = blockIdx.x * 8 + wave, NGW = G * 8; const float* gf = P.in[I_GFIN];
    for (int row = gw; row < R; row += NGW) {
        f32x4* xr = (f32x4*)(P.out + (size_t)row * DM) + lane; f32x4 v[4]; float s = 0.f;
#pragma unroll
        for (int j = 0; j < 4; ++j) { v[j] = xr[64 * j]; s += (v[j].x * v[j].x + v[j].y * v[j].y) + (v[j].z * v[j].z + v[j].w * v[j].w); }
        const float rs = rsqrtf(wave_sum(s) * (1.f / DM) + EPS);
#pragma unroll
        for (int j = 0; j < 4; ++j) xr[64 * j] = v[j] * rs * *(const f32x4*)(gf + 4 * lane + 256 * j);
    }
}

constexpr int G_SLOT_OFF = 126 * 1024;
__device__ __forceinline__ void phase_ssd_a(const Params& P, LAS unsigned char* lds) {
    PHASE_IDS
    norm_new_ckv(P, lane, wave, G);
    unsigned* qa = (unsigned*)(P.ws + WS_CTL) + 8192 + 256; volatile LAS int* slot = (volatile LAS int*)(lds + G_SLOT_OFF);
    for (;;) {
        if (tid == 0) *slot = (int)__hip_atomic_fetch_add(qa, 1u, __ATOMIC_RELAXED, __HIP_MEMORY_SCOPE_AGENT);
        __syncthreads();
        const int gu = *slot;
        __syncthreads();
        if (gu >= 384) break;
        int t2 = tid; asm volatile("" : "+v"(t2)); ssd::pass_a_group(P, gu, (LAS char*)lds, t2);
    }
}
__device__ __forceinline__ void phase_ssd_scan(const Params& P) {
    PHASE_IDS unsigned char* ws = P.ws; bf16_t* ST = (bf16_t*)(ws + WS_ST); const float* DEC = (const float*)(ws + WS_DEC);
    const int gt = blockIdx.x * NT + tid, GT = G * NT;
    for (int it = gt; it < 64 * 512; it += GT) {
        const int chain = it >> 9, e = (it & 511) * 8, b = chain >> 5, h = (chain >> 1) & 15, d = chain & 1;
        float H[8];
        { const float* h0 = P.in[I_SSD] + (((size_t)b * 2 + d) * 16 + h) * 4096 + e; const f32x4 a = *(const f32x4*)h0, c4 = *(const f32x4*)(h0 + 4);
#pragma unroll
          for (int q = 0; q < 4; ++q) { H[q] = a[q]; H[4 + q] = c4[q]; } }
        u32x4 S[16]; float dc[16];
#pragma unroll
        for (int c = 0; c < 16; ++c) { const int u = ssd::unit_id(true, b, c, h); S[c] = *(const u32x4*)(ST + ((size_t)u * 2 + d) * 4096 + e); dc[c] = DEC[(size_t)u * 2 + d]; }
#define SCAN_STEP(c) { const int u = ssd::unit_id(true, b, (c), h); \
            *(u32x4*)(ST + ((size_t)u * 2 + d) * 4096 + e) = (u32x4){pk2(H[0], H[1]), pk2(H[2], H[3]), pk2(H[4], H[5]), pk2(H[6], H[7])}; \
            float sv[8]; unpack8(S[(c)], sv); _Pragma("unroll") for (int q = 0; q < 8; ++q) H[q] = H[q] * dc[(c)] + sv[q]; }
        if (d == 0) {
#pragma unroll
            for (int c = 0; c < 16; ++c) SCAN_STEP(c)
        } else {
#pragma unroll
            for (int c = 15; c >= 0; --c) SCAN_STEP(c)
        }
#undef SCAN_STEP
    }
    for (int it = gt; it < 1024 * 512; it += GT) {
        const int bhd = it >> 9, e = (it & 511) * 8, b = bhd >> 5, d = (bhd >> 4) & 1, h = bhd & 15;
        const int ufirst = ssd::unit_id(false, b, d ? 1 : 0, h), ulast = ssd::unit_id(false, b, d ? 0 : 1, h);
        float f[8], l[8]; unpack8(*(const u32x4*)(ST + ((size_t)ufirst * 2 + d) * 4096 + e), f); unpack8(*(const u32x4*)(ST + ((size_t)ulast * 2 + d) * 4096 + e), l);
        const float dl = DEC[(size_t)ulast * 2 + d]; float* o = P.out + O_SSD + (((size_t)b * 2 + d) * 16 + h) * 4096 + e;
        *(f32x4*)o = (f32x4){f[0] * dl + l[0], f[1] * dl + l[1], f[2] * dl + l[2], f[3] * dl + l[3]};
        *(f32x4*)(o + 4) = (f32x4){f[4] * dl + l[4], f[5] * dl + l[5], f[6] * dl + l[6], f[7] * dl + l[7]};
    }
}
template <int PART>
__device__ __forceinline__ void phase_mix(const Params& P, LAS unsigned char* lds) {
    PHASE_IDS unsigned char* ws = P.ws; bf16_t* qn = (bf16_t*)(ws + WS_QN); const bf16_t* qr = (const bf16_t*)(ws + WS_QR);
    const bf16_t* kv = (const bf16_t*)(ws + WS_KV); const bf16_t* kr = (const bf16_t*)(ws + WS_KROPE);
    const int nbA = G / 2, bx = blockIdx.x;
    if (bx < nbA) {
        if (PART != 2) for (int u = bx; u < 128; u += nbA) {
            const int x = u & 7, k = u >> 3, bh = x + 8 * (k >> 3), qb = k & 7, b = bh >> 3, h = bh & 7, row0 = RP + b * SEQS + qb * 256, kv0 = RP + b * KVS;
            int t2 = tid; asm volatile("" : "+v"(t2));
            att::attn_unit(qn + (size_t)row0 * 1024 + h * 128, qr + (size_t)row0 * 512 + h * 64, kv + (size_t)kv0 * 2048 + h * 256, kv + (size_t)kv0 * 2048 + h * 256 + 128,
                           kr + (size_t)kv0 * 64, qn + (size_t)row0 * 1024 + h * 128, KVS, (LAS char*)lds, t2);
        }
    } else {
        const int k0 = bx - nbA, nb2 = G - nbA;
        if (PART != 2) for (int q = k0; q < 256; q += nb2) {
            const int b = q >> 3, h = q & 7, row0 = b * SEQP;
            int t2 = tid; asm volatile("" : "+v"(t2));
            att::attn_unit(qn + (size_t)row0 * 1024 + h * 128, qr + (size_t)row0 * 512 + h * 64, kv + (size_t)row0 * 2048 + h * 256, kv + (size_t)row0 * 2048 + h * 256 + 128,
                           kr + (size_t)row0 * 64, qn + (size_t)row0 * 1024 + h * 128, SEQP, (LAS char*)lds, t2);
        }
        if (PART != 1) for (int gu = k0; gu < 384; gu += nb2) { int t2 = tid; asm volatile("" : "+v"(t2)); ssd::pass_b_group(P, gu, (LAS char*)lds, t2); }
    }
}
#define XB_TMO      128
#define XB_XCNT(j)  (256  + 64 * (j))
#define XB_XSUB(j)  (1280 + 64 * (j))
#define XB_XGEN(j)  (2304 + 64 * (j))
#define XB_TOP      3328
#define XB_TOPGEN   3392
#define XCD_BAR_WORDS 3456
#define XB_SPIN_CAP (1u << 18)

__device__ __forceinline__ unsigned xb_ld(unsigned* p)              { return __hip_atomic_load(p, __ATOMIC_RELAXED, __HIP_MEMORY_SCOPE_AGENT); }
__device__ __forceinline__ unsigned xb_add(unsigned* p, unsigned v) { return __hip_atomic_fetch_add(p, v, __ATOMIC_RELAXED, __HIP_MEMORY_SCOPE_AGENT); }
__device__ __forceinline__ unsigned xb_xcc_id() { return (unsigned)__builtin_amdgcn_s_getreg((3 << 11) | 20) & 0xFu; }
#define XB_SPIN(cond, bar) do { unsigned _sp = 0; while (cond) { __builtin_amdgcn_s_sleep(1); \
    if ((++_sp & 255u) == 0u) { if (xb_ld(&(bar)[XB_TMO])) break; if (_sp > XB_SPIN_CAP) { atomicAdd(&(bar)[XB_TMO], 1u); break; } } } } while (0)

struct XcdBarrier {
    unsigned* bar; unsigned x;
    volatile LAS unsigned* st;
};

__device__ __forceinline__ XcdBarrier xcd_barrier_post(unsigned* bar, volatile LAS unsigned* st) {
    XcdBarrier b; b.bar = bar; b.x = xb_xcc_id(); b.st = st;
    if (threadIdx.x == 0) (void)xb_add(&bar[XB_XCNT(b.x)], 1u);
    return b;
}
__device__ __forceinline__ void xcd_barrier_complete(unsigned* bar, unsigned x, unsigned& nloc, unsigned& nx) {
    const unsigned G = gridDim.x * gridDim.y * gridDim.z;
    unsigned sum, cnt, mine, sp = 0u;
    for (;;) {
        sum = 0u; cnt = 0u; mine = 0u;
#pragma unroll
        for (unsigned j = 0; j < 16; ++j) { const unsigned c = xb_ld(&bar[XB_XCNT(j)]); sum += c; cnt += (c > 0u) ? 1u : 0u; mine = (j == x) ? c : mine; }
        if (sum == G) break;
        __builtin_amdgcn_s_sleep(1);
        if ((++sp & 255u) == 0u) { if (xb_ld(&bar[XB_TMO])) break; if (sp > XB_SPIN_CAP) { atomicAdd(&bar[XB_TMO], 1u); break; } }
    }
    nloc = mine > 0u ? mine : 1u; nx = cnt > 0u ? cnt : 1u;
}

__device__ __forceinline__ void xcd_barrier(const XcdBarrier& b) {
    asm volatile("s_waitcnt vmcnt(0)" ::: "memory");
    __syncthreads();
    if (threadIdx.x == 0) {
        unsigned* bar = b.bar;
        __builtin_amdgcn_s_waitcnt(0);
        unsigned nloc = b.st[0], nx = b.st[1];
        if (nloc == 0u) { xcd_barrier_complete(bar, b.x, nloc, nx); b.st[0] = nloc; b.st[1] = nx; }
        const unsigned old = xb_add(&bar[XB_XSUB(b.x)], 1u);
        const unsigned gen = old / nloc;
        if (old + 1u == (gen + 1u) * nloc) {
            __builtin_amdgcn_fence(__ATOMIC_RELEASE, "agent");
            asm volatile("s_waitcnt vmcnt(0)" ::: "memory");
            const unsigned og = xb_add(&bar[XB_TOP], 1u);
            const unsigned tg = og / nx;
            if (og + 1u == (tg + 1u) * nx) xb_add(&bar[XB_TOPGEN], 1u);
            else XB_SPIN(xb_ld(&bar[XB_TOPGEN]) == tg, bar);
            __builtin_amdgcn_fence(__ATOMIC_ACQUIRE, "agent");
            xb_add(&bar[XB_XGEN(b.x)], 1u);
            asm volatile("s_waitcnt vmcnt(0)" ::: "memory");
        } else {
            XB_SPIN(xb_ld(&bar[XB_XGEN(b.x)]) == gen, bar);
            __builtin_amdgcn_fence(__ATOMIC_ACQUIRE, "agent");
            asm volatile("s_waitcnt vmcnt(0)" ::: "memory");
        }
    }
    __syncthreads();
}

__global__ void __launch_bounds__(NT, 2) mega_fwd(Params P) {
    extern __shared__ __attribute__((aligned(16))) unsigned char lds_raw[];
    LAS unsigned char* lds = (LAS unsigned char*)lds_raw;
    const int G = gridDim.x, bx = blockIdx.x;
    unsigned char* ws = P.ws;
    volatile LAS unsigned* misc = (volatile LAS unsigned*)(lds + 131072);
    if (threadIdx.x < 4) misc[threadIdx.x] = 0u;
    __syncthreads();
    const XcdBarrier xbar = xcd_barrier_post((unsigned*)(ws + WS_CTL) + 1024, misc);
#define GSYNC() xcd_barrier(xbar)
    unsigned long long pt0 = 0, pacc = 0; (void)pt0; (void)pacc;
#define PB(k) do { if ((PROBE_MASK >> (k)) & 1) pt0 = __builtin_amdgcn_s_memrealtime(); } while (0)
#define PE(k) do { if ((PROBE_MASK >> (k)) & 1) pacc += __builtin_amdgcn_s_memrealtime() - pt0; } while (0)

#ifdef PG8_TIME
    if (blockIdx.x == 0 && threadIdx.x == 0) { pg8::pg8_tacc[0] = 0; pg8::pg8_tacc[1] = 0; }
#endif
    PB(0); phase_p0(P, lds);
    GSYNC(); PE(0);
    PB(1); phase_p1(P, lds);
    GSYNC(); PE(1);
    PB(2); PB(20);
    {
        EpiInMain E{(bf16_t*)(ws + WS_CQ), (bf16_t*)(ws + WS_CKVA), (bf16_t*)(ws + WS_Z), (bf16_t*)(ws + WS_XBC), (bf16_t*)P.out, (bf16_t*)P.out + (size_t)R * 1024,
                    (float*)(ws + WS_SSQ_CQ), (float*)(ws + WS_SSQ_CKV), P.out + O_CKV,
                    (bf16_t*)(ws + WS_KROPE), (float*)(ws + WS_DT), P.out + O_KR, P.in[I_DTB], (const f32x2*)(ws + WS_ROPE)};
        run_gemm(lds, (const bf16_t*)(ws + WS_H), (const bf16_t*)(ws + WS_WIN), R, 5376, 1024, G, bx, E);
    }
    PE(20);
    GSYNC(); PE(2);
    PB(4);
    {
        EpiG2 E{(bf16_t*)(ws + WS_QN), (bf16_t*)(ws + WS_KV), (const float*)(ws + WS_SSQ_CQ), (const float*)(ws + WS_SSQ_CKV)};
        pg8::Gemm g{(const bf16_t*)(ws + WS_CQ), (const bf16_t*)(ws + WS_WUQ), R + KVR, 3584, 256}; Gemm2Order S; S.init(G, bx);
        pg8::gemm_phase<EpiG2, Gemm2Order, PG8_ALIGN, PG8_SP2>(lds, g, S, E);
        EpiQR EQR{(bf16_t*)(ws + WS_QR), (const float*)(ws + WS_SSQ_CQ), (const f32x2*)(ws + WS_ROPE)};
        run_gemm(lds, (const bf16_t*)(ws + WS_CQ), (const bf16_t*)(ws + WS_WUQ) + (size_t)1024 * 256, R, 512, 256, G, (bx + 160) % G, EQR);
        phase_ssd_a(P, lds);
    }
    GSYNC();
    PB(14); phase_ssd_scan(P); PE(14);
    GSYNC(); PE(4);
    PB(5); PB(12); PB(13); PB(18); phase_mix<1>(P, lds); PE(18); PB(19); phase_mix<2>(P, lds); PE(19); PE(12); PE(13);
    GSYNC(); PE(5);
    PB(6);
    {
        EpiMerged E{(const bf16_t*)P.out, (const bf16_t*)P.out + (size_t)R * 1024, (const float*)(ws + WS_SSQ_Y), (bf16_t*)(ws + WS_MERGED)};
        pg8::Gemm g{(const bf16_t*)(ws + WS_Z), (const bf16_t*)(ws + WS_WOMLA), R, 1024, 1024}; PairOrder S; S.init(G, bx);
        pg8::gemm_phase<EpiMerged, PairOrder, PG8_ALIGN, PG8_SP2, 3>(lds, g, S, E);
    }
    GSYNC(); PE(6);
    PB(7);
    {
        EpiOut<3> E{P.in[I_XP], P.in[I_XS], (const float*)(ws + WS_MOD), P.in[I_GFFN], P.out, (bf16_t*)(ws + WS_A1), (float*)(ws + WS_SSQ2)};
        run_gemm192(lds, (const bf16_t*)(ws + WS_MERGED), (const bf16_t*)(ws + WS_WOUT), R, 1024, 1024, G, bx, E);
    }
    GSYNC(); PE(7);
    PB(8);
    {
        EpiUpGate E{(const float*)(ws + WS_SSQ2), (const float*)(ws + WS_CUP), P.in[I_FCW], (const float*)(ws + WS_CST), (bf16_t*)(ws + WS_UG), (bf16_t*)(ws + WS_HALO)};
#ifdef WARM_WUP
        {
            const u32x4* wp = (const u32x4*)(ws + WS_WUP); u32x4 x = {0u, 0u, 0u, 0u};
            for (unsigned i = (unsigned)bx * NT + threadIdx.x; i < (unsigned)((size_t)UPN * 1024 * 2 / 16); i += (unsigned)G * NT) x ^= wp[i];
            if ((x.x ^ x.y ^ x.z ^ x.w) == 0x9e3779b9u) ((volatile unsigned*)(ws + WS_CTL))[8000] = x.x;
        }
#endif
        run_gemm(lds, (const bf16_t*)(ws + WS_A1), (const bf16_t*)(ws + WS_WUP), R, UPN, 1024, G, bx, E);
    }
    GSYNC(); PE(8);
    PB(9); PE(9);
    PB(10);
    const bool fuse_final = (G == 256);
    if (fuse_final) {
        { pg8::StaticOrder S0; S0.init(R, 1024, G, bx, 192); pg8::Unit u0; if (S0.next(0, u0)) fixup_rows(P, u0.pm * 192, u0.pm * 192 + 192, threadIdx.x);
          asm volatile("s_waitcnt vmcnt(0)" ::: "memory"); __syncthreads(); }
        EpiDownNorm E{(const float*)(ws + WS_MOD), P.out, P.in[I_GFIN], (float*)(ws + WS_SSQ_CQ), (unsigned*)(ws + WS_CTL) + 4608};
        pg8::Gemm g{(const bf16_t*)(ws + WS_UG), (const bf16_t*)(ws + WS_WDOWN), R, 1024, DFF}; pg8::StaticOrder S; S.init(R, 1024, G, bx, 192);
        pg8::gemm_phase<EpiDownNorm, pg8::StaticOrder, false, PG8_SP2, 3>(lds, g, S, E);
        PE(10);
#ifdef PG8_TIME
        if (blockIdx.x == 0 && threadIdx.x == 0) pacc += pg8::pg8_tacc[PG8_TIME];
#endif
        if (PROBE_MASK != 0 && blockIdx.x == PROBE_BLK && threadIdx.x == 0) { const unsigned long long te = __builtin_amdgcn_s_memrealtime() + (unsigned long long)PROBE_MULT * pacc; while (__builtin_amdgcn_s_memrealtime() < te) __builtin_amdgcn_s_sleep(32); }
        return;
    }
    for (int k = bx; k < R / 64; k += G) fixup_rows(P, 64 * k, 64 * k + 64, threadIdx.x);
    GSYNC();
    {
        EpiDown<3> E{(const float*)(ws + WS_MOD), P.out};
        run_gemm192(lds, (const bf16_t*)(ws + WS_UG), (const bf16_t*)(ws + WS_WDOWN), R, 1024, DFF, G, bx, E);
    }
    GSYNC(); PE(10);
    PB(11); phase_final(P); PE(11);
    if (PROBE_MASK != 0 && blockIdx.x == PROBE_BLK && threadIdx.x == 0) { const unsigned long long te = __builtin_amdgcn_s_memrealtime() + (unsigned long long)PROBE_MULT * pacc; while (__builtin_amdgcn_s_memrealtime() < te) __builtin_amdgcn_s_sleep(32); }
}

extern "C" void kernel_launch(void* const* d_in, const int* in_sizes, int n_in, void* d_out, int out_size, void* d_ws, size_t ws_size, hipStream_t stream) {
    static int grid = 0;
    if (grid == 0) {
        if (n_in != 30 || ws_size < WS_END || out_size != (int)(O_SSD + (size_t)32 * 2 * 16 * 64 * 64)) {
            fprintf(stderr, "kernel_launch: unexpected shapes: n_in %d out %d ws %zu (need %zu)\n", n_in, out_size, ws_size, (size_t)WS_END); grid = -1; return; }
        int dev = 0, cus = 0, per_cu = 0;
        if (hipGetDevice(&dev) != hipSuccess || hipDeviceGetAttribute(&cus, hipDeviceAttributeMultiprocessorCount, dev) != hipSuccess) { grid = -1; return; }
        if (hipFuncSetAttribute((const void*)mega_fwd, hipFuncAttributeMaxDynamicSharedMemorySize, LDS_BYTES) != hipSuccess) { fprintf(stderr, "kernel_launch: hipFuncSetAttribute failed\n"); grid = -1; return; }
        if (hipOccupancyMaxActiveBlocksPerMultiprocessor(&per_cu, (const void*)mega_fwd, NT, LDS_BYTES) != hipSuccess || per_cu < 1) { fprintf(stderr, "kernel_launch: occupancy query failed (%d)\n", per_cu); (void)hipGetLastError(); grid = -1; return; }
        grid = cus;
    }
    if (grid < 0) return;
    (void)hipMemsetAsync((char*)d_ws + WS_CTL, 0, CTL_ZERO, stream);
    Params p{};
    for (int i = 0; i < 30; ++i) p.in[i] = (const float*)d_in[i];
    p.out = (float*)d_out; p.ws = (unsigned char*)d_ws;
    void* args[] = {&p};
    hipError_t e = hipLaunchCooperativeKernel((const void*)mega_fwd, dim3(grid), dim3(NT), args, LDS_BYTES, stream);
    if (e != hipSuccess) fprintf(stderr, "kernel_launch: cooperative launch failed: %s (grid %d)\n", hipGetErrorString(e), grid);
}
```

```cpp
#include <hip/hip_runtime.h>
#include <hip/hip_cooperative_groups.h>
#include <cstdio>
#include <cstdint>
#include <type_traits>
namespace cg = cooperative_groups;

namespace pg8 {
#define PG8_LAS __attribute__((address_space(3)))
typedef unsigned short bf16_t;
typedef short bf16x8 __attribute__((ext_vector_type(8)));
typedef float f32x4 __attribute__((ext_vector_type(4)));
typedef unsigned u32x4 __attribute__((ext_vector_type(4)));
constexpr int BM = 256, BK = 64, HALF = 128, HTB = HALF * BK * 2  , STAGE_BYTES = 8 * HTB, NXCD = 8, WGM = 8;

__host__ __device__ __forceinline__ int lds_byte(int r, int c) { const int st = (r >> 4) * 2 + (c >> 5), rr = r & 15, cc = c & 31, ob = rr * 64 + cc * 2; return st * 1024 + (ob ^ (((ob >> 9) & 1) << 5)); }
__host__ __device__ __forceinline__ void stage_rc(int b, int& R, int& C) { const int st = b / 1024, sb = b % 1024, swz = sb ^ (((sb >> 9) & 1) << 5); R = (st >> 1) * 16 + swz / 64; C = (st & 1) * 32 + (swz % 64) / 2; }
__host__ __device__ __forceinline__ int perm32(int rho) { const int n = rho >> 4, i = rho & 15; return 8 * (i >> 2) + 4 * n + (i & 3); }

struct Unit { int pm, pn; };
#ifdef PG8_TIME
#ifndef PG8_TBLK
#define PG8_TBLK 0
#endif
__device__ unsigned long long pg8_tacc[2];
#endif
struct Gemm { const bf16_t* A; const bf16_t* Bt; int M, N, K; };

struct StaticOrder {
    int nM, nN, nwg, G, c;
    __host__ __device__ void init(int M, int N, int G_, int c_, int bm = BM) { nM = M / bm; nN = N / BM; nwg = nM * nN; G = G_; c = c_; }
    __host__ __device__ __forceinline__ bool next(int i, Unit& u) const {
        const long L = (long)i * G + c; if (L >= nwg) return false;
        int wgid = (int)L; { const int q = nwg / NXCD, r = nwg % NXCD, xcd = wgid % NXCD, off = wgid / NXCD; wgid = (xcd < r ? xcd * (q + 1) : r * (q + 1) + (xcd - r) * q) + off; }
        const int nig = WGM * nN, gid = wgid / nig, fm = gid * WGM, gsz = (nM - fm) < WGM ? (nM - fm) : WGM;
        u.pm = fm + ((wgid % nig) % gsz); u.pn = (wgid % nig) / gsz; return true;
    }
    __device__ __forceinline__ void a_ready(const Unit&) const {}
    __device__ __forceinline__ void done(const Unit&) const {}
};


template <class E, class = void> struct epi_state { struct type {}; static constexpr bool value = false; };
template <class E> struct epi_state<E, std::void_t<typename E::State>> { using type = typename E::State; static constexpr bool value = true; };
template <class E, class = void> struct epi_pre : std::false_type {};
template <class E> struct epi_pre<E, std::void_t<decltype(E::PRE_SLOT)>> : std::true_type {};
template <class E, class = void> struct epi_timed : std::false_type {};
template <class E> struct epi_timed<E, std::void_t<decltype(E::TIMED)>> : std::true_type {};
template <class Epi, class Sched, bool ALIGN_EPI = false, bool SP2 = false, int MFR = 4  >
__device__ __forceinline__ void gemm_phase(PG8_LAS unsigned char* lds, const Gemm g, const Sched& S, const Epi& E) {
    int tid_ = threadIdx.x; asm volatile("" : "+v"(tid_));
    const int tid = tid_, wid = __builtin_amdgcn_readfirstlane(tid >> 6), lane = tid & 63, wr = wid >> 2, wc = wid & 3, fr = lane & 15, fq = lane >> 4;
    static_assert(SP2 || MFR == 4, "192-row tiles need the two-super-phase loop");
    const bool shortA = (MFR == 3) && (wr == 1);
    const int K = g.K, nt = K / BK;
    unsigned voffA[2], voffB[2];
#pragma unroll
    for (int i = 0; i < 2; ++i) { int R, C; stage_rc(tid * 16 + i * 8192, R, C); const int Rb = Epi::PERM ? ((R & ~31) + perm32(R & 31)) : R;
        voffA[i] = (unsigned)(R * K + C) * 2u; voffB[i] = (unsigned)(Rb * K + C) * 2u; }
    const size_t kstep = (size_t)(BK * 2);
    const size_t hstep = (size_t)HALF * K * 2;
    const size_t tstep = 2 * hstep;
    const size_t hstepA = (size_t)(32 * MFR) * K * 2, tstepA = 2 * hstepA;
    const unsigned ldsw = (unsigned)wid * 1024u;
    const int aoff = lds_byte(wr * (16 * MFR) + fr, fq * 8), boff = lds_byte(wc * 32 + fr, fq * 8);
#define PG8_SA(b, h) (((b) * 2 + (h)) * HTB)
#define PG8_SB(b, h) ((4 + (b) * 2 + (h)) * HTB)
#define PG8_STAGE(bufoff, gbase, voff) do { _Pragma("unroll") for (int _i = 0; _i < 2; ++_i) \
        __builtin_amdgcn_global_load_lds((const unsigned*)((const char*)(gbase) + (voff)[_i]), (PG8_LAS unsigned*)(lds + (bufoff) + ldsw + _i * 8192), 16, 0, 0); } while (0)
#define PG8_LDA(dst, b, h) do { _Pragma("unroll") for (int m = 0; m < MFR; ++m) _Pragma("unroll") for (int k = 0; k < 2; ++k) dst[m][k] = *(const PG8_LAS bf16x8*)(lds + PG8_SA(b, h) + aoff + m * 2048 + k * 1024); } while (0)
#define PG8_LDB(dst, b, h) do { _Pragma("unroll") for (int n = 0; n < 2; ++n) _Pragma("unroll") for (int k = 0; k < 2; ++k) dst[n][k] = *(const PG8_LAS bf16x8*)(lds + PG8_SB(b, h) + boff + n * 2048 + k * 1024); } while (0)
#define PG8_MMA(ai, bj, At, Bt) do { __builtin_amdgcn_s_setprio(1); _Pragma("unroll") for (int m = 0; m < MFR; ++m) _Pragma("unroll") for (int n = 0; n < 2; ++n) _Pragma("unroll") for (int k = 0; k < 2; ++k) \
        acc[ai][bj][m][n] = __builtin_amdgcn_mfma_f32_16x16x32_bf16(Bt[n][k], At[m][k], acc[ai][bj][m][n], 0, 0, 0); __builtin_amdgcn_s_setprio(0); } while (0)
#define PG8_WAIT_V(n) asm volatile("s_waitcnt vmcnt(" #n ")" ::: "memory")
#define PG8_WAIT_VS(nf, ns) do { if (shortA) PG8_WAIT_V(ns); else PG8_WAIT_V(nf); } while (0)
#define PG8_STAGE_A(bufoff, gbase) do { __builtin_amdgcn_global_load_lds((const unsigned*)((const char*)(gbase) + voffA[0]), (PG8_LAS unsigned*)(lds + (bufoff) + ldsw), 16, 0, 0); \
        if (!shortA) __builtin_amdgcn_global_load_lds((const unsigned*)((const char*)(gbase) + voffA[1]), (PG8_LAS unsigned*)(lds + (bufoff) + ldsw + 8192), 16, 0, 0); } while (0)
#define PG8_WAIT_L(n) asm volatile("s_waitcnt lgkmcnt(" #n ")" ::: "memory")
#define PG8_BAR __builtin_amdgcn_s_barrier()
#define PG8_SCHED __builtin_amdgcn_sched_barrier(0)
    Unit cur, nxt; int ui = 0;
    if (!S.next(0, cur)) return;
#ifdef PG8_TIME
    const bool tme = epi_timed<Epi>::value && (wid == 0 && blockIdx.x == PG8_TBLK); unsigned long long tk0 = 0;
#endif
    typename epi_state<Epi>::type est; (void)est;
    f32x4 acc[2][2][MFR][2];
#pragma unroll
    for (int a = 0; a < 2; ++a)
#pragma unroll
        for (int b = 0; b < 2; ++b)
#pragma unroll
            for (int m = 0; m < MFR; ++m)
#pragma unroll
                for (int n = 0; n < 2; ++n) acc[a][b][m][n] = (f32x4){0.f, 0.f, 0.f, 0.f};
    bf16x8 At[MFR][2], B0[2][2], B1[2][2];
    const char* cA = (const char*)g.A + (size_t)cur.pm * tstepA; const char* cB = (const char*)g.Bt + (size_t)cur.pn * tstep;
    S.a_ready(cur);
    if constexpr (epi_pre<Epi>::value) E.pre(cur, lds + STAGE_BYTES + Epi::PRE_SLOT, wr, wc, lane);
    if constexpr (SP2) {
        PG8_STAGE(PG8_SB(0, 0), cB, voffB); PG8_STAGE(PG8_SB(0, 1), cB + hstep, voffB); PG8_STAGE_A(PG8_SA(0, 0), cA); PG8_STAGE_A(PG8_SA(0, 1), cA + hstepA);
        if (wr == 1) PG8_BAR;
        PG8_WAIT_VS(2, 1); PG8_BAR;
        PG8_STAGE(PG8_SB(1, 0), cB + kstep, voffB); PG8_STAGE_A(PG8_SA(1, 0), cA + kstep); PG8_STAGE(PG8_SB(1, 1), cB + hstep + kstep, voffB);
        PG8_WAIT_VS(6, 5); PG8_BAR;
    } else {
        PG8_STAGE(PG8_SB(0, 0), cB, voffB); PG8_STAGE_A(PG8_SA(0, 0), cA); PG8_STAGE(PG8_SB(0, 1), cB + hstep, voffB); PG8_STAGE_A(PG8_SA(0, 1), cA + hstepA);
        if (wr == 1) PG8_BAR;
        PG8_WAIT_V(4); PG8_BAR;
        PG8_STAGE(PG8_SB(1, 0), cB + kstep, voffB); PG8_STAGE_A(PG8_SA(1, 0), cA + kstep); PG8_STAGE(PG8_SB(1, 1), cB + hstep + kstep, voffB);
        PG8_WAIT_V(6); PG8_BAR;
    }
    for (;;) {
        const bool has_next = S.next(ui + 1, nxt);
        const char* nA = has_next ? (const char*)g.A + (size_t)nxt.pm * tstepA : cA; const char* nB = has_next ? (const char*)g.Bt + (size_t)nxt.pn * tstep : cB;
#ifdef PG8_TIME
        if (tme) tk0 = __builtin_amdgcn_s_memrealtime();
#endif
        for (int t = 0; t < nt; t += 2) {
            const bool last = (t == nt - 2);
            const char* a1 = cA + (size_t)(t + 1) * kstep;
            const char* a2 = last ? nA : cA + (size_t)(t + 2) * kstep; const char* b2 = last ? nB : cB + (size_t)(t + 2) * kstep;
            const char* a3 = a2 + kstep; const char* b3 = b2 + kstep;
            if (last && has_next) S.a_ready(nxt);
            if constexpr (SP2) {
            PG8_LDB(B0, 0, 0); PG8_LDB(B1, 0, 1); PG8_SCHED; PG8_LDA(At, 0, 0); PG8_STAGE_A(PG8_SA(1, 1), a1 + hstepA);
            PG8_WAIT_VS(8, 6); PG8_WAIT_L(0); PG8_BAR; PG8_MMA(0, 0, At, B0); PG8_MMA(0, 1, At, B1); PG8_BAR; PG8_SCHED;
            PG8_LDA(At, 0, 1); PG8_STAGE(PG8_SB(0, 0), b2, voffB); PG8_STAGE(PG8_SB(0, 1), b2 + hstep, voffB); PG8_STAGE_A(PG8_SA(0, 0), a2);
            PG8_WAIT_VS(8, 6); PG8_WAIT_L(0); PG8_BAR; PG8_MMA(1, 0, At, B0); PG8_MMA(1, 1, At, B1); PG8_BAR; PG8_SCHED;
            PG8_LDB(B0, 1, 0); PG8_LDB(B1, 1, 1); PG8_SCHED; PG8_LDA(At, 1, 0); PG8_STAGE_A(PG8_SA(0, 1), a2 + hstepA);
            PG8_WAIT_VS(8, 6); PG8_WAIT_L(0); PG8_BAR; PG8_MMA(0, 0, At, B0); PG8_MMA(0, 1, At, B1); PG8_BAR; PG8_SCHED;
            PG8_LDA(At, 1, 1); PG8_STAGE(PG8_SB(1, 0), b3, voffB); PG8_STAGE(PG8_SB(1, 1), b3 + hstep, voffB); PG8_STAGE_A(PG8_SA(1, 0), a3);
            PG8_WAIT_VS(8, 6); PG8_WAIT_L(0); PG8_BAR; PG8_MMA(1, 0, At, B0); PG8_MMA(1, 1, At, B1); PG8_BAR; PG8_SCHED;
            } else {
            PG8_LDB(B0, 0, 0); PG8_SCHED; PG8_LDA(At, 0, 0); PG8_STAGE_A(PG8_SA(1, 1), a1 + hstepA);
            PG8_WAIT_L(8); PG8_BAR; PG8_WAIT_L(0); PG8_MMA(0, 0, At, B0); PG8_BAR; PG8_SCHED;
            PG8_LDB(B1, 0, 1); PG8_STAGE(PG8_SB(0, 0), b2, voffB);
            PG8_BAR; PG8_WAIT_L(0); PG8_MMA(0, 1, At, B1); PG8_BAR;
            PG8_LDA(At, 0, 1); PG8_STAGE_A(PG8_SA(0, 0), a2);
            PG8_BAR; PG8_WAIT_L(0); PG8_MMA(1, 0, At, B0); PG8_BAR; PG8_SCHED;
            PG8_STAGE(PG8_SB(0, 1), b2 + hstep, voffB);
            PG8_WAIT_V(6); PG8_BAR; PG8_MMA(1, 1, At, B1); PG8_BAR;
            PG8_LDB(B0, 1, 0); PG8_SCHED; PG8_LDA(At, 1, 0); PG8_STAGE_A(PG8_SA(0, 1), a2 + hstepA);
            PG8_WAIT_L(8); PG8_BAR; PG8_WAIT_L(0); PG8_MMA(0, 0, At, B0); PG8_BAR; PG8_SCHED;
            PG8_LDB(B1, 1, 1); PG8_STAGE(PG8_SB(1, 0), b3, voffB);
            PG8_BAR; PG8_WAIT_L(0); PG8_MMA(0, 1, At, B1); PG8_BAR;
            PG8_LDA(At, 1, 1); PG8_STAGE_A(PG8_SA(1, 0), a3);
            PG8_BAR; PG8_WAIT_L(0); PG8_MMA(1, 0, At, B0); PG8_BAR; PG8_SCHED;
            PG8_STAGE(PG8_SB(1, 1), b3 + hstep, voffB);
            PG8_WAIT_V(6); PG8_BAR; PG8_MMA(1, 1, At, B1); PG8_BAR;
            }
        }
#ifdef PG8_TIME
        if (tme) { const unsigned long long t1 = __builtin_amdgcn_s_memrealtime(); pg8_tacc[0] += t1 - tk0; tk0 = t1; }
#endif
        if constexpr (ALIGN_EPI) { if (wr == 0) PG8_BAR; }
        if constexpr (!Epi::AFTER_DRAIN) { if constexpr (epi_state<Epi>::value) E(acc, cur, wr, wc, fr, fq, est); else if constexpr (epi_pre<Epi>::value) E(acc, cur, wr, wc, fr, fq, lds + STAGE_BYTES + Epi::PRE_SLOT + (ui & 1) * Epi::PRE_BYTES);
            else E(acc, cur, wr, wc, fr, fq); S.done(cur);
            if constexpr (epi_pre<Epi>::value) { if (has_next) E.pre(nxt, lds + STAGE_BYTES + Epi::PRE_SLOT + ((ui + 1) & 1) * Epi::PRE_BYTES, wr, wc, lane); } }
#ifdef PG8_TIME
        if (tme) { const unsigned long long t1 = __builtin_amdgcn_s_memrealtime(); pg8_tacc[1] += t1 - tk0; }
#endif
        if (!has_next) break;
#pragma unroll
        for (int a = 0; a < 2; ++a)
#pragma unroll
            for (int b = 0; b < 2; ++b)
#pragma unroll
                for (int m = 0; m < MFR; ++m)
#pragma unroll
                    for (int n = 0; n < 2; ++n) acc[a][b][m][n] = (f32x4){0.f, 0.f, 0.f, 0.f};
        cur = nxt; cA = nA; cB = nB; ++ui;
        if constexpr (ALIGN_EPI) { if (wr == 1) PG8_BAR; }
    }
    PG8_WAIT_V(0);
    if constexpr (!ALIGN_EPI) { if (wr == 0) PG8_BAR; }
    PG8_BAR;
    if constexpr (Epi::AFTER_DRAIN) { E.fused(acc, cur, wr, wc, fr, fq, lds, wid, lane); S.done(cur); }
#undef PG8_SA
#undef PG8_SB
#undef PG8_STAGE
#undef PG8_LDA
#undef PG8_LDB
#undef PG8_MMA
#undef PG8_WAIT_V
#undef PG8_WAIT_VS
#undef PG8_STAGE_A
#undef PG8_WAIT_L
#undef PG8_BAR
#undef PG8_SCHED
}
}

#ifndef PROBE_MASK
#define PROBE_MASK 0
#endif
#define PROBE_MULT 8
#ifndef PROBE_BLK
#define PROBE_BLK (((PROBE_MASK >> 13) & 0x61) ? gridDim.x / 2 : 0)
#endif
#ifndef PB_DUP1
#define PB_DUP1 1
#endif
#ifndef PG8_SP2
#define PG8_SP2 true
#endif
#ifndef PG8_ALIGN
#define PG8_ALIGN true
#endif

#define LAS __attribute__((address_space(3)))
using pg8::bf16_t; using pg8::f32x4; using pg8::bf16x8; using pg8::u32x4;
typedef unsigned u32x2 __attribute__((ext_vector_type(2)));
typedef float f32x2 __attribute__((ext_vector_type(2)));

constexpr int DM = 1024;
constexpr int RP = 8192, RS = 4096, R = 12288;
constexpr int SEQP = 256, SEQS = 2048, PAST = 512, KVS = PAST + SEQS;
constexpr int KVR = RP + 2 * KVS;
constexpr int NH = 8;
constexpr int INC = 5216, INP = 5376;
constexpr int DFF = 2816, UPN = 5632;
constexpr float EPS = 1e-6f;
constexpr float ATT_SCALE = 0.07216878364870322f;

enum { I_XP = 0, I_XS, I_C, I_CKV, I_CKR, I_SSD, I_CCTX, I_WADA, I_BADA, I_GATTN, I_WIN, I_GQ, I_GKV, I_WUQ, I_WUKV, I_WOMLA,
       I_CONVW, I_CONVB, I_DTB, I_ALOG, I_SSDD, I_GSSD, I_WOSSD, I_WOUT, I_GFFN, I_WUP, I_FCW, I_FCB, I_WDOWN, I_GFIN };

constexpr size_t O_Y = 0, O_CKV = (size_t)R * DM, O_KR = O_CKV + (size_t)RP * 256, O_SSD = O_KR + (size_t)RP * 64;

constexpr size_t MiB = 1u << 20;
constexpr size_t WS_CTL = 0, CTL_ZERO = 65536;
constexpr size_t WS_MOD = 64 * 1024;
constexpr size_t WS_CUP = 160 * 1024;
constexpr size_t WS_ROPE = 256 * 1024;
constexpr size_t WS_CST = 800 * 1024;
constexpr size_t WS_SSQ_CQ = 1 * MiB;
constexpr size_t WS_SSQ_CKV = 1 * MiB + 204800;
constexpr size_t WS_SSQ_Y = 1 * MiB + 430080;
constexpr size_t WS_SSQ2 = 1 * MiB + 1216512;
constexpr size_t WS_DT = 3 * MiB;
constexpr size_t WS_DEC = 3 * MiB + 1572864;
constexpr size_t WS_ZERO = WS_DEC + 16384;
constexpr size_t WS_WIN = 5 * MiB;
constexpr size_t WS_WUQ = WS_WIN + (size_t)INP * 1024 * 2;
constexpr size_t WS_WUKV = WS_WUQ + 1536 * 256 * 2;
constexpr size_t WS_WOMLA = WS_WUKV + 2048 * 256 * 2;
constexpr size_t WS_WOSSD = WS_WOMLA + 2 * MiB;
constexpr size_t WS_WOUT = WS_WOSSD + 2 * MiB;
constexpr size_t WS_WUP = WS_WOUT + 2 * MiB;
constexpr size_t WS_WDOWN = WS_WUP + (size_t)UPN * 1024 * 2;
static_assert(WS_WDOWN + (size_t)1024 * DFF * 2 <= 40 * MiB, "weights");
constexpr size_t WS_CQ = 40 * MiB;
constexpr size_t WS_CKVA = 46 * MiB;
constexpr size_t WS_KROPE = 46 * MiB + (size_t)KVR * 256 * 2;
constexpr size_t WS_Z = 55 * MiB;
constexpr size_t WS_XBC = 79 * MiB;
constexpr size_t WS_H = 115 * MiB;
constexpr size_t WS_QN = 115 * MiB;
constexpr size_t WS_QR = 139 * MiB;
constexpr size_t WS_KV = 151 * MiB;
constexpr size_t WS_ST = 203 * MiB;
constexpr size_t WS_MERGED = 151 * MiB;
constexpr size_t WS_A1 = 83 * MiB;
constexpr size_t WS_U = 115 * MiB;
constexpr size_t WS_UG = 115 * MiB;
constexpr size_t WS_HALO = 182 * MiB;
constexpr size_t WS_END = 251 * MiB;
static_assert(WS_KROPE + (size_t)KVR * 64 * 2 <= WS_Z && WS_KV + (size_t)KVR * 2048 * 2 <= WS_ST && WS_ST + (size_t)R * 1024 * 4 <= WS_END, "map");
static_assert(WS_UG + (size_t)R * DFF * 2 <= WS_HALO && WS_HALO + (size_t)192 * 4 * UPN * 2 <= WS_END, "map2");
static_assert(WS_A1 + (size_t)R * 1024 * 2 <= WS_UG, "a1 clear of ug");

constexpr int LDS_BYTES = 147456;
constexpr int NT = 512;

struct Params { const float* in[30]; float* out; unsigned char* ws; };
#define PHASE_IDS int tid = threadIdx.x; asm volatile("" : "+v"(tid)); const int lane = tid & 63, wave = __builtin_amdgcn_readfirstlane(tid >> 6), G = gridDim.x; (void)lane; (void)wave; (void)G;

#define LDS_WAIT() asm volatile("s_waitcnt lgkmcnt(0)" ::: "memory")
__device__ __forceinline__ unsigned f2bf(float f) { unsigned u = __builtin_bit_cast(unsigned, f); return (u + 0x7fffu + ((u >> 16) & 1u)) >> 16; }
__device__ __forceinline__ float bf2f(unsigned short b) { return __builtin_bit_cast(float, (unsigned)b << 16); }
typedef __bf16 bf16x2_t __attribute__((ext_vector_type(2)));
__device__ __forceinline__ unsigned pk2(float lo, float hi) { const f32x2 v = {lo, hi}; const bf16x2_t b = __builtin_convertvector(v, bf16x2_t); return __builtin_bit_cast(unsigned, b); }
__device__ __forceinline__ float bflo(unsigned w) { return __builtin_bit_cast(float, w << 16); }
__device__ __forceinline__ float bfhi(unsigned w) { return __builtin_bit_cast(float, w & 0xffff0000u); }
__device__ __forceinline__ float wave_sum(float v) {
#pragma unroll
    for (int o = 1; o < 64; o <<= 1) v += __shfl_xor(v, o);
    return v;
}
__device__ __forceinline__ float wave_max(float v) {
#pragma unroll
    for (int o = 1; o < 64; o <<= 1) v = fmaxf(v, __shfl_xor(v, o));
    return v;
}
__device__ __forceinline__ void unpack8(const u32x4 w, float* f) {
#pragma unroll
    for (int e = 0; e < 4; ++e) { f[2 * e] = bflo(w[e]); f[2 * e + 1] = bfhi(w[e]); }
}
__device__ __forceinline__ float sigm(float x) { return __builtin_amdgcn_rcpf(1.f + __expf(-x)); }
__device__ __forceinline__ float siluf(float x) { return x * sigm(x); }
__device__ __forceinline__ float softplusf(float x) { return fmaxf(x, 0.f) + __logf(1.f + __expf(-fabsf(x))); }
__device__ __forceinline__ int grp_of_row(int row) { return row < RP ? 0 : 1 + ((row - RP) >> 11); }
__device__ __forceinline__ int kvrow_of_row(int row) { return row < RP ? row : RP + ((row - RP) >> 11) * KVS + PAST + ((row - RP) & 2047); }
__device__ __forceinline__ const float* xrow_ptr(const Params& P, int row) { return row < RP ? P.in[I_XP] + (size_t)row * DM : P.in[I_XS] + (size_t)(row - RP) * DM; }

__device__ __forceinline__ int pair_pos(int i) { return 8 * ((i & 15) >> 2) + (i & 3) + (i >= 16 ? 4 : 0); }
__device__ __forceinline__ void transpose_item(const float* W, int K, int N, bf16_t* WT, int k0, int n0, int drow0, const float* kscale, LAS float* scr, int lane, bool pairs = false) {
    float wv[32];
#pragma unroll
    for (int i = 0; i < 32; ++i) wv[i] = __builtin_nontemporal_load(W + (size_t)(k0 + 2 * i + (lane >> 5)) * N + n0 + (lane & 31));
#pragma unroll
    for (int i = 0; i < 32; ++i) { const int kk = 2 * i + (lane >> 5); float w = wv[i]; if (kscale) w *= kscale[k0 + kk]; scr[kk * 33 + (lane & 31)] = w; }
    LDS_WAIT(); asm volatile("" ::: "memory");
    const int c = lane & 7;
#pragma unroll
    for (int j = 0; j < 4; ++j) { const int n = (lane >> 3) + 8 * j; const LAS float* s = scr + (8 * c) * 33 + n;
        u32x4 o; o.x = pk2(s[0 * 33], s[1 * 33]); o.y = pk2(s[2 * 33], s[3 * 33]); o.z = pk2(s[4 * 33], s[5 * 33]); o.w = pk2(s[6 * 33], s[7 * 33]);
        *(u32x4*)(WT + (size_t)(drow0 + (pairs ? pair_pos(n) : n)) * K + k0 + 8 * c) = o; }
    LDS_WAIT(); asm volatile("" ::: "memory");
}
__device__ __forceinline__ int win_dst(int n0) {
    if (n0 < 512) return n0;
    if (n0 < 576) return 5120 + (n0 - 512);
    if (n0 < 1600) return 512 + (n0 - 576);
    if (n0 < 2624) return 1536 + (n0 - 1600);
    if (n0 < 2880) return 2560 + (n0 - 2624);
    if (n0 < 3136) return 2816 + (n0 - 2880);
    if (n0 < 3168) return 5184 + (n0 - 3136);
    if (n0 < 4192) return 3072 + (n0 - 3168);
    return 4096 + (n0 - 4192);
}
__device__ __forceinline__ int wup_dst(int n0) { const bool isv = n0 >= DFF; const int j = isv ? n0 - DFF : n0; return (j >> 7) * 256 + (isv ? 128 : 0) + (j & 127); }
__device__ __forceinline__ int wuq_dst(int n0) { const int h = n0 / 192, d0 = n0 - h * 192; return d0 < 128 ? h * 128 + d0 : 1024 + h * 64 + (d0 - 128); }

template <int CW>
__device__ __forceinline__ void gemv3_block(const LAS float* vec  , const float* W, int N, int col0, const float* bias, float* out, int ldo, LAS float* red, int tid) {
    const int j = tid & 31, kq = tid >> 5;
    float a0 = 0.f, a1 = 0.f, a2 = 0.f;
    if (j < CW) {
        const float* wp = W + (size_t)(kq * 64) * N + col0 + j;
#pragma unroll 32
        for (int k = 0; k < 64; ++k) { const float w = __builtin_nontemporal_load(wp + (size_t)k * N); const int kk = kq * 64 + k; a0 += vec[kk] * w; a1 += vec[1024 + kk] * w; a2 += vec[2048 + kk] * w; }
    }
    red[(kq * 3 + 0) * 32 + j] = a0; red[(kq * 3 + 1) * 32 + j] = a1; red[(kq * 3 + 2) * 32 + j] = a2;
    __syncthreads();
    if (tid < 96) { const int g = tid >> 5, jj = tid & 31;
        if (jj < CW) { float s = 0.f;
#pragma unroll
            for (int q = 0; q < 16; ++q) s += red[(q * 3 + g) * 32 + jj];
            out[(size_t)g * ldo + col0 + jj] = s + (bias ? bias[col0 + jj] : 0.f); } }
    __syncthreads();
}

__device__ __forceinline__ void phase_p0(const Params& P, LAS unsigned char* lds) {
    PHASE_IDS unsigned char* ws = P.ws;
    {
        LAS float* sc = (LAS float*)lds; LAS float* red = sc + 3072;
        for (int i = tid; i < 3072; i += NT) { const int g = i >> 10, k = i & 1023; const float c = (g == 0) ? P.in[I_CCTX][k] : P.in[I_C][(g - 1) * 1024 + k]; sc[i] = siluf(c); }
        __syncthreads();
        for (int cb = blockIdx.x; cb < 256; cb += G) gemv3_block<24>(sc, P.in[I_WADA], 6144, cb * 24, P.in[I_BADA], (float*)(ws + WS_MOD), 6144, red, tid);
    }
    {
        LAS float* scr = (LAS float*)(lds + wave * 16384);
        const int gw = blockIdx.x * 8 + wave, NGW = G * 8;
        constexpr int I_IN = 16 * 163, I_UQ = 4 * 48, I_UKV = 4 * 64, I_SQ = 16 * 32, I_UP = 16 * 176, I_DN = 44 * 32;
        constexpr int NITEMS = I_IN + I_UQ + I_UKV + 3 * I_SQ + I_UP + I_DN;
        for (int it = gw; it < NITEMS; it += NGW) {
            int r = it;
            if (r < I_IN) { const int kb = r / 163, nb = r % 163; transpose_item(P.in[I_WIN], 1024, INC, (bf16_t*)(ws + WS_WIN), kb * 64, nb * 32, win_dst(nb * 32), nullptr, scr, lane, win_dst(nb * 32) >= 5120); continue; } r -= I_IN;
            if (r < I_UQ) { const int kb = r / 48, nb = r % 48; transpose_item(P.in[I_WUQ], 256, 1536, (bf16_t*)(ws + WS_WUQ), kb * 64, nb * 32, wuq_dst(nb * 32), P.in[I_GQ], scr, lane); continue; } r -= I_UQ;
            if (r < I_UKV) { const int kb = r / 64, nb = r % 64; transpose_item(P.in[I_WUKV], 256, 2048, (bf16_t*)(ws + WS_WUKV), kb * 64, nb * 32, nb * 32, P.in[I_GKV], scr, lane); continue; } r -= I_UKV;
            if (r < I_SQ) { const int kb = r / 32, nb = r % 32; transpose_item(P.in[I_WOMLA], 1024, 1024, (bf16_t*)(ws + WS_WOMLA), kb * 64, nb * 32, nb * 32, nullptr, scr, lane); continue; } r -= I_SQ;
            if (r < I_SQ) { const int kb = r / 32, nb = r % 32; transpose_item(P.in[I_WOSSD], 1024, 1024, (bf16_t*)(ws + WS_WOSSD), kb * 64, nb * 32, nb * 32, P.in[I_GSSD], scr, lane); continue; } r -= I_SQ;
            if (r < I_SQ) { const int kb = r / 32, nb = r % 32; transpose_item(P.in[I_WOUT], 1024, 1024, (bf16_t*)(ws + WS_WOUT), kb * 64, nb * 32, nb * 32, nullptr, scr, lane); continue; } r -= I_SQ;
            if (r < I_UP) { const int kb = r / 176, nb = r % 176; transpose_item(P.in[I_WUP], 1024, UPN, (bf16_t*)(ws + WS_WUP), kb * 64, nb * 32, wup_dst(nb * 32), nullptr, scr, lane); continue; } r -= I_UP;
            { const int kb = r / 32, nb = r % 32; transpose_item(P.in[I_WDOWN], DFF, 1024, (bf16_t*)(ws + WS_WDOWN), kb * 64, nb * 32, nb * 32, nullptr, scr, lane); }
        }
    }
    {
        const int gt = blockIdx.x * NT + tid, GT = G * NT;
        for (int i = gt; i < 8192 / 16; i += GT) *(u32x4*)(ws + WS_ZERO + (size_t)i * 16) = (u32x4){0u, 0u, 0u, 0u};
        for (int i = gt; i < 160 * 1024 / 8; i += GT) *(u32x4*)((bf16_t*)(ws + WS_WIN) + (size_t)5216 * 1024 + (size_t)i * 8) = (u32x4){0u, 0u, 0u, 0u};
        for (int i = gt; i < 2048 * 32; i += GT) { const int t = i >> 5, a = (i >> 4) & 1, fi = i & 15; const float pos = (float)(a ? (t & 63) : (t >> 6));
            const float inv = exp2f(-(float)fi * 0.8304820237218406f); const float ang = pos * inv;
            ((f32x2*)(ws + WS_ROPE))[i] = (f32x2){__cosf(ang), __sinf(ang)}; }
        for (int i = gt; i < 2 * PAST * 256; i += GT) { const int k = i & 255, s = (i >> 8) & 511, b = i >> 17;
            ((bf16_t*)(ws + WS_CKVA))[(size_t)(RP + b * KVS + s) * 256 + k] = (bf16_t)f2bf(P.in[I_CKV][i] / P.in[I_GKV][k]); }
        for (int i = gt; i < 2 * PAST * 64; i += GT) { const int j = i & 63, s = (i >> 6) & 511, b = i >> 15;
            ((bf16_t*)(ws + WS_KROPE))[(size_t)(RP + b * KVS + s) * 64 + j] = (bf16_t)f2bf(P.in[I_CKR][i]); }
        for (int i = gt; i < 2 * PAST; i += GT) { const int s = i & 511, b = i >> 9;
            *(f32x4*)((float*)(ws + WS_SSQ_CKV) + (size_t)(RP + b * KVS + s) * 4) = (f32x4){256.f * (1.f - EPS), 0.f, 0.f, 0.f}; }
    }
}

__device__ __forceinline__ void phase_p1(const Params& P, LAS unsigned char* lds) {
    PHASE_IDS unsigned char* ws = P.ws; const float* mod = (const float*)(ws + WS_MOD);
    const int gw = blockIdx.x * 8 + wave, NGW = G * 8;
    {
        float s2[3][16];
#pragma unroll
        for (int g = 0; g < 3; ++g)
#pragma unroll
            for (int q = 0; q < 4; ++q) { const f32x4 a = *(const f32x4*)(mod + g * 6144 + 3072 + (q >> 1) * 512 + 8 * lane + 4 * (q & 1));
#pragma unroll
                for (int e = 0; e < 4; ++e) s2[g][4 * q + e] = a[e]; }
        const bf16_t* wt = (const bf16_t*)(ws + WS_WUP);
        for (int j = gw; j < UPN; j += NGW) {
            const size_t jr = (size_t)(wup_dst(j & ~31) + (j & 31)) * 1024;
            float wf[16]; unpack8(*(const u32x4*)(wt + jr + 8 * lane), wf); unpack8(*(const u32x4*)(wt + jr + 512 + 8 * lane), wf + 8);
            float a0 = 0.f, a1 = 0.f, a2 = 0.f;
#pragma unroll
            for (int e = 0; e < 16; ++e) { a0 += s2[0][e] * wf[e]; a1 += s2[1][e] * wf[e]; a2 += s2[2][e] * wf[e]; }
            a0 = wave_sum(a0); a1 = wave_sum(a1); a2 = wave_sum(a2);
            if (lane == 0) { float* cu = (float*)(ws + WS_CUP); cu[j] = a0; cu[UPN + j] = a1; cu[2 * UPN + j] = a2;
                const float* fw = P.in[I_FCW]; const float wsum = (fw[j] + fw[UPN + j]) + fw[2 * UPN + j], bb = P.in[I_FCB][j]; float* cs = (float*)(ws + WS_CST);
                cs[j] = a0 * wsum + bb; cs[UPN + j] = a1 * wsum + bb; cs[2 * UPN + j] = a2 * wsum + bb; }
        }
    }
    const float* gat = P.in[I_GATTN];
    for (int row0 = gw * 2; row0 < R; row0 += NGW * 2) {
        const int g = grp_of_row(row0);
        f32x4 v[2][4]; float s[2] = {0.f, 0.f};
#pragma unroll
        for (int q = 0; q < 2; ++q) { const f32x4* xr = (const f32x4*)xrow_ptr(P, row0 + q) + lane;
#pragma unroll
            for (int j = 0; j < 4; ++j) v[q][j] = __builtin_nontemporal_load(xr + 64 * j); }
#pragma unroll
        for (int q = 0; q < 2; ++q)
#pragma unroll
            for (int j = 0; j < 4; ++j) s[q] += (v[q][j].x * v[q][j].x + v[q][j].y * v[q][j].y) + (v[q][j].z * v[q][j].z + v[q][j].w * v[q][j].w);
        const float rs0 = rsqrtf(wave_sum(s[0]) * (1.f / DM) + EPS), rs1 = rsqrtf(wave_sum(s[1]) * (1.f / DM) + EPS);
#pragma unroll
        for (int j = 0; j < 4; ++j) { const int c = 4 * lane + 256 * j;
            const f32x4 gg = *(const f32x4*)(gat + c), sc = *(const f32x4*)(mod + g * 6144 + 1024 + c), sh = *(const f32x4*)(mod + g * 6144 + c);
            const f32x4 gs = gg * (sc + 1.f);
            const f32x4 h0 = v[0][j] * rs0 * gs + sh, h1 = v[1][j] * rs1 * gs + sh;
            ((u32x2*)((bf16_t*)(ws + WS_H) + (size_t)row0 * DM) + lane)[64 * j] = (u32x2){pk2(h0.x, h0.y), pk2(h0.z, h0.w)};
            ((u32x2*)((bf16_t*)(ws + WS_H) + (size_t)(row0 + 1) * DM) + lane)[64 * j] = (u32x2){pk2(h1.x, h1.y), pk2(h1.z, h1.w)}; }
    }
}

typedef const f32x4 (&AccRef)[2][2][4][2];
typedef const f32x4 (&AccRef3)[2][2][3][2];
#define EPI_ROWS_M(pm, MFR) _Pragma("unroll") for (int ai = 0; ai < 2; ++ai) _Pragma("unroll") for (int m = 0; m < (MFR); ++m) { const int row = (pm) * (64 * (MFR)) + ai * (32 * (MFR)) + wr * (16 * (MFR)) + m * 16 + fr;
#define EPI_ROWS(pm) _Pragma("unroll") for (int ai = 0; ai < 2; ++ai) _Pragma("unroll") for (int m = 0; m < 4; ++m) { const int row = (pm) * 256 + ai * 128 + wr * 64 + m * 16 + fr;
#define EPI_COLS _Pragma("unroll") for (int bj = 0; bj < 2; ++bj) _Pragma("unroll") for (int n = 0; n < 2; ++n) { const int col = bj * 128 + wc * 32 + n * 16 + fq * 4; const f32x4 v = acc[ai][bj][m][n];
#define EPI_END }
#define EPI_COLS8 _Pragma("unroll") for (int bj = 0; bj < 2; ++bj) { const int col = bj * 128 + wc * 32 + fq * 8; const f32x4 v0 = acc[ai][bj][m][0], v1 = acc[ai][bj][m][1];
__device__ __forceinline__ void st_bf8(bf16_t* p, f32x4 a, f32x4 b) { *(u32x4*)p = (u32x4){pk2(a.x, a.y), pk2(a.z, a.w), pk2(b.x, b.y), pk2(b.z, b.w)}; }
__device__ __forceinline__ void st_bf4(bf16_t* p, f32x4 v) { *(u32x2*)p = (u32x2){pk2(v.x, v.y), pk2(v.z, v.w)}; }
__device__ __forceinline__ f32x4 ld_bf4(const bf16_t* p) { const u32x2 w = *(const u32x2*)p; return (f32x4){bflo(w.x), bfhi(w.x), bflo(w.y), bfhi(w.y)}; }
__device__ __forceinline__ float quad_sum16(float s) { s += __shfl_xor(s, 16); s += __shfl_xor(s, 32); return s; }

struct EpiInMain {
    static constexpr bool PERM = true, AFTER_DRAIN = false;
#if defined(PG8_TIME) && PG8_TPH == 1
    static constexpr bool TIMED = true;
#endif
    bf16_t *cq, *ckv, *z, *xbc, *sgm, *sgs; float *ssq_cq, *ssq_ckv, *new_ckv;
    bf16_t* krope; float *dt, *new_krope; const float* dt_bias; const f32x2* rope;
    __device__ __forceinline__ void operator()(AccRef acc, const pg8::Unit& u, int wr, int wc, int fr, int fq) const {
        const int pn = u.pn;
        if (pn == 20) {
            if (wc < 2) {
                EPI_ROWS(u.pm)
                    const f32x4 x0 = acc[ai][0][m][0], x1 = acc[ai][0][m][1]; const int i0 = fq * 4;
                    if (row < RP) {
                        st_bf4(krope + (size_t)row * 64 + wc * 32 + i0, x0); st_bf4(krope + (size_t)row * 64 + wc * 32 + 16 + i0, x1);
                        *(f32x4*)(new_krope + (size_t)row * 64 + wc * 32 + i0) = x0; *(f32x4*)(new_krope + (size_t)row * 64 + wc * 32 + 16 + i0) = x1;
                    } else {
                        const int t = (row - RP) & 2047; const f32x2* rp = rope + t * 32 + wc * 16 + i0; f32x4 o0, o1;
#pragma unroll
                        for (int e = 0; e < 4; ++e) { const f32x2 cs = rp[e]; o0[e] = x0[e] * cs.x - x1[e] * cs.y; o1[e] = x0[e] * cs.y + x1[e] * cs.x; }
                        bf16_t* dst = krope + (size_t)kvrow_of_row(row) * 64 + wc * 32 + i0; st_bf4(dst, o0); st_bf4(dst + 16, o1);
                    }
                EPI_END
            } else if (wc == 2) {
                EPI_ROWS(u.pm)
#pragma unroll
                    for (int n = 0; n < 2; ++n) { const int j = n * 16 + fq * 4; const f32x4 v = acc[ai][0][m][n]; const f32x4 b = *(const f32x4*)(dt_bias + j);
                        *(f32x4*)(dt + (size_t)row * 32 + j) = (f32x4){softplusf(v.x + b.x), softplusf(v.y + b.y), softplusf(v.z + b.z), softplusf(v.w + b.w)}; }
                EPI_END
            }
        } else if (pn < 2) {
            EPI_ROWS(u.pm)
                const int orow = pn == 0 ? row : kvrow_of_row(row); bf16_t* dst = (pn == 0 ? cq : ckv) + (size_t)orow * 256; float s = 0.f;
                EPI_COLS8
                    st_bf8(dst + col, v0, v1); s += ((v0.x * v0.x + v0.y * v0.y) + (v0.z * v0.z + v0.w * v0.w)) + ((v1.x * v1.x + v1.y * v1.y) + (v1.z * v1.z + v1.w * v1.w));
                    if (pn == 1 && row < RP) { *(f32x4*)(new_ckv + (size_t)row * 256 + col) = v0; *(f32x4*)(new_ckv + (size_t)row * 256 + col + 4) = v1; }
                EPI_END
                s = quad_sum16(s);
                if (fq == 0) (pn == 0 ? ssq_cq : ssq_ckv)[(size_t)orow * 4 + wc] = s;
            EPI_END
        } else if (pn < 12) {
            bf16_t* base = pn < 6 ? z : xbc; const int ld = pn < 6 ? 1024 : 1536, c0 = pn < 6 ? (pn - 2) * 256 : (pn - 6) * 256;
            EPI_ROWS(u.pm)
                bf16_t* dst = base + (size_t)row * ld + c0;
                EPI_COLS8 st_bf8(dst + col, v0, v1); EPI_END
            EPI_END
        } else {
            bf16_t* base = pn < 16 ? sgm : sgs; const int c0 = (pn & 3) * 256;
            EPI_ROWS(u.pm)
                bf16_t* dst = base + (size_t)row * 1024 + c0;
                EPI_COLS8 __builtin_nontemporal_store((u32x4){pk2(sigm(v0.x), sigm(v0.y)), pk2(sigm(v0.z), sigm(v0.w)), pk2(sigm(v1.x), sigm(v1.y)), pk2(sigm(v1.z), sigm(v1.w))}, (u32x4*)(dst + col)); EPI_END
            EPI_END
        }
    }
};
struct EpiInTail {
    static constexpr bool PERM = false, AFTER_DRAIN = false;
    bf16_t* krope; float *dt, *new_krope; const float* dt_bias; const f32x2* rope;
    __device__ __forceinline__ void operator()(AccRef acc, const pg8::Unit& u, int wr, int wc, int fr, int fq) const {
        if (wc < 2) {
            EPI_ROWS(u.pm)
                const f32x4 x0 = acc[ai][0][m][0], x1 = acc[ai][0][m][1]; const int i0 = fq * 4;
                if (row < RP) {
                    st_bf4(krope + (size_t)row * 64 + wc * 32 + i0, x0); st_bf4(krope + (size_t)row * 64 + wc * 32 + 16 + i0, x1);
                    *(f32x4*)(new_krope + (size_t)row * 64 + wc * 32 + i0) = x0; *(f32x4*)(new_krope + (size_t)row * 64 + wc * 32 + 16 + i0) = x1;
                } else {
                    const int t = (row - RP) & 2047; const f32x2* rp = rope + t * 32 + wc * 16 + i0; f32x4 o0, o1;
#pragma unroll
                    for (int e = 0; e < 4; ++e) { const f32x2 cs = rp[e]; o0[e] = x0[e] * cs.x - x1[e] * cs.y; o1[e] = x0[e] * cs.y + x1[e] * cs.x; }
                    bf16_t* dst = krope + (size_t)kvrow_of_row(row) * 64 + wc * 32 + i0; st_bf4(dst, o0); st_bf4(dst + 16, o1);
                }
            EPI_END
        } else if (wc == 2) {
            EPI_ROWS(u.pm)
#pragma unroll
                for (int n = 0; n < 2; ++n) { const int j = n * 16 + fq * 4; const f32x4 v = acc[ai][0][m][n]; const f32x4 b = *(const f32x4*)(dt_bias + j);
                    *(f32x4*)(dt + (size_t)row * 32 + j) = (f32x4){softplusf(v.x + b.x), softplusf(v.y + b.y), softplusf(v.z + b.z), softplusf(v.w + b.w)}; }
            EPI_END
        }
    }
};

struct EpiQR {
    static constexpr bool PERM = false, AFTER_DRAIN = false;
    bf16_t* qr; const float* ssq; const f32x2* rope;
    __device__ __forceinline__ void operator()(AccRef acc, const pg8::Unit& u, int wr, int wc, int fr, int fq) const {
        EPI_ROWS(u.pm)
            const f32x4 sq = *(const f32x4*)(ssq + (size_t)row * 4); const float rs = rsqrtf(((sq.x + sq.y) + (sq.z + sq.w)) * (1.f / 256.f) + EPS);
            bf16_t* dst = qr + (size_t)row * 512 + u.pn * 256;
#pragma unroll
            for (int bj = 0; bj < 2; ++bj) { const int cb = bj * 128 + wc * 32, i0 = fq * 4; const f32x4 x0 = acc[ai][bj][m][0] * rs, x1 = acc[ai][bj][m][1] * rs;
                if (row < RP) { st_bf4(dst + cb + i0, x0); st_bf4(dst + cb + 16 + i0, x1); }
                else { const int t = (row - RP) & 2047; const f32x2* rp = rope + t * 32 + (wc & 1) * 16 + i0; f32x4 o0, o1;
#pragma unroll
                    for (int e = 0; e < 4; ++e) { const f32x2 cs = rp[e]; o0[e] = x0[e] * cs.x - x1[e] * cs.y; o1[e] = x0[e] * cs.y + x1[e] * cs.x; }
                    st_bf4(dst + cb + i0, o0); st_bf4(dst + cb + 16 + i0, o1); } }
        EPI_END
    }
};
template <int MFR> struct EpiMla {
    static constexpr bool PERM = true, AFTER_DRAIN = false;
    const bf16_t* sgm; float* t;
    __device__ __forceinline__ void operator()(const f32x4 (&acc)[2][2][MFR][2], const pg8::Unit& u, int wr, int wc, int fr, int fq) const {
        EPI_ROWS_M(u.pm, MFR)
            const size_t off = (size_t)row * 1024 + u.pn * 256;
            EPI_COLS8 const u32x4 gw = *(const u32x4*)(sgm + off + col);
                *(f32x4*)(t + off + col) = (f32x4){bflo(gw.x), bfhi(gw.x), bflo(gw.y), bfhi(gw.y)} * v0; *(f32x4*)(t + off + col + 4) = (f32x4){bflo(gw.z), bfhi(gw.z), bflo(gw.w), bfhi(gw.w)} * v1; EPI_END
        EPI_END
    }
};
template <int MFR> struct EpiSsd {
    static constexpr bool PERM = true, AFTER_DRAIN = false;
    const bf16_t* sgs; const float* t; const float* ssq_y; bf16_t* merged;
    __device__ __forceinline__ void operator()(const f32x4 (&acc)[2][2][MFR][2], const pg8::Unit& u, int wr, int wc, int fr, int fq) const {
        EPI_ROWS_M(u.pm, MFR)
            float s = 0.f;
#pragma unroll
            for (int q = 0; q < 4; ++q) { const f32x4 a = *(const f32x4*)(ssq_y + (size_t)row * 16 + q * 4); s += (a.x + a.y) + (a.z + a.w); }
            const float rs = rsqrtf(s * (1.f / 1024.f) + EPS); const size_t off = (size_t)row * 1024 + u.pn * 256;
            EPI_COLS8 const u32x4 gw = *(const u32x4*)(sgs + off + col);
                st_bf8(merged + off + col, *(const f32x4*)(t + off + col) + (f32x4){bflo(gw.x), bfhi(gw.x), bflo(gw.y), bfhi(gw.y)} * (v0 * rs),
                       *(const f32x4*)(t + off + col + 4) + (f32x4){bflo(gw.z), bfhi(gw.z), bflo(gw.w), bfhi(gw.w)} * (v1 * rs)); EPI_END
        EPI_END
    }
};
template <int MFR> struct EpiOut {
    static constexpr bool PERM = true, AFTER_DRAIN = false;
    const float *xp, *xs, *mod, *gffn; float* x1; bf16_t* a1; float* ssq2;
    __device__ __forceinline__ void operator()(const f32x4 (&acc)[2][2][MFR][2], const pg8::Unit& u, int wr, int wc, int fr, int fq) const {
        EPI_ROWS_M(u.pm, MFR)
            const float* md = mod + grp_of_row(row) * 6144;
            const float* xr = row < RP ? xp + (size_t)row * DM : xs + (size_t)(row - RP) * DM; const size_t off = (size_t)row * 1024; float s = 0.f;
            EPI_COLS8
                const int c = u.pn * 256 + col;
                const f32x4 xa = __builtin_nontemporal_load((const f32x4*)(xr + c)) + *(const f32x4*)(md + 2048 + c) * v0, xb = __builtin_nontemporal_load((const f32x4*)(xr + c + 4)) + *(const f32x4*)(md + 2048 + c + 4) * v1;
                *(f32x4*)(x1 + off + c) = xa; *(f32x4*)(x1 + off + c + 4) = xb;
                s += ((xa.x * xa.x + xa.y * xa.y) + (xa.z * xa.z + xa.w * xa.w)) + ((xb.x * xb.x + xb.y * xb.y) + (xb.z * xb.z + xb.w * xb.w));
                st_bf8(a1 + off + c, xa * *(const f32x4*)(gffn + c) * (*(const f32x4*)(md + 4096 + c) + 1.f), xb * *(const f32x4*)(gffn + c + 4) * (*(const f32x4*)(md + 4096 + c + 4) + 1.f));
            EPI_END
            s = quad_sum16(s);
            if (fq == 0) ssq2[(size_t)row * 16 + u.pn * 4 + wc] = s;
        EPI_END
    }
};
struct EpiUp {
    static constexpr bool PERM = true, AFTER_DRAIN = false;
    const float *ssq2, *cup; bf16_t* uo; int pm_off;
    __device__ __forceinline__ void operator()(AccRef acc, const pg8::Unit& u, int wr, int wc, int fr, int fq) const {
        const int pmo = u.pm + pm_off; const int g = pmo < 32 ? 0 : 1 + ((pmo - 32) >> 3); const float* cu = cup + g * UPN + u.pn * 256;
        EPI_ROWS(pmo)
            float s = 0.f;
#pragma unroll
            for (int q = 0; q < 4; ++q) { const f32x4 a = *(const f32x4*)(ssq2 + (size_t)row * 16 + q * 4); s += (a.x + a.y) + (a.z + a.w); }
            const float rs = rsqrtf(s * (1.f / 1024.f) + EPS); bf16_t* dst = uo + (size_t)row * UPN + u.pn * 256;
            EPI_COLS8 st_bf8(dst + col, v0 * rs + *(const f32x4*)(cu + col), v1 * rs + *(const f32x4*)(cu + col + 4)); EPI_END
        EPI_END
    }
};
constexpr int CG_RB = 16;
struct CgW { float wg[3][8], wv[3][8], bg[8], bv[8]; };
__device__ __forceinline__ void cg_load_w(CgW& W, const float* fw, const float* fb, int c) {
#pragma unroll
    for (int k = 0; k < 3; ++k)
#pragma unroll
        for (int q = 0; q < 2; ++q) { const f32x4 a = *(const f32x4*)(fw + k * UPN + c + 4 * q), b = *(const f32x4*)(fw + k * UPN + DFF + c + 4 * q);
#pragma unroll
            for (int e = 0; e < 4; ++e) { W.wg[k][4 * q + e] = a[e]; W.wv[k][4 * q + e] = b[e]; } }
#pragma unroll
    for (int q = 0; q < 2; ++q) { const f32x4 a = *(const f32x4*)(fb + c + 4 * q), b = *(const f32x4*)(fb + DFF + c + 4 * q);
#pragma unroll
        for (int e = 0; e < 4; ++e) { W.bg[4 * q + e] = a[e]; W.bv[4 * q + e] = b[e]; } }
}
__device__ __forceinline__ float dpp_row_prev(float cur, float prv) {
    const int o = __builtin_amdgcn_update_dpp(0, __float_as_int(prv), 0x121, 0xf, 0xf, true);
    return __int_as_float(__builtin_amdgcn_update_dpp(o, __float_as_int(cur), 0x111, 0xf, 0xf, false)); }
__device__ __forceinline__ float dpp_row_next(float cur, float nxt) {
    const int o = __builtin_amdgcn_update_dpp(0, __float_as_int(nxt), 0x12F, 0xf, 0xf, true);
    return __int_as_float(__builtin_amdgcn_update_dpp(o, __float_as_int(cur), 0x101, 0xf, 0xf, false)); }
__device__ __forceinline__ void conv4_rows(float (&c)[4], float a0, float a1, float a2, float a3, float r0, float r1, float r2, float r3,
                                           float w0, float w1, float w2, float cs) {
    float t0, t1, t2, t3, z; const unsigned long long mlo = 0x0001000100010001ull, mhi = 0x8000800080008000ull;
    asm volatile(
        "v_cndmask_b32_e64 %[z], 0, %[w0], %[mlo]\n\t"
        "v_mul_f32 %[t0], %[a0], %[r0]\n\t" "v_mul_f32 %[t1], %[a1], %[r1]\n\t" "v_mul_f32 %[t2], %[a2], %[r2]\n\t" "v_mul_f32 %[t3], %[a3], %[r3]\n\t"
        "v_fma_f32 %[c0], %[w1], %[t0], %[cs]\n\t" "v_fma_f32 %[c1], %[w1], %[t1], %[cs]\n\t" "v_fma_f32 %[c2], %[w1], %[t2], %[cs]\n\t" "v_fma_f32 %[c3], %[w1], %[t3], %[cs]\n\t"
        "v_fmac_f32_dpp %[c0], %[t0], %[w0] row_shr:1 row_mask:0xf bank_mask:0xf bound_ctrl:1\n\t"
        "v_fmac_f32_dpp %[c1], %[t1], %[w0] row_shr:1 row_mask:0xf bank_mask:0xf bound_ctrl:1\n\t"
        "v_fmac_f32_dpp %[c2], %[t2], %[w0] row_shr:1 row_mask:0xf bank_mask:0xf bound_ctrl:1\n\t"
        "v_fmac_f32_dpp %[c3], %[t3], %[w0] row_shr:1 row_mask:0xf bank_mask:0xf bound_ctrl:1\n\t"
        "v_fmac_f32_dpp %[c0], %[t0], %[w2] row_shl:1 row_mask:0xf bank_mask:0xf bound_ctrl:1\n\t"
        "v_fmac_f32_dpp %[c1], %[t1], %[w2] row_shl:1 row_mask:0xf bank_mask:0xf bound_ctrl:1\n\t"
        "v_fmac_f32_dpp %[c2], %[t2], %[w2] row_shl:1 row_mask:0xf bank_mask:0xf bound_ctrl:1\n\t"
        "v_fmac_f32_dpp %[c3], %[t3], %[w2] row_shl:1 row_mask:0xf bank_mask:0xf bound_ctrl:1\n\t"
        "v_fmac_f32_dpp %[c1], %[t0], %[z] row_ror:1 row_mask:0xf bank_mask:0xf\n\t"
        "v_fmac_f32_dpp %[c2], %[t1], %[z] row_ror:1 row_mask:0xf bank_mask:0xf\n\t"
        "v_fmac_f32_dpp %[c3], %[t2], %[z] row_ror:1 row_mask:0xf bank_mask:0xf\n\t"
        "v_cndmask_b32_e64 %[z], 0, %[w2], %[mhi]\n\t"
        "v_fmac_f32_dpp %[c0], %[t1], %[z] row_ror:15 row_mask:0xf bank_mask:0xf\n\t"
        "v_fmac_f32_dpp %[c1], %[t2], %[z] row_ror:15 row_mask:0xf bank_mask:0xf\n\t"
        "v_fmac_f32_dpp %[c2], %[t3], %[z] row_ror:15 row_mask:0xf bank_mask:0xf"
        : [c0] "=&v"(c[0]), [c1] "=&v"(c[1]), [c2] "=&v"(c[2]), [c3] "=&v"(c[3]), [t0] "=&v"(t0), [t1] "=&v"(t1), [t2] "=&v"(t2), [t3] "=&v"(t3), [z] "=&v"(z)
        : [a0] "v"(a0), [a1] "v"(a1), [a2] "v"(a2), [a3] "v"(a3), [r0] "v"(r0), [r1] "v"(r1), [r2] "v"(r2), [r3] "v"(r3),
          [w0] "v"(w0), [w1] "v"(w1), [w2] "v"(w2), [cs] "v"(cs), [mlo] "s"(mlo), [mhi] "s"(mhi));
}
struct EpiUpGate {
    static constexpr bool PERM = true, AFTER_DRAIN = false;
#if defined(PG8_TIME) && PG8_TPH == 5
    static constexpr bool TIMED = true;
#endif
    static constexpr int PRE_SLOT = 1024, PRE_BYTES = 5120;
    const float *ssq2, *cup, *fcw, *cstp; bf16_t *ug, *halo;
    __device__ __forceinline__ void pre(const pg8::Unit& u, LAS unsigned char* slot, int wr, int wc, int lane) const {
        if (wr != 0) return;
        const int g = u.pm < 32 ? 0 : 1 + ((u.pm - 32) >> 3); const int cb = u.pn * 128 + wc * 32; const int a = lane >> 4, hv = (lane >> 3) & 1, c4 = lane & 7;
        const float* src = (a < 3 ? fcw + a * UPN : cstp + g * UPN) + hv * DFF + cb + c4 * 4;
        __builtin_amdgcn_global_load_lds((const unsigned*)src, (LAS unsigned*)(slot + wc * 1280), 16, 0, 0);
        if (lane < 16) __builtin_amdgcn_global_load_lds((const unsigned*)(cup + g * UPN + hv * DFF + cb + c4 * 4), (LAS unsigned*)(slot + wc * 1280 + 1024), 16, 0, 0);
    }
    __device__ __forceinline__ void operator()(const f32x4 (&acc)[2][2][4][2], const pg8::Unit& u, int wr, int wc, int fr, int fq, LAS unsigned char* slot) const {
        asm volatile("" : "+v"(fr), "+v"(fq));
        const int cb = u.pn * 128 + wc * 32;
        LAS const unsigned char* cl = slot + wc * 1280 + fq * 32;
        const char* sb = (const char*)(ssq2 + (size_t)(u.pm * 256 + wr * 64) * 16); const size_t slo = (unsigned)fr * 64u + (unsigned)fq * 16u;
        f32x4 raw[4];
#pragma unroll
        for (int m = 0; m < 4; ++m) raw[m] = *(const f32x4*)(sb + m * 1024 + slo);
#pragma unroll
        for (int ai = 0; ai < 2; ++ai) {
            const int row0 = u.pm * 256 + ai * 128 + wr * 64;
            float rsv[4];
#pragma unroll
            for (int m = 0; m < 4; ++m) rsv[m] = rsqrtf(quad_sum16((raw[m].x + raw[m].y) + (raw[m].z + raw[m].w)) * (1.f / 1024.f) + EPS);
            if (ai == 0) {
#pragma unroll
                for (int m = 0; m < 4; ++m) raw[m] = *(const f32x4*)(sb + 128 * 64 + m * 1024 + slo); }
            unsigned pk[4][4];
#ifdef CG_REP
            for (int rep = 0; rep < CG_REP; ++rep)
#endif
#pragma unroll
            for (int h = 0; h < 4; ++h) {
                f32x2 w0[2], w1[2], w2[2], cst[2];
#pragma unroll
                for (int hv = 0; hv < 2; ++hv) { const int co = hv * 128 + h * 8;
                    w0[hv] = *(LAS const f32x2*)(cl + co); w1[hv] = *(LAS const f32x2*)(cl + 256 + co); w2[hv] = *(LAS const f32x2*)(cl + 512 + co); cst[hv] = *(LAS const f32x2*)(cl + 768 + co); }
                float o[4][2];
#pragma unroll
                for (int e2 = 0; e2 < 2; ++e2) { const int n = h >> 1, e = (h & 1) * 2 + e2;
                    float cv[2][4];
#pragma unroll
                    for (int hv = 0; hv < 2; ++hv)
                        conv4_rows(cv[hv], acc[ai][hv][0][n][e], acc[ai][hv][1][n][e], acc[ai][hv][2][n][e], acc[ai][hv][3][n][e], rsv[0], rsv[1], rsv[2], rsv[3],
                                   w0[hv][e2], w1[hv][e2], w2[hv][e2], cst[hv][e2]);
#pragma unroll
                    for (int m = 0; m < 4; ++m) o[m][e2] = siluf(cv[0][m]) * cv[1][m];
                }
#pragma unroll
                for (int m = 0; m < 4; ++m) pk[m][h] = pk2(o[m][0], o[m][1]);
                __builtin_amdgcn_sched_barrier(0);
            }
            { char* ub = (char*)(ug + (size_t)row0 * DFF + cb); const size_t lo = (unsigned)fr * (unsigned)(DFF * 2) + (unsigned)fq * 16u;
#pragma unroll
                for (int m = 0; m < 4; ++m) { const bool edge = (m == 0 && fr == 0) || (m == 3 && fr == 15);
                    if (!edge) *(u32x4*)(ub + (size_t)m * 16 * DFF * 2 + lo) = (u32x4){pk[m][0], pk[m][1], pk[m][2], pk[m][3]}; } }
            const int slab = u.pm * 4 + ai * 2 + wr; char* hb = (char*)(halo + (size_t)slab * 4 * UPN + cb);
#pragma unroll
            for (int mm = 0; mm < 2; ++mm) { const int m = mm * 3; const bool act = mm == 0 ? (fr < 2) : (fr >= 14); const unsigned r4 = mm == 0 ? fr : fr - 12;
                if (act) { const size_t ho = r4 * (unsigned)(UPN * 2) + (unsigned)fq * 16u;
#pragma unroll
                    for (int hv = 0; hv < 2; ++hv) { const f32x4 c0 = *(LAS const f32x4*)(cl + 1024 + hv * 128), c1 = *(LAS const f32x4*)(cl + 1024 + hv * 128 + 16);
                        st_bf8((bf16_t*)(hb + hv * DFF * 2 + ho), acc[ai][hv][m][0] * rsv[m] + c0, acc[ai][hv][m][1] * rsv[m] + c1); } } }
        }
    }
};
__device__ __forceinline__ void fixup_rows(const Params& P, int row_lo, int row_hi, int tid) {
    if (tid >= DFF / 8) return;
    unsigned char* ws = P.ws; const bf16_t* halo = (const bf16_t*)(ws + WS_HALO); bf16_t* ug = (bf16_t*)(ws + WS_UG); const int c = tid * 8;
    CgW W; cg_load_w(W, P.in[I_FCW], P.in[I_FCB], c);
    const u32x4 zero = {0u, 0u, 0u, 0u};
    for (int k = row_lo / 64; k < row_hi / 64; ++k)
#pragma unroll
        for (int wh = 0; wh < 2; ++wh) {
            const int row = 64 * k + (wh ? 63 : 0); const int t = row < RP ? (row & 255) : ((row - RP) & 2047), L = row < RP ? SEQP : SEQS;
            const bf16_t* hp = nullptr; const bf16_t* hc; const bf16_t* hn = nullptr;
            if (wh == 0) { hc = halo + ((size_t)k * 4 + 0) * UPN; hn = halo + ((size_t)k * 4 + 1) * UPN; if (t > 0) hp = halo + ((size_t)(k - 1) * 4 + 3) * UPN; }
            else { hp = halo + ((size_t)k * 4 + 2) * UPN; hc = halo + ((size_t)k * 4 + 3) * UPN; if (t < L - 1) hn = halo + ((size_t)(k + 1) * 4 + 0) * UPN; }
            const u32x4 gp = hp ? *(const u32x4*)(hp + c) : zero, vp = hp ? *(const u32x4*)(hp + DFF + c) : zero;
            const u32x4 gc = *(const u32x4*)(hc + c), vc = *(const u32x4*)(hc + DFF + c);
            const u32x4 gn = hn ? *(const u32x4*)(hn + c) : zero, vn = hn ? *(const u32x4*)(hn + DFF + c) : zero;
            float a[8], b[8], x[8];
#pragma unroll
            for (int e = 0; e < 8; ++e) { a[e] = W.bg[e]; b[e] = W.bv[e]; }
            unpack8(gp, x);
#pragma unroll
            for (int e = 0; e < 8; ++e) a[e] += x[e] * W.wg[0][e];
            unpack8(gc, x);
#pragma unroll
            for (int e = 0; e < 8; ++e) a[e] += x[e] * W.wg[1][e];
            unpack8(gn, x);
#pragma unroll
            for (int e = 0; e < 8; ++e) a[e] += x[e] * W.wg[2][e];
            unpack8(vp, x);
#pragma unroll
            for (int e = 0; e < 8; ++e) b[e] += x[e] * W.wv[0][e];
            unpack8(vc, x);
#pragma unroll
            for (int e = 0; e < 8; ++e) b[e] += x[e] * W.wv[1][e];
            unpack8(vn, x);
#pragma unroll
            for (int e = 0; e < 8; ++e) b[e] += x[e] * W.wv[2][e];
            u32x4 o;
#pragma unroll
            for (int e = 0; e < 4; ++e) o[e] = pk2(siluf(a[2 * e]) * b[2 * e], siluf(a[2 * e + 1]) * b[2 * e + 1]);
            *(u32x4*)(ug + (size_t)row * DFF + c) = o;
        }
}

template <int MFR> struct EpiDown {
    static constexpr bool PERM = true, AFTER_DRAIN = false;
    const float* mod; float* x;
    __device__ __forceinline__ void operator()(const f32x4 (&acc)[2][2][MFR][2], const pg8::Unit& u, int wr, int wc, int fr, int fq) const {
        EPI_ROWS_M(u.pm, MFR)
            const float* g2 = mod + grp_of_row(row) * 6144 + 5120 + u.pn * 256;
            float* xr = x + (size_t)row * 1024 + u.pn * 256;
            EPI_COLS8 *(f32x4*)(xr + col) = *(const f32x4*)(xr + col) + *(const f32x4*)(g2 + col) * v0; *(f32x4*)(xr + col + 4) = *(const f32x4*)(xr + col + 4) + *(const f32x4*)(g2 + col + 4) * v1; EPI_END
        EPI_END
    }
};

struct EpiDownNorm {
    static constexpr bool PERM = true, AFTER_DRAIN = true;
    const float* mod; float* x; const float* gfin; float* xbuf; unsigned* cnt;
    __device__ __forceinline__ void fused(f32x4 (&acc)[2][2][3][2], const pg8::Unit& u, int wr, int wc, int fr, int fq, LAS unsigned char* lds, int wid, int lane) const {
        LAS float* Pt = (LAS float*)lds;
        LAS float* St = (LAS float*)(lds + 4096);
        EPI_ROWS_M(u.pm, 3)
            const float* g2 = mod + grp_of_row(row) * 6144 + 5120 + u.pn * 256; const float* xr = x + (size_t)row * 1024 + u.pn * 256; float s = 0.f;
#pragma unroll
            for (int bj = 0; bj < 2; ++bj) { const int col = bj * 128 + wc * 32 + fq * 8;
                const f32x4 a = *(const f32x4*)(xr + col) + *(const f32x4*)(g2 + col) * acc[ai][bj][m][0], b = *(const f32x4*)(xr + col + 4) + *(const f32x4*)(g2 + col + 4) * acc[ai][bj][m][1];
                acc[ai][bj][m][0] = a; acc[ai][bj][m][1] = b;
                s += ((a.x * a.x + a.y * a.y) + (a.z * a.z + a.w * a.w)) + ((b.x * b.x + b.y * b.y) + (b.z * b.z + b.w * b.w)); }
            s = quad_sum16(s);
            if (fq == 0) Pt[(ai * 96 + wr * 48 + m * 16 + fr) * 4 + wc] = s;
        EPI_END
        asm volatile("s_waitcnt lgkmcnt(0)" ::: "memory"); __builtin_amdgcn_s_barrier(); asm volatile("" ::: "memory");
        const int rloc = wid * 32 + (lane & 31);
        if (lane < 32 && rloc < 192) { const float tot = (Pt[rloc * 4 + 0] + Pt[rloc * 4 + 1]) + (Pt[rloc * 4 + 2] + Pt[rloc * 4 + 3]);
            __hip_atomic_store(xbuf + ((size_t)(u.pm * 192 + rloc) * 4 + u.pn), tot, __ATOMIC_RELAXED, __HIP_MEMORY_SCOPE_AGENT); }
        asm volatile("s_waitcnt vmcnt(0)" ::: "memory");
        if (lane == 0) __hip_atomic_fetch_add(cnt + 16 * u.pm, 1u, __ATOMIC_RELAXED, __HIP_MEMORY_SCOPE_AGENT);
        if (wid == 0) { unsigned sp = 0;
            while ((unsigned)__builtin_amdgcn_readfirstlane(__hip_atomic_load(cnt + 16 * u.pm, __ATOMIC_RELAXED, __HIP_MEMORY_SCOPE_AGENT)) < 32u) { __builtin_amdgcn_s_sleep(2); if (++sp > (1u << 22)) break; }
            __builtin_amdgcn_fence(__ATOMIC_ACQUIRE, "agent"); }
        asm volatile("s_waitcnt vmcnt(0) lgkmcnt(0)" ::: "memory"); __builtin_amdgcn_s_barrier(); asm volatile("" ::: "memory");
        if (lane < 32 && rloc < 192) { const float* sl = xbuf + (size_t)(u.pm * 192 + rloc) * 4; float tot = 0.f;
#pragma unroll
            for (int t = 0; t < 4; ++t) tot += __hip_atomic_load(sl + t, __ATOMIC_RELAXED, __HIP_MEMORY_SCOPE_AGENT);
            St[rloc] = rsqrtf(tot * (1.f / 1024.f) + EPS); }
        asm volatile("s_waitcnt lgkmcnt(0)" ::: "memory"); __builtin_amdgcn_s_barrier(); asm volatile("" ::: "memory");
        EPI_ROWS_M(u.pm, 3)
            const float rs = St[ai * 96 + wr * 48 + m * 16 + fr]; float* xr = x + (size_t)row * 1024 + u.pn * 256; const float* gf = gfin + u.pn * 256;
#pragma unroll
            for (int bj = 0; bj < 2; ++bj) { const int col = bj * 128 + wc * 32 + fq * 8;
                *(f32x4*)(xr + col) = acc[ai][bj][m][0] * rs * *(const f32x4*)(gf + col); *(f32x4*)(xr + col + 4) = acc[ai][bj][m][1] * rs * *(const f32x4*)(gf + col + 4); }
        EPI_END
    }
};

struct Gemm2Order {
    int G, c;
    __device__ void init(int G_, int c_) { G = G_; c = c_; }
    __device__ bool next(int i, pg8::Unit& u) const {
        const int L = i * G + c; if (L >= 608) return false;
        if (L < 416) { u.pm = 48 + L % 52; u.pn = 6 + L / 52; } else { const int l = L - 416; u.pm = l % 48; u.pn = l / 48; }
        return true;
    }
    __device__ __forceinline__ void a_ready(const pg8::Unit&) const {}
    __device__ __forceinline__ void done(const pg8::Unit&) const {}
};
struct EpiG2 {
    static constexpr bool PERM = true, AFTER_DRAIN = false;
    bf16_t *qn, *kv; const float *ssq_cq, *ssq_ckv;
    __device__ __forceinline__ void operator()(AccRef acc, const pg8::Unit& u, int wr, int wc, int fr, int fq) const {
        if (u.pn >= 6) {
            const int pm = u.pm - 48, pn = u.pn - 6;
            EPI_ROWS(pm)
                const f32x4 sq = *(const f32x4*)(ssq_ckv + (size_t)row * 4); const float rs = rsqrtf(((sq.x + sq.y) + (sq.z + sq.w)) * (1.f / 256.f) + EPS);
                bf16_t* dst = kv + (size_t)row * 2048 + pn * 256;
                EPI_COLS8 st_bf8(dst + col, v0 * rs, v1 * rs); EPI_END
            EPI_END
        } else {
            EPI_ROWS(u.pm)
                const f32x4 sq = *(const f32x4*)(ssq_cq + (size_t)row * 4); const float rs = rsqrtf(((sq.x + sq.y) + (sq.z + sq.w)) * (1.f / 256.f) + EPS);
                bf16_t* dst = qn + (size_t)row * 1024 + u.pn * 256;
                EPI_COLS8 st_bf8(dst + col, v0 * rs, v1 * rs); EPI_END
            EPI_END
        }
    }
};
static_assert(WS_CKVA - WS_CQ == (size_t)48 * 256 * 256 * 2 && WS_WUKV - WS_WUQ == (size_t)6 * 256 * 256 * 2, "GEMM2 addressing");

struct PairOrder {
    int nwg, G, c;
    __device__ void init(int G_, int c_) { nwg = 256; G = G_; c = c_; }
    __device__ bool next(int i, pg8::Unit& u) const {
        const int k = i >> 1; const long L = (long)k * G + c; if (L >= nwg) return false;
        int wgid = (int)L; { const int q = nwg / 8, xcd = wgid % 8, off = wgid / 8; wgid = xcd * q + off; }
        const int nig = 8 * 4, gid = wgid / nig, fm = gid * 8; const int pm = fm + ((wgid % nig) % 8), pn = (wgid % nig) / 8;
        if ((i & 1) == 0) { u.pm = pm + 160; u.pn = pn; } else { u.pm = pm; u.pn = pn + 4; }
        return true;
    }
    __device__ __forceinline__ void a_ready(const pg8::Unit&) const {}
    __device__ __forceinline__ void done(const pg8::Unit&) const {}
};
struct EpiMerged {
    static constexpr bool PERM = true, AFTER_DRAIN = false;
    struct State { u32x4 t[2][3][2]; };
    const bf16_t *sgm, *sgs; const float* ssq_y; bf16_t* merged;
    __device__ __forceinline__ void operator()(const f32x4 (&acc)[2][2][3][2], const pg8::Unit& u, int wr, int wc, int fr, int fq, State& st) const {
        if (u.pn < 4) {
            const int pm = u.pm - 160;
            EPI_ROWS_M(pm, 3)
                const size_t off = (size_t)row * 1024 + u.pn * 256;
                EPI_COLS8 const u32x4 gw = __builtin_nontemporal_load((const u32x4*)(sgm + off + col));
                    const f32x4 a = (f32x4){bflo(gw.x), bfhi(gw.x), bflo(gw.y), bfhi(gw.y)} * v0, b = (f32x4){bflo(gw.z), bfhi(gw.z), bflo(gw.w), bfhi(gw.w)} * v1;
                    st.t[ai][m][bj] = (u32x4){pk2(a.x, a.y), pk2(a.z, a.w), pk2(b.x, b.y), pk2(b.z, b.w)}; EPI_END
            EPI_END
        } else {
            const int pn = u.pn - 4;
            EPI_ROWS_M(u.pm, 3)
                float s = 0.f;
#pragma unroll
                for (int q = 0; q < 4; ++q) { const f32x4 a = *(const f32x4*)(ssq_y + (size_t)row * 16 + q * 4); s += (a.x + a.y) + (a.z + a.w); }
                const float rs = rsqrtf(s * (1.f / 1024.f) + EPS); const size_t off = (size_t)row * 1024 + pn * 256;
                EPI_COLS8 const u32x4 gw = __builtin_nontemporal_load((const u32x4*)(sgs + off + col)); const u32x4 tw = st.t[ai][m][bj];
                    st_bf8(merged + off + col, (f32x4){bflo(tw.x), bfhi(tw.x), bflo(tw.y), bfhi(tw.y)} + (f32x4){bflo(gw.x), bfhi(gw.x), bflo(gw.y), bfhi(gw.y)} * (v0 * rs),
                           (f32x4){bflo(tw.z), bfhi(tw.z), bflo(tw.w), bfhi(tw.w)} + (f32x4){bflo(gw.z), bfhi(gw.z), bflo(gw.w), bfhi(gw.w)} * (v1 * rs)); EPI_END
            EPI_END
        }
    }
};
static_assert(WS_QN - WS_Z == (size_t)160 * 192 * 1024 * 2 && WS_WOSSD - WS_WOMLA == (size_t)4 * 256 * 1024 * 2, "GEMM3 pair addressing");

template <class Epi>
__device__ __forceinline__ void run_gemm(LAS unsigned char* lds, const bf16_t* A, const bf16_t* Bt, int M, int N, int K, int G, int c, const Epi& E) {
    pg8::Gemm g{A, Bt, M, N, K}; pg8::StaticOrder S; S.init(M, N, G, c);
    pg8::gemm_phase<Epi, pg8::StaticOrder, PG8_ALIGN, PG8_SP2>(lds, g, S, E);
}
template <class Epi>
__device__ __forceinline__ void run_gemm192(LAS unsigned char* lds, const bf16_t* A, const bf16_t* Bt, int M, int N, int K, int G, int c, const Epi& E) {
    pg8::Gemm g{A, Bt, M, N, K}; pg8::StaticOrder S; S.init(M, N, G, c, 192);
    pg8::gemm_phase<Epi, pg8::StaticOrder, PG8_ALIGN, PG8_SP2, 3>(lds, g, S, E);
}

__device__ __forceinline__ void norm_new_ckv(const Params& P, int lane, int wave, int G) {
    const int gw = blockIdx.x * 8 + wave, NGW = G * 8;
    float* nck = P.out + O_CKV; const float* ssq = (const float*)(P.ws + WS_SSQ_CKV); const float* gk = P.in[I_GKV];
    for (int row = gw; row < RP; row += NGW) {
        const f32x4 sq = *(const f32x4*)(ssq + (size_t)row * 4); const float rs = rsqrtf(((sq.x + sq.y) + (sq.z + sq.w)) * (1.f / 256.f) + EPS);
        f32x4* p = (f32x4*)(nck + (size_t)row * 256) + lane; *p = *p * rs * *(const f32x4*)(gk + 4 * lane);
    }
}
namespace att {
using s16x4 = __attribute__((ext_vector_type(4))) short;
using f32x16 = __attribute__((ext_vector_type(16))) float;
constexpr int QBLK = 32, KVBLK = 64;
constexpr float SCALE = ATT_SCALE, THR = 8.f;
constexpr int SHM_V = 16384, SHM_K = 16384, SHM_KR = 8192;
constexpr int L_V = 0, L_K = 2 * SHM_V, L_KR = L_K + 2 * SHM_K, L_WS = L_KR + 2 * SHM_KR, L_QR = L_WS + 8 * 64 * 4, L_END = L_QR + 8 * 4096;
#define KSWZ(row, colB) ((row) * 256 + ((colB) ^ (((row) & 7) << 4)))
#define KRSWZ(row, colB) ((row) * 128 + ((colB) ^ ((((row) >> 1) & 7) << 4)))
#define SBAR() __builtin_amdgcn_sched_barrier(0)
__device__ __forceinline__ int crow(int r, int hi) { return (r & 3) + 8 * (r >> 2) + 4 * hi; }
__device__ __forceinline__ unsigned cvtpk(float lo, float hi) { unsigned r; asm volatile("v_cvt_pk_bf16_f32 %0, %1, %2" : "=v"(r) : "v"(lo), "v"(hi)); return r; }
__device__ __forceinline__ void partialSM(f32x16& p0, f32x16& p1, float& m_reg, float& mn, float& alpha) {
  constexpr float C = SCALE * 1.4426950408889634f;
  float pmax = p0[0];
#pragma unroll
  for (int r = 1; r < 16; ++r) pmax = fmaxf(pmax, p0[r]);
#pragma unroll
  for (int r = 0; r < 16; ++r) pmax = fmaxf(pmax, p1[r]);
  { auto rr = __builtin_amdgcn_permlane32_swap(__float_as_uint(pmax), __float_as_uint(pmax), false, false);
    pmax = fmaxf(__uint_as_float(rr[0]), __uint_as_float(rr[1])); }
  if (__builtin_expect(__all(pmax - m_reg <= THR / SCALE), 1)) { mn = m_reg; alpha = 1.f; }
  else { mn = fmaxf(m_reg, pmax); alpha = __builtin_amdgcn_exp2f((m_reg - mn) * C); m_reg = mn; }
  float mnC = -mn * C;
#pragma unroll
  for (int r = 0; r < 16; ++r) p0[r] = fmaf(p0[r], C, mnC);
#pragma unroll
  for (int r = 0; r < 16; ++r) p1[r] = fmaf(p1[r], C, mnC);
#pragma unroll
  for (int r = 0; r < 16; ++r) p0[r] = __builtin_amdgcn_exp2f(p0[r]);
}
__device__ __forceinline__ void finishSM(f32x16& p0, f32x16& p1, float alpha, float& l_reg, bf16x8& pa0, bf16x8& pa1, bf16x8& pa2, bf16x8& pa3) {
#pragma unroll
  for (int r = 0; r < 16; ++r) p1[r] = __builtin_amdgcn_exp2f(p1[r]);
  float ps = 0;
#pragma unroll
  for (int r = 0; r < 16; ++r) ps += p0[r];
#pragma unroll
  for (int r = 0; r < 16; ++r) ps += p1[r];
  { auto rr = __builtin_amdgcn_permlane32_swap(__float_as_uint(ps), __float_as_uint(ps), false, false);
    ps = __uint_as_float(rr[0]) + __uint_as_float(rr[1]); }
  l_reg = l_reg * alpha + ps;
#define PK4(P, BASE, OUT) do { unsigned a0 = cvtpk(P[BASE + 0], P[BASE + 1]), a1 = cvtpk(P[BASE + 2], P[BASE + 3]);   \
    unsigned b0 = cvtpk(P[BASE + 4], P[BASE + 5]), b1 = cvtpk(P[BASE + 6], P[BASE + 7]);                              \
    auto r0 = __builtin_amdgcn_permlane32_swap(a0, b0, false, false); auto r1 = __builtin_amdgcn_permlane32_swap(a1, b1, false, false); \
    u32x4 w = {r0[0], r1[0], r0[1], r1[1]}; OUT = *reinterpret_cast<bf16x8*>(&w); } while (0)
  PK4(p0, 0, pa0); PK4(p0, 8, pa1); PK4(p1, 0, pa2); PK4(p1, 8, pa3);
#undef PK4
}
__device__ __forceinline__ void qkt(f32x16& p0, f32x16& p1, const LAS char* Ks, const LAS char* Krs, const bf16x8* qr, const LAS char* qrl, int r32, int hi) {
  p0 = f32x16{}; p1 = f32x16{};
#pragma unroll
  for (int d0 = 0; d0 < 8; ++d0) { const int cb = (d0 * 16 + hi * 8) * 2;
    const bf16x8 b0 = *reinterpret_cast<const LAS bf16x8*>(Ks + KSWZ(r32, cb));
    const bf16x8 b1 = *reinterpret_cast<const LAS bf16x8*>(Ks + KSWZ(32 + r32, cb));
    p0 = __builtin_amdgcn_mfma_f32_32x32x16_bf16(b0, qr[d0], p0, 0, 0, 0);
    p1 = __builtin_amdgcn_mfma_f32_32x32x16_bf16(b1, qr[d0], p1, 0, 0, 0); }
#pragma unroll
  for (int d0 = 0; d0 < 4; ++d0) { const int cb = (d0 * 16 + hi * 8) * 2;
    const bf16x8 b0 = *reinterpret_cast<const LAS bf16x8*>(Krs + KRSWZ(r32, cb));
    const bf16x8 b1 = *reinterpret_cast<const LAS bf16x8*>(Krs + KRSWZ(32 + r32, cb));
    const bf16x8 qq = *reinterpret_cast<const LAS bf16x8*>(qrl + d0 * 1024);
    p0 = __builtin_amdgcn_mfma_f32_32x32x16_bf16(b0, qq, p0, 0, 0, 0);
    p1 = __builtin_amdgcn_mfma_f32_32x32x16_bf16(b1, qq, p1, 0, 0, 0); }
}
__device__ __forceinline__ int v_st(int k, int c) { const int kk = (k & ~0xC) | ((k & 4) << 1) | ((k & 8) >> 1); return ((kk >> 3) * 4 + (c >> 5)) * 512 + ((kk & 7) * 32 + (c & 31)) * 2; }
__device__ __forceinline__ int v_rd_base(int lane) { return ((lane & 3) << 3) | (((lane >> 2) & 3) << 6) | (((lane >> 4) & 1) << 5) | (((lane >> 5) & 1) << 8); }
constexpr int v_rd_off(int d0, int ks, int half) { return d0 * 512 + ks * 4096 + half * 2048; }
template <int OFF> __device__ __forceinline__ s16x4 tr_read(int vb) {
  s16x4 r; asm volatile("ds_read_b64_tr_b16 %0, %1 offset:%2" : "=&v"(r) : "v"(vb), "i"(OFF) : "memory"); return r;
}
template <int D0> __device__ __forceinline__ void pv_one(f32x16& od, int vb, bf16x8 pa0, bf16x8 pa1, bf16x8 pa2, bf16x8 pa3) {
  const s16x4 l0 = tr_read<v_rd_off(D0, 0, 0)>(vb), h0 = tr_read<v_rd_off(D0, 0, 1)>(vb), l1 = tr_read<v_rd_off(D0, 1, 0)>(vb), h1 = tr_read<v_rd_off(D0, 1, 1)>(vb);
  const s16x4 l2 = tr_read<v_rd_off(D0, 2, 0)>(vb), h2 = tr_read<v_rd_off(D0, 2, 1)>(vb), l3 = tr_read<v_rd_off(D0, 3, 0)>(vb), h3 = tr_read<v_rd_off(D0, 3, 1)>(vb);
  asm volatile("s_waitcnt lgkmcnt(0)" ::: "memory"); SBAR();
#define PK(L, H) (bf16x8){L[0], L[1], L[2], L[3], H[0], H[1], H[2], H[3]}
  od = __builtin_amdgcn_mfma_f32_32x32x16_bf16(pa0, PK(l0, h0), od, 0, 0, 0);
  od = __builtin_amdgcn_mfma_f32_32x32x16_bf16(pa1, PK(l1, h1), od, 0, 0, 0);
  od = __builtin_amdgcn_mfma_f32_32x32x16_bf16(pa2, PK(l2, h2), od, 0, 0, 0);
  od = __builtin_amdgcn_mfma_f32_32x32x16_bf16(pa3, PK(l3, h3), od, 0, 0, 0);
#undef PK
}
__device__ __forceinline__ void pv_d0(f32x16* o, int vb, bf16x8 pa0, bf16x8 pa1, bf16x8 pa2, bf16x8 pa3) {
  pv_one<0>(o[0], vb, pa0, pa1, pa2, pa3); pv_one<1>(o[1], vb, pa0, pa1, pa2, pa3); pv_one<2>(o[2], vb, pa0, pa1, pa2, pa3); pv_one<3>(o[3], vb, pa0, pa1, pa2, pa3);
}
__device__ __forceinline__ void attn_unit(const bf16_t* __restrict__ Qn, const bf16_t* __restrict__ Qr, const bf16_t* __restrict__ Kh, const bf16_t* __restrict__ Vh,
                                          const bf16_t* __restrict__ Krh, bf16_t* Ob, int seq, LAS char* lds, int tid) {
  constexpr int LDQ = 1024, LDQR = 512, LDK = 2048, LDKR = 64, LDO = 1024;
  const int wid = tid >> 6, lane = tid & 63, r32 = lane & 31, hi = lane >> 5;
  LAS char* V_lds = lds + L_V; LAS char* K_lds = lds + L_K; LAS char* KR_lds = lds + L_KR;
  LAS float* wsf = (LAS float*)(lds + L_WS) + wid * 64; LAS float* li_l = wsf; LAS float* al_l = wsf + 32;
  float m_reg = -1e30f, l_reg = 0; f32x16 o[4] = {}; bf16x8 qr[8];
  LAS char* qrl = lds + L_QR + wid * 4096 + lane * 16;
  { const unsigned qo = (unsigned)((wid * QBLK + r32) * LDQ + hi * 8);
#pragma unroll
    for (int d0 = 0; d0 < 8; ++d0) qr[d0] = *reinterpret_cast<const bf16x8*>(Qn + (qo + d0 * 16));
    const unsigned qo2 = (unsigned)((wid * QBLK + r32) * LDQR + hi * 8);
#pragma unroll
    for (int d0 = 0; d0 < 4; ++d0) *reinterpret_cast<LAS bf16x8*>(qrl + d0 * 1024) = *reinterpret_cast<const bf16x8*>(Qr + (qo2 + d0 * 16)); }
  const int sr = tid >> 4, sc = (tid & 15) * 8, vst0 = v_st(sr, sc), vst1 = v_st(32 + sr, sc);
  const int rr_ = tid >> 3, rc_ = (tid & 7) * 8, krst = KRSWZ(rr_, rc_ * 2);
  const int vb0 = (int)(unsigned)(uintptr_t)V_lds + v_rd_base(lane);
  constexpr int SDEPTH = 1;
  struct { bf16x8 vs0, vs1, ks0, ks1, kr; } sr_[SDEPTH];
  const unsigned kvo = (unsigned)(sr * LDK + sc), kro = (unsigned)(rr_ * LDKR + rc_);
#define SLOAD(i, k0) do { const bf16_t* vp_ = Vh + (size_t)(k0) * LDK; const bf16_t* kp_ = Kh + (size_t)(k0) * LDK; const bf16_t* rp_ = Krh + (size_t)(k0) * LDKR; \
    sr_[i].vs0 = *reinterpret_cast<const bf16x8*>(vp_ + kvo); sr_[i].vs1 = *reinterpret_cast<const bf16x8*>(vp_ + (kvo + 32u * LDK)); \
    sr_[i].ks0 = *reinterpret_cast<const bf16x8*>(kp_ + kvo); sr_[i].ks1 = *reinterpret_cast<const bf16x8*>(kp_ + (kvo + 32u * LDK)); \
    sr_[i].kr = *reinterpret_cast<const bf16x8*>(rp_ + kro); } while (0)
#define SWRITE(b, i) do { *(LAS bf16x8*)(V_lds + (b) * SHM_V + vst0) = sr_[i].vs0; *(LAS bf16x8*)(V_lds + (b) * SHM_V + vst1) = sr_[i].vs1; const int kc = sc * 2; \
    *(LAS bf16x8*)(K_lds + (b) * SHM_K + KSWZ(sr, kc)) = sr_[i].ks0; *(LAS bf16x8*)(K_lds + (b) * SHM_K + KSWZ(32 + sr, kc)) = sr_[i].ks1; \
    *(LAS bf16x8*)(KR_lds + (b) * SHM_KR + krst) = sr_[i].kr; } while (0)
#define SWAIT() do { if constexpr (SDEPTH == 2) asm volatile("s_waitcnt vmcnt(5)" ::: "memory"); else asm volatile("s_waitcnt vmcnt(0)" ::: "memory"); } while (0)
#define RESC(a) do { if (__any((a) < 1.f)) { if (hi == 0) al_l[r32] = (a); asm volatile("s_waitcnt lgkmcnt(0)" ::: "memory"); \
    _Pragma("unroll") for (int d = 0; d < 4; ++d) _Pragma("unroll") for (int r = 0; r < 16; ++r) o[d][r] *= al_l[crow(r, hi)]; } } while (0)
  f32x16 pA0, pA1, pB0, pB1; float mnA, mnB, alA, alB; bf16x8 pa0, pa1, pa2, pa3; const int NTL = seq / KVBLK;
  constexpr int SE = 0, SO = SDEPTH - 1;
  SLOAD(SE, 0); asm volatile("s_waitcnt vmcnt(0)" ::: "memory"); SWRITE(0, SE); __syncthreads();
  qkt(pA0, pA1, K_lds, KR_lds, qr, qrl, r32, hi); partialSM(pA0, pA1, m_reg, mnA, alA);
  SLOAD(SO, KVBLK); if constexpr (SDEPTH == 2) { if (2 < NTL) SLOAD(SE, 2 * KVBLK); }
  SWAIT(); SWRITE(1, SO); __syncthreads();
  for (int j = 1; j + 1 < NTL; j += 2) {
    SBAR(); qkt(pB0, pB1, K_lds + SHM_K, KR_lds + SHM_KR, qr, qrl, r32, hi);
    finishSM(pA0, pA1, alA, l_reg, pa0, pa1, pa2, pa3); SBAR();
    SLOAD(SO, (j + SDEPTH) * KVBLK); SBAR();
    pv_d0(o, vb0, pa0, pa1, pa2, pa3); partialSM(pB0, pB1, m_reg, mnB, alB);
    __syncthreads(); SWAIT(); SWRITE(0, SE);
    RESC(alB); __syncthreads();
    SBAR(); qkt(pA0, pA1, K_lds, KR_lds, qr, qrl, r32, hi);
    finishSM(pB0, pB1, alB, l_reg, pa0, pa1, pa2, pa3); SBAR();
    if (SDEPTH == 1 || j + 3 < NTL) SLOAD(SE, (j + 1 + SDEPTH) * KVBLK); SBAR();
    pv_d0(o, vb0 + SHM_V, pa0, pa1, pa2, pa3); partialSM(pA0, pA1, m_reg, mnA, alA);
    __syncthreads(); SWAIT(); SWRITE(1, SO);
    RESC(alA); __syncthreads();
  }
  SBAR(); qkt(pB0, pB1, K_lds + SHM_K, KR_lds + SHM_KR, qr, qrl, r32, hi);
  finishSM(pA0, pA1, alA, l_reg, pa0, pa1, pa2, pa3); SBAR();
  pv_d0(o, vb0, pa0, pa1, pa2, pa3); partialSM(pB0, pB1, m_reg, mnB, alB);
  __syncthreads(); RESC(alB);
  finishSM(pB0, pB1, alB, l_reg, pa0, pa1, pa2, pa3); SBAR();
  pv_d0(o, vb0 + SHM_V, pa0, pa1, pa2, pa3);
  if (hi == 0) li_l[r32] = l_reg; asm volatile("s_waitcnt lgkmcnt(0)" ::: "memory");
  float rli[16];
#pragma unroll
  for (int r = 0; r < 16; ++r) rli[r] = __builtin_amdgcn_rcpf(li_l[crow(r, hi)]);
#pragma unroll
  for (int r = 0; r < 16; ++r) { const unsigned oo = (unsigned)((wid * QBLK + crow(r, hi)) * LDO + r32);
#pragma unroll
    for (int d0 = 0; d0 < 4; ++d0) Ob[oo + d0 * 32] = (bf16_t)f2bf(o[d0][r] * rli[r]); }
  __syncthreads();
#undef SLOAD
#undef SWRITE
#undef SWAIT
#undef RESC
}
}

namespace ssd {
typedef short v4i16_t __attribute__((ext_vector_type(4)));
constexpr int RSB = 144;
constexpr int TB = 128 * RSB;
constexpr int L_X = 0, L_B = TB, L_C = 2 * TB, L_HF = 3 * TB, L_HB = 3 * TB + 64 * RSB, L_ARR = 3 * TB + 128 * RSB, L_SC = L_ARR + 2048, L_END = L_SC + 64;
struct UnitInfo { int b, c, h, nc, row0; bool smp; };
__device__ __forceinline__ UnitInfo decode(int u) { UnitInfo I; if (u < 512) { I.smp = true; I.b = u >> 8; I.c = (u >> 4) & 15; I.h = u & 15; I.nc = 16; I.row0 = RP + I.b * SEQS + I.c * 128; }
    else { const int q = u - 512; I.smp = false; I.b = q >> 5; I.c = (q >> 4) & 1; I.h = q & 15; I.nc = 2; I.row0 = I.b * SEQP + I.c * 128; } return I; }
__device__ __forceinline__ int unit_id(bool smp, int b, int c, int h) { return smp ? ((b * 16 + c) * 16 + h) : 512 + ((b * 2 + c) * 16 + h); }
__device__ __forceinline__ bf16x8 tr2(const LAS char* p0, const LAS char* p1) {
    const v4i16_t a = __builtin_amdgcn_ds_read_tr16_b64_v4i16((LAS v4i16_t*)p0), b = __builtin_amdgcn_ds_read_tr16_b64_v4i16((LAS v4i16_t*)p1);
    return (bf16x8){a[0], a[1], a[2], a[3], b[0], b[1], b[2], b[3]};
}
__device__ __forceinline__ float wave_incl_scan(float v, int lane) {
#pragma unroll
    for (int o = 1; o < 64; o <<= 1) { const float t = __shfl_up(v, o); if (lane >= o) v += t; }
    return v;
}
__device__ __forceinline__ void chunk_scalars(const float* dt, int row0, int h, float Af, float Ab, LAS f32x4* arr, LAS float* sc, int lane) {
    const float df0 = dt[(size_t)(row0 + lane) * 32 + h], df1 = dt[(size_t)(row0 + 64 + lane) * 32 + h];
    const float db0 = dt[(size_t)(row0 + lane) * 32 + 16 + h], db1 = dt[(size_t)(row0 + 64 + lane) * 32 + 16 + h];
    const float af0 = df0 * Af, af1 = df1 * Af, ab0 = db0 * Ab, ab1 = db1 * Ab;
    const float s0 = wave_incl_scan(af0, lane), t0 = __shfl(s0, 63), s1 = wave_incl_scan(af1, lane) + t0;
    const float r0 = wave_incl_scan(ab0, lane), u0 = __shfl(r0, 63), r1 = wave_incl_scan(ab1, lane) + u0, tot = __shfl(r1, 63);
    arr[lane] = (f32x4){s0, tot - (r0 - ab0), df0, db0};
    arr[64 + lane] = (f32x4){s1, tot - (r1 - ab1), df1, db1};
    if (lane == 63) { sc[0] = s1; sc[1] = tot; }
}
constexpr int G_B = 0, G_C = TB, G_X = 2 * TB, G_ARR = 6 * TB, G_SC = G_ARR + 4 * 2048, G_END = G_SC + 64;
struct GInfo { int b, c, g, nc, row0; bool smp; };
__device__ __forceinline__ GInfo gdecode(int gu) { GInfo I; if (gu < 128) { I.smp = true; I.b = gu >> 6; I.c = (gu >> 2) & 15; I.g = gu & 3; I.nc = 16; I.row0 = RP + I.b * SEQS + I.c * 128; }
    else { const int q = gu - 128; I.smp = false; I.b = q >> 3; I.c = (q >> 2) & 1; I.g = q & 3; I.nc = 2; I.row0 = I.b * SEQP + I.c * 128; } return I; }
template <bool WITH_C>
__device__ __forceinline__ void stage_group(const Params& P, const GInfo& I, LAS char* lds, int tid) {
    const bf16_t* xbc = (const bf16_t*)(P.ws + WS_XBC); const int lane = tid & 63, wave = tid >> 6;
    if (wave >= 6) {
        const float* dt = (const float*)(P.ws + WS_DT);
#pragma unroll 1
        for (int q = 0; q < 2; ++q) { const int hl = 2 * (wave - 6) + q, h = 4 * I.g + hl;
            chunk_scalars(dt, I.row0, h, -__expf(P.in[I_ALOG][h]), -__expf(P.in[I_ALOG][16 + h]), (LAS f32x4*)(lds + G_ARR + hl * 2048), (LAS float*)(lds + G_SC + hl * 16), lane); }
        return;
    }
    if (!WITH_C && wave == 5) return;
    const int p8 = lane & 7, rs = lane >> 3;
    const int cbase = (wave == 0 ? 1024 + I.g * 64 : wave == 5 ? 1280 + I.g * 64 : (4 * I.g + wave - 1) * 64) + p8 * 8;
    const int lbase = (wave == 0 ? G_B : wave == 5 ? G_C : G_X + (wave - 1) * TB) + p8 * 16;
    const float* cw = P.in[I_CONVW]; const float* cb = P.in[I_CONVB];
    float w[3][8], bb[8];
#pragma unroll
    for (int q = 0; q < 2; ++q) { const f32x4 b4 = *(const f32x4*)(cb + cbase + 4 * q);
#pragma unroll
        for (int e = 0; e < 4; ++e) bb[4 * q + e] = b4[e];
#pragma unroll
        for (int k = 0; k < 3; ++k) { const f32x4 a = *(const f32x4*)(cw + k * 1536 + cbase + 4 * q);
#pragma unroll
            for (int e = 0; e < 4; ++e) w[k][4 * q + e] = a[e]; } }
    const int r0 = rs * 16; const bf16_t* xr = xbc + (size_t)(I.row0 + r0) * 1536 + cbase;
    const bool first = (I.c == 0 && rs == 0), last = (I.c == I.nc - 1 && rs == 7);
    const u32x4 zero = {0u, 0u, 0u, 0u};
    u32x4 rows[18];
    rows[0] = first ? zero : *(const u32x4*)(xr - 1536);
#pragma unroll
    for (int i = 0; i < 16; ++i) rows[1 + i] = *(const u32x4*)(xr + (size_t)i * 1536);
    rows[17] = last ? zero : *(const u32x4*)(xr + (size_t)16 * 1536);
#pragma unroll
    for (int i = 0; i < 16; ++i) {
        float a[8], x[8];
        unpack8(rows[i], x);
#pragma unroll
        for (int e = 0; e < 8; ++e) a[e] = bb[e] + x[e] * w[0][e];
        unpack8(rows[i + 1], x);
#pragma unroll
        for (int e = 0; e < 8; ++e) a[e] += x[e] * w[1][e];
        unpack8(rows[i + 2], x);
#pragma unroll
        for (int e = 0; e < 8; ++e) a[e] += x[e] * w[2][e];
        u32x4 o;
#pragma unroll
        for (int e = 0; e < 4; ++e) o[e] = pk2(siluf(a[2 * e]), siluf(a[2 * e + 1]));
        *(LAS u32x4*)(lds + lbase + (r0 + i) * RSB) = o;
    }
}
__device__ __forceinline__ void pass_a_group(const Params& P, int gu, LAS char* lds, int tid) {
    unsigned char* ws = P.ws;
    const int lane = tid & 63, wave = tid >> 6; const GInfo I = gdecode(gu);
    stage_group<false>(P, I, lds, tid);
    __syncthreads();
    { const int hl = wave >> 1, d = wave & 1, h = 4 * I.g + hl, gq = lane >> 4, q4 = (lane >> 2) & 3, p4 = lane & 3, li = lane & 15;
      const LAS f32x4* arr = (const LAS f32x4*)(lds + G_ARR + hl * 2048); const float tot = ((const LAS float*)(lds + G_SC + hl * 16))[d];
      const LAS char* xb = lds + G_X + hl * TB + (8 * gq + q4) * RSB + (4 * p4) * 2;
      const LAS char* bb = lds + G_B + (8 * gq + q4) * RSB + (4 * p4) * 2;
      f32x4 acc[4][4] = {};
#pragma unroll
      for (int s4 = 0; s4 < 4; ++s4) {
          float wj[8];
#pragma unroll
          for (int jj = 0; jj < 8; ++jj) { const f32x4 a = arr[32 * s4 + 8 * gq + jj]; wj[jj] = d ? a.w * __expf(tot - a.y) : a.z * __expf(tot - a.x); }
          bf16x8 bfr[4];
#pragma unroll
          for (int nt = 0; nt < 4; ++nt) bfr[nt] = tr2(bb + s4 * 32 * RSB + nt * 32, bb + s4 * 32 * RSB + 4 * RSB + nt * 32);
#pragma unroll
          for (int pt = 0; pt < 4; ++pt) { const bf16x8 xr_ = tr2(xb + s4 * 32 * RSB + pt * 32, xb + s4 * 32 * RSB + 4 * RSB + pt * 32);
              const u32x4 xw = *reinterpret_cast<const u32x4*>(&xr_); u32x4 sw;
#pragma unroll
              for (int e = 0; e < 4; ++e) sw[e] = pk2(bflo(xw[e]) * wj[2 * e], bfhi(xw[e]) * wj[2 * e + 1]);
              const bf16x8 xf = *reinterpret_cast<const bf16x8*>(&sw);
#pragma unroll
              for (int nt = 0; nt < 4; ++nt) acc[pt][nt] = __builtin_amdgcn_mfma_f32_16x16x32_bf16(bfr[nt], xf, acc[pt][nt], 0, 0, 0); } }
      const int u = unit_id(I.smp, I.b, I.c, h);
      bf16_t* So = (bf16_t*)(ws + WS_ST) + ((size_t)u * 2 + d) * 4096;
#pragma unroll
      for (int pt = 0; pt < 4; ++pt)
#pragma unroll
          for (int nt = 0; nt < 4; ++nt) st_bf4(So + (16 * pt + li) * 64 + nt * 16 + 4 * gq, acc[pt][nt]);
      if (lane == 0) ((float*)(ws + WS_DEC))[(size_t)u * 2 + d] = __expf(tot);
    }
    __syncthreads();
}
__device__ __forceinline__ bf16x8 ld_h_frag(const bf16_t* H, int p, int n) { return *(const bf16x8*)(H + p * 64 + n); }
__device__ __forceinline__ void pass_b_group(const Params& P, int gu, LAS char* lds, int tid) {
    unsigned char* ws = P.ws;
    const bf16_t* ST = (const bf16_t*)(ws + WS_ST);
    const int lane = tid & 63, wave = tid >> 6; const GInfo I = gdecode(gu);
    stage_group<true>(P, I, lds, tid);
    const int hl = wave >> 1, half = wave & 1, h = 4 * I.g + hl, li = lane & 15, gq = lane >> 4, q4 = (lane >> 2) & 3, p4 = lane & 3;
    const bf16_t *Hf, *Hb;
    if (I.smp) { const int u = unit_id(true, I.b, I.c, h); Hf = ST + ((size_t)u * 2) * 4096; Hb = ST + ((size_t)u * 2 + 1) * 4096; }
    else { const bf16_t* zp = (const bf16_t*)(ws + WS_ZERO); Hf = I.c == 1 ? ST + ((size_t)unit_id(false, I.b, 0, h) * 2) * 4096 : zp; Hb = I.c == 0 ? ST + ((size_t)unit_id(false, I.b, 1, h) * 2 + 1) * 4096 : zp; }
    __syncthreads();
    const LAS f32x4* arr = (const LAS f32x4*)(lds + G_ARR + hl * 2048); const LAS char* Xl = lds + G_X + hl * TB;
    const float Dh = P.in[I_SSDD][h];
#pragma unroll 1
    for (int st = 0; st < 4; st += 2) {
        int ii[2], tdiag[2]; bf16x8 cf[2][2]; f32x4 ai[2]; bf16_t* zrow[2]; u32x2 zw[2][4]; bf16x8 pf[2][4];
#pragma unroll
        for (int u = 0; u < 2; ++u) { ii[u] = 64 * half + 16 * (st + u) + li; tdiag[u] = __builtin_amdgcn_readfirstlane(4 * half + st + u);
#pragma unroll
            for (int ks = 0; ks < 2; ++ks) cf[u][ks] = *(const LAS bf16x8*)(lds + G_C + ii[u] * RSB + (8 * gq + 32 * ks) * 2);
            ai[u] = arr[ii[u]];
            zrow[u] = (bf16_t*)(ws + WS_Z) + (size_t)(I.row0 + ii[u]) * 1024 + h * 64;
#pragma unroll
            for (int pt = 0; pt < 4; ++pt) zw[u][pt] = *(const u32x2*)(zrow[u] + 16 * pt + 4 * gq); }
#pragma unroll
        for (int s4 = 0; s4 < 4; ++s4) {
            unsigned pk[2][4];
#pragma unroll
            for (int hf2 = 0; hf2 < 2; ++hf2) { const int t = 2 * s4 + hf2, jb = 16 * t + 4 * gq;
                f32x4 sacc[2] = {{0.f, 0.f, 0.f, 0.f}, {0.f, 0.f, 0.f, 0.f}};
#pragma unroll
                for (int ks = 0; ks < 2; ++ks) { const bf16x8 bfr = *(const LAS bf16x8*)(lds + G_B + (16 * t + li) * RSB + (8 * gq + 32 * ks) * 2);
                    sacc[0] = __builtin_amdgcn_mfma_f32_16x16x32_bf16(bfr, cf[0][ks], sacc[0], 0, 0, 0);
                    sacc[1] = __builtin_amdgcn_mfma_f32_16x16x32_bf16(bfr, cf[1][ks], sacc[1], 0, 0, 0); }
                f32x4 aj[4];
#pragma unroll
                for (int r = 0; r < 4; ++r) aj[r] = arr[jb + r];
#pragma unroll
                for (int u = 0; u < 2; ++u) {
                    float m[4];
                    if (t < tdiag[u]) {
#pragma unroll
                        for (int r = 0; r < 4; ++r) m[r] = sacc[u][r] * (__expf(ai[u].x - aj[r].x) * aj[r].z);
                    } else if (t > tdiag[u]) {
#pragma unroll
                        for (int r = 0; r < 4; ++r) m[r] = sacc[u][r] * (__expf(ai[u].y - aj[r].y) * aj[r].w);
                    } else {
#pragma unroll
                        for (int r = 0; r < 4; ++r) { const int j = jb + r;
                            const bool lower = j < ii[u]; const float arg = lower ? ai[u].x - aj[r].x : ai[u].y - aj[r].y; const float w = lower ? aj[r].z : aj[r].w;
                            float mm = __expf(arg) * w; if (j == ii[u]) mm = ai[u].z + ai[u].w; m[r] = sacc[u][r] * mm; }
                    }
                    pk[u][hf2 * 2 + 0] = pk2(m[0], m[1]); pk[u][hf2 * 2 + 1] = pk2(m[2], m[3]); } }
#pragma unroll
            for (int u = 0; u < 2; ++u) { const u32x4 w4 = {pk[u][0], pk[u][1], pk[u][2], pk[u][3]}; pf[u][s4] = *reinterpret_cast<const bf16x8*>(&w4); }
            __builtin_amdgcn_sched_barrier(0);
        }
        float ef[2], eb[2], ssq[2] = {0.f, 0.f};
#pragma unroll
        for (int u = 0; u < 2; ++u) { ef[u] = __expf(ai[u].x); eb[u] = __expf(ai[u].y); }
        bf16x8 hfc[2], hbc[2], hfn[2], hbn[2];
#pragma unroll
        for (int ks = 0; ks < 2; ++ks) { hfc[ks] = ld_h_frag(Hf, li, 8 * gq + 32 * ks); hbc[ks] = ld_h_frag(Hb, li, 8 * gq + 32 * ks); }
#pragma unroll
        for (int pt = 0; pt < 4; ++pt) {
            if (pt < 3) {
#pragma unroll
                for (int ks = 0; ks < 2; ++ks) { hfn[ks] = ld_h_frag(Hf, 16 * (pt + 1) + li, 8 * gq + 32 * ks); hbn[ks] = ld_h_frag(Hb, 16 * (pt + 1) + li, 8 * gq + 32 * ks); } }
            f32x4 yd[2] = {{0.f, 0.f, 0.f, 0.f}, {0.f, 0.f, 0.f, 0.f}}, yf[2] = {{0.f, 0.f, 0.f, 0.f}, {0.f, 0.f, 0.f, 0.f}}, yb[2] = {{0.f, 0.f, 0.f, 0.f}, {0.f, 0.f, 0.f, 0.f}};
#pragma unroll
            for (int s4 = 0; s4 < 4; ++s4) { const LAS char* xb = Xl + (32 * s4 + 4 * gq + q4) * RSB + (16 * pt + 4 * p4) * 2; const bf16x8 xf = tr2(xb, xb + 16 * RSB);
                yd[0] = __builtin_amdgcn_mfma_f32_16x16x32_bf16(xf, pf[0][s4], yd[0], 0, 0, 0);
                yd[1] = __builtin_amdgcn_mfma_f32_16x16x32_bf16(xf, pf[1][s4], yd[1], 0, 0, 0); }
#pragma unroll
            for (int ks = 0; ks < 2; ++ks)
#pragma unroll
                for (int u = 0; u < 2; ++u) { yf[u] = __builtin_amdgcn_mfma_f32_16x16x32_bf16(hfc[ks], cf[u][ks], yf[u], 0, 0, 0);
                    yb[u] = __builtin_amdgcn_mfma_f32_16x16x32_bf16(hbc[ks], cf[u][ks], yb[u], 0, 0, 0); }
            const int pc = 16 * pt + 4 * gq;
#pragma unroll
            for (int u = 0; u < 2; ++u) {
                const u32x2 xw = *(const LAS u32x2*)(Xl + ii[u] * RSB + pc * 2);
                const f32x4 xx = {bflo(xw.x), bfhi(xw.x), bflo(xw.y), bfhi(xw.y)};
                const f32x4 zz = {bflo(zw[u][pt].x), bfhi(zw[u][pt].x), bflo(zw[u][pt].y), bfhi(zw[u][pt].y)};
                f32x4 y = yd[u] + yf[u] * ef[u] + yb[u] * eb[u] + xx * Dh;
                y = y * (f32x4){siluf(zz.x), siluf(zz.y), siluf(zz.z), siluf(zz.w)};
                ssq[u] += (y.x * y.x + y.y * y.y) + (y.z * y.z + y.w * y.w);
                st_bf4(zrow[u] + pc, y); }
#pragma unroll
            for (int ks = 0; ks < 2; ++ks) { hfc[ks] = hfn[ks]; hbc[ks] = hbn[ks]; }
            __builtin_amdgcn_sched_barrier(0);
        }
#pragma unroll
        for (int u = 0; u < 2; ++u) { float sq = ssq[u]; sq += __shfl_xor(sq, 16); sq += __shfl_xor(sq, 32);
            if (gq == 0) ((float*)(ws + WS_SSQ_Y))[(size_t)(I.row0 + ii[u]) * 16 + h] = sq; }
    }
    __syncthreads();
}
}

__device__ __forceinline__ void cg_rowblock(const bf16_t* u, bf16_t* ug, const CgW& W, int rb, int c) {
    const int r0 = rb * CG_RB; const int t0 = r0 < RP ? (r0 & 255) : ((r0 - RP) & 2047), L = r0 < RP ? SEQP : SEQS;
    const u32x4 zero = {0u, 0u, 0u, 0u};
    u32x4 gp = zero, vp = zero, gc, vc, gn, vn;
    if (t0 > 0) { gp = *(const u32x4*)(u + (size_t)(r0 - 1) * UPN + c); vp = *(const u32x4*)(u + (size_t)(r0 - 1) * UPN + DFF + c); }
    gc = *(const u32x4*)(u + (size_t)r0 * UPN + c); vc = *(const u32x4*)(u + (size_t)r0 * UPN + DFF + c);
#pragma unroll 16
    for (int i = 0; i < CG_RB; ++i) {
        const int row = r0 + i;
        if (t0 + i + 1 < L) { gn = *(const u32x4*)(u + (size_t)(row + 1) * UPN + c); vn = *(const u32x4*)(u + (size_t)(row + 1) * UPN + DFF + c); } else { gn = zero; vn = zero; }
        float a[8], b[8], x[8];
#pragma unroll
        for (int e = 0; e < 8; ++e) { a[e] = W.bg[e]; b[e] = W.bv[e]; }
        unpack8(gp, x);
#pragma unroll
        for (int e = 0; e < 8; ++e) a[e] += x[e] * W.wg[0][e];
        unpack8(gc, x);
#pragma unroll
        for (int e = 0; e < 8; ++e) a[e] += x[e] * W.wg[1][e];
        unpack8(gn, x);
#pragma unroll
        for (int e = 0; e < 8; ++e) a[e] += x[e] * W.wg[2][e];
        unpack8(vp, x);
#pragma unroll
        for (int e = 0; e < 8; ++e) b[e] += x[e] * W.wv[0][e];
        unpack8(vc, x);
#pragma unroll
        for (int e = 0; e < 8; ++e) b[e] += x[e] * W.wv[1][e];
        unpack8(vn, x);
#pragma unroll
        for (int e = 0; e < 8; ++e) b[e] += x[e] * W.wv[2][e];
        u32x4 o;
#pragma unroll
        for (int e = 0; e < 4; ++e) o[e] = pk2(siluf(a[2 * e]) * b[2 * e], siluf(a[2 * e + 1]) * b[2 * e + 1]);
        *(u32x4*)(ug + (size_t)row * DFF + c) = o;
        gp = gc; vp = vc; gc = gn; vc = vn;
    }
}
__device__ __forceinline__ void cnt_arrive(unsigned* cnt) {
    asm volatile("s_waitcnt vmcnt(0)" ::: "memory");
    __syncthreads();
    if (threadIdx.x == 0) { __builtin_amdgcn_fence(__ATOMIC_RELEASE, "agent"); asm volatile("s_waitcnt vmcnt(0)" ::: "memory");
        __hip_atomic_fetch_add(cnt, 1u, __ATOMIC_RELAXED, __HIP_MEMORY_SCOPE_AGENT); }
}
__device__ __forceinline__ void cnt_wait(unsigned* cnt, unsigned target) {
    if (threadIdx.x == 0) { unsigned sp = 0;
        while (__hip_atomic_load(cnt, __ATOMIC_RELAXED, __HIP_MEMORY_SCOPE_AGENT) < target) { __builtin_amdgcn_s_sleep(4); if (++sp > (1u << 22)) break; }
        __builtin_amdgcn_fence(__ATOMIC_ACQUIRE, "agent"); asm volatile("s_waitcnt vmcnt(0)" ::: "memory"); }
    __syncthreads();
}
constexpr int CG_ROWS1 = 46 * 256, CG_SPLIT = CG_ROWS1 / CG_RB - 1, CG_ITEMS = R / CG_RB;
__device__ __forceinline__ void phase_convgate_queue(const Params& P, LAS unsigned char* lds, unsigned* c1, unsigned* c2, unsigned* q) {
    PHASE_IDS unsigned char* ws = P.ws; const bf16_t* u = (const bf16_t*)(ws + WS_U); bf16_t* ug = (bf16_t*)(ws + WS_UG);
    volatile LAS int* slot = (volatile LAS int*)(lds + 1024);
    const int c = tid * 8; const bool act = tid < DFF / 8;
    CgW W; if (act) cg_load_w(W, P.in[I_FCW], P.in[I_FCB], c);
    bool w1 = false, w2 = false;
    for (;;) {
        if (tid == 0) *slot = (int)__hip_atomic_fetch_add(q, 1u, __ATOMIC_RELAXED, __HIP_MEMORY_SCOPE_AGENT);
        __syncthreads();
        const int rb = *slot;
        __syncthreads();
        if (rb >= CG_ITEMS) break;
        if (!w1) { cnt_wait(c1, (unsigned)G); w1 = true; }
        if (rb >= CG_SPLIT && !w2) { cnt_wait(c2, (unsigned)G); w2 = true; }
        if (act) cg_rowblock(u, ug, W, rb, c);
    }
}
__device__ __forceinline__ void phase_final(const Params& P) {
    PHASE_IDS const int gw = blockIdx.x * 8 + wave, NGW = G * 8; const float* gf = P.in[I_GFIN];
    for (int row = gw; row < R; row += NGW) {
        f32x4* xr = (f32x4*)(P.out + (size_t)row * DM) + lane; f32x4 v[4]; float s = 0.f;
#pragma unroll
        for (int j = 0; j < 4; ++j) { v[j] = xr[64 * j]; s += (v[j].x * v[j].x + v[j].y * v[j].y) + (v[j].z * v[j].z + v[j].w * v[j].w); }
        const float rs = rsqrtf(wave_sum(s) * (1.f / DM) + EPS);
#pragma unroll
        for (int j = 0; j < 4; ++j) xr[64 * j] = v[j] * rs * *(const f32x4*)(gf + 4 * lane + 256 * j);
    }
}

constexpr int G_SLOT_OFF = 126 * 1024;
__device__ __forceinline__ void phase_ssd_a(const Params& P, LAS unsigned char* lds) {
    PHASE_IDS
    norm_new_ckv(P, lane, wave, G);
    unsigned* qa = (unsigned*)(P.ws + WS_CTL) + 8192 + 256; volatile LAS int* slot = (volatile LAS int*)(lds + G_SLOT_OFF);
    for (;;) {
        if (tid == 0) *slot = (int)__hip_atomic_fetch_add(qa, 1u, __ATOMIC_RELAXED, __HIP_MEMORY_SCOPE_AGENT);
        __syncthreads();
        const int gu = *slot;
        __syncthreads();
        if (gu >= 384) break;
        int t2 = tid; asm volatile("" : "+v"(t2)); ssd::pass_a_group(P, gu, (LAS char*)lds, t2);
    }
}
__device__ __forceinline__ void phase_ssd_scan(const Params& P) {
    PHASE_IDS unsigned char* ws = P.ws; bf16_t* ST = (bf16_t*)(ws + WS_ST); const float* DEC = (const float*)(ws + WS_DEC);
    const int gt = blockIdx.x * NT + tid, GT = G * NT;
    for (int it = gt; it < 64 * 512; it += GT) {
        const int chain = it >> 9, e = (it & 511) * 8, b = chain >> 5, h = (chain >> 1) & 15, d = chain & 1;
        float H[8];
        { const float* h0 = P.in[I_SSD] + (((size_t)b * 2 + d) * 16 + h) * 4096 + e; const f32x4 a = *(const f32x4*)h0, c4 = *(const f32x4*)(h0 + 4);
#pragma unroll
          for (int q = 0; q < 4; ++q) { H[q] = a[q]; H[4 + q] = c4[q]; } }
        u32x4 S[16]; float dc[16];
#pragma unroll
        for (int c = 0; c < 16; ++c) { const int u = ssd::unit_id(true, b, c, h); S[c] = *(const u32x4*)(ST + ((size_t)u * 2 + d) * 4096 + e); dc[c] = DEC[(size_t)u * 2 + d]; }
#define SCAN_STEP(c) { const int u = ssd::unit_id(true, b, (c), h); \
            *(u32x4*)(ST + ((size_t)u * 2 + d) * 4096 + e) = (u32x4){pk2(H[0], H[1]), pk2(H[2], H[3]), pk2(H[4], H[5]), pk2(H[6], H[7])}; \
            float sv[8]; unpack8(S[(c)], sv); _Pragma("unroll") for (int q = 0; q < 8; ++q) H[q] = H[q] * dc[(c)] + sv[q]; }
        if (d == 0) {
#pragma unroll
            for (int c = 0; c < 16; ++c) SCAN_STEP(c)
        } else {
#pragma unroll
            for (int c = 15; c >= 0; --c) SCAN_STEP(c)
        }
#undef SCAN_STEP
    }
    for (int it = gt; it < 1024 * 512; it += GT) {
        const int bhd = it >> 9, e = (it & 511) * 8, b = bhd >> 5, d = (bhd >> 4) & 1, h = bhd & 15;
        const int ufirst = ssd::unit_id(false, b, d ? 1 : 0, h), ulast = ssd::unit_id(false, b, d ? 0 : 1, h);
        float f[8], l[8]; unpack8(*(const u32x4*)(ST + ((size_t)ufirst * 2 + d) * 4096 + e), f); unpack8(*(const u32x4*)(ST + ((size_t)ulast * 2 + d) * 4096 + e), l);
        const float dl = DEC[(size_t)ulast * 2 + d]; float* o = P.out + O_SSD + (((size_t)b * 2 + d) * 16 + h) * 4096 + e;
        *(f32x4*)o = (f32x4){f[0] * dl + l[0], f[1] * dl + l[1], f[2] * dl + l[2], f[3] * dl + l[3]};
        *(f32x4*)(o + 4) = (f32x4){f[4] * dl + l[4], f[5] * dl + l[5], f[6] * dl + l[6], f[7] * dl + l[7]};
    }
}
template <int PART>
__device__ __forceinline__ void phase_mix(const Params& P, LAS unsigned char* lds) {
    PHASE_IDS unsigned char* ws = P.ws; bf16_t* qn = (bf16_t*)(ws + WS_QN); const bf16_t* qr = (const bf16_t*)(ws + WS_QR);
    const bf16_t* kv = (const bf16_t*)(ws + WS_KV); const bf16_t* kr = (const bf16_t*)(ws + WS_KROPE);
    const int nbA = G / 2, bx = blockIdx.x;
    if (bx < nbA) {
        if (PART != 2) for (int u = bx; u < 128; u += nbA) {
            const int x = u & 7, k = u >> 3, bh = x + 8 * (k >> 3), qb = k & 7, b = bh >> 3, h = bh & 7, row0 = RP + b * SEQS + qb * 256, kv0 = RP + b * KVS;
            int t2 = tid; asm volatile("" : "+v"(t2));
            att::attn_unit(qn + (size_t)row0 * 1024 + h * 128, qr + (size_t)row0 * 512 + h * 64, kv + (size_t)kv0 * 2048 + h * 256, kv + (size_t)kv0 * 2048 + h * 256 + 128,
                           kr + (size_t)kv0 * 64, qn + (size_t)row0 * 1024 + h * 128, KVS, (LAS char*)lds, t2);
        }
    } else {
        const int k0 = bx - nbA, nb2 = G - nbA;
        if (PART != 2) for (int q = k0; q < 256; q += nb2) {
            const int b = q >> 3, h = q & 7, row0 = b * SEQP;
            int t2 = tid; asm volatile("" : "+v"(t2));
            att::attn_unit(qn + (size_t)row0 * 1024 + h * 128, qr + (size_t)row0 * 512 + h * 64, kv + (size_t)row0 * 2048 + h * 256, kv + (size_t)row0 * 2048 + h * 256 + 128,
                           kr + (size_t)row0 * 64, qn + (size_t)row0 * 1024 + h * 128, SEQP, (LAS char*)lds, t2);
        }
        if (PART != 1) for (int gu = k0; gu < 384; gu += nb2) { int t2 = tid; asm volatile("" : "+v"(t2)); ssd::pass_b_group(P, gu, (LAS char*)lds, t2); }
    }
}
#define XB_TMO      128
#define XB_XCNT(j)  (256  + 64 * (j))
#define XB_XSUB(j)  (1280 + 64 * (j))
#define XB_XGEN(j)  (2304 + 64 * (j))
#define XB_TOP      3328
#define XB_TOPGEN   3392
#define XCD_BAR_WORDS 3456
#define XB_SPIN_CAP (1u << 18)

__device__ __forceinline__ unsigned xb_ld(unsigned* p)              { return __hip_atomic_load(p, __ATOMIC_RELAXED, __HIP_MEMORY_SCOPE_AGENT); }
__device__ __forceinline__ unsigned xb_add(unsigned* p, unsigned v) { return __hip_atomic_fetch_add(p, v, __ATOMIC_RELAXED, __HIP_MEMORY_SCOPE_AGENT); }
__device__ __forceinline__ unsigned xb_xcc_id() { return (unsigned)__builtin_amdgcn_s_getreg((3 << 11) | 20) & 0xFu; }
#define XB_SPIN(cond, bar) do { unsigned _sp = 0; while (cond) { __builtin_amdgcn_s_sleep(1); \
    if ((++_sp & 255u) == 0u) { if (xb_ld(&(bar)[XB_TMO])) break; if (_sp > XB_SPIN_CAP) { atomicAdd(&(bar)[XB_TMO], 1u); break; } } } } while (0)

struct XcdBarrier {
    unsigned* bar; unsigned x;
    volatile LAS unsigned* st;
};

__device__ __forceinline__ XcdBarrier xcd_barrier_post(unsigned* bar, volatile LAS unsigned* st) {
    XcdBarrier b; b.bar = bar; b.x = xb_xcc_id(); b.st = st;
    if (threadIdx.x == 0) (void)xb_add(&bar[XB_XCNT(b.x)], 1u);
    return b;
}
__device__ __forceinline__ void xcd_barrier_complete(unsigned* bar, unsigned x, unsigned& nloc, unsigned& nx) {
    const unsigned G = gridDim.x * gridDim.y * gridDim.z;
    unsigned sum, cnt, mine, sp = 0u;
    for (;;) {
        sum = 0u; cnt = 0u; mine = 0u;
#pragma unroll
        for (unsigned j = 0; j < 16; ++j) { const unsigned c = xb_ld(&bar[XB_XCNT(j)]); sum += c; cnt += (c > 0u) ? 1u : 0u; mine = (j == x) ? c : mine; }
        if (sum == G) break;
        __builtin_amdgcn_s_sleep(1);
        if ((++sp & 255u) == 0u) { if (xb_ld(&bar[XB_TMO])) break; if (sp > XB_SPIN_CAP) { atomicAdd(&bar[XB_TMO], 1u); break; } }
    }
    nloc = mine > 0u ? mine : 1u; nx = cnt > 0u ? cnt : 1u;
}

__device__ __forceinline__ void xcd_barrier(const XcdBarrier& b) {
    asm volatile("s_waitcnt vmcnt(0)" ::: "memory");
    __syncthreads();
    if (threadIdx.x == 0) {
        unsigned* bar = b.bar;
        __builtin_amdgcn_s_waitcnt(0);
        unsigned nloc = b.st[0], nx = b.st[1];
        if (nloc == 0u) { xcd_barrier_complete(bar, b.x, nloc, nx); b.st[0] = nloc; b.st[1] = nx; }
        const unsigned old = xb_add(&bar[XB_XSUB(b.x)], 1u);
        const unsigned gen = old / nloc;
        if (old + 1u == (gen + 1u) * nloc) {
            __builtin_amdgcn_fence(__ATOMIC_RELEASE, "agent");
            asm volatile("s_waitcnt vmcnt(0)" ::: "memory");
            const unsigned og = xb_add(&bar[XB_TOP], 1u);
            const unsigned tg = og / nx;
            if (og + 1u == (tg + 1u) * nx) xb_add(&bar[XB_TOPGEN], 1u);
            else XB_SPIN(xb_ld(&bar[XB_TOPGEN]) == tg, bar);
            __builtin_amdgcn_fence(__ATOMIC_ACQUIRE, "agent");
            xb_add(&bar[XB_XGEN(b.x)], 1u);
            asm volatile("s_waitcnt vmcnt(0)" ::: "memory");
        } else {
            XB_SPIN(xb_ld(&bar[XB_XGEN(b.x)]) == gen, bar);
            __builtin_amdgcn_fence(__ATOMIC_ACQUIRE, "agent");
            asm volatile("s_waitcnt vmcnt(0)" ::: "memory");
        }
    }
    __syncthreads();
}

__global__ void __launch_bounds__(NT, 2) mega_fwd(Params P) {
    extern __shared__ __attribute__((aligned(16))) unsigned char lds_raw[];
    LAS unsigned char* lds = (LAS unsigned char*)lds_raw;
    const int G = gridDim.x, bx = blockIdx.x;
    unsigned char* ws = P.ws;
    volatile LAS unsigned* misc = (volatile LAS unsigned*)(lds + 131072);
    if (threadIdx.x < 4) misc[threadIdx.x] = 0u;
    __syncthreads();
    const XcdBarrier xbar = xcd_barrier_post((unsigned*)(ws + WS_CTL) + 1024, misc);
#define GSYNC() xcd_barrier(xbar)
    unsigned long long pt0 = 0, pacc = 0; (void)pt0; (void)pacc;
#define PB(k) do { if ((PROBE_MASK >> (k)) & 1) pt0 = __builtin_amdgcn_s_memrealtime(); } while (0)
#define PE(k) do { if ((PROBE_MASK >> (k)) & 1) pacc += __builtin_amdgcn_s_memrealtime() - pt0; } while (0)

#ifdef PG8_TIME
    if (blockIdx.x == 0 && threadIdx.x == 0) { pg8::pg8_tacc[0] = 0; pg8::pg8_tacc[1] = 0; }
#endif
    PB(0); phase_p0(P, lds);
    GSYNC(); PE(0);
    PB(1); phase_p1(P, lds);
    GSYNC(); PE(1);
    PB(2); PB(20);
    {
        EpiInMain E{(bf16_t*)(ws + WS_CQ), (bf16_t*)(ws + WS_CKVA), (bf16_t*)(ws + WS_Z), (bf16_t*)(ws + WS_XBC), (bf16_t*)P.out, (bf16_t*)P.out + (size_t)R * 1024,
                    (float*)(ws + WS_SSQ_CQ), (float*)(ws + WS_SSQ_CKV), P.out + O_CKV,
                    (bf16_t*)(ws + WS_KROPE), (float*)(ws + WS_DT), P.out + O_KR, P.in[I_DTB], (const f32x2*)(ws + WS_ROPE)};
        run_gemm(lds, (const bf16_t*)(ws + WS_H), (const bf16_t*)(ws + WS_WIN), R, 5376, 1024, G, bx, E);
    }
    PE(20);
    GSYNC(); PE(2);
    PB(4);
    {
        EpiG2 E{(bf16_t*)(ws + WS_QN), (bf16_t*)(ws + WS_KV), (const float*)(ws + WS_SSQ_CQ), (const float*)(ws + WS_SSQ_CKV)};
        pg8::Gemm g{(const bf16_t*)(ws + WS_CQ), (const bf16_t*)(ws + WS_WUQ), R + KVR, 3584, 256}; Gemm2Order S; S.init(G, bx);
        pg8::gemm_phase<EpiG2, Gemm2Order, PG8_ALIGN, PG8_SP2>(lds, g, S, E);
        EpiQR EQR{(bf16_t*)(ws + WS_QR), (const float*)(ws + WS_SSQ_CQ), (const f32x2*)(ws + WS_ROPE)};
        run_gemm(lds, (const bf16_t*)(ws + WS_CQ), (const bf16_t*)(ws + WS_WUQ) + (size_t)1024 * 256, R, 512, 256, G, (bx + 160) % G, EQR);
        phase_ssd_a(P, lds);
    }
    GSYNC();
    PB(14); phase_ssd_scan(P); PE(14);
    GSYNC(); PE(4);
    PB(5); PB(12); PB(13); PB(18); phase_mix<1>(P, lds); PE(18); PB(19); phase_mix<2>(P, lds); PE(19); PE(12); PE(13);
    GSYNC(); PE(5);
    PB(6);
    {
        EpiMerged E{(const bf16_t*)P.out, (const bf16_t*)P.out + (size_t)R * 1024, (const float*)(ws + WS_SSQ_Y), (bf16_t*)(ws + WS_MERGED)};
        pg8::Gemm g{(const bf16_t*)(ws + WS_Z), (const bf16_t*)(ws + WS_WOMLA), R, 1024, 1024}; PairOrder S; S.init(G, bx);
        pg8::gemm_phase<EpiMerged, PairOrder, PG8_ALIGN, PG8_SP2, 3>(lds, g, S, E);
    }
    GSYNC(); PE(6);
    PB(7);
    {
        EpiOut<3> E{P.in[I_XP], P.in[I_XS], (const float*)(ws + WS_MOD), P.in[I_GFFN], P.out, (bf16_t*)(ws + WS_A1), (float*)(ws + WS_SSQ2)};
        run_gemm192(lds, (const bf16_t*)(ws + WS_MERGED), (const bf16_t*)(ws + WS_WOUT), R, 1024, 1024, G, bx, E);
    }
    GSYNC(); PE(7);
    PB(8);
    {
        EpiUpGate E{(const float*)(ws + WS_SSQ2), (const float*)(ws + WS_CUP), P.in[I_FCW], (const float*)(ws + WS_CST), (bf16_t*)(ws + WS_UG), (bf16_t*)(ws + WS_HALO)};
#ifdef WARM_WUP
        {
            const u32x4* wp = (const u32x4*)(ws + WS_WUP); u32x4 x = {0u, 0u, 0u, 0u};
            for (unsigned i = (unsigned)bx * NT + threadIdx.x; i < (unsigned)((size_t)UPN * 1024 * 2 / 16); i += (unsigned)G * NT) x ^= wp[i];
            if ((x.x ^ x.y ^ x.z ^ x.w) == 0x9e3779b9u) ((volatile unsigned*)(ws + WS_CTL))[8000] = x.x;
        }
#endif
        run_gemm(lds, (const bf16_t*)(ws + WS_A1), (const bf16_t*)(ws + WS_WUP), R, UPN, 1024, G, bx, E);
    }
    GSYNC(); PE(8);
    PB(9); PE(9);
    PB(10);
    const bool fuse_final = (G == 256);
    if (fuse_final) {
        { pg8::StaticOrder S0; S0.init(R, 1024, G, bx, 192); pg8::Unit u0; if (S0.next(0, u0)) fixup_rows(P, u0.pm * 192, u0.pm * 192 + 192, threadIdx.x);
          asm volatile("s_waitcnt vmcnt(0)" ::: "memory"); __syncthreads(); }
        EpiDownNorm E{(const float*)(ws + WS_MOD), P.out, P.in[I_GFIN], (float*)(ws + WS_SSQ_CQ), (unsigned*)(ws + WS_CTL) + 4608};
        pg8::Gemm g{(const bf16_t*)(ws + WS_UG), (const bf16_t*)(ws + WS_WDOWN), R, 1024, DFF}; pg8::StaticOrder S; S.init(R, 1024, G, bx, 192);
        pg8::gemm_phase<EpiDownNorm, pg8::StaticOrder, false, PG8_SP2, 3>(lds, g, S, E);
        PE(10);
#ifdef PG8_TIME
        if (blockIdx.x == 0 && threadIdx.x == 0) pacc += pg8::pg8_tacc[PG8_TIME];
#endif
        if (PROBE_MASK != 0 && blockIdx.x == PROBE_BLK && threadIdx.x == 0) { const unsigned long long te = __builtin_amdgcn_s_memrealtime() + (unsigned long long)PROBE_MULT * pacc; while (__builtin_amdgcn_s_memrealtime() < te) __builtin_amdgcn_s_sleep(32); }
        return;
    }
    for (int k = bx; k < R / 64; k += G) fixup_rows(P, 64 * k, 64 * k + 64, threadIdx.x);
    GSYNC();
    {
        EpiDown<3> E{(const float*)(ws + WS_MOD), P.out};
        run_gemm192(lds, (const bf16_t*)(ws + WS_UG), (const bf16_t*)(ws + WS_WDOWN), R, 1024, DFF, G, bx, E);
    }
    GSYNC(); PE(10);
    PB(11); phase_final(P); PE(11);
    if (PROBE_MASK != 0 && blockIdx.x == PROBE_BLK && threadIdx.x == 0) { const unsigned long long te = __builtin_amdgcn_s_memrealtime() + (unsigned long long)PROBE_MULT * pacc; while (__builtin_amdgcn_s_memrealtime() < te) __builtin_amdgcn_s_sleep(32); }
}

extern "C" void kernel_launch(void* const* d_in, const int* in_sizes, int n_in, void* d_out, int out_size, void* d_ws, size_t ws_size, hipStream_t stream) {
    static int grid = 0;
    if (grid == 0) {
        if (n_in != 30 || ws_size < WS_END || out_size != (int)(O_SSD + (size_t)32 * 2 * 16 * 64 * 64)) {
            fprintf(stderr, "kernel_launch: unexpected shapes: n_in %d out %d ws %zu (need %zu)\n", n_in, out_size, ws_size, (size_t)WS_END); grid = -1; return; }
        int dev = 0, cus = 0, per_cu = 0;
        if (hipGetDevice(&dev) != hipSuccess || hipDeviceGetAttribute(&cus, hipDeviceAttributeMultiprocessorCount, dev) != hipSuccess) { grid = -1; return; }
        if (hipFuncSetAttribute((const void*)mega_fwd, hipFuncAttributeMaxDynamicSharedMemorySize, LDS_BYTES) != hipSuccess) { fprintf(stderr, "kernel_launch: hipFuncSetAttribute failed\n"); grid = -1; return; }
        if (hipOccupancyMaxActiveBlocksPerMultiprocessor(&per_cu, (const void*)mega_fwd, NT, LDS_BYTES) != hipSuccess || per_cu < 1) { fprintf(stderr, "kernel_launch: occupancy query failed (%d)\n", per_cu); (void)hipGetLastError(); grid = -1; return; }
        grid = cus;
    }
    if (grid < 0) return;
    (void)hipMemsetAsync((char*)d_ws + WS_CTL, 0, CTL_ZERO, stream);
    Params p{};
    for (int i = 0; i < 30; ++i) p.in[i] = (const float*)d_in[i];
    p.out = (float*)d_out; p.ws = (unsigned char*)d_ws;
    void* args[] = {&p};
    hipError_t e = hipLaunchCooperativeKernel((const void*)mega_fwd, dim3(grid), dim3(NT), args, LDS_BYTES, stream);
    if (e != hipSuccess) fprintf(stderr, "kernel_launch: cooperative launch failed: %s (grid %d)\n", hipGetErrorString(e), grid);
}
```

```cpp
#include <hip/hip_runtime.h>
#include <hip/hip_cooperative_groups.h>
#include <cstdio>
#include <cstdint>
#include <type_traits>
namespace cg = cooperative_groups;

namespace pg8 {
#define PG8_LAS __attribute__((address_space(3)))
typedef unsigned short bf16_t;
typedef short bf16x8 __attribute__((ext_vector_type(8)));
typedef float f32x4 __attribute__((ext_vector_type(4)));
typedef unsigned u32x4 __attribute__((ext_vector_type(4)));
constexpr int BM = 256, BK = 64, HALF = 128, HTB = HALF * BK * 2  , STAGE_BYTES = 8 * HTB, NXCD = 8, WGM = 8;

__host__ __device__ __forceinline__ int lds_byte(int r, int c) { const int st = (r >> 4) * 2 + (c >> 5), rr = r & 15, cc = c & 31, ob = rr * 64 + cc * 2; return st * 1024 + (ob ^ (((ob >> 9) & 1) << 5)); }
__host__ __device__ __forceinline__ void stage_rc(int b, int& R, int& C) { const int st = b / 1024, sb = b % 1024, swz = sb ^ (((sb >> 9) & 1) << 5); R = (st >> 1) * 16 + swz / 64; C = (st & 1) * 32 + (swz % 64) / 2; }
__host__ __device__ __forceinline__ int perm32(int rho) { const int n = rho >> 4, i = rho & 15; return 8 * (i >> 2) + 4 * n + (i & 3); }

struct Unit { int pm, pn; };
#ifdef PG8_TIME
#ifndef PG8_TBLK
#define PG8_TBLK 0
#endif
#ifndef PG8_TWAVE
#define PG8_TWAVE 0
#endif
__device__ unsigned long long pg8_tacc[2];
#endif
struct Gemm { const bf16_t* A; const bf16_t* Bt; int M, N, K; };

struct StaticOrder {
    int nM, nN, nwg, G, c;
    __host__ __device__ void init(int M, int N, int G_, int c_, int bm = BM) { nM = M / bm; nN = N / BM; nwg = nM * nN; G = G_; c = c_; }
    __host__ __device__ __forceinline__ bool next(int i, Unit& u) const {
        const long L = (long)i * G + c; if (L >= nwg) return false;
        int wgid = (int)L; { const int q = nwg / NXCD, r = nwg % NXCD, xcd = wgid % NXCD, off = wgid / NXCD; wgid = (xcd < r ? xcd * (q + 1) : r * (q + 1) + (xcd - r) * q) + off; }
        const int nig = WGM * nN, gid = wgid / nig, fm = gid * WGM, gsz = (nM - fm) < WGM ? (nM - fm) : WGM;
        u.pm = fm + ((wgid % nig) % gsz); u.pn = (wgid % nig) / gsz; return true;
    }
    __device__ __forceinline__ void a_ready(const Unit&) const {}
    __device__ __forceinline__ void done(const Unit&) const {}
};


template <class E, class = void> struct epi_state { struct type {}; static constexpr bool value = false; };
template <class E> struct epi_state<E, std::void_t<typename E::State>> { using type = typename E::State; static constexpr bool value = true; };
template <class E, class = void> struct epi_pre : std::false_type {};
template <class E> struct epi_pre<E, std::void_t<decltype(E::PRE_SLOT)>> : std::true_type {};
template <class E, class = void> struct epi_timed : std::false_type {};
template <class E> struct epi_timed<E, std::void_t<decltype(E::TIMED)>> : std::true_type {};
template <class Epi, class Sched, bool ALIGN_EPI = false, bool SP2 = false, int MFR = 4  >
__device__ __forceinline__ void gemm_phase(PG8_LAS unsigned char* lds, const Gemm g, const Sched& S, const Epi& E) {
    int tid_ = threadIdx.x; asm volatile("" : "+v"(tid_));
    const int tid = tid_, wid = __builtin_amdgcn_readfirstlane(tid >> 6), lane = tid & 63, wr = wid >> 2, wc = wid & 3, fr = lane & 15, fq = lane >> 4;
    static_assert(SP2 || MFR == 4, "192-row tiles need the two-super-phase loop");
    const bool shortA = (MFR == 3) && (wr == 1);
    const int K = g.K, nt = K / BK;
    unsigned voffA[2], voffB[2];
#pragma unroll
    for (int i = 0; i < 2; ++i) { int R, C; stage_rc(tid * 16 + i * 8192, R, C); const int Rb = Epi::PERM ? ((R & ~31) + perm32(R & 31)) : R;
        voffA[i] = (unsigned)(R * K + C) * 2u; voffB[i] = (unsigned)(Rb * K + C) * 2u; }
    const size_t kstep = (size_t)(BK * 2);
    const size_t hstep = (size_t)HALF * K * 2;
    const size_t tstep = 2 * hstep;
    const size_t hstepA = (size_t)(32 * MFR) * K * 2, tstepA = 2 * hstepA;
    const unsigned ldsw = (unsigned)wid * 1024u;
    const int aoff = lds_byte(wr * (16 * MFR) + fr, fq * 8), boff = lds_byte(wc * 32 + fr, fq * 8);
#define PG8_SA(b, h) (((b) * 2 + (h)) * HTB)
#define PG8_SB(b, h) ((4 + (b) * 2 + (h)) * HTB)
#define PG8_STAGE(bufoff, gbase, voff) do { _Pragma("unroll") for (int _i = 0; _i < 2; ++_i) \
        __builtin_amdgcn_global_load_lds((const unsigned*)((const char*)(gbase) + (voff)[_i]), (PG8_LAS unsigned*)(lds + (bufoff) + ldsw + _i * 8192), 16, 0, 0); } while (0)
#define PG8_LDA(dst, b, h) do { _Pragma("unroll") for (int m = 0; m < MFR; ++m) _Pragma("unroll") for (int k = 0; k < 2; ++k) dst[m][k] = *(const PG8_LAS bf16x8*)(lds + PG8_SA(b, h) + aoff + m * 2048 + k * 1024); } while (0)
#define PG8_LDB(dst, b, h) do { _Pragma("unroll") for (int n = 0; n < 2; ++n) _Pragma("unroll") for (int k = 0; k < 2; ++k) dst[n][k] = *(const PG8_LAS bf16x8*)(lds + PG8_SB(b, h) + boff + n * 2048 + k * 1024); } while (0)
#define PG8_MMA(ai, bj, At, Bt) do { __builtin_amdgcn_s_setprio(1); _Pragma("unroll") for (int m = 0; m < MFR; ++m) _Pragma("unroll") for (int n = 0; n < 2; ++n) _Pragma("unroll") for (int k = 0; k < 2; ++k) \
        acc[ai][bj][m][n] = __builtin_amdgcn_mfma_f32_16x16x32_bf16(Bt[n][k], At[m][k], acc[ai][bj][m][n], 0, 0, 0); __builtin_amdgcn_s_setprio(0); } while (0)
#define PG8_WAIT_V(n) asm volatile("s_waitcnt vmcnt(" #n ")" ::: "memory")
#define PG8_WAIT_VS(nf, ns) do { if (shortA) PG8_WAIT_V(ns); else PG8_WAIT_V(nf); } while (0)
#define PG8_STAGE_A(bufoff, gbase) do { __builtin_amdgcn_global_load_lds((const unsigned*)((const char*)(gbase) + voffA[0]), (PG8_LAS unsigned*)(lds + (bufoff) + ldsw), 16, 0, 0); \
        if (!shortA) __builtin_amdgcn_global_load_lds((const unsigned*)((const char*)(gbase) + voffA[1]), (PG8_LAS unsigned*)(lds + (bufoff) + ldsw + 8192), 16, 0, 0); } while (0)
#define PG8_WAIT_L(n) asm volatile("s_waitcnt lgkmcnt(" #n ")" ::: "memory")
#define PG8_BAR __builtin_amdgcn_s_barrier()
#define PG8_SCHED __builtin_amdgcn_sched_barrier(0)
    Unit cur, nxt; int ui = 0;
    if (!S.next(0, cur)) return;
#ifdef PG8_TIME
    const bool tme = epi_timed<Epi>::value && (wid == PG8_TWAVE && blockIdx.x == PG8_TBLK); unsigned long long tk0 = 0;
#endif
    typename epi_state<Epi>::type est; (void)est;
    f32x4 acc[2][2][MFR][2];
#pragma unroll
    for (int a = 0; a < 2; ++a)
#pragma unroll
        for (int b = 0; b < 2; ++b)
#pragma unroll
            for (int m = 0; m < MFR; ++m)
#pragma unroll
                for (int n = 0; n < 2; ++n) acc[a][b][m][n] = (f32x4){0.f, 0.f, 0.f, 0.f};
    bf16x8 At[MFR][2], B0[2][2], B1[2][2];
    const char* cA = (const char*)g.A + (size_t)cur.pm * tstepA; const char* cB = (const char*)g.Bt + (size_t)cur.pn * tstep;
    S.a_ready(cur);
    if constexpr (epi_pre<Epi>::value) E.pre(cur, lds + STAGE_BYTES + Epi::PRE_SLOT, wr, wc, lane);
    if constexpr (SP2) {
        PG8_STAGE(PG8_SB(0, 0), cB, voffB); PG8_STAGE(PG8_SB(0, 1), cB + hstep, voffB); PG8_STAGE_A(PG8_SA(0, 0), cA); PG8_STAGE_A(PG8_SA(0, 1), cA + hstepA);
        if (wr == 1) PG8_BAR;
        PG8_WAIT_VS(2, 1); PG8_BAR;
        PG8_STAGE(PG8_SB(1, 0), cB + kstep, voffB); PG8_STAGE_A(PG8_SA(1, 0), cA + kstep); PG8_STAGE(PG8_SB(1, 1), cB + hstep + kstep, voffB);
        PG8_WAIT_VS(6, 5); PG8_BAR;
    } else {
        PG8_STAGE(PG8_SB(0, 0), cB, voffB); PG8_STAGE_A(PG8_SA(0, 0), cA); PG8_STAGE(PG8_SB(0, 1), cB + hstep, voffB); PG8_STAGE_A(PG8_SA(0, 1), cA + hstepA);
        if (wr == 1) PG8_BAR;
        PG8_WAIT_V(4); PG8_BAR;
        PG8_STAGE(PG8_SB(1, 0), cB + kstep, voffB); PG8_STAGE_A(PG8_SA(1, 0), cA + kstep); PG8_STAGE(PG8_SB(1, 1), cB + hstep + kstep, voffB);
        PG8_WAIT_V(6); PG8_BAR;
    }
    for (;;) {
        const bool has_next = S.next(ui + 1, nxt);
        const char* nA = has_next ? (const char*)g.A + (size_t)nxt.pm * tstepA : cA; const char* nB = has_next ? (const char*)g.Bt + (size_t)nxt.pn * tstep : cB;
#ifdef PG8_TIME
        if (tme) tk0 = __builtin_amdgcn_s_memrealtime();
#endif
        for (int t = 0; t < nt; t += 2) {
            const bool last = (t == nt - 2);
            const char* a1 = cA + (size_t)(t + 1) * kstep;
            const char* a2 = last ? nA : cA + (size_t)(t + 2) * kstep; const char* b2 = last ? nB : cB + (size_t)(t + 2) * kstep;
            const char* a3 = a2 + kstep; const char* b3 = b2 + kstep;
            if (last && has_next) S.a_ready(nxt);
            if constexpr (SP2) {
            PG8_LDB(B0, 0, 0); PG8_LDB(B1, 0, 1); PG8_SCHED; PG8_LDA(At, 0, 0); PG8_STAGE_A(PG8_SA(1, 1), a1 + hstepA);
            PG8_WAIT_VS(8, 6); PG8_WAIT_L(0); PG8_BAR; PG8_MMA(0, 0, At, B0); PG8_MMA(0, 1, At, B1); PG8_BAR; PG8_SCHED;
            PG8_LDA(At, 0, 1); PG8_STAGE(PG8_SB(0, 0), b2, voffB); PG8_STAGE(PG8_SB(0, 1), b2 + hstep, voffB); PG8_STAGE_A(PG8_SA(0, 0), a2);
            PG8_WAIT_VS(8, 6); PG8_WAIT_L(0); PG8_BAR; PG8_MMA(1, 0, At, B0); PG8_MMA(1, 1, At, B1); PG8_BAR; PG8_SCHED;
            PG8_LDB(B0, 1, 0); PG8_LDB(B1, 1, 1); PG8_SCHED; PG8_LDA(At, 1, 0); PG8_STAGE_A(PG8_SA(0, 1), a2 + hstepA);
            PG8_WAIT_VS(8, 6); PG8_WAIT_L(0); PG8_BAR; PG8_MMA(0, 0, At, B0); PG8_MMA(0, 1, At, B1); PG8_BAR; PG8_SCHED;
            PG8_LDA(At, 1, 1); PG8_STAGE(PG8_SB(1, 0), b3, voffB); PG8_STAGE(PG8_SB(1, 1), b3 + hstep, voffB); PG8_STAGE_A(PG8_SA(1, 0), a3);
            PG8_WAIT_VS(8, 6); PG8_WAIT_L(0); PG8_BAR; PG8_MMA(1, 0, At, B0); PG8_MMA(1, 1, At, B1); PG8_BAR; PG8_SCHED;
            } else {
            PG8_LDB(B0, 0, 0); PG8_SCHED; PG8_LDA(At, 0, 0); PG8_STAGE_A(PG8_SA(1, 1), a1 + hstepA);
            PG8_WAIT_L(8); PG8_BAR; PG8_WAIT_L(0); PG8_MMA(0, 0, At, B0); PG8_BAR; PG8_SCHED;
            PG8_LDB(B1, 0, 1); PG8_STAGE(PG8_SB(0, 0), b2, voffB);
            PG8_BAR; PG8_WAIT_L(0); PG8_MMA(0, 1, At, B1); PG8_BAR;
            PG8_LDA(At, 0, 1); PG8_STAGE_A(PG8_SA(0, 0), a2);
            PG8_BAR; PG8_WAIT_L(0); PG8_MMA(1, 0, At, B0); PG8_BAR; PG8_SCHED;
            PG8_STAGE(PG8_SB(0, 1), b2 + hstep, voffB);
            PG8_WAIT_V(6); PG8_BAR; PG8_MMA(1, 1, At, B1); PG8_BAR;
            PG8_LDB(B0, 1, 0); PG8_SCHED; PG8_LDA(At, 1, 0); PG8_STAGE_A(PG8_SA(0, 1), a2 + hstepA);
            PG8_WAIT_L(8); PG8_BAR; PG8_WAIT_L(0); PG8_MMA(0, 0, At, B0); PG8_BAR; PG8_SCHED;
            PG8_LDB(B1, 1, 1); PG8_STAGE(PG8_SB(1, 0), b3, voffB);
            PG8_BAR; PG8_WAIT_L(0); PG8_MMA(0, 1, At, B1); PG8_BAR;
            PG8_LDA(At, 1, 1); PG8_STAGE_A(PG8_SA(1, 0), a3);
            PG8_BAR; PG8_WAIT_L(0); PG8_MMA(1, 0, At, B0); PG8_BAR; PG8_SCHED;
            PG8_STAGE(PG8_SB(1, 1), b3 + hstep, voffB);
            PG8_WAIT_V(6); PG8_BAR; PG8_MMA(1, 1, At, B1); PG8_BAR;
            }
        }
#ifdef PG8_TIME
#ifdef PG8_TUI
        if (tme) { const unsigned long long t1 = __builtin_amdgcn_s_memrealtime(); if (ui == PG8_TUI) pg8_tacc[0] += t1 - tk0; tk0 = t1; }
#else
        if (tme) { const unsigned long long t1 = __builtin_amdgcn_s_memrealtime(); pg8_tacc[0] += t1 - tk0; tk0 = t1; }
#endif
#endif
        if constexpr (ALIGN_EPI) { if (wr == 0) PG8_BAR; }
        if constexpr (!Epi::AFTER_DRAIN) { if constexpr (epi_state<Epi>::value) E(acc, cur, wr, wc, fr, fq, est); else if constexpr (epi_pre<Epi>::value) E(acc, cur, wr, wc, fr, fq, lds + STAGE_BYTES + Epi::PRE_SLOT + (ui & 1) * Epi::PRE_BYTES);
            else E(acc, cur, wr, wc, fr, fq); S.done(cur);
            if constexpr (epi_pre<Epi>::value) { if (has_next) E.pre(nxt, lds + STAGE_BYTES + Epi::PRE_SLOT + ((ui + 1) & 1) * Epi::PRE_BYTES, wr, wc, lane); } }
#ifdef PG8_TIME
        if (tme) { const unsigned long long t1 = __builtin_amdgcn_s_memrealtime(); pg8_tacc[1] += t1 - tk0; }
#endif
        if (!has_next) break;
#pragma unroll
        for (int a = 0; a < 2; ++a)
#pragma unroll
            for (int b = 0; b < 2; ++b)
#pragma unroll
                for (int m = 0; m < MFR; ++m)
#pragma unroll
                    for (int n = 0; n < 2; ++n) acc[a][b][m][n] = (f32x4){0.f, 0.f, 0.f, 0.f};
        cur = nxt; cA = nA; cB = nB; ++ui;
        if constexpr (ALIGN_EPI) { if (wr == 1) PG8_BAR; }
    }
    PG8_WAIT_V(0);
    if constexpr (!ALIGN_EPI) { if (wr == 0) PG8_BAR; }
    PG8_BAR;
    if constexpr (Epi::AFTER_DRAIN) { E.fused(acc, cur, wr, wc, fr, fq, lds, wid, lane); S.done(cur); }
#undef PG8_SA
#undef PG8_SB
#undef PG8_STAGE
#undef PG8_LDA
#undef PG8_LDB
#undef PG8_MMA
#undef PG8_WAIT_V
#undef PG8_WAIT_VS
#undef PG8_STAGE_A
#undef PG8_WAIT_L
#undef PG8_BAR
#undef PG8_SCHED
}
}

#ifndef PROBE_MASK
#define PROBE_MASK 0
#endif
#define PROBE_MULT 8
#ifndef PROBE_BLK
#define PROBE_BLK (((PROBE_MASK >> 13) & 0x61) ? gridDim.x / 2 : 0)
#endif
#ifndef PB_DUP1
#define PB_DUP1 1
#endif
#ifndef PG8_SP2
#define PG8_SP2 true
#endif
#ifndef PG8_ALIGN
#define PG8_ALIGN true
#endif

#define LAS __attribute__((address_space(3)))
using pg8::bf16_t; using pg8::f32x4; using pg8::bf16x8; using pg8::u32x4;
typedef unsigned u32x2 __attribute__((ext_vector_type(2)));
typedef float f32x2 __attribute__((ext_vector_type(2)));

constexpr int DM = 1024;
constexpr int RP = 8192, RS = 4096, R = 12288;
constexpr int SEQP = 256, SEQS = 2048, PAST = 512, KVS = PAST + SEQS;
constexpr int KVR = RP + 2 * KVS;
constexpr int NH = 8;
constexpr int INC = 5216, INP = 5376;
constexpr int DFF = 2816, UPN = 5632;
constexpr float EPS = 1e-6f;
constexpr float ATT_SCALE = 0.07216878364870322f;

enum { I_XP = 0, I_XS, I_C, I_CKV, I_CKR, I_SSD, I_CCTX, I_WADA, I_BADA, I_GATTN, I_WIN, I_GQ, I_GKV, I_WUQ, I_WUKV, I_WOMLA,
       I_CONVW, I_CONVB, I_DTB, I_ALOG, I_SSDD, I_GSSD, I_WOSSD, I_WOUT, I_GFFN, I_WUP, I_FCW, I_FCB, I_WDOWN, I_GFIN };

constexpr size_t O_Y = 0, O_CKV = (size_t)R * DM, O_KR = O_CKV + (size_t)RP * 256, O_SSD = O_KR + (size_t)RP * 64;

constexpr size_t MiB = 1u << 20;
constexpr size_t WS_CTL = 0, CTL_ZERO = 65536;
constexpr size_t WS_MOD = 64 * 1024;
constexpr size_t WS_CUP = 160 * 1024;
constexpr size_t WS_ROPE = 256 * 1024;
constexpr size_t WS_CST = 800 * 1024;
constexpr size_t WS_SSQ_CQ = 1 * MiB;
constexpr size_t WS_SSQ_CKV = 1 * MiB + 204800;
constexpr size_t WS_SSQ_Y = 1 * MiB + 430080;
constexpr size_t WS_SSQ2 = 1 * MiB + 1216512;
constexpr size_t WS_DT = 3 * MiB;
constexpr size_t WS_DEC = 3 * MiB + 1572864;
constexpr size_t WS_ZERO = WS_DEC + 16384;
constexpr size_t WS_WIN = 5 * MiB;
constexpr size_t WS_WUQ = WS_WIN + (size_t)INP * 1024 * 2;
constexpr size_t WS_WUKV = WS_WUQ + 1536 * 256 * 2;
constexpr size_t WS_WOMLA = WS_WUKV + 2048 * 256 * 2;
constexpr size_t WS_WOSSD = WS_WOMLA + 2 * MiB;
constexpr size_t WS_WOUT = WS_WOSSD + 2 * MiB;
constexpr size_t WS_WUP = WS_WOUT + 2 * MiB;
constexpr size_t WS_WDOWN = WS_WUP + (size_t)UPN * 1024 * 2;
static_assert(WS_WDOWN + (size_t)1024 * DFF * 2 <= 40 * MiB, "weights");
constexpr size_t WS_CQ = 40 * MiB;
constexpr size_t WS_CKVA = 46 * MiB;
constexpr size_t WS_KROPE = 46 * MiB + (size_t)KVR * 256 * 2;
constexpr size_t WS_Z = 55 * MiB;
constexpr size_t WS_XBC = 79 * MiB;
constexpr size_t WS_H = 115 * MiB;
constexpr size_t WS_QN = 115 * MiB;
constexpr size_t WS_QR = 139 * MiB;
constexpr size_t WS_KV = 151 * MiB;
constexpr size_t WS_ST = 203 * MiB;
constexpr size_t WS_MERGED = 151 * MiB;
constexpr size_t WS_A1 = 83 * MiB;
constexpr size_t WS_U = 115 * MiB;
constexpr size_t WS_UG = 115 * MiB;
constexpr size_t WS_HALO = 182 * MiB;
constexpr size_t WS_X1 = 203 * MiB;
constexpr size_t WS_END = 251 * MiB;
static_assert(WS_KROPE + (size_t)KVR * 64 * 2 <= WS_Z && WS_KV + (size_t)KVR * 2048 * 2 <= WS_ST && WS_ST + (size_t)R * 1024 * 4 <= WS_END, "map");
static_assert(WS_UG + (size_t)R * DFF * 2 <= WS_HALO && WS_HALO + (size_t)192 * 4 * UPN * 2 <= WS_END, "map2");
static_assert(WS_A1 + (size_t)R * 1024 * 2 <= WS_UG, "a1 clear of ug");

constexpr int LDS_BYTES = 147456;
constexpr int NT = 512;

struct Params { const float* in[30]; float* out; unsigned char* ws; };
#define PHASE_IDS int tid = threadIdx.x; asm volatile("" : "+v"(tid)); const int lane = tid & 63, wave = __builtin_amdgcn_readfirstlane(tid >> 6), G = gridDim.x; (void)lane; (void)wave; (void)G;

#define LDS_WAIT() asm volatile("s_waitcnt lgkmcnt(0)" ::: "memory")
__device__ __forceinline__ unsigned f2bf(float f) { unsigned u = __builtin_bit_cast(unsigned, f); return (u + 0x7fffu + ((u >> 16) & 1u)) >> 16; }
__device__ __forceinline__ float bf2f(unsigned short b) { return __builtin_bit_cast(float, (unsigned)b << 16); }
typedef __bf16 bf16x2_t __attribute__((ext_vector_type(2)));
__device__ __forceinline__ unsigned pk2(float lo, float hi) { const f32x2 v = {lo, hi}; const bf16x2_t b = __builtin_convertvector(v, bf16x2_t); return __builtin_bit_cast(unsigned, b); }
__device__ __forceinline__ float bflo(unsigned w) { return __builtin_bit_cast(float, w << 16); }
__device__ __forceinline__ float bfhi(unsigned w) { return __builtin_bit_cast(float, w & 0xffff0000u); }
__device__ __forceinline__ float wave_sum(float v) {
#pragma unroll
    for (int o = 1; o < 64; o <<= 1) v += __shfl_xor(v, o);
    return v;
}
__device__ __forceinline__ float wave_max(float v) {
#pragma unroll
    for (int o = 1; o < 64; o <<= 1) v = fmaxf(v, __shfl_xor(v, o));
    return v;
}
__device__ __forceinline__ void unpack8(const u32x4 w, float* f) {
#pragma unroll
    for (int e = 0; e < 4; ++e) { f[2 * e] = bflo(w[e]); f[2 * e + 1] = bfhi(w[e]); }
}
__device__ __forceinline__ float sigm(float x) { return __builtin_amdgcn_rcpf(1.f + __expf(-x)); }
__device__ __forceinline__ float siluf(float x) { return x * sigm(x); }
__device__ __forceinline__ float softplusf(float x) { return fmaxf(x, 0.f) + __logf(1.f + __expf(-fabsf(x))); }
__device__ __forceinline__ int grp_of_row(int row) { return row < RP ? 0 : 1 + ((row - RP) >> 11); }
__device__ __forceinline__ int kvrow_of_row(int row) { return row < RP ? row : RP + ((row - RP) >> 11) * KVS + PAST + ((row - RP) & 2047); }
__device__ __forceinline__ const float* xrow_ptr(const Params& P, int row) { return row < RP ? P.in[I_XP] + (size_t)row * DM : P.in[I_XS] + (size_t)(row - RP) * DM; }

__device__ __forceinline__ int pair_pos(int i) { return 8 * ((i & 15) >> 2) + (i & 3) + (i >= 16 ? 4 : 0); }
__device__ __forceinline__ void transpose_item(const float* W, int K, int N, bf16_t* WT, int k0, int n0, int drow0, const float* kscale, LAS float* scr, int lane, bool pairs = false) {
    float wv[32];
#pragma unroll
    for (int i = 0; i < 32; ++i) wv[i] = __builtin_nontemporal_load(W + (size_t)(k0 + 2 * i + (lane >> 5)) * N + n0 + (lane & 31));
#pragma unroll
    for (int i = 0; i < 32; ++i) { const int kk = 2 * i + (lane >> 5); float w = wv[i]; if (kscale) w *= kscale[k0 + kk]; scr[kk * 33 + (lane & 31)] = w; }
    LDS_WAIT(); asm volatile("" ::: "memory");
    const int c = lane & 7;
#pragma unroll
    for (int j = 0; j < 4; ++j) { const int n = (lane >> 3) + 8 * j; const LAS float* s = scr + (8 * c) * 33 + n;
        u32x4 o; o.x = pk2(s[0 * 33], s[1 * 33]); o.y = pk2(s[2 * 33], s[3 * 33]); o.z = pk2(s[4 * 33], s[5 * 33]); o.w = pk2(s[6 * 33], s[7 * 33]);
        *(u32x4*)(WT + (size_t)(drow0 + (pairs ? pair_pos(n) : n)) * K + k0 + 8 * c) = o; }
    LDS_WAIT(); asm volatile("" ::: "memory");
}
__device__ __forceinline__ int win_dst(int n0) {
    if (n0 < 512) return n0;
    if (n0 < 576) return 5120 + (n0 - 512);
    if (n0 < 1600) return 512 + (n0 - 576);
    if (n0 < 2624) return 1536 + (n0 - 1600);
    if (n0 < 2880) return 2560 + (n0 - 2624);
    if (n0 < 3136) return 2816 + (n0 - 2880);
    if (n0 < 3168) return 5184 + (n0 - 3136);
    if (n0 < 4192) return 3072 + (n0 - 3168);
    return 4096 + (n0 - 4192);
}
__device__ __forceinline__ int wup_dst(int n0) { const bool isv = n0 >= DFF; const int j = isv ? n0 - DFF : n0; return (j >> 7) * 256 + (isv ? 128 : 0) + (j & 127); }
__device__ __forceinline__ int wuq_dst(int n0) { const int h = n0 / 192, d0 = n0 - h * 192; return d0 < 128 ? h * 128 + d0 : 1024 + h * 64 + (d0 - 128); }

template <int CW>
__device__ __forceinline__ void gemv3_block(const LAS float* vec  , const float* W, int N, int col0, const float* bias, float* out, int ldo, LAS float* red, int tid) {
    const int j = tid & 31, kq = tid >> 5;
    float a0 = 0.f, a1 = 0.f, a2 = 0.f;
    if (j < CW) {
        const float* wp = W + (size_t)(kq * 64) * N + col0 + j;
#pragma unroll 32
        for (int k = 0; k < 64; ++k) { const float w = __builtin_nontemporal_load(wp + (size_t)k * N); const int kk = kq * 64 + k; a0 += vec[kk] * w; a1 += vec[1024 + kk] * w; a2 += vec[2048 + kk] * w; }
    }
    red[(kq * 3 + 0) * 32 + j] = a0; red[(kq * 3 + 1) * 32 + j] = a1; red[(kq * 3 + 2) * 32 + j] = a2;
    __syncthreads();
    if (tid < 96) { const int g = tid >> 5, jj = tid & 31;
        if (jj < CW) { float s = 0.f;
#pragma unroll
            for (int q = 0; q < 16; ++q) s += red[(q * 3 + g) * 32 + jj];
            out[(size_t)g * ldo + col0 + jj] = s + (bias ? bias[col0 + jj] : 0.f); } }
    __syncthreads();
}

__device__ __forceinline__ void phase_p0(const Params& P, LAS unsigned char* lds) {
    PHASE_IDS unsigned char* ws = P.ws;
    {
        LAS float* sc = (LAS float*)lds; LAS float* red = sc + 3072;
        for (int i = tid; i < 3072; i += NT) { const int g = i >> 10, k = i & 1023; const float c = (g == 0) ? P.in[I_CCTX][k] : P.in[I_C][(g - 1) * 1024 + k]; sc[i] = siluf(c); }
        __syncthreads();
        for (int cb = blockIdx.x; cb < 256; cb += G) gemv3_block<24>(sc, P.in[I_WADA], 6144, cb * 24, P.in[I_BADA], (float*)(ws + WS_MOD), 6144, red, tid);
    }
    {
        LAS float* scr = (LAS float*)(lds + wave * 16384);
        const int gw = blockIdx.x * 8 + wave, NGW = G * 8;
        constexpr int I_IN = 16 * 163, I_UQ = 4 * 48, I_UKV = 4 * 64, I_SQ = 16 * 32, I_UP = 16 * 176, I_DN = 44 * 32;
        constexpr int NITEMS = I_IN + I_UQ + I_UKV + 3 * I_SQ + I_UP + I_DN;
        for (int it = gw; it < NITEMS; it += NGW) {
            int r = it;
            if (r < I_IN) { const int kb = r / 163, nb = r % 163; transpose_item(P.in[I_WIN], 1024, INC, (bf16_t*)(ws + WS_WIN), kb * 64, nb * 32, win_dst(nb * 32), nullptr, scr, lane, win_dst(nb * 32) >= 5120); continue; } r -= I_IN;
            if (r < I_UQ) { const int kb = r / 48, nb = r % 48; transpose_item(P.in[I_WUQ], 256, 1536, (bf16_t*)(ws + WS_WUQ), kb * 64, nb * 32, wuq_dst(nb * 32), P.in[I_GQ], scr, lane); continue; } r -= I_UQ;
            if (r < I_UKV) { const int kb = r / 64, nb = r % 64; transpose_item(P.in[I_WUKV], 256, 2048, (bf16_t*)(ws + WS_WUKV), kb * 64, nb * 32, nb * 32, P.in[I_GKV], scr, lane); continue; } r -= I_UKV;
            if (r < I_SQ) { const int kb = r / 32, nb = r % 32; transpose_item(P.in[I_WOMLA], 1024, 1024, (bf16_t*)(ws + WS_WOMLA), kb * 64, nb * 32, nb * 32, nullptr, scr, lane); continue; } r -= I_SQ;
            if (r < I_SQ) { const int kb = r / 32, nb = r % 32; transpose_item(P.in[I_WOSSD], 1024, 1024, (bf16_t*)(ws + WS_WOSSD), kb * 64, nb * 32, nb * 32, P.in[I_GSSD], scr, lane); continue; } r -= I_SQ;
            if (r < I_SQ) { const int kb = r / 32, nb = r % 32; transpose_item(P.in[I_WOUT], 1024, 1024, (bf16_t*)(ws + WS_WOUT), kb * 64, nb * 32, nb * 32, nullptr, scr, lane); continue; } r -= I_SQ;
            if (r < I_UP) { const int kb = r / 176, nb = r % 176; transpose_item(P.in[I_WUP], 1024, UPN, (bf16_t*)(ws + WS_WUP), kb * 64, nb * 32, wup_dst(nb * 32), nullptr, scr, lane); continue; } r -= I_UP;
            { const int kb = r / 32, nb = r % 32; transpose_item(P.in[I_WDOWN], DFF, 1024, (bf16_t*)(ws + WS_WDOWN), kb * 64, nb * 32, nb * 32, nullptr, scr, lane); }
        }
    }
    {
        const int gt = blockIdx.x * NT + tid, GT = G * NT;
        for (int i = gt; i < 8192 / 16; i += GT) *(u32x4*)(ws + WS_ZERO + (size_t)i * 16) = (u32x4){0u, 0u, 0u, 0u};
        for (int i = gt; i < 160 * 1024 / 8; i += GT) *(u32x4*)((bf16_t*)(ws + WS_WIN) + (size_t)5216 * 1024 + (size_t)i * 8) = (u32x4){0u, 0u, 0u, 0u};
        for (int i = gt; i < 2048 * 32; i += GT) { const int t = i >> 5, a = (i >> 4) & 1, fi = i & 15; const float pos = (float)(a ? (t & 63) : (t >> 6));
            const float inv = exp2f(-(float)fi * 0.8304820237218406f); const float ang = pos * inv;
            ((f32x2*)(ws + WS_ROPE))[i] = (f32x2){__cosf(ang), __sinf(ang)}; }
        for (int i = gt; i < 2 * PAST * 256; i += GT) { const int k = i & 255, s = (i >> 8) & 511, b = i >> 17;
            ((bf16_t*)(ws + WS_CKVA))[(size_t)(RP + b * KVS + s) * 256 + k] = (bf16_t)f2bf(P.in[I_CKV][i] / P.in[I_GKV][k]); }
        for (int i = gt; i < 2 * PAST * 64; i += GT) { const int j = i & 63, s = (i >> 6) & 511, b = i >> 15;
            ((bf16_t*)(ws + WS_KROPE))[(size_t)(RP + b * KVS + s) * 64 + j] = (bf16_t)f2bf(P.in[I_CKR][i]); }
        for (int i = gt; i < 2 * PAST; i += GT) { const int s = i & 511, b = i >> 9;
            *(f32x4*)((float*)(ws + WS_SSQ_CKV) + (size_t)(RP + b * KVS + s) * 4) = (f32x4){256.f * (1.f - EPS), 0.f, 0.f, 0.f}; }
    }
}

__device__ __forceinline__ void phase_p1(const Params& P, LAS unsigned char* lds) {
    PHASE_IDS unsigned char* ws = P.ws; const float* mod = (const float*)(ws + WS_MOD);
    const int gw = blockIdx.x * 8 + wave, NGW = G * 8;
    {
        float s2[3][16];
#pragma unroll
        for (int g = 0; g < 3; ++g)
#pragma unroll
            for (int q = 0; q < 4; ++q) { const f32x4 a = *(const f32x4*)(mod + g * 6144 + 3072 + (q >> 1) * 512 + 8 * lane + 4 * (q & 1));
#pragma unroll
                for (int e = 0; e < 4; ++e) s2[g][4 * q + e] = a[e]; }
        const bf16_t* wt = (const bf16_t*)(ws + WS_WUP);
        for (int j = gw; j < UPN; j += NGW) {
            const size_t jr = (size_t)(wup_dst(j & ~31) + (j & 31)) * 1024;
            float wf[16]; unpack8(*(const u32x4*)(wt + jr + 8 * lane), wf); unpack8(*(const u32x4*)(wt + jr + 512 + 8 * lane), wf + 8);
            float a0 = 0.f, a1 = 0.f, a2 = 0.f;
#pragma unroll
            for (int e = 0; e < 16; ++e) { a0 += s2[0][e] * wf[e]; a1 += s2[1][e] * wf[e]; a2 += s2[2][e] * wf[e]; }
            a0 = wave_sum(a0); a1 = wave_sum(a1); a2 = wave_sum(a2);
            if (lane == 0) { float* cu = (float*)(ws + WS_CUP); cu[j] = a0; cu[UPN + j] = a1; cu[2 * UPN + j] = a2;
                const float* fw = P.in[I_FCW]; const float wsum = (fw[j] + fw[UPN + j]) + fw[2 * UPN + j], bb = P.in[I_FCB][j]; float* cs = (float*)(ws + WS_CST);
                cs[j] = a0 * wsum + bb; cs[UPN + j] = a1 * wsum + bb; cs[2 * UPN + j] = a2 * wsum + bb; }
        }
    }
    const float* gat = P.in[I_GATTN];
    for (int row0 = gw * 2; row0 < R; row0 += NGW * 2) {
        const int g = grp_of_row(row0);
        f32x4 v[2][4]; float s[2] = {0.f, 0.f};
#pragma unroll
        for (int q = 0; q < 2; ++q) { const f32x4* xr = (const f32x4*)xrow_ptr(P, row0 + q) + lane;
#pragma unroll
            for (int j = 0; j < 4; ++j) v[q][j] = __builtin_nontemporal_load(xr + 64 * j); }
#pragma unroll
        for (int q = 0; q < 2; ++q)
#pragma unroll
            for (int j = 0; j < 4; ++j) s[q] += (v[q][j].x * v[q][j].x + v[q][j].y * v[q][j].y) + (v[q][j].z * v[q][j].z + v[q][j].w * v[q][j].w);
        const float rs0 = rsqrtf(wave_sum(s[0]) * (1.f / DM) + EPS), rs1 = rsqrtf(wave_sum(s[1]) * (1.f / DM) + EPS);
#pragma unroll
        for (int j = 0; j < 4; ++j) { const int c = 4 * lane + 256 * j;
            const f32x4 gg = *(const f32x4*)(gat + c), sc = *(const f32x4*)(mod + g * 6144 + 1024 + c), sh = *(const f32x4*)(mod + g * 6144 + c);
            const f32x4 gs = gg * (sc + 1.f);
            const f32x4 h0 = v[0][j] * rs0 * gs + sh, h1 = v[1][j] * rs1 * gs + sh;
            ((u32x2*)((bf16_t*)(ws + WS_H) + (size_t)row0 * DM) + lane)[64 * j] = (u32x2){pk2(h0.x, h0.y), pk2(h0.z, h0.w)};
            ((u32x2*)((bf16_t*)(ws + WS_H) + (size_t)(row0 + 1) * DM) + lane)[64 * j] = (u32x2){pk2(h1.x, h1.y), pk2(h1.z, h1.w)}; }
    }
}

typedef const f32x4 (&AccRef)[2][2][4][2];
typedef const f32x4 (&AccRef3)[2][2][3][2];
#define EPI_ROWS_M(pm, MFR) _Pragma("unroll") for (int ai = 0; ai < 2; ++ai) _Pragma("unroll") for (int m = 0; m < (MFR); ++m) { const int row = (pm) * (64 * (MFR)) + ai * (32 * (MFR)) + wr * (16 * (MFR)) + m * 16 + fr;
#define EPI_ROWS(pm) _Pragma("unroll") for (int ai = 0; ai < 2; ++ai) _Pragma("unroll") for (int m = 0; m < 4; ++m) { const int row = (pm) * 256 + ai * 128 + wr * 64 + m * 16 + fr;
#define EPI_COLS _Pragma("unroll") for (int bj = 0; bj < 2; ++bj) _Pragma("unroll") for (int n = 0; n < 2; ++n) { const int col = bj * 128 + wc * 32 + n * 16 + fq * 4; const f32x4 v = acc[ai][bj][m][n];
#define EPI_END }
#define EPI_COLS8 _Pragma("unroll") for (int bj = 0; bj < 2; ++bj) { const int col = bj * 128 + wc * 32 + fq * 8; const f32x4 v0 = acc[ai][bj][m][0], v1 = acc[ai][bj][m][1];
__device__ __forceinline__ void st_bf8(bf16_t* p, f32x4 a, f32x4 b) { *(u32x4*)p = (u32x4){pk2(a.x, a.y), pk2(a.z, a.w), pk2(b.x, b.y), pk2(b.z, b.w)}; }
__device__ __forceinline__ void st_bf4(bf16_t* p, f32x4 v) { *(u32x2*)p = (u32x2){pk2(v.x, v.y), pk2(v.z, v.w)}; }
__device__ __forceinline__ f32x4 ld_bf4(const bf16_t* p) { const u32x2 w = *(const u32x2*)p; return (f32x4){bflo(w.x), bfhi(w.x), bflo(w.y), bfhi(w.y)}; }
__device__ __forceinline__ float quad_sum16(float s) { s += __shfl_xor(s, 16); s += __shfl_xor(s, 32); return s; }

struct EpiInMain {
    static constexpr bool PERM = true, AFTER_DRAIN = false;
#if defined(PG8_TIME) && PG8_TPH == 1
    static constexpr bool TIMED = true;
#endif
    bf16_t *cq, *ckv, *z, *xbc, *sgm, *sgs; float *ssq_cq, *ssq_ckv, *new_ckv;
    bf16_t* krope; float *dt, *new_krope; const float* dt_bias; const f32x2* rope;
    __device__ __forceinline__ void operator()(AccRef acc, const pg8::Unit& u, int wr, int wc, int fr, int fq) const {
        const int pn = u.pn;
        if (pn == 20) {
            if (wc < 2) {
                EPI_ROWS(u.pm)
                    const f32x4 x0 = acc[ai][0][m][0], x1 = acc[ai][0][m][1]; const int i0 = fq * 4;
                    if (row < RP) {
                        st_bf4(krope + (size_t)row * 64 + wc * 32 + i0, x0); st_bf4(krope + (size_t)row * 64 + wc * 32 + 16 + i0, x1);
                        *(f32x4*)(new_krope + (size_t)row * 64 + wc * 32 + i0) = x0; *(f32x4*)(new_krope + (size_t)row * 64 + wc * 32 + 16 + i0) = x1;
                    } else {
                        const int t = (row - RP) & 2047; const f32x2* rp = rope + t * 32 + wc * 16 + i0; f32x4 o0, o1;
#pragma unroll
                        for (int e = 0; e < 4; ++e) { const f32x2 cs = rp[e]; o0[e] = x0[e] * cs.x - x1[e] * cs.y; o1[e] = x0[e] * cs.y + x1[e] * cs.x; }
                        bf16_t* dst = krope + (size_t)kvrow_of_row(row) * 64 + wc * 32 + i0; st_bf4(dst, o0); st_bf4(dst + 16, o1);
                    }
                EPI_END
            } else if (wc == 2) {
                EPI_ROWS(u.pm)
#pragma unroll
                    for (int n = 0; n < 2; ++n) { const int j = n * 16 + fq * 4; const f32x4 v = acc[ai][0][m][n]; const f32x4 b = *(const f32x4*)(dt_bias + j);
                        *(f32x4*)(dt + (size_t)row * 32 + j) = (f32x4){softplusf(v.x + b.x), softplusf(v.y + b.y), softplusf(v.z + b.z), softplusf(v.w + b.w)}; }
                EPI_END
            }
        } else if (pn < 2) {
            EPI_ROWS(u.pm)
                const int orow = pn == 0 ? row : kvrow_of_row(row); bf16_t* dst = (pn == 0 ? cq : ckv) + (size_t)orow * 256; float s = 0.f;
                EPI_COLS8
                    st_bf8(dst + col, v0, v1); s += ((v0.x * v0.x + v0.y * v0.y) + (v0.z * v0.z + v0.w * v0.w)) + ((v1.x * v1.x + v1.y * v1.y) + (v1.z * v1.z + v1.w * v1.w));
                    if (pn == 1 && row < RP) { *(f32x4*)(new_ckv + (size_t)row * 256 + col) = v0; *(f32x4*)(new_ckv + (size_t)row * 256 + col + 4) = v1; }
                EPI_END
                s = quad_sum16(s);
                if (fq == 0) (pn == 0 ? ssq_cq : ssq_ckv)[(size_t)orow * 4 + wc] = s;
            EPI_END
        } else if (pn < 12) {
            bf16_t* base = pn < 6 ? z : xbc; const int ld = pn < 6 ? 1024 : 1536, c0 = pn < 6 ? (pn - 2) * 256 : (pn - 6) * 256;
            EPI_ROWS(u.pm)
                bf16_t* dst = base + (size_t)row * ld + c0;
                EPI_COLS8 st_bf8(dst + col, v0, v1); EPI_END
            EPI_END
        } else {
            bf16_t* base = pn < 16 ? sgm : sgs; const int c0 = (pn & 3) * 256;
            EPI_ROWS(u.pm)
                bf16_t* dst = base + (size_t)row * 1024 + c0;
                EPI_COLS8 __builtin_nontemporal_store((u32x4){pk2(sigm(v0.x), sigm(v0.y)), pk2(sigm(v0.z), sigm(v0.w)), pk2(sigm(v1.x), sigm(v1.y)), pk2(sigm(v1.z), sigm(v1.w))}, (u32x4*)(dst + col)); EPI_END
            EPI_END
        }
    }
};
struct EpiInTail {
    static constexpr bool PERM = false, AFTER_DRAIN = false;
    bf16_t* krope; float *dt, *new_krope; const float* dt_bias; const f32x2* rope;
    __device__ __forceinline__ void operator()(AccRef acc, const pg8::Unit& u, int wr, int wc, int fr, int fq) const {
        if (wc < 2) {
            EPI_ROWS(u.pm)
                const f32x4 x0 = acc[ai][0][m][0], x1 = acc[ai][0][m][1]; const int i0 = fq * 4;
                if (row < RP) {
                    st_bf4(krope + (size_t)row * 64 + wc * 32 + i0, x0); st_bf4(krope + (size_t)row * 64 + wc * 32 + 16 + i0, x1);
                    *(f32x4*)(new_krope + (size_t)row * 64 + wc * 32 + i0) = x0; *(f32x4*)(new_krope + (size_t)row * 64 + wc * 32 + 16 + i0) = x1;
                } else {
                    const int t = (row - RP) & 2047; const f32x2* rp = rope + t * 32 + wc * 16 + i0; f32x4 o0, o1;
#pragma unroll
                    for (int e = 0; e < 4; ++e) { const f32x2 cs = rp[e]; o0[e] = x0[e] * cs.x - x1[e] * cs.y; o1[e] = x0[e] * cs.y + x1[e] * cs.x; }
                    bf16_t* dst = krope + (size_t)kvrow_of_row(row) * 64 + wc * 32 + i0; st_bf4(dst, o0); st_bf4(dst + 16, o1);
                }
            EPI_END
        } else if (wc == 2) {
            EPI_ROWS(u.pm)
#pragma unroll
                for (int n = 0; n < 2; ++n) { const int j = n * 16 + fq * 4; const f32x4 v = acc[ai][0][m][n]; const f32x4 b = *(const f32x4*)(dt_bias + j);
                    *(f32x4*)(dt + (size_t)row * 32 + j) = (f32x4){softplusf(v.x + b.x), softplusf(v.y + b.y), softplusf(v.z + b.z), softplusf(v.w + b.w)}; }
            EPI_END
        }
    }
};

struct EpiQR {
    static constexpr bool PERM = false, AFTER_DRAIN = false;
    bf16_t* qr; const float* ssq; const f32x2* rope;
    __device__ __forceinline__ void operator()(AccRef acc, const pg8::Unit& u, int wr, int wc, int fr, int fq) const {
        EPI_ROWS(u.pm)
            const f32x4 sq = *(const f32x4*)(ssq + (size_t)row * 4); const float rs = rsqrtf(((sq.x + sq.y) + (sq.z + sq.w)) * (1.f / 256.f) + EPS);
            bf16_t* dst = qr + (size_t)row * 512 + u.pn * 256;
#pragma unroll
            for (int bj = 0; bj < 2; ++bj) { const int cb = bj * 128 + wc * 32, i0 = fq * 4; const f32x4 x0 = acc[ai][bj][m][0] * rs, x1 = acc[ai][bj][m][1] * rs;
                if (row < RP) { st_bf4(dst + cb + i0, x0); st_bf4(dst + cb + 16 + i0, x1); }
                else { const int t = (row - RP) & 2047; const f32x2* rp = rope + t * 32 + (wc & 1) * 16 + i0; f32x4 o0, o1;
#pragma unroll
                    for (int e = 0; e < 4; ++e) { const f32x2 cs = rp[e]; o0[e] = x0[e] * cs.x - x1[e] * cs.y; o1[e] = x0[e] * cs.y + x1[e] * cs.x; }
                    st_bf4(dst + cb + i0, o0); st_bf4(dst + cb + 16 + i0, o1); } }
        EPI_END
    }
};
template <int MFR> struct EpiMla {
    static constexpr bool PERM = true, AFTER_DRAIN = false;
    const bf16_t* sgm; float* t;
    __device__ __forceinline__ void operator()(const f32x4 (&acc)[2][2][MFR][2], const pg8::Unit& u, int wr, int wc, int fr, int fq) const {
        EPI_ROWS_M(u.pm, MFR)
            const size_t off = (size_t)row * 1024 + u.pn * 256;
            EPI_COLS8 const u32x4 gw = *(const u32x4*)(sgm + off + col);
                *(f32x4*)(t + off + col) = (f32x4){bflo(gw.x), bfhi(gw.x), bflo(gw.y), bfhi(gw.y)} * v0; *(f32x4*)(t + off + col + 4) = (f32x4){bflo(gw.z), bfhi(gw.z), bflo(gw.w), bfhi(gw.w)} * v1; EPI_END
        EPI_END
    }
};
template <int MFR> struct EpiSsd {
    static constexpr bool PERM = true, AFTER_DRAIN = false;
    const bf16_t* sgs; const float* t; const float* ssq_y; bf16_t* merged;
    __device__ __forceinline__ void operator()(const f32x4 (&acc)[2][2][MFR][2], const pg8::Unit& u, int wr, int wc, int fr, int fq) const {
        EPI_ROWS_M(u.pm, MFR)
            float s = 0.f;
#pragma unroll
            for (int q = 0; q < 4; ++q) { const f32x4 a = *(const f32x4*)(ssq_y + (size_t)row * 16 + q * 4); s += (a.x + a.y) + (a.z + a.w); }
            const float rs = rsqrtf(s * (1.f / 1024.f) + EPS); const size_t off = (size_t)row * 1024 + u.pn * 256;
            EPI_COLS8 const u32x4 gw = *(const u32x4*)(sgs + off + col);
                st_bf8(merged + off + col, *(const f32x4*)(t + off + col) + (f32x4){bflo(gw.x), bfhi(gw.x), bflo(gw.y), bfhi(gw.y)} * (v0 * rs),
                       *(const f32x4*)(t + off + col + 4) + (f32x4){bflo(gw.z), bfhi(gw.z), bflo(gw.w), bfhi(gw.w)} * (v1 * rs)); EPI_END
        EPI_END
    }
};
template <int MFR> struct EpiOut {
    static constexpr bool PERM = true, AFTER_DRAIN = false;
    const float *xp, *xs, *mod, *gffn; bf16_t* x1; bf16_t* a1; float* ssq2;
    __device__ __forceinline__ void operator()(const f32x4 (&acc)[2][2][MFR][2], const pg8::Unit& u, int wr, int wc, int fr, int fq) const {
        EPI_ROWS_M(u.pm, MFR)
            const float* md = mod + grp_of_row(row) * 6144;
            const float* xr = row < RP ? xp + (size_t)row * DM : xs + (size_t)(row - RP) * DM; const size_t off = (size_t)row * 1024; float s = 0.f;
            EPI_COLS8
                const int c = u.pn * 256 + col;
                const f32x4 xa = __builtin_nontemporal_load((const f32x4*)(xr + c)) + *(const f32x4*)(md + 2048 + c) * v0, xb = __builtin_nontemporal_load((const f32x4*)(xr + c + 4)) + *(const f32x4*)(md + 2048 + c + 4) * v1;
                st_bf8(x1 + off + c, xa, xb);
                s += ((xa.x * xa.x + xa.y * xa.y) + (xa.z * xa.z + xa.w * xa.w)) + ((xb.x * xb.x + xb.y * xb.y) + (xb.z * xb.z + xb.w * xb.w));
                st_bf8(a1 + off + c, xa * *(const f32x4*)(gffn + c) * (*(const f32x4*)(md + 4096 + c) + 1.f), xb * *(const f32x4*)(gffn + c + 4) * (*(const f32x4*)(md + 4096 + c + 4) + 1.f));
            EPI_END
            s = quad_sum16(s);
            if (fq == 0) ssq2[(size_t)row * 16 + u.pn * 4 + wc] = s;
        EPI_END
    }
};
struct EpiUp {
    static constexpr bool PERM = true, AFTER_DRAIN = false;
    const float *ssq2, *cup; bf16_t* uo; int pm_off;
    __device__ __forceinline__ void operator()(AccRef acc, const pg8::Unit& u, int wr, int wc, int fr, int fq) const {
        const int pmo = u.pm + pm_off; const int g = pmo < 32 ? 0 : 1 + ((pmo - 32) >> 3); const float* cu = cup + g * UPN + u.pn * 256;
        EPI_ROWS(pmo)
            float s = 0.f;
#pragma unroll
            for (int q = 0; q < 4; ++q) { const f32x4 a = *(const f32x4*)(ssq2 + (size_t)row * 16 + q * 4); s += (a.x + a.y) + (a.z + a.w); }
            const float rs = rsqrtf(s * (1.f / 1024.f) + EPS); bf16_t* dst = uo + (size_t)row * UPN + u.pn * 256;
            EPI_COLS8 st_bf8(dst + col, v0 * rs + *(const f32x4*)(cu + col), v1 * rs + *(const f32x4*)(cu + col + 4)); EPI_END
        EPI_END
    }
};
constexpr int CG_RB = 16;
struct CgW { float wg[3][8], wv[3][8], bg[8], bv[8]; };
__device__ __forceinline__ void cg_load_w(CgW& W, const float* fw, const float* fb, int c) {
#pragma unroll
    for (int k = 0; k < 3; ++k)
#pragma unroll
        for (int q = 0; q < 2; ++q) { const f32x4 a = *(const f32x4*)(fw + k * UPN + c + 4 * q), b = *(const f32x4*)(fw + k * UPN + DFF + c + 4 * q);
#pragma unroll
            for (int e = 0; e < 4; ++e) { W.wg[k][4 * q + e] = a[e]; W.wv[k][4 * q + e] = b[e]; } }
#pragma unroll
    for (int q = 0; q < 2; ++q) { const f32x4 a = *(const f32x4*)(fb + c + 4 * q), b = *(const f32x4*)(fb + DFF + c + 4 * q);
#pragma unroll
        for (int e = 0; e < 4; ++e) { W.bg[4 * q + e] = a[e]; W.bv[4 * q + e] = b[e]; } }
}
__device__ __forceinline__ float dpp_row_prev(float cur, float prv) {
    const int o = __builtin_amdgcn_update_dpp(0, __float_as_int(prv), 0x121, 0xf, 0xf, true);
    return __int_as_float(__builtin_amdgcn_update_dpp(o, __float_as_int(cur), 0x111, 0xf, 0xf, false)); }
__device__ __forceinline__ float dpp_row_next(float cur, float nxt) {
    const int o = __builtin_amdgcn_update_dpp(0, __float_as_int(nxt), 0x12F, 0xf, 0xf, true);
    return __int_as_float(__builtin_amdgcn_update_dpp(o, __float_as_int(cur), 0x101, 0xf, 0xf, false)); }
__device__ __forceinline__ void conv4_rows(float (&c)[4], float a0, float a1, float a2, float a3, float r0, float r1, float r2, float r3,
                                           float w0, float w1, float w2, float cs) {
    float t0, t1, t2, t3, z; const unsigned long long mlo = 0x0001000100010001ull, mhi = 0x8000800080008000ull;
    asm volatile(
        "v_cndmask_b32_e64 %[z], 0, %[w0], %[mlo]\n\t"
        "v_mul_f32 %[t0], %[a0], %[r0]\n\t" "v_mul_f32 %[t1], %[a1], %[r1]\n\t" "v_mul_f32 %[t2], %[a2], %[r2]\n\t" "v_mul_f32 %[t3], %[a3], %[r3]\n\t"
        "v_fma_f32 %[c0], %[w1], %[t0], %[cs]\n\t" "v_fma_f32 %[c1], %[w1], %[t1], %[cs]\n\t" "v_fma_f32 %[c2], %[w1], %[t2], %[cs]\n\t" "v_fma_f32 %[c3], %[w1], %[t3], %[cs]\n\t"
        "v_fmac_f32_dpp %[c0], %[t0], %[w0] row_shr:1 row_mask:0xf bank_mask:0xf bound_ctrl:1\n\t"
        "v_fmac_f32_dpp %[c1], %[t1], %[w0] row_shr:1 row_mask:0xf bank_mask:0xf bound_ctrl:1\n\t"
        "v_fmac_f32_dpp %[c2], %[t2], %[w0] row_shr:1 row_mask:0xf bank_mask:0xf bound_ctrl:1\n\t"
        "v_fmac_f32_dpp %[c3], %[t3], %[w0] row_shr:1 row_mask:0xf bank_mask:0xf bound_ctrl:1\n\t"
        "v_fmac_f32_dpp %[c0], %[t0], %[w2] row_shl:1 row_mask:0xf bank_mask:0xf bound_ctrl:1\n\t"
        "v_fmac_f32_dpp %[c1], %[t1], %[w2] row_shl:1 row_mask:0xf bank_mask:0xf bound_ctrl:1\n\t"
        "v_fmac_f32_dpp %[c2], %[t2], %[w2] row_shl:1 row_mask:0xf bank_mask:0xf bound_ctrl:1\n\t"
        "v_fmac_f32_dpp %[c3], %[t3], %[w2] row_shl:1 row_mask:0xf bank_mask:0xf bound_ctrl:1\n\t"
        "v_fmac_f32_dpp %[c1], %[t0], %[z] row_ror:1 row_mask:0xf bank_mask:0xf\n\t"
        "v_fmac_f32_dpp %[c2], %[t1], %[z] row_ror:1 row_mask:0xf bank_mask:0xf\n\t"
        "v_fmac_f32_dpp %[c3], %[t2], %[z] row_ror:1 row_mask:0xf bank_mask:0xf\n\t"
        "v_cndmask_b32_e64 %[z], 0, %[w2], %[mhi]\n\t"
        "v_fmac_f32_dpp %[c0], %[t1], %[z] row_ror:15 row_mask:0xf bank_mask:0xf\n\t"
        "v_fmac_f32_dpp %[c1], %[t2], %[z] row_ror:15 row_mask:0xf bank_mask:0xf\n\t"
        "v_fmac_f32_dpp %[c2], %[t3], %[z] row_ror:15 row_mask:0xf bank_mask:0xf"
        : [c0] "=&v"(c[0]), [c1] "=&v"(c[1]), [c2] "=&v"(c[2]), [c3] "=&v"(c[3]), [t0] "=&v"(t0), [t1] "=&v"(t1), [t2] "=&v"(t2), [t3] "=&v"(t3), [z] "=&v"(z)
        : [a0] "v"(a0), [a1] "v"(a1), [a2] "v"(a2), [a3] "v"(a3), [r0] "v"(r0), [r1] "v"(r1), [r2] "v"(r2), [r3] "v"(r3),
          [w0] "v"(w0), [w1] "v"(w1), [w2] "v"(w2), [cs] "v"(cs), [mlo] "s"(mlo), [mhi] "s"(mhi));
}
struct EpiUpGate {
    static constexpr bool PERM = true, AFTER_DRAIN = false;
#if defined(PG8_TIME) && PG8_TPH == 5
    static constexpr bool TIMED = true;
#endif
    static constexpr int PRE_SLOT = 1024, PRE_BYTES = 5120;
    const float *ssq2, *cup, *fcw, *cstp; bf16_t *ug, *halo;
    __device__ __forceinline__ void pre(const pg8::Unit& u, LAS unsigned char* slot, int wr, int wc, int lane) const {
        if (wr != 0) return;
        const int g = u.pm < 32 ? 0 : 1 + ((u.pm - 32) >> 3); const int cb = u.pn * 128 + wc * 32; const int a = lane >> 4, hv = (lane >> 3) & 1, c4 = lane & 7;
        const float* src = (a < 3 ? fcw + a * UPN : cstp + g * UPN) + hv * DFF + cb + c4 * 4;
        __builtin_amdgcn_global_load_lds((const unsigned*)src, (LAS unsigned*)(slot + wc * 1280), 16, 0, 0);
        if (lane < 16) __builtin_amdgcn_global_load_lds((const unsigned*)(cup + g * UPN + hv * DFF + cb + c4 * 4), (LAS unsigned*)(slot + wc * 1280 + 1024), 16, 0, 0);
    }
    __device__ __forceinline__ void operator()(const f32x4 (&acc)[2][2][4][2], const pg8::Unit& u, int wr, int wc, int fr, int fq, LAS unsigned char* slot) const {
        asm volatile("" : "+v"(fr), "+v"(fq));
        const int cb = u.pn * 128 + wc * 32;
        LAS const unsigned char* cl = slot + wc * 1280 + fq * 32;
        const char* sb = (const char*)(ssq2 + (size_t)(u.pm * 256 + wr * 64) * 16); const size_t slo = (unsigned)fr * 64u + (unsigned)fq * 16u;
        f32x4 raw[4];
#pragma unroll
        for (int m = 0; m < 4; ++m) raw[m] = *(const f32x4*)(sb + m * 1024 + slo);
#pragma unroll
        for (int ai = 0; ai < 2; ++ai) {
            const int row0 = u.pm * 256 + ai * 128 + wr * 64;
            float rsv[4];
#pragma unroll
            for (int m = 0; m < 4; ++m) rsv[m] = rsqrtf(quad_sum16((raw[m].x + raw[m].y) + (raw[m].z + raw[m].w)) * (1.f / 1024.f) + EPS);
            if (ai == 0) {
#pragma unroll
                for (int m = 0; m < 4; ++m) raw[m] = *(const f32x4*)(sb + 128 * 64 + m * 1024 + slo); }
            unsigned pk[4][4];
#ifdef CG_REP
            for (int rep = 0; rep < CG_REP; ++rep)
#endif
#pragma unroll
            for (int h = 0; h < 4; ++h) {
                f32x2 w0[2], w1[2], w2[2], cst[2];
#pragma unroll
                for (int hv = 0; hv < 2; ++hv) { const int co = hv * 128 + h * 8;
                    w0[hv] = *(LAS const f32x2*)(cl + co); w1[hv] = *(LAS const f32x2*)(cl + 256 + co); w2[hv] = *(LAS const f32x2*)(cl + 512 + co); cst[hv] = *(LAS const f32x2*)(cl + 768 + co); }
                float o[4][2];
#pragma unroll
                for (int e2 = 0; e2 < 2; ++e2) { const int n = h >> 1, e = (h & 1) * 2 + e2;
                    float cv[2][4];
#pragma unroll
                    for (int hv = 0; hv < 2; ++hv)
                        conv4_rows(cv[hv], acc[ai][hv][0][n][e], acc[ai][hv][1][n][e], acc[ai][hv][2][n][e], acc[ai][hv][3][n][e], rsv[0], rsv[1], rsv[2], rsv[3],
                                   w0[hv][e2], w1[hv][e2], w2[hv][e2], cst[hv][e2]);
#pragma unroll
                    for (int m = 0; m < 4; ++m) o[m][e2] = siluf(cv[0][m]) * cv[1][m];
                }
#pragma unroll
                for (int m = 0; m < 4; ++m) pk[m][h] = pk2(o[m][0], o[m][1]);
                __builtin_amdgcn_sched_barrier(0);
            }
            { char* ub = (char*)(ug + (size_t)row0 * DFF + cb); const size_t lo = (unsigned)fr * (unsigned)(DFF * 2) + (unsigned)fq * 16u;
#pragma unroll
                for (int m = 0; m < 4; ++m) { const bool edge = (m == 0 && fr == 0) || (m == 3 && fr == 15);
                    if (!edge) *(u32x4*)(ub + (size_t)m * 16 * DFF * 2 + lo) = (u32x4){pk[m][0], pk[m][1], pk[m][2], pk[m][3]}; } }
            const int slab = u.pm * 4 + ai * 2 + wr; char* hb = (char*)(halo + (size_t)slab * 4 * UPN + cb);
#pragma unroll
            for (int mm = 0; mm < 2; ++mm) { const int m = mm * 3; const bool act = mm == 0 ? (fr < 2) : (fr >= 14); const unsigned r4 = mm == 0 ? fr : fr - 12;
                if (act) { const size_t ho = r4 * (unsigned)(UPN * 2) + (unsigned)fq * 16u;
#pragma unroll
                    for (int hv = 0; hv < 2; ++hv) { const f32x4 c0 = *(LAS const f32x4*)(cl + 1024 + hv * 128), c1 = *(LAS const f32x4*)(cl + 1024 + hv * 128 + 16);
                        st_bf8((bf16_t*)(hb + hv * DFF * 2 + ho), acc[ai][hv][m][0] * rsv[m] + c0, acc[ai][hv][m][1] * rsv[m] + c1); } } }
        }
    }
};
__device__ __forceinline__ void fixup_rows(const Params& P, int row_lo, int row_hi, int tid) {
    if (tid >= DFF / 8) return;
    unsigned char* ws = P.ws; const bf16_t* halo = (const bf16_t*)(ws + WS_HALO); bf16_t* ug = (bf16_t*)(ws + WS_UG); const int c = tid * 8;
    CgW W; cg_load_w(W, P.in[I_FCW], P.in[I_FCB], c);
    const u32x4 zero = {0u, 0u, 0u, 0u};
    for (int k = row_lo / 64; k < row_hi / 64; ++k)
#pragma unroll
        for (int wh = 0; wh < 2; ++wh) {
            const int row = 64 * k + (wh ? 63 : 0); const int t = row < RP ? (row & 255) : ((row - RP) & 2047), L = row < RP ? SEQP : SEQS;
            const bf16_t* hp = nullptr; const bf16_t* hc; const bf16_t* hn = nullptr;
            if (wh == 0) { hc = halo + ((size_t)k * 4 + 0) * UPN; hn = halo + ((size_t)k * 4 + 1) * UPN; if (t > 0) hp = halo + ((size_t)(k - 1) * 4 + 3) * UPN; }
            else { hp = halo + ((size_t)k * 4 + 2) * UPN; hc = halo + ((size_t)k * 4 + 3) * UPN; if (t < L - 1) hn = halo + ((size_t)(k + 1) * 4 + 0) * UPN; }
            const u32x4 gp = hp ? *(const u32x4*)(hp + c) : zero, vp = hp ? *(const u32x4*)(hp + DFF + c) : zero;
            const u32x4 gc = *(const u32x4*)(hc + c), vc = *(const u32x4*)(hc + DFF + c);
            const u32x4 gn = hn ? *(const u32x4*)(hn + c) : zero, vn = hn ? *(const u32x4*)(hn + DFF + c) : zero;
            float a[8], b[8], x[8];
#pragma unroll
            for (int e = 0; e < 8; ++e) { a[e] = W.bg[e]; b[e] = W.bv[e]; }
            unpack8(gp, x);
#pragma unroll
            for (int e = 0; e < 8; ++e) a[e] += x[e] * W.wg[0][e];
            unpack8(gc, x);
#pragma unroll
            for (int e = 0; e < 8; ++e) a[e] += x[e] * W.wg[1][e];
            unpack8(gn, x);
#pragma unroll
            for (int e = 0; e < 8; ++e) a[e] += x[e] * W.wg[2][e];
            unpack8(vp, x);
#pragma unroll
            for (int e = 0; e < 8; ++e) b[e] += x[e] * W.wv[0][e];
            unpack8(vc, x);
#pragma unroll
            for (int e = 0; e < 8; ++e) b[e] += x[e] * W.wv[1][e];
            unpack8(vn, x);
#pragma unroll
            for (int e = 0; e < 8; ++e) b[e] += x[e] * W.wv[2][e];
            u32x4 o;
#pragma unroll
            for (int e = 0; e < 4; ++e) o[e] = pk2(siluf(a[2 * e]) * b[2 * e], siluf(a[2 * e + 1]) * b[2 * e + 1]);
            *(u32x4*)(ug + (size_t)row * DFF + c) = o;
        }
}

template <int MFR> struct EpiDown {
    static constexpr bool PERM = true, AFTER_DRAIN = false;
    const float* mod; float* x; const bf16_t* x1;
    __device__ __forceinline__ void operator()(const f32x4 (&acc)[2][2][MFR][2], const pg8::Unit& u, int wr, int wc, int fr, int fq) const {
        EPI_ROWS_M(u.pm, MFR)
            const float* g2 = mod + grp_of_row(row) * 6144 + 5120 + u.pn * 256;
            float* xr = x + (size_t)row * 1024 + u.pn * 256; const bf16_t* x1r = x1 + (size_t)row * 1024 + u.pn * 256;
            EPI_COLS8 const u32x4 w = *(const u32x4*)(x1r + col);
                *(f32x4*)(xr + col) = (f32x4){bflo(w.x), bfhi(w.x), bflo(w.y), bfhi(w.y)} + *(const f32x4*)(g2 + col) * v0; *(f32x4*)(xr + col + 4) = (f32x4){bflo(w.z), bfhi(w.z), bflo(w.w), bfhi(w.w)} + *(const f32x4*)(g2 + col + 4) * v1; EPI_END
        EPI_END
    }
};

struct EpiDownNorm {
    static constexpr bool PERM = true, AFTER_DRAIN = true;
    const float* mod; float* x; const bf16_t* x1; const float* gfin; float* xbuf; unsigned* cnt;
    __device__ __forceinline__ void fused(f32x4 (&acc)[2][2][3][2], const pg8::Unit& u, int wr, int wc, int fr, int fq, LAS unsigned char* lds, int wid, int lane) const {
        LAS float* Pt = (LAS float*)lds;
        LAS float* St = (LAS float*)(lds + 4096);
        EPI_ROWS_M(u.pm, 3)
            const float* g2 = mod + grp_of_row(row) * 6144 + 5120 + u.pn * 256; const bf16_t* xr = x1 + (size_t)row * 1024 + u.pn * 256; float s = 0.f;
#pragma unroll
            for (int bj = 0; bj < 2; ++bj) { const int col = bj * 128 + wc * 32 + fq * 8; const u32x4 w = *(const u32x4*)(xr + col);
                const f32x4 a = (f32x4){bflo(w.x), bfhi(w.x), bflo(w.y), bfhi(w.y)} + *(const f32x4*)(g2 + col) * acc[ai][bj][m][0], b = (f32x4){bflo(w.z), bfhi(w.z), bflo(w.w), bfhi(w.w)} + *(const f32x4*)(g2 + col + 4) * acc[ai][bj][m][1];
                acc[ai][bj][m][0] = a; acc[ai][bj][m][1] = b;
                s += ((a.x * a.x + a.y * a.y) + (a.z * a.z + a.w * a.w)) + ((b.x * b.x + b.y * b.y) + (b.z * b.z + b.w * b.w)); }
            s = quad_sum16(s);
            if (fq == 0) Pt[(ai * 96 + wr * 48 + m * 16 + fr) * 4 + wc] = s;
        EPI_END
        asm volatile("s_waitcnt lgkmcnt(0)" ::: "memory"); __builtin_amdgcn_s_barrier(); asm volatile("" ::: "memory");
        const int rloc = wid * 32 + (lane & 31);
        if (lane < 32 && rloc < 192) { const float tot = (Pt[rloc * 4 + 0] + Pt[rloc * 4 + 1]) + (Pt[rloc * 4 + 2] + Pt[rloc * 4 + 3]);
            __hip_atomic_store(xbuf + ((size_t)(u.pm * 192 + rloc) * 4 + u.pn), tot, __ATOMIC_RELAXED, __HIP_MEMORY_SCOPE_AGENT); }
        asm volatile("s_waitcnt vmcnt(0)" ::: "memory");
        if (lane == 0) __hip_atomic_fetch_add(cnt + 16 * u.pm, 1u, __ATOMIC_RELAXED, __HIP_MEMORY_SCOPE_AGENT);
        if (wid == 0) { unsigned sp = 0;
            while ((unsigned)__builtin_amdgcn_readfirstlane(__hip_atomic_load(cnt + 16 * u.pm, __ATOMIC_RELAXED, __HIP_MEMORY_SCOPE_AGENT)) < 32u) { __builtin_amdgcn_s_sleep(2); if (++sp > (1u << 22)) break; }
            __builtin_amdgcn_fence(__ATOMIC_ACQUIRE, "agent"); }
        asm volatile("s_waitcnt vmcnt(0) lgkmcnt(0)" ::: "memory"); __builtin_amdgcn_s_barrier(); asm volatile("" ::: "memory");
        if (lane < 32 && rloc < 192) { const float* sl = xbuf + (size_t)(u.pm * 192 + rloc) * 4; float tot = 0.f;
#pragma unroll
            for (int t = 0; t < 4; ++t) tot += __hip_atomic_load(sl + t, __ATOMIC_RELAXED, __HIP_MEMORY_SCOPE_AGENT);
            St[rloc] = rsqrtf(tot * (1.f / 1024.f) + EPS); }
        asm volatile("s_waitcnt lgkmcnt(0)" ::: "memory"); __builtin_amdgcn_s_barrier(); asm volatile("" ::: "memory");
        EPI_ROWS_M(u.pm, 3)
            const float rs = St[ai * 96 + wr * 48 + m * 16 + fr]; float* xr = x + (size_t)row * 1024 + u.pn * 256; const float* gf = gfin + u.pn * 256;
#pragma unroll
            for (int bj = 0; bj < 2; ++bj) { const int col = bj * 128 + wc * 32 + fq * 8;
                *(f32x4*)(xr + col) = acc[ai][bj][m][0] * rs * *(const f32x4*)(gf + col); *(f32x4*)(xr + col + 4) = acc[ai][bj][m][1] * rs * *(const f32x4*)(gf + col + 4); }
        EPI_END
    }
};

struct Gemm2Order {
    int G, c;
    __device__ void init(int G_, int c_) { G = G_; c = c_; }
    __device__ bool next(int i, pg8::Unit& u) const {
        const int L = i * G + c; if (L >= 608) return false;
        if (L < 416) { u.pm = 48 + L % 52; u.pn = 6 + L / 52; } else { const int l = L - 416; u.pm = l % 48; u.pn = l / 48; }
        return true;
    }
    __device__ __forceinline__ void a_ready(const pg8::Unit&) const {}
    __device__ __forceinline__ void done(const pg8::Unit&) const {}
};
struct EpiG2 {
    static constexpr bool PERM = true, AFTER_DRAIN = false;
    bf16_t *qn, *kv; const float *ssq_cq, *ssq_ckv;
    __device__ __forceinline__ void operator()(AccRef acc, const pg8::Unit& u, int wr, int wc, int fr, int fq) const {
        if (u.pn >= 6) {
            const int pm = u.pm - 48, pn = u.pn - 6;
            EPI_ROWS(pm)
                const f32x4 sq = *(const f32x4*)(ssq_ckv + (size_t)row * 4); const float rs = rsqrtf(((sq.x + sq.y) + (sq.z + sq.w)) * (1.f / 256.f) + EPS);
                bf16_t* dst = kv + (size_t)row * 2048 + pn * 256;
                EPI_COLS8 st_bf8(dst + col, v0 * rs, v1 * rs); EPI_END
            EPI_END
        } else {
            EPI_ROWS(u.pm)
                const f32x4 sq = *(const f32x4*)(ssq_cq + (size_t)row * 4); const float rs = rsqrtf(((sq.x + sq.y) + (sq.z + sq.w)) * (1.f / 256.f) + EPS);
                bf16_t* dst = qn + (size_t)row * 1024 + u.pn * 256;
                EPI_COLS8 st_bf8(dst + col, v0 * rs, v1 * rs); EPI_END
            EPI_END
        }
    }
};
static_assert(WS_CKVA - WS_CQ == (size_t)48 * 256 * 256 * 2 && WS_WUKV - WS_WUQ == (size_t)6 * 256 * 256 * 2, "GEMM2 addressing");

struct PairOrder {
    int nwg, G, c;
    __device__ void init(int G_, int c_) { nwg = 256; G = G_; c = c_; }
    __device__ bool next(int i, pg8::Unit& u) const {
        const int k = i >> 1; const long L = (long)k * G + c; if (L >= nwg) return false;
        int wgid = (int)L; { const int q = nwg / 8, xcd = wgid % 8, off = wgid / 8; wgid = xcd * q + off; }
        const int nig = 8 * 4, gid = wgid / nig, fm = gid * 8; const int pm = fm + ((wgid % nig) % 8), pn = (wgid % nig) / 8;
        if ((i & 1) == 0) { u.pm = pm + 160; u.pn = pn; } else { u.pm = pm; u.pn = pn + 4; }
        return true;
    }
    __device__ __forceinline__ void a_ready(const pg8::Unit&) const {}
    __device__ __forceinline__ void done(const pg8::Unit&) const {}
};
struct EpiMerged {
    static constexpr bool PERM = true, AFTER_DRAIN = false;
    struct State { u32x4 t[2][3][2]; };
    const bf16_t *sgm, *sgs; const float* ssq_y; bf16_t* merged;
    __device__ __forceinline__ void operator()(const f32x4 (&acc)[2][2][3][2], const pg8::Unit& u, int wr, int wc, int fr, int fq, State& st) const {
        if (u.pn < 4) {
            const int pm = u.pm - 160;
            EPI_ROWS_M(pm, 3)
                const size_t off = (size_t)row * 1024 + u.pn * 256;
                EPI_COLS8 const u32x4 gw = __builtin_nontemporal_load((const u32x4*)(sgm + off + col));
                    const f32x4 a = (f32x4){bflo(gw.x), bfhi(gw.x), bflo(gw.y), bfhi(gw.y)} * v0, b = (f32x4){bflo(gw.z), bfhi(gw.z), bflo(gw.w), bfhi(gw.w)} * v1;
                    st.t[ai][m][bj] = (u32x4){pk2(a.x, a.y), pk2(a.z, a.w), pk2(b.x, b.y), pk2(b.z, b.w)}; EPI_END
            EPI_END
        } else {
            const int pn = u.pn - 4;
            EPI_ROWS_M(u.pm, 3)
                float s = 0.f;
#pragma unroll
                for (int q = 0; q < 4; ++q) { const f32x4 a = *(const f32x4*)(ssq_y + (size_t)row * 16 + q * 4); s += (a.x + a.y) + (a.z + a.w); }
                const float rs = rsqrtf(s * (1.f / 1024.f) + EPS); const size_t off = (size_t)row * 1024 + pn * 256;
                EPI_COLS8 const u32x4 gw = __builtin_nontemporal_load((const u32x4*)(sgs + off + col)); const u32x4 tw = st.t[ai][m][bj];
                    st_bf8(merged + off + col, (f32x4){bflo(tw.x), bfhi(tw.x), bflo(tw.y), bfhi(tw.y)} + (f32x4){bflo(gw.x), bfhi(gw.x), bflo(gw.y), bfhi(gw.y)} * (v0 * rs),
                           (f32x4){bflo(tw.z), bfhi(tw.z), bflo(tw.w), bfhi(tw.w)} + (f32x4){bflo(gw.z), bfhi(gw.z), bflo(gw.w), bfhi(gw.w)} * (v1 * rs)); EPI_END
            EPI_END
        }
    }
};
static_assert(WS_QN - WS_Z == (size_t)160 * 192 * 1024 * 2 && WS_WOSSD - WS_WOMLA == (size_t)4 * 256 * 1024 * 2, "GEMM3 pair addressing");

template <class Epi>
__device__ __forceinline__ void run_gemm(LAS unsigned char* lds, const bf16_t* A, const bf16_t* Bt, int M, int N, int K, int G, int c, const Epi& E) {
    pg8::Gemm g{A, Bt, M, N, K}; pg8::StaticOrder S; S.init(M, N, G, c);
    pg8::gemm_phase<Epi, pg8::StaticOrder, PG8_ALIGN, PG8_SP2>(lds, g, S, E);
}
template <class Epi>
__device__ __forceinline__ void run_gemm192(LAS unsigned char* lds, const bf16_t* A, const bf16_t* Bt, int M, int N, int K, int G, int c, const Epi& E) {
    pg8::Gemm g{A, Bt, M, N, K}; pg8::StaticOrder S; S.init(M, N, G, c, 192);
    pg8::gemm_phase<Epi, pg8::StaticOrder, PG8_ALIGN, PG8_SP2, 3>(lds, g, S, E);
}

__device__ __forceinline__ void norm_new_ckv(const Params& P, int lane, int wave, int G) {
    const int gw = blockIdx.x * 8 + wave, NGW = G * 8;
    float* nck = P.out + O_CKV; const float* ssq = (const float*)(P.ws + WS_SSQ_CKV); const float* gk = P.in[I_GKV];
    for (int row = gw; row < RP; row += NGW) {
        const f32x4 sq = *(const f32x4*)(ssq + (size_t)row * 4); const float rs = rsqrtf(((sq.x + sq.y) + (sq.z + sq.w)) * (1.f / 256.f) + EPS);
        f32x4* p = (f32x4*)(nck + (size_t)row * 256) + lane; *p = *p * rs * *(const f32x4*)(gk + 4 * lane);
    }
}
namespace att {
using s16x4 = __attribute__((ext_vector_type(4))) short;
using f32x16 = __attribute__((ext_vector_type(16))) float;
constexpr int QBLK = 32, KVBLK = 64;
constexpr float SCALE = ATT_SCALE, THR = 8.f;
constexpr int SHM_V = 16384, SHM_K = 16384, SHM_KR = 8192;
constexpr int L_V = 0, L_K = 2 * SHM_V, L_KR = L_K + 2 * SHM_K, L_WS = L_KR + 2 * SHM_KR, L_QR = L_WS + 8 * 64 * 4, L_END = L_QR + 8 * 4096;
#define KSWZ(row, colB) ((row) * 256 + ((colB) ^ (((row) & 7) << 4)))
#define KRSWZ(row, colB) ((row) * 128 + ((colB) ^ ((((row) >> 1) & 7) << 4)))
#define SBAR() __builtin_amdgcn_sched_barrier(0)
__device__ __forceinline__ int crow(int r, int hi) { return (r & 3) + 8 * (r >> 2) + 4 * hi; }
__device__ __forceinline__ unsigned cvtpk(float lo, float hi) { unsigned r; asm volatile("v_cvt_pk_bf16_f32 %0, %1, %2" : "=v"(r) : "v"(lo), "v"(hi)); return r; }
__device__ __forceinline__ void partialSM(f32x16& p0, f32x16& p1, float& m_reg, float& mn, float& alpha) {
  constexpr float C = SCALE * 1.4426950408889634f;
  float pmax = p0[0];
#pragma unroll
  for (int r = 1; r < 16; ++r) pmax = fmaxf(pmax, p0[r]);
#pragma unroll
  for (int r = 0; r < 16; ++r) pmax = fmaxf(pmax, p1[r]);
  { auto rr = __builtin_amdgcn_permlane32_swap(__float_as_uint(pmax), __float_as_uint(pmax), false, false);
    pmax = fmaxf(__uint_as_float(rr[0]), __uint_as_float(rr[1])); }
  if (__builtin_expect(__all(pmax - m_reg <= THR / SCALE), 1)) { mn = m_reg; alpha = 1.f; }
  else { mn = fmaxf(m_reg, pmax); alpha = __builtin_amdgcn_exp2f((m_reg - mn) * C); m_reg = mn; }
  float mnC = -mn * C;
#pragma unroll
  for (int r = 0; r < 16; ++r) p0[r] = fmaf(p0[r], C, mnC);
#pragma unroll
  for (int r = 0; r < 16; ++r) p1[r] = fmaf(p1[r], C, mnC);
#pragma unroll
  for (int r = 0; r < 16; ++r) p0[r] = __builtin_amdgcn_exp2f(p0[r]);
}
__device__ __forceinline__ void finishSM(f32x16& p0, f32x16& p1, float alpha, float& l_reg, bf16x8& pa0, bf16x8& pa1, bf16x8& pa2, bf16x8& pa3) {
#pragma unroll
  for (int r = 0; r < 16; ++r) p1[r] = __builtin_amdgcn_exp2f(p1[r]);
  float ps = 0;
#pragma unroll
  for (int r = 0; r < 16; ++r) ps += p0[r];
#pragma unroll
  for (int r = 0; r < 16; ++r) ps += p1[r];
  { auto rr = __builtin_amdgcn_permlane32_swap(__float_as_uint(ps), __float_as_uint(ps), false, false);
    ps = __uint_as_float(rr[0]) + __uint_as_float(rr[1]); }
  l_reg = l_reg * alpha + ps;
#define PK4(P, BASE, OUT) do { unsigned a0 = cvtpk(P[BASE + 0], P[BASE + 1]), a1 = cvtpk(P[BASE + 2], P[BASE + 3]);   \
    unsigned b0 = cvtpk(P[BASE + 4], P[BASE + 5]), b1 = cvtpk(P[BASE + 6], P[BASE + 7]);                              \
    auto r0 = __builtin_amdgcn_permlane32_swap(a0, b0, false, false); auto r1 = __builtin_amdgcn_permlane32_swap(a1, b1, false, false); \
    u32x4 w = {r0[0], r1[0], r0[1], r1[1]}; OUT = *reinterpret_cast<bf16x8*>(&w); } while (0)
  PK4(p0, 0, pa0); PK4(p0, 8, pa1); PK4(p1, 0, pa2); PK4(p1, 8, pa3);
#undef PK4
}
__device__ __forceinline__ void qkt(f32x16& p0, f32x16& p1, const LAS char* Ks, const LAS char* Krs, const bf16x8* qr, const LAS char* qrl, int r32, int hi) {
  p0 = f32x16{}; p1 = f32x16{};
#pragma unroll
  for (int d0 = 0; d0 < 8; ++d0) { const int cb = (d0 * 16 + hi * 8) * 2;
    const bf16x8 b0 = *reinterpret_cast<const LAS bf16x8*>(Ks + KSWZ(r32, cb));
    const bf16x8 b1 = *reinterpret_cast<const LAS bf16x8*>(Ks + KSWZ(32 + r32, cb));
    p0 = __builtin_amdgcn_mfma_f32_32x32x16_bf16(b0, qr[d0], p0, 0, 0, 0);
    p1 = __builtin_amdgcn_mfma_f32_32x32x16_bf16(b1, qr[d0], p1, 0, 0, 0); }
#pragma unroll
  for (int d0 = 0; d0 < 4; ++d0) { const int cb = (d0 * 16 + hi * 8) * 2;
    const bf16x8 b0 = *reinterpret_cast<const LAS bf16x8*>(Krs + KRSWZ(r32, cb));
    const bf16x8 b1 = *reinterpret_cast<const LAS bf16x8*>(Krs + KRSWZ(32 + r32, cb));
    const bf16x8 qq = *reinterpret_cast<const LAS bf16x8*>(qrl + d0 * 1024);
    p0 = __builtin_amdgcn_mfma_f32_32x32x16_bf16(b0, qq, p0, 0, 0, 0);
    p1 = __builtin_amdgcn_mfma_f32_32x32x16_bf16(b1, qq, p1, 0, 0, 0); }
}
__device__ __forceinline__ int v_st(int k, int c) { const int kk = (k & ~0xC) | ((k & 4) << 1) | ((k & 8) >> 1); return ((kk >> 3) * 4 + (c >> 5)) * 512 + ((kk & 7) * 32 + (c & 31)) * 2; }
__device__ __forceinline__ int v_rd_base(int lane) { return ((lane & 3) << 3) | (((lane >> 2) & 3) << 6) | (((lane >> 4) & 1) << 5) | (((lane >> 5) & 1) << 8); }
constexpr int v_rd_off(int d0, int ks, int half) { return d0 * 512 + ks * 4096 + half * 2048; }
template <int OFF> __device__ __forceinline__ s16x4 tr_read(int vb) {
  s16x4 r; asm volatile("ds_read_b64_tr_b16 %0, %1 offset:%2" : "=&v"(r) : "v"(vb), "i"(OFF) : "memory"); return r;
}
template <int D0> __device__ __forceinline__ void pv_one(f32x16& od, int vb, bf16x8 pa0, bf16x8 pa1, bf16x8 pa2, bf16x8 pa3) {
  const s16x4 l0 = tr_read<v_rd_off(D0, 0, 0)>(vb), h0 = tr_read<v_rd_off(D0, 0, 1)>(vb), l1 = tr_read<v_rd_off(D0, 1, 0)>(vb), h1 = tr_read<v_rd_off(D0, 1, 1)>(vb);
  const s16x4 l2 = tr_read<v_rd_off(D0, 2, 0)>(vb), h2 = tr_read<v_rd_off(D0, 2, 1)>(vb), l3 = tr_read<v_rd_off(D0, 3, 0)>(vb), h3 = tr_read<v_rd_off(D0, 3, 1)>(vb);
  asm volatile("s_waitcnt lgkmcnt(0)" ::: "memory"); SBAR();
#define PK(L, H) (bf16x8){L[0], L[1], L[2], L[3], H[0], H[1], H[2], H[3]}
  od = __builtin_amdgcn_mfma_f32_32x32x16_bf16(pa0, PK(l0, h0), od, 0, 0, 0);
  od = __builtin_amdgcn_mfma_f32_32x32x16_bf16(pa1, PK(l1, h1), od, 0, 0, 0);
  od = __builtin_amdgcn_mfma_f32_32x32x16_bf16(pa2, PK(l2, h2), od, 0, 0, 0);
  od = __builtin_amdgcn_mfma_f32_32x32x16_bf16(pa3, PK(l3, h3), od, 0, 0, 0);
#undef PK
}
__device__ __forceinline__ void pv_d0(f32x16* o, int vb, bf16x8 pa0, bf16x8 pa1, bf16x8 pa2, bf16x8 pa3) {
  pv_one<0>(o[0], vb, pa0, pa1, pa2, pa3); pv_one<1>(o[1], vb, pa0, pa1, pa2, pa3); pv_one<2>(o[2], vb, pa0, pa1, pa2, pa3); pv_one<3>(o[3], vb, pa0, pa1, pa2, pa3);
}
__device__ __forceinline__ void attn_unit(const bf16_t* __restrict__ Qn, const bf16_t* __restrict__ Qr, const bf16_t* __restrict__ Kh, const bf16_t* __restrict__ Vh,
                                          const bf16_t* __restrict__ Krh, bf16_t* Ob, int seq, LAS char* lds, int tid) {
  constexpr int LDQ = 1024, LDQR = 512, LDK = 2048, LDKR = 64, LDO = 1024;
  const int wid = tid >> 6, lane = tid & 63, r32 = lane & 31, hi = lane >> 5;
  LAS char* V_lds = lds + L_V; LAS char* K_lds = lds + L_K; LAS char* KR_lds = lds + L_KR;
  LAS float* wsf = (LAS float*)(lds + L_WS) + wid * 64; LAS float* li_l = wsf; LAS float* al_l = wsf + 32;
  float m_reg = -1e30f, l_reg = 0; f32x16 o[4] = {}; bf16x8 qr[8];
  LAS char* qrl = lds + L_QR + wid * 4096 + lane * 16;
  { const unsigned qo = (unsigned)((wid * QBLK + r32) * LDQ + hi * 8);
#pragma unroll
    for (int d0 = 0; d0 < 8; ++d0) qr[d0] = *reinterpret_cast<const bf16x8*>(Qn + (qo + d0 * 16));
    const unsigned qo2 = (unsigned)((wid * QBLK + r32) * LDQR + hi * 8);
#pragma unroll
    for (int d0 = 0; d0 < 4; ++d0) *reinterpret_cast<LAS bf16x8*>(qrl + d0 * 1024) = *reinterpret_cast<const bf16x8*>(Qr + (qo2 + d0 * 16)); }
  const int sr = tid >> 4, sc = (tid & 15) * 8, vst0 = v_st(sr, sc), vst1 = v_st(32 + sr, sc);
  const int rr_ = tid >> 3, rc_ = (tid & 7) * 8, krst = KRSWZ(rr_, rc_ * 2);
  const int vb0 = (int)(unsigned)(uintptr_t)V_lds + v_rd_base(lane);
  constexpr int SDEPTH = 1;
  struct { bf16x8 vs0, vs1, ks0, ks1, kr; } sr_[SDEPTH];
  const unsigned kvo = (unsigned)(sr * LDK + sc), kro = (unsigned)(rr_ * LDKR + rc_);
#define SLOAD(i, k0) do { const bf16_t* vp_ = Vh + (size_t)(k0) * LDK; const bf16_t* kp_ = Kh + (size_t)(k0) * LDK; const bf16_t* rp_ = Krh + (size_t)(k0) * LDKR; \
    sr_[i].vs0 = *reinterpret_cast<const bf16x8*>(vp_ + kvo); sr_[i].vs1 = *reinterpret_cast<const bf16x8*>(vp_ + (kvo + 32u * LDK)); \
    sr_[i].ks0 = *reinterpret_cast<const bf16x8*>(kp_ + kvo); sr_[i].ks1 = *reinterpret_cast<const bf16x8*>(kp_ + (kvo + 32u * LDK)); \
    sr_[i].kr = *reinterpret_cast<const bf16x8*>(rp_ + kro); } while (0)
#define SWRITE(b, i) do { *(LAS bf16x8*)(V_lds + (b) * SHM_V + vst0) = sr_[i].vs0; *(LAS bf16x8*)(V_lds + (b) * SHM_V + vst1) = sr_[i].vs1; const int kc = sc * 2; \
    *(LAS bf16x8*)(K_lds + (b) * SHM_K + KSWZ(sr, kc)) = sr_[i].ks0; *(LAS bf16x8*)(K_lds + (b) * SHM_K + KSWZ(32 + sr, kc)) = sr_[i].ks1; \
    *(LAS bf16x8*)(KR_lds + (b) * SHM_KR + krst) = sr_[i].kr; } while (0)
#define SWAIT() do { if constexpr (SDEPTH == 2) asm volatile("s_waitcnt vmcnt(5)" ::: "memory"); else asm volatile("s_waitcnt vmcnt(0)" ::: "memory"); } while (0)
#define RESC(a) do { if (__any((a) < 1.f)) { if (hi == 0) al_l[r32] = (a); asm volatile("s_waitcnt lgkmcnt(0)" ::: "memory"); \
    _Pragma("unroll") for (int d = 0; d < 4; ++d) _Pragma("unroll") for (int r = 0; r < 16; ++r) o[d][r] *= al_l[crow(r, hi)]; } } while (0)
  f32x16 pA0, pA1, pB0, pB1; float mnA, mnB, alA, alB; bf16x8 pa0, pa1, pa2, pa3; const int NTL = seq / KVBLK;
  constexpr int SE = 0, SO = SDEPTH - 1;
  SLOAD(SE, 0); asm volatile("s_waitcnt vmcnt(0)" ::: "memory"); SWRITE(0, SE); __syncthreads();
  qkt(pA0, pA1, K_lds, KR_lds, qr, qrl, r32, hi); partialSM(pA0, pA1, m_reg, mnA, alA);
  SLOAD(SO, KVBLK); if constexpr (SDEPTH == 2) { if (2 < NTL) SLOAD(SE, 2 * KVBLK); }
  SWAIT(); SWRITE(1, SO); __syncthreads();
  for (int j = 1; j + 1 < NTL; j += 2) {
    SBAR(); qkt(pB0, pB1, K_lds + SHM_K, KR_lds + SHM_KR, qr, qrl, r32, hi);
    finishSM(pA0, pA1, alA, l_reg, pa0, pa1, pa2, pa3); SBAR();
    SLOAD(SO, (j + SDEPTH) * KVBLK); SBAR();
    pv_d0(o, vb0, pa0, pa1, pa2, pa3); partialSM(pB0, pB1, m_reg, mnB, alB);
    __syncthreads(); SWAIT(); SWRITE(0, SE);
    RESC(alB); __syncthreads();
    SBAR(); qkt(pA0, pA1, K_lds, KR_lds, qr, qrl, r32, hi);
    finishSM(pB0, pB1, alB, l_reg, pa0, pa1, pa2, pa3); SBAR();
    if (SDEPTH == 1 || j + 3 < NTL) SLOAD(SE, (j + 1 + SDEPTH) * KVBLK); SBAR();
    pv_d0(o, vb0 + SHM_V, pa0, pa1, pa2, pa3); partialSM(pA0, pA1, m_reg, mnA, alA);
    __syncthreads(); SWAIT(); SWRITE(1, SO);
    RESC(alA); __syncthreads();
  }
  SBAR(); qkt(pB0, pB1, K_lds + SHM_K, KR_lds + SHM_KR, qr, qrl, r32, hi);
  finishSM(pA0, pA1, alA, l_reg, pa0, pa1, pa2, pa3); SBAR();
  pv_d0(o, vb0, pa0, pa1, pa2, pa3); partialSM(pB0, pB1, m_reg, mnB, alB);
  __syncthreads(); RESC(alB);
  finishSM(pB0, pB1, alB, l_reg, pa0, pa1, pa2, pa3); SBAR();
  pv_d0(o, vb0 + SHM_V, pa0, pa1, pa2, pa3);
  if (hi == 0) li_l[r32] = l_reg; asm volatile("s_waitcnt lgkmcnt(0)" ::: "memory");
  float rli[16];
#pragma unroll
  for (int r = 0; r < 16; ++r) rli[r] = __builtin_amdgcn_rcpf(li_l[crow(r, hi)]);
#pragma unroll
  for (int r = 0; r < 16; ++r) { const unsigned oo = (unsigned)((wid * QBLK + crow(r, hi)) * LDO + r32);
#pragma unroll
    for (int d0 = 0; d0 < 4; ++d0) Ob[oo + d0 * 32] = (bf16_t)f2bf(o[d0][r] * rli[r]); }
  __syncthreads();
#undef SLOAD
#undef SWRITE
#undef SWAIT
#undef RESC
}
}

namespace ssd {
typedef short v4i16_t __attribute__((ext_vector_type(4)));
constexpr int RSB = 144;
constexpr int TB = 128 * RSB;
constexpr int L_X = 0, L_B = TB, L_C = 2 * TB, L_HF = 3 * TB, L_HB = 3 * TB + 64 * RSB, L_ARR = 3 * TB + 128 * RSB, L_SC = L_ARR + 2048, L_END = L_SC + 64;
struct UnitInfo { int b, c, h, nc, row0; bool smp; };
__device__ __forceinline__ UnitInfo decode(int u) { UnitInfo I; if (u < 512) { I.smp = true; I.b = u >> 8; I.c = (u >> 4) & 15; I.h = u & 15; I.nc = 16; I.row0 = RP + I.b * SEQS + I.c * 128; }
    else { const int q = u - 512; I.smp = false; I.b = q >> 5; I.c = (q >> 4) & 1; I.h = q & 15; I.nc = 2; I.row0 = I.b * SEQP + I.c * 128; } return I; }
__device__ __forceinline__ int unit_id(bool smp, int b, int c, int h) { return smp ? ((b * 16 + c) * 16 + h) : 512 + ((b * 2 + c) * 16 + h); }
__device__ __forceinline__ bf16x8 tr2(const LAS char* p0, const LAS char* p1) {
    const v4i16_t a = __builtin_amdgcn_ds_read_tr16_b64_v4i16((LAS v4i16_t*)p0), b = __builtin_amdgcn_ds_read_tr16_b64_v4i16((LAS v4i16_t*)p1);
    return (bf16x8){a[0], a[1], a[2], a[3], b[0], b[1], b[2], b[3]};
}
__device__ __forceinline__ float wave_incl_scan(float v, int lane) {
#pragma unroll
    for (int o = 1; o < 64; o <<= 1) { const float t = __shfl_up(v, o); if (lane >= o) v += t; }
    return v;
}
__device__ __forceinline__ void chunk_scalars(const float* dt, int row0, int h, float Af, float Ab, LAS f32x4* arr, LAS float* sc, int lane) {
    const float df0 = dt[(size_t)(row0 + lane) * 32 + h], df1 = dt[(size_t)(row0 + 64 + lane) * 32 + h];
    const float db0 = dt[(size_t)(row0 + lane) * 32 + 16 + h], db1 = dt[(size_t)(row0 + 64 + lane) * 32 + 16 + h];
    const float af0 = df0 * Af, af1 = df1 * Af, ab0 = db0 * Ab, ab1 = db1 * Ab;
    const float s0 = wave_incl_scan(af0, lane), t0 = __shfl(s0, 63), s1 = wave_incl_scan(af1, lane) + t0;
    const float r0 = wave_incl_scan(ab0, lane), u0 = __shfl(r0, 63), r1 = wave_incl_scan(ab1, lane) + u0, tot = __shfl(r1, 63);
    arr[lane] = (f32x4){s0, tot - (r0 - ab0), df0, db0};
    arr[64 + lane] = (f32x4){s1, tot - (r1 - ab1), df1, db1};
    if (lane == 63) { sc[0] = s1; sc[1] = tot; }
}
constexpr int G_B = 0, G_C = TB, G_X = 2 * TB, G_ARR = 6 * TB, G_SC = G_ARR + 4 * 2048, G_END = G_SC + 64;
struct GInfo { int b, c, g, nc, row0; bool smp; };
__device__ __forceinline__ GInfo gdecode(int gu) { GInfo I; if (gu < 128) { I.smp = true; I.b = gu >> 6; I.c = (gu >> 2) & 15; I.g = gu & 3; I.nc = 16; I.row0 = RP + I.b * SEQS + I.c * 128; }
    else { const int q = gu - 128; I.smp = false; I.b = q >> 3; I.c = (q >> 2) & 1; I.g = q & 3; I.nc = 2; I.row0 = I.b * SEQP + I.c * 128; } return I; }
template <bool WITH_C>
__device__ __forceinline__ void stage_group(const Params& P, const GInfo& I, LAS char* lds, int tid) {
    const bf16_t* xbc = (const bf16_t*)(P.ws + WS_XBC); const int lane = tid & 63, wave = tid >> 6;
    if (wave >= 6) {
        const float* dt = (const float*)(P.ws + WS_DT);
#pragma unroll 1
        for (int q = 0; q < 2; ++q) { const int hl = 2 * (wave - 6) + q, h = 4 * I.g + hl;
            chunk_scalars(dt, I.row0, h, -__expf(P.in[I_ALOG][h]), -__expf(P.in[I_ALOG][16 + h]), (LAS f32x4*)(lds + G_ARR + hl * 2048), (LAS float*)(lds + G_SC + hl * 16), lane); }
        return;
    }
    if (!WITH_C && wave == 5) return;
    const int p8 = lane & 7, rs = lane >> 3;
    const int cbase = (wave == 0 ? 1024 + I.g * 64 : wave == 5 ? 1280 + I.g * 64 : (4 * I.g + wave - 1) * 64) + p8 * 8;
    const int lbase = (wave == 0 ? G_B : wave == 5 ? G_C : G_X + (wave - 1) * TB) + p8 * 16;
    const float* cw = P.in[I_CONVW]; const float* cb = P.in[I_CONVB];
    float w[3][8], bb[8];
#pragma unroll
    for (int q = 0; q < 2; ++q) { const f32x4 b4 = *(const f32x4*)(cb + cbase + 4 * q);
#pragma unroll
        for (int e = 0; e < 4; ++e) bb[4 * q + e] = b4[e];
#pragma unroll
        for (int k = 0; k < 3; ++k) { const f32x4 a = *(const f32x4*)(cw + k * 1536 + cbase + 4 * q);
#pragma unroll
            for (int e = 0; e < 4; ++e) w[k][4 * q + e] = a[e]; } }
    const int r0 = rs * 16; const bf16_t* xr = xbc + (size_t)(I.row0 + r0) * 1536 + cbase;
    const bool first = (I.c == 0 && rs == 0), last = (I.c == I.nc - 1 && rs == 7);
    const u32x4 zero = {0u, 0u, 0u, 0u};
    u32x4 rows[18];
    rows[0] = first ? zero : *(const u32x4*)(xr - 1536);
#pragma unroll
    for (int i = 0; i < 16; ++i) rows[1 + i] = *(const u32x4*)(xr + (size_t)i * 1536);
    rows[17] = last ? zero : *(const u32x4*)(xr + (size_t)16 * 1536);
#pragma unroll
    for (int i = 0; i < 16; ++i) {
        float a[8], x[8];
        unpack8(rows[i], x);
#pragma unroll
        for (int e = 0; e < 8; ++e) a[e] = bb[e] + x[e] * w[0][e];
        unpack8(rows[i + 1], x);
#pragma unroll
        for (int e = 0; e < 8; ++e) a[e] += x[e] * w[1][e];
        unpack8(rows[i + 2], x);
#pragma unroll
        for (int e = 0; e < 8; ++e) a[e] += x[e] * w[2][e];
        u32x4 o;
#pragma unroll
        for (int e = 0; e < 4; ++e) o[e] = pk2(siluf(a[2 * e]), siluf(a[2 * e + 1]));
        *(LAS u32x4*)(lds + lbase + (r0 + i) * RSB) = o;
    }
}
__device__ __forceinline__ void pass_a_group(const Params& P, int gu, LAS char* lds, int tid) {
    unsigned char* ws = P.ws;
    const int lane = tid & 63, wave = tid >> 6; const GInfo I = gdecode(gu);
    stage_group<false>(P, I, lds, tid);
    __syncthreads();
    { const int hl = wave >> 1, d = wave & 1, h = 4 * I.g + hl, gq = lane >> 4, q4 = (lane >> 2) & 3, p4 = lane & 3, li = lane & 15;
      const LAS f32x4* arr = (const LAS f32x4*)(lds + G_ARR + hl * 2048); const float tot = ((const LAS float*)(lds + G_SC + hl * 16))[d];
      const LAS char* xb = lds + G_X + hl * TB + (8 * gq + q4) * RSB + (4 * p4) * 2;
      const LAS char* bb = lds + G_B + (8 * gq + q4) * RSB + (4 * p4) * 2;
      f32x4 acc[4][4] = {};
#pragma unroll
      for (int s4 = 0; s4 < 4; ++s4) {
          float wj[8];
#pragma unroll
          for (int jj = 0; jj < 8; ++jj) { const f32x4 a = arr[32 * s4 + 8 * gq + jj]; wj[jj] = d ? a.w * __expf(tot - a.y) : a.z * __expf(tot - a.x); }
          bf16x8 bfr[4];
#pragma unroll
          for (int nt = 0; nt < 4; ++nt) bfr[nt] = tr2(bb + s4 * 32 * RSB + nt * 32, bb + s4 * 32 * RSB + 4 * RSB + nt * 32);
#pragma unroll
          for (int pt = 0; pt < 4; ++pt) { const bf16x8 xr_ = tr2(xb + s4 * 32 * RSB + pt * 32, xb + s4 * 32 * RSB + 4 * RSB + pt * 32);
              const u32x4 xw = *reinterpret_cast<const u32x4*>(&xr_); u32x4 sw;
#pragma unroll
              for (int e = 0; e < 4; ++e) sw[e] = pk2(bflo(xw[e]) * wj[2 * e], bfhi(xw[e]) * wj[2 * e + 1]);
              const bf16x8 xf = *reinterpret_cast<const bf16x8*>(&sw);
#pragma unroll
              for (int nt = 0; nt < 4; ++nt) acc[pt][nt] = __builtin_amdgcn_mfma_f32_16x16x32_bf16(bfr[nt], xf, acc[pt][nt], 0, 0, 0); } }
      const int u = unit_id(I.smp, I.b, I.c, h);
      bf16_t* So = (bf16_t*)(ws + WS_ST) + ((size_t)u * 2 + d) * 4096;
#pragma unroll
      for (int pt = 0; pt < 4; ++pt)
#pragma unroll
          for (int nt = 0; nt < 4; ++nt) st_bf4(So + (16 * pt + li) * 64 + nt * 16 + 4 * gq, acc[pt][nt]);
      if (lane == 0) ((float*)(ws + WS_DEC))[(size_t)u * 2 + d] = __expf(tot);
    }
    __syncthreads();
}
__device__ __forceinline__ bf16x8 ld_h_frag(const bf16_t* H, int p, int n) { return *(const bf16x8*)(H + p * 64 + n); }
__device__ __forceinline__ void pass_b_group(const Params& P, int gu, LAS char* lds, int tid) {
    unsigned char* ws = P.ws;
    const bf16_t* ST = (const bf16_t*)(ws + WS_ST);
    const int lane = tid & 63, wave = tid >> 6; const GInfo I = gdecode(gu);
    stage_group<true>(P, I, lds, tid);
    const int hl = wave >> 1, half = wave & 1, h = 4 * I.g + hl, li = lane & 15, gq = lane >> 4, q4 = (lane >> 2) & 3, p4 = lane & 3;
    const bf16_t *Hf, *Hb;
    if (I.smp) { const int u = unit_id(true, I.b, I.c, h); Hf = ST + ((size_t)u * 2) * 4096; Hb = ST + ((size_t)u * 2 + 1) * 4096; }
    else { const bf16_t* zp = (const bf16_t*)(ws + WS_ZERO); Hf = I.c == 1 ? ST + ((size_t)unit_id(false, I.b, 0, h) * 2) * 4096 : zp; Hb = I.c == 0 ? ST + ((size_t)unit_id(false, I.b, 1, h) * 2 + 1) * 4096 : zp; }
    __syncthreads();
    const LAS f32x4* arr = (const LAS f32x4*)(lds + G_ARR + hl * 2048); const LAS char* Xl = lds + G_X + hl * TB;
    const float Dh = P.in[I_SSDD][h];
#pragma unroll 1
    for (int st = 0; st < 4; st += 2) {
        int ii[2], tdiag[2]; bf16x8 cf[2][2]; f32x4 ai[2]; bf16_t* zrow[2]; u32x2 zw[2][4]; bf16x8 pf[2][4];
#pragma unroll
        for (int u = 0; u < 2; ++u) { ii[u] = 64 * half + 16 * (st + u) + li; tdiag[u] = __builtin_amdgcn_readfirstlane(4 * half + st + u);
#pragma unroll
            for (int ks = 0; ks < 2; ++ks) cf[u][ks] = *(const LAS bf16x8*)(lds + G_C + ii[u] * RSB + (8 * gq + 32 * ks) * 2);
            ai[u] = arr[ii[u]];
            zrow[u] = (bf16_t*)(ws + WS_Z) + (size_t)(I.row0 + ii[u]) * 1024 + h * 64;
#pragma unroll
            for (int pt = 0; pt < 4; ++pt) zw[u][pt] = *(const u32x2*)(zrow[u] + 16 * pt + 4 * gq); }
#pragma unroll
        for (int s4 = 0; s4 < 4; ++s4) {
            unsigned pk[2][4];
#pragma unroll
            for (int hf2 = 0; hf2 < 2; ++hf2) { const int t = 2 * s4 + hf2, jb = 16 * t + 4 * gq;
                f32x4 sacc[2] = {{0.f, 0.f, 0.f, 0.f}, {0.f, 0.f, 0.f, 0.f}};
#pragma unroll
                for (int ks = 0; ks < 2; ++ks) { const bf16x8 bfr = *(const LAS bf16x8*)(lds + G_B + (16 * t + li) * RSB + (8 * gq + 32 * ks) * 2);
                    sacc[0] = __builtin_amdgcn_mfma_f32_16x16x32_bf16(bfr, cf[0][ks], sacc[0], 0, 0, 0);
                    sacc[1] = __builtin_amdgcn_mfma_f32_16x16x32_bf16(bfr, cf[1][ks], sacc[1], 0, 0, 0); }
                f32x4 aj[4];
#pragma unroll
                for (int r = 0; r < 4; ++r) aj[r] = arr[jb + r];
#pragma unroll
                for (int u = 0; u < 2; ++u) {
                    float m[4];
                    if (t < tdiag[u]) {
#pragma unroll
                        for (int r = 0; r < 4; ++r) m[r] = sacc[u][r] * (__expf(ai[u].x - aj[r].x) * aj[r].z);
                    } else if (t > tdiag[u]) {
#pragma unroll
                        for (int r = 0; r < 4; ++r) m[r] = sacc[u][r] * (__expf(ai[u].y - aj[r].y) * aj[r].w);
                    } else {
#pragma unroll
                        for (int r = 0; r < 4; ++r) { const int j = jb + r;
                            const bool lower = j < ii[u]; const float arg = lower ? ai[u].x - aj[r].x : ai[u].y - aj[r].y; const float w = lower ? aj[r].z : aj[r].w;
                            float mm = __expf(arg) * w; if (j == ii[u]) mm = ai[u].z + ai[u].w; m[r] = sacc[u][r] * mm; }
                    }
                    pk[u][hf2 * 2 + 0] = pk2(m[0], m[1]); pk[u][hf2 * 2 + 1] = pk2(m[2], m[3]); } }
#pragma unroll
            for (int u = 0; u < 2; ++u) { const u32x4 w4 = {pk[u][0], pk[u][1], pk[u][2], pk[u][3]}; pf[u][s4] = *reinterpret_cast<const bf16x8*>(&w4); }
            __builtin_amdgcn_sched_barrier(0);
        }
        float ef[2], eb[2], ssq[2] = {0.f, 0.f};
#pragma unroll
        for (int u = 0; u < 2; ++u) { ef[u] = __expf(ai[u].x); eb[u] = __expf(ai[u].y); }
        bf16x8 hfc[2], hbc[2], hfn[2], hbn[2];
#pragma unroll
        for (int ks = 0; ks < 2; ++ks) { hfc[ks] = ld_h_frag(Hf, li, 8 * gq + 32 * ks); hbc[ks] = ld_h_frag(Hb, li, 8 * gq + 32 * ks); }
#pragma unroll
        for (int pt = 0; pt < 4; ++pt) {
            if (pt < 3) {
#pragma unroll
                for (int ks = 0; ks < 2; ++ks) { hfn[ks] = ld_h_frag(Hf, 16 * (pt + 1) + li, 8 * gq + 32 * ks); hbn[ks] = ld_h_frag(Hb, 16 * (pt + 1) + li, 8 * gq + 32 * ks); } }
            f32x4 yd[2] = {{0.f, 0.f, 0.f, 0.f}, {0.f, 0.f, 0.f, 0.f}}, yf[2] = {{0.f, 0.f, 0.f, 0.f}, {0.f, 0.f, 0.f, 0.f}}, yb[2] = {{0.f, 0.f, 0.f, 0.f}, {0.f, 0.f, 0.f, 0.f}};
#pragma unroll
            for (int s4 = 0; s4 < 4; ++s4) { const LAS char* xb = Xl + (32 * s4 + 4 * gq + q4) * RSB + (16 * pt + 4 * p4) * 2; const bf16x8 xf = tr2(xb, xb + 16 * RSB);
                yd[0] = __builtin_amdgcn_mfma_f32_16x16x32_bf16(xf, pf[0][s4], yd[0], 0, 0, 0);
                yd[1] = __builtin_amdgcn_mfma_f32_16x16x32_bf16(xf, pf[1][s4], yd[1], 0, 0, 0); }
#pragma unroll
            for (int ks = 0; ks < 2; ++ks)
#pragma unroll
                for (int u = 0; u < 2; ++u) { yf[u] = __builtin_amdgcn_mfma_f32_16x16x32_bf16(hfc[ks], cf[u][ks], yf[u], 0, 0, 0);
                    yb[u] = __builtin_amdgcn_mfma_f32_16x16x32_bf16(hbc[ks], cf[u][ks], yb[u], 0, 0, 0); }
            const int pc = 16 * pt + 4 * gq;
#pragma unroll
            for (int u = 0; u < 2; ++u) {
                const u32x2 xw = *(const LAS u32x2*)(Xl + ii[u] * RSB + pc * 2);
                const f32x4 xx = {bflo(xw.x), bfhi(xw.x), bflo(xw.y), bfhi(xw.y)};
                const f32x4 zz = {bflo(zw[u][pt].x), bfhi(zw[u][pt].x), bflo(zw[u][pt].y), bfhi(zw[u][pt].y)};
                f32x4 y = yd[u] + yf[u] * ef[u] + yb[u] * eb[u] + xx * Dh;
                y = y * (f32x4){siluf(zz.x), siluf(zz.y), siluf(zz.z), siluf(zz.w)};
                ssq[u] += (y.x * y.x + y.y * y.y) + (y.z * y.z + y.w * y.w);
                st_bf4(zrow[u] + pc, y); }
#pragma unroll
            for (int ks = 0; ks < 2; ++ks) { hfc[ks] = hfn[ks]; hbc[ks] = hbn[ks]; }
            __builtin_amdgcn_sched_barrier(0);
        }
#pragma unroll
        for (int u = 0; u < 2; ++u) { float sq = ssq[u]; sq += __shfl_xor(sq, 16); sq += __shfl_xor(sq, 32);
            if (gq == 0) ((float*)(ws + WS_SSQ_Y))[(size_t)(I.row0 + ii[u]) * 16 + h] = sq; }
    }
    __syncthreads();
}
}

__device__ __forceinline__ void cg_rowblock(const bf16_t* u, bf16_t* ug, const CgW& W, int rb, int c) {
    const int r0 = rb * CG_RB; const int t0 = r0 < RP ? (r0 & 255) : ((r0 - RP) & 2047), L = r0 < RP ? SEQP : SEQS;
    const u32x4 zero = {0u, 0u, 0u, 0u};
    u32x4 gp = zero, vp = zero, gc, vc, gn, vn;
    if (t0 > 0) { gp = *(const u32x4*)(u + (size_t)(r0 - 1) * UPN + c); vp = *(const u32x4*)(u + (size_t)(r0 - 1) * UPN + DFF + c); }
    gc = *(const u32x4*)(u + (size_t)r0 * UPN + c); vc = *(const u32x4*)(u + (size_t)r0 * UPN + DFF + c);
#pragma unroll 16
    for (int i = 0; i < CG_RB; ++i) {
        const int row = r0 + i;
        if (t0 + i + 1 < L) { gn = *(const u32x4*)(u + (size_t)(row + 1) * UPN + c); vn = *(const u32x4*)(u + (size_t)(row + 1) * UPN + DFF + c); } else { gn = zero; vn = zero; }
        float a[8], b[8], x[8];
#pragma unroll
        for (int e = 0; e < 8; ++e) { a[e] = W.bg[e]; b[e] = W.bv[e]; }
        unpack8(gp, x);
#pragma unroll
        for (int e = 0; e < 8; ++e) a[e] += x[e] * W.wg[0][e];
        unpack8(gc, x);
#pragma unroll
        for (int e = 0; e < 8; ++e) a[e] += x[e] * W.wg[1][e];
        unpack8(gn, x);
#pragma unroll
        for (int e = 0; e < 8; ++e) a[e] += x[e] * W.wg[2][e];
        unpack8(vp, x);
#pragma unroll
        for (int e = 0; e < 8; ++e) b[e] += x[e] * W.wv[0][e];
        unpack8(vc, x);
#pragma unroll
        for (int e = 0; e < 8; ++e) b[e] += x[e] * W.wv[1][e];
        unpack8(vn, x);
#pragma unroll
        for (int e = 0; e < 8; ++e) b[e] += x[e] * W.wv[2][e];
        u32x4 o;
#pragma unroll
        for (int e = 0; e < 4; ++e) o[e] = pk2(siluf(a[2 * e]) * b[2 * e], siluf(a[2 * e + 1]) * b[2 * e + 1]);
        *(u32x4*)(ug + (size_t)row * DFF + c) = o;
        gp = gc; vp = vc; gc = gn; vc = vn;
    }
}
__device__ __forceinline__ void cnt_arrive(unsigned* cnt) {
    asm volatile("s_waitcnt vmcnt(0)" ::: "memory");
    __syncthreads();
    if (threadIdx.x == 0) { __builtin_amdgcn_fence(__ATOMIC_RELEASE, "agent"); asm volatile("s_waitcnt vmcnt(0)" ::: "memory");
        __hip_atomic_fetch_add(cnt, 1u, __ATOMIC_RELAXED, __HIP_MEMORY_SCOPE_AGENT); }
}
__device__ __forceinline__ void cnt_wait(unsigned* cnt, unsigned target) {
    if (threadIdx.x == 0) { unsigned sp = 0;
        while (__hip_atomic_load(cnt, __ATOMIC_RELAXED, __HIP_MEMORY_SCOPE_AGENT) < target) { __builtin_amdgcn_s_sleep(4); if (++sp > (1u << 22)) break; }
        __builtin_amdgcn_fence(__ATOMIC_ACQUIRE, "agent"); asm volatile("s_waitcnt vmcnt(0)" ::: "memory"); }
    __syncthreads();
}
constexpr int CG_ROWS1 = 46 * 256, CG_SPLIT = CG_ROWS1 / CG_RB - 1, CG_ITEMS = R / CG_RB;
__device__ __forceinline__ void phase_convgate_queue(const Params& P, LAS unsigned char* lds, unsigned* c1, unsigned* c2, unsigned* q) {
    PHASE_IDS unsigned char* ws = P.ws; const bf16_t* u = (const bf16_t*)(ws + WS_U); bf16_t* ug = (bf16_t*)(ws + WS_UG);
    volatile LAS int* slot = (volatile LAS int*)(lds + 1024);
    const int c = tid * 8; const bool act = tid < DFF / 8;
    CgW W; if (act) cg_load_w(W, P.in[I_FCW], P.in[I_FCB], c);
    bool w1 = false, w2 = false;
    for (;;) {
        if (tid == 0) *slot = (int)__hip_atomic_fetch_add(q, 1u, __ATOMIC_RELAXED, __HIP_MEMORY_SCOPE_AGENT);
        __syncthreads();
        const int rb = *slot;
        __syncthreads();
        if (rb >= CG_ITEMS) break;
        if (!w1) { cnt_wait(c1, (unsigned)G); w1 = true; }
        if (rb >= CG_SPLIT && !w2) { cnt_wait(c2, (unsigned)G); w2 = true; }
        if (act) cg_rowblock(u, ug, W, rb, c);
    }
}
__device__ __forceinline__ void phase_final(const Params& P) {
    PHASE_IDS const int gw = blockIdx.x * 8 + wave, NGW = G * 8; const float* gf = P.in[I_GFIN];
    for (int row = gw; row < R; row += NGW) {
        f32x4* xr = (f32x4*)(P.out + (size_t)row * DM) + lane; f32x4 v[4]; float s = 0.f;
#pragma unroll
        for (int j = 0; j < 4; ++j) { v[j] = xr[64 * j]; s += (v[j].x * v[j].x + v[j].y * v[j].y) + (v[j].z * v[j].z + v[j].w * v[j].w); }
        const float rs = rsqrtf(wave_sum(s) * (1.f / DM) + EPS);
#pragma unroll
        for (int j = 0; j < 4; ++j) xr[64 * j] = v[j] * rs * *(const f32x4*)(gf + 4 * lane + 256 * j);
    }
}

constexpr int G_SLOT_OFF = 126 * 1024;
__device__ __forceinline__ void phase_ssd_a(const Params& P, LAS unsigned char* lds) {
    PHASE_IDS
    norm_new_ckv(P, lane, wave, G);
    unsigned* qa = (unsigned*)(P.ws + WS_CTL) + 8192 + 256; volatile LAS int* slot = (volatile LAS int*)(lds + G_SLOT_OFF);
    for (;;) {
        if (tid == 0) *slot = (int)__hip_atomic_fetch_add(qa, 1u, __ATOMIC_RELAXED, __HIP_MEMORY_SCOPE_AGENT);
        __syncthreads();
        const int gu = *slot;
        __syncthreads();
        if (gu >= 384) break;
        int t2 = tid; asm volatile("" : "+v"(t2)); ssd::pass_a_group(P, gu, (LAS char*)lds, t2);
    }
}
__device__ __forceinline__ void phase_ssd_scan(const Params& P) {
    PHASE_IDS unsigned char* ws = P.ws; bf16_t* ST = (bf16_t*)(ws + WS_ST); const float* DEC = (const float*)(ws + WS_DEC);
    const int gt = blockIdx.x * NT + tid, GT = G * NT;
    for (int it = gt; it < 64 * 512; it += GT) {
        const int chain = it >> 9, e = (it & 511) * 8, b = chain >> 5, h = (chain >> 1) & 15, d = chain & 1;
        float H[8];
        { const float* h0 = P.in[I_SSD] + (((size_t)b * 2 + d) * 16 + h) * 4096 + e; const f32x4 a = *(const f32x4*)h0, c4 = *(const f32x4*)(h0 + 4);
#pragma unroll
          for (int q = 0; q < 4; ++q) { H[q] = a[q]; H[4 + q] = c4[q]; } }
        u32x4 S[16]; float dc[16];
#pragma unroll
        for (int c = 0; c < 16; ++c) { const int u = ssd::unit_id(true, b, c, h); S[c] = *(const u32x4*)(ST + ((size_t)u * 2 + d) * 4096 + e); dc[c] = DEC[(size_t)u * 2 + d]; }
#define SCAN_STEP(c) { const int u = ssd::unit_id(true, b, (c), h); \
            *(u32x4*)(ST + ((size_t)u * 2 + d) * 4096 + e) = (u32x4){pk2(H[0], H[1]), pk2(H[2], H[3]), pk2(H[4], H[5]), pk2(H[6], H[7])}; \
            float sv[8]; unpack8(S[(c)], sv); _Pragma("unroll") for (int q = 0; q < 8; ++q) H[q] = H[q] * dc[(c)] + sv[q]; }
        if (d == 0) {
#pragma unroll
            for (int c = 0; c < 16; ++c) SCAN_STEP(c)
        } else {
#pragma unroll
            for (int c = 15; c >= 0; --c) SCAN_STEP(c)
        }
#undef SCAN_STEP
    }
    for (int it = gt; it < 1024 * 512; it += GT) {
        const int bhd = it >> 9, e = (it & 511) * 8, b = bhd >> 5, d = (bhd >> 4) & 1, h = bhd & 15;
        const int ufirst = ssd::unit_id(false, b, d ? 1 : 0, h), ulast = ssd::unit_id(false, b, d ? 0 : 1, h);
        float f[8], l[8]; unpack8(*(const u32x4*)(ST + ((size_t)ufirst * 2 + d) * 4096 + e), f); unpack8(*(const u32x4*)(ST + ((size_t)ulast * 2 + d) * 4096 + e), l);
        const float dl = DEC[(size_t)ulast * 2 + d]; float* o = P.out + O_SSD + (((size_t)b * 2 + d) * 16 + h) * 4096 + e;
        *(f32x4*)o = (f32x4){f[0] * dl + l[0], f[1] * dl + l[1], f[2] * dl + l[2], f[3] * dl + l[3]};
        *(f32x4*)(o + 4) = (f32x4){f[4] * dl + l[4], f[5] * dl + l[5], f[6] * dl + l[6], f[7] * dl + l[7]};
    }
}
template <int PART>
__device__ __forceinline__ void phase_mix(const Params& P, LAS unsigned char* lds) {
    PHASE_IDS unsigned char* ws = P.ws; bf16_t* qn = (bf16_t*)(ws + WS_QN); const bf16_t* qr = (const bf16_t*)(ws + WS_QR);
    const bf16_t* kv = (const bf16_t*)(ws + WS_KV); const bf16_t* kr = (const bf16_t*)(ws + WS_KROPE);
    const int nbA = G / 2, bx = blockIdx.x;
    if (bx < nbA) {
        if (PART != 2) for (int u = bx; u < 128; u += nbA) {
            const int x = u & 7, k = u >> 3, bh = x + 8 * (k >> 3), qb = k & 7, b = bh >> 3, h = bh & 7, row0 = RP + b * SEQS + qb * 256, kv0 = RP + b * KVS;
            int t2 = tid; asm volatile("" : "+v"(t2));
            att::attn_unit(qn + (size_t)row0 * 1024 + h * 128, qr + (size_t)row0 * 512 + h * 64, kv + (size_t)kv0 * 2048 + h * 256, kv + (size_t)kv0 * 2048 + h * 256 + 128,
                           kr + (size_t)kv0 * 64, qn + (size_t)row0 * 1024 + h * 128, KVS, (LAS char*)lds, t2);
        }
    } else {
        const int k0 = bx - nbA, nb2 = G - nbA;
        if (PART != 2) for (int q = k0; q < 256; q += nb2) {
            const int b = q >> 3, h = q & 7, row0 = b * SEQP;
            int t2 = tid; asm volatile("" : "+v"(t2));
            att::attn_unit(qn + (size_t)row0 * 1024 + h * 128, qr + (size_t)row0 * 512 + h * 64, kv + (size_t)row0 * 2048 + h * 256, kv + (size_t)row0 * 2048 + h * 256 + 128,
                           kr + (size_t)row0 * 64, qn + (size_t)row0 * 1024 + h * 128, SEQP, (LAS char*)lds, t2);
        }
        if (PART != 1) for (int gu = k0; gu < 384; gu += nb2) { int t2 = tid; asm volatile("" : "+v"(t2)); ssd::pass_b_group(P, gu, (LAS char*)lds, t2); }
    }
}
#define XB_TMO      128
#define XB_XCNT(j)  (256  + 64 * (j))
#define XB_XSUB(j)  (1280 + 64 * (j))
#define XB_XGEN(j)  (2304 + 64 * (j))
#define XB_TOP      3328
#define XB_TOPGEN   3392
#define XCD_BAR_WORDS 3456
#define XB_SPIN_CAP (1u << 18)

__device__ __forceinline__ unsigned xb_ld(unsigned* p)              { return __hip_atomic_load(p, __ATOMIC_RELAXED, __HIP_MEMORY_SCOPE_AGENT); }
__device__ __forceinline__ unsigned xb_add(unsigned* p, unsigned v) { return __hip_atomic_fetch_add(p, v, __ATOMIC_RELAXED, __HIP_MEMORY_SCOPE_AGENT); }
__device__ __forceinline__ unsigned xb_xcc_id() { return (unsigned)__builtin_amdgcn_s_getreg((3 << 11) | 20) & 0xFu; }
#define XB_SPIN(cond, bar) do { unsigned _sp = 0; while (cond) { __builtin_amdgcn_s_sleep(1); \
    if ((++_sp & 255u) == 0u) { if (xb_ld(&(bar)[XB_TMO])) break; if (_sp > XB_SPIN_CAP) { atomicAdd(&(bar)[XB_TMO], 1u); break; } } } } while (0)

struct XcdBarrier {
    unsigned* bar; unsigned x;
    volatile LAS unsigned* st;
};

__device__ __forceinline__ XcdBarrier xcd_barrier_post(unsigned* bar, volatile LAS unsigned* st) {
    XcdBarrier b; b.bar = bar; b.x = xb_xcc_id(); b.st = st;
    if (threadIdx.x == 0) (void)xb_add(&bar[XB_XCNT(b.x)], 1u);
    return b;
}
__device__ __forceinline__ void xcd_barrier_complete(unsigned* bar, unsigned x, unsigned& nloc, unsigned& nx) {
    const unsigned G = gridDim.x * gridDim.y * gridDim.z;
    unsigned sum, cnt, mine, sp = 0u;
    for (;;) {
        sum = 0u; cnt = 0u; mine = 0u;
#pragma unroll
        for (unsigned j = 0; j < 16; ++j) { const unsigned c = xb_ld(&bar[XB_XCNT(j)]); sum += c; cnt += (c > 0u) ? 1u : 0u; mine = (j == x) ? c : mine; }
        if (sum == G) break;
        __builtin_amdgcn_s_sleep(1);
        if ((++sp & 255u) == 0u) { if (xb_ld(&bar[XB_TMO])) break; if (sp > XB_SPIN_CAP) { atomicAdd(&bar[XB_TMO], 1u); break; } }
    }
    nloc = mine > 0u ? mine : 1u; nx = cnt > 0u ? cnt : 1u;
}

__device__ __forceinline__ void xcd_barrier(const XcdBarrier& b) {
    asm volatile("s_waitcnt vmcnt(0)" ::: "memory");
    __syncthreads();
    if (threadIdx.x == 0) {
        unsigned* bar = b.bar;
        __builtin_amdgcn_s_waitcnt(0);
        unsigned nloc = b.st[0], nx = b.st[1];
        if (nloc == 0u) { xcd_barrier_complete(bar, b.x, nloc, nx); b.st[0] = nloc; b.st[1] = nx; }
        const unsigned old = xb_add(&bar[XB_XSUB(b.x)], 1u);
        const unsigned gen = old / nloc;
        if (old + 1u == (gen + 1u) * nloc) {
            __builtin_amdgcn_fence(__ATOMIC_RELEASE, "agent");
            asm volatile("s_waitcnt vmcnt(0)" ::: "memory");
            const unsigned og = xb_add(&bar[XB_TOP], 1u);
            const unsigned tg = og / nx;
            if (og + 1u == (tg + 1u) * nx) xb_add(&bar[XB_TOPGEN], 1u);
            else XB_SPIN(xb_ld(&bar[XB_TOPGEN]) == tg, bar);
            __builtin_amdgcn_fence(__ATOMIC_ACQUIRE, "agent");
            xb_add(&bar[XB_XGEN(b.x)], 1u);
            asm volatile("s_waitcnt vmcnt(0)" ::: "memory");
        } else {
            XB_SPIN(xb_ld(&bar[XB_XGEN(b.x)]) == gen, bar);
            __builtin_amdgcn_fence(__ATOMIC_ACQUIRE, "agent");
            asm volatile("s_waitcnt vmcnt(0)" ::: "memory");
        }
    }
    __syncthreads();
}

__global__ void __launch_bounds__(NT, 2) mega_fwd(Params P) {
    extern __shared__ __attribute__((aligned(16))) unsigned char lds_raw[];
    LAS unsigned char* lds = (LAS unsigned char*)lds_raw;
    const int G = gridDim.x, bx = blockIdx.x;
    unsigned char* ws = P.ws;
    volatile LAS unsigned* misc = (volatile LAS unsigned*)(lds + 131072);
    if (threadIdx.x < 4) misc[threadIdx.x] = 0u;
    __syncthreads();
    const XcdBarrier xbar = xcd_barrier_post((unsigned*)(ws + WS_CTL) + 1024, misc);
#define GSYNC() xcd_barrier(xbar)
    unsigned long long pt0 = 0, pacc = 0; (void)pt0; (void)pacc;
#define PB(k) do { if ((PROBE_MASK >> (k)) & 1) pt0 = __builtin_amdgcn_s_memrealtime(); } while (0)
#define PE(k) do { if ((PROBE_MASK >> (k)) & 1) pacc += __builtin_amdgcn_s_memrealtime() - pt0; } while (0)
#ifdef PROBE_BUSY
#define BB(k) do { if (PROBE_BUSY == (k) && threadIdx.x == 0) ((unsigned*)(lds + 131072))[8] = (unsigned)__builtin_amdgcn_s_memrealtime(); } while (0)
#define BE(k) do { if (PROBE_BUSY == (k) && threadIdx.x == 0) atomicMax((unsigned*)(P.ws + WS_CTL) + 12000, (unsigned)__builtin_amdgcn_s_memrealtime() - ((unsigned*)(lds + 131072))[8]); } while (0)
#define BA(k) do { if (PROBE_BUSY == (k) && threadIdx.x == 0) ((unsigned*)(lds + 131072))[9] = __hip_atomic_load((unsigned*)(P.ws + WS_CTL) + 12000, __ATOMIC_RELAXED, __HIP_MEMORY_SCOPE_AGENT); } while (0)
#else
#define BB(k)
#define BE(k)
#define BA(k)
#endif

#ifdef PG8_TIME
    if (blockIdx.x == 0 && threadIdx.x == 0) { pg8::pg8_tacc[0] = 0; pg8::pg8_tacc[1] = 0; }
#endif
    PB(0); phase_p0(P, lds);
    GSYNC(); PE(0);
    PB(1); phase_p1(P, lds);
    GSYNC(); PE(1);
    PB(2); PB(20); BB(2);
    {
        EpiInMain E{(bf16_t*)(ws + WS_CQ), (bf16_t*)(ws + WS_CKVA), (bf16_t*)(ws + WS_Z), (bf16_t*)(ws + WS_XBC), (bf16_t*)P.out, (bf16_t*)P.out + (size_t)R * 1024,
                    (float*)(ws + WS_SSQ_CQ), (float*)(ws + WS_SSQ_CKV), P.out + O_CKV,
                    (bf16_t*)(ws + WS_KROPE), (float*)(ws + WS_DT), P.out + O_KR, P.in[I_DTB], (const f32x2*)(ws + WS_ROPE)};
        run_gemm(lds, (const bf16_t*)(ws + WS_H), (const bf16_t*)(ws + WS_WIN), R, 5376, 1024, G, bx, E);
    }
    PE(20); BE(2);
    GSYNC(); PE(2); BA(2);
    PB(4); BB(4);
    {
        EpiG2 E{(bf16_t*)(ws + WS_QN), (bf16_t*)(ws + WS_KV), (const float*)(ws + WS_SSQ_CQ), (const float*)(ws + WS_SSQ_CKV)};
        pg8::Gemm g{(const bf16_t*)(ws + WS_CQ), (const bf16_t*)(ws + WS_WUQ), R + KVR, 3584, 256}; Gemm2Order S; S.init(G, bx);
        pg8::gemm_phase<EpiG2, Gemm2Order, PG8_ALIGN, PG8_SP2>(lds, g, S, E);
        EpiQR EQR{(bf16_t*)(ws + WS_QR), (const float*)(ws + WS_SSQ_CQ), (const f32x2*)(ws + WS_ROPE)};
        run_gemm(lds, (const bf16_t*)(ws + WS_CQ), (const bf16_t*)(ws + WS_WUQ) + (size_t)1024 * 256, R, 512, 256, G, (bx + 160) % G, EQR);
        phase_ssd_a(P, lds);
    }
    GSYNC();
    PB(14); phase_ssd_scan(P); PE(14);
    BE(4);
    GSYNC(); PE(4); BA(4);
    BB(5); PB(5); PB(12); PB(13); PB(18); phase_mix<1>(P, lds); PE(18); PB(19); phase_mix<2>(P, lds); PE(19); PE(12); PE(13);
    BE(5);
    GSYNC(); PE(5); BA(5);
    PB(6); BB(6);
    {
        EpiMerged E{(const bf16_t*)P.out, (const bf16_t*)P.out + (size_t)R * 1024, (const float*)(ws + WS_SSQ_Y), (bf16_t*)(ws + WS_MERGED)};
        pg8::Gemm g{(const bf16_t*)(ws + WS_Z), (const bf16_t*)(ws + WS_WOMLA), R, 1024, 1024}; PairOrder S; S.init(G, bx);
        pg8::gemm_phase<EpiMerged, PairOrder, PG8_ALIGN, PG8_SP2, 3>(lds, g, S, E);
    }
    BE(6);
    GSYNC(); PE(6); BA(6);
    PB(7); BB(7);
    {
        EpiOut<3> E{P.in[I_XP], P.in[I_XS], (const float*)(ws + WS_MOD), P.in[I_GFFN], (bf16_t*)(ws + WS_X1), (bf16_t*)(ws + WS_A1), (float*)(ws + WS_SSQ2)};
        run_gemm192(lds, (const bf16_t*)(ws + WS_MERGED), (const bf16_t*)(ws + WS_WOUT), R, 1024, 1024, G, bx, E);
    }
    BE(7);
    GSYNC(); PE(7); BA(7);
    PB(8); BB(8);
    {
        EpiUpGate E{(const float*)(ws + WS_SSQ2), (const float*)(ws + WS_CUP), P.in[I_FCW], (const float*)(ws + WS_CST), (bf16_t*)(ws + WS_UG), (bf16_t*)(ws + WS_HALO)};
#ifdef WARM_WUP
        {
            const u32x4* wp = (const u32x4*)(ws + WS_WUP); u32x4 x = {0u, 0u, 0u, 0u};
            for (unsigned i = (unsigned)bx * NT + threadIdx.x; i < (unsigned)((size_t)UPN * 1024 * 2 / 16); i += (unsigned)G * NT) x ^= wp[i];
            if ((x.x ^ x.y ^ x.z ^ x.w) == 0x9e3779b9u) ((volatile unsigned*)(ws + WS_CTL))[8000] = x.x;
        }
#endif
        run_gemm(lds, (const bf16_t*)(ws + WS_A1), (const bf16_t*)(ws + WS_WUP), R, UPN, 1024, G, bx, E);
    }
    BE(8);
    GSYNC(); PE(8); BA(8);
    PB(9); PE(9);
    PB(10);
    const bool fuse_final = (G == 256);
    if (fuse_final) {
        { pg8::StaticOrder S0; S0.init(R, 1024, G, bx, 192); pg8::Unit u0; if (S0.next(0, u0)) fixup_rows(P, u0.pm * 192, u0.pm * 192 + 192, threadIdx.x);
          asm volatile("s_waitcnt vmcnt(0)" ::: "memory"); __syncthreads(); }
        EpiDownNorm E{(const float*)(ws + WS_MOD), P.out, (const bf16_t*)(ws + WS_X1), P.in[I_GFIN], (float*)(ws + WS_SSQ_CQ), (unsigned*)(ws + WS_CTL) + 4608};
        pg8::Gemm g{(const bf16_t*)(ws + WS_UG), (const bf16_t*)(ws + WS_WDOWN), R, 1024, DFF}; pg8::StaticOrder S; S.init(R, 1024, G, bx, 192);
        pg8::gemm_phase<EpiDownNorm, pg8::StaticOrder, false, PG8_SP2, 3>(lds, g, S, E);
        PE(10);
#ifdef PROBE_BUSY
        if (threadIdx.x == 0) pacc += ((unsigned*)(lds + 131072))[9];
#endif
#ifdef PG8_TIME
        if (blockIdx.x == 0 && threadIdx.x == 0) pacc += pg8::pg8_tacc[PG8_TIME];
#endif
        if (PROBE_MASK != 0 && blockIdx.x == PROBE_BLK && threadIdx.x == 0) { const unsigned long long te = __builtin_amdgcn_s_memrealtime() + (unsigned long long)PROBE_MULT * pacc; while (__builtin_amdgcn_s_memrealtime() < te) __builtin_amdgcn_s_sleep(32); }
        return;
    }
    for (int k = bx; k < R / 64; k += G) fixup_rows(P, 64 * k, 64 * k + 64, threadIdx.x);
    GSYNC();
    {
        EpiDown<3> E{(const float*)(ws + WS_MOD), P.out, (const bf16_t*)(ws + WS_X1)};
        run_gemm192(lds, (const bf16_t*)(ws + WS_UG), (const bf16_t*)(ws + WS_WDOWN), R, 1024, DFF, G, bx, E);
    }
    GSYNC(); PE(10);
    PB(11); phase_final(P); PE(11);
    if (PROBE_MASK != 0 && blockIdx.x == PROBE_BLK && threadIdx.x == 0) { const unsigned long long te = __builtin_amdgcn_s_memrealtime() + (unsigned long long)PROBE_MULT * pacc; while (__builtin_amdgcn_s_memrealtime() < te) __builtin_amdgcn_s_sleep(32); }
}

extern "C" void kernel_launch(void* const* d_in, const int* in_sizes, int n_in, void* d_out, int out_size, void* d_ws, size_t ws_size, hipStream_t stream) {
    static int grid = 0;
    if (grid == 0) {
        if (n_in != 30 || ws_size < WS_END || out_size != (int)(O_SSD + (size_t)32 * 2 * 16 * 64 * 64)) {
            fprintf(stderr, "kernel_launch: unexpected shapes: n_in %d out %d ws %zu (need %zu)\n", n_in, out_size, ws_size, (size_t)WS_END); grid = -1; return; }
        int dev = 0, cus = 0, per_cu = 0;
        if (hipGetDevice(&dev) != hipSuccess || hipDeviceGetAttribute(&cus, hipDeviceAttributeMultiprocessorCount, dev) != hipSuccess) { grid = -1; return; }
        if (hipFuncSetAttribute((const void*)mega_fwd, hipFuncAttributeMaxDynamicSharedMemorySize, LDS_BYTES) != hipSuccess) { fprintf(stderr, "kernel_launch: hipFuncSetAttribute failed\n"); grid = -1; return; }
        if (hipOccupancyMaxActiveBlocksPerMultiprocessor(&per_cu, (const void*)mega_fwd, NT, LDS_BYTES) != hipSuccess || per_cu < 1) { fprintf(stderr, "kernel_launch: occupancy query failed (%d)\n", per_cu); (void)hipGetLastError(); grid = -1; return; }
        grid = cus;
    }
    if (grid < 0) return;
    (void)hipMemsetAsync((char*)d_ws + WS_CTL, 0, CTL_ZERO, stream);
    Params p{};
    for (int i = 0; i < 30; ++i) p.in[i] = (const float*)d_in[i];
    p.out = (float*)d_out; p.ws = (unsigned char*)d_ws;
    void* args[] = {&p};
    hipError_t e = hipLaunchCooperativeKernel((const void*)mega_fwd, dim3(grid), dim3(NT), args, LDS_BYTES, stream);
    if (e != hipSuccess) fprintf(stderr, "kernel_launch: cooperative launch failed: %s (grid %d)\n", hipGetErrorString(e), grid);
}
```

```cpp
#include <hip/hip_runtime.h>
#include <hip/hip_cooperative_groups.h>
#include <cstdio>
#include <cstdint>
#include <type_traits>
namespace cg = cooperative_groups;

namespace pg8 {
#define PG8_LAS __attribute__((address_space(3)))
typedef unsigned short bf16_t;
typedef short bf16x8 __attribute__((ext_vector_type(8)));
typedef float f32x4 __attribute__((ext_vector_type(4)));
typedef unsigned u32x4 __attribute__((ext_vector_type(4)));
constexpr int BM = 256, BK = 64, HALF = 128, HTB = HALF * BK * 2  , STAGE_BYTES = 8 * HTB, NXCD = 8, WGM = 8;

__host__ __device__ __forceinline__ int lds_byte(int r, int c) { const int st = (r >> 4) * 2 + (c >> 5), rr = r & 15, cc = c & 31, ob = rr * 64 + cc * 2; return st * 1024 + (ob ^ (((ob >> 9) & 1) << 5)); }
__host__ __device__ __forceinline__ void stage_rc(int b, int& R, int& C) { const int st = b / 1024, sb = b % 1024, swz = sb ^ (((sb >> 9) & 1) << 5); R = (st >> 1) * 16 + swz / 64; C = (st & 1) * 32 + (swz % 64) / 2; }
__host__ __device__ __forceinline__ int perm32(int rho) { const int n = rho >> 4, i = rho & 15; return 8 * (i >> 2) + 4 * n + (i & 3); }

struct Unit { int pm, pn; int half = 0, hm = 0; };
#ifdef PG8_TIME
#ifndef PG8_TBLK
#define PG8_TBLK 0
#endif
#ifndef PG8_TWAVE
#define PG8_TWAVE 0
#endif
__device__ unsigned long long pg8_tacc[2];
#endif
struct Gemm { const bf16_t* A; const bf16_t* Bt; int M, N, K; };

struct StaticOrder {
    int nM, nN, nwg, G, c;
    __host__ __device__ void init(int M, int N, int G_, int c_, int bm = BM) { nM = M / bm; nN = N / BM; nwg = nM * nN; G = G_; c = c_; }
    __host__ __device__ __forceinline__ bool next(int i, Unit& u) const { return at((long)i * G + c, u); }
    __host__ __device__ __forceinline__ bool at(long L, Unit& u) const {
        if (L >= nwg) return false;
        int wgid = (int)L; { const int q = nwg / NXCD, r = nwg % NXCD, xcd = wgid % NXCD, off = wgid / NXCD; wgid = (xcd < r ? xcd * (q + 1) : r * (q + 1) + (xcd - r) * q) + off; }
        const int ng = (nM + WGM - 1) / WGM, gb = nM / ng, grem = nM % ng, tbig = (gb + 1) * nN, nbig = grem * tbig;
        int gid, wl, gsz, fm;
        if (wgid < nbig) { gid = wgid / tbig; wl = wgid - gid * tbig; gsz = gb + 1; fm = gid * (gb + 1); }
        else { const int w2 = wgid - nbig, tsm = gb * nN; gid = w2 / tsm; wl = w2 - gid * tsm; gsz = gb; fm = grem * (gb + 1) + gid * gb; }
        u.pm = fm + (wl % gsz); u.pn = wl / gsz; return true;
    }
    __device__ __forceinline__ void a_ready(const Unit&) const {}
    __device__ __forceinline__ void done(const Unit&) const {}
};


template <class E, class = void> struct epi_state { struct type {}; static constexpr bool value = false; };
template <class E> struct epi_state<E, std::void_t<typename E::State>> { using type = typename E::State; static constexpr bool value = true; };
template <class E, class = void> struct epi_pre : std::false_type {};
template <class E> struct epi_pre<E, std::void_t<decltype(E::PRE_SLOT)>> : std::true_type {};
template <class E, class = void> struct epi_early { struct type {}; static constexpr bool value = false; };
template <class E> struct epi_early<E, std::void_t<typename E::Early>> { using type = typename E::Early; static constexpr bool value = true; };
template <class E, class = void> struct epi_halfm : std::false_type {};
template <class E> struct epi_halfm<E, std::void_t<decltype(E::HALF_M)>> : std::true_type {};
template <class E, class = void> struct epi_timed : std::false_type {};
template <class E> struct epi_timed<E, std::void_t<decltype(E::TIMED)>> : std::true_type {};
template <class Epi, class Sched, bool ALIGN_EPI = false, bool SP2 = false, int MFR = 4  , bool HM = false  >
__device__ __forceinline__ void gemm_phase(PG8_LAS unsigned char* lds, const Gemm g, const Sched& S, const Epi& E) {
    int tid_ = threadIdx.x; asm volatile("" : "+v"(tid_));
    const int tid = tid_, wid = __builtin_amdgcn_readfirstlane(tid >> 6), lane = tid & 63, wr = wid >> 2, wc = wid & 3, fr = lane & 15, fq = lane >> 4;
    static_assert(SP2 || MFR == 4, "192-row tiles need the two-super-phase loop");
    const bool shortA = (MFR == 3) && (wr == 1);
    const int K = g.K, nt = K / BK;
    unsigned voffA[2], voffB[2];
#pragma unroll
    for (int i = 0; i < 2; ++i) { int R, C; stage_rc(tid * 16 + i * 8192, R, C); const int Rb = Epi::PERM ? ((R & ~31) + perm32(R & 31)) : R;
        voffA[i] = (unsigned)(R * K + C) * 2u; voffB[i] = (unsigned)(Rb * K + C) * 2u; }
    const size_t kstep = (size_t)(BK * 2);
    const size_t hstep = (size_t)HALF * K * 2;
    const size_t tstep = 2 * hstep;
    const size_t hstepA = (size_t)(32 * MFR) * K * 2, tstepA = 2 * hstepA;
    const unsigned ldsw = (unsigned)wid * 1024u;
    const int aoff = lds_byte(wr * (16 * MFR) + fr, fq * 8), boff = lds_byte(wc * 32 + fr, fq * 8);
#define PG8_SA(b, h) (((b) * 2 + (h)) * HTB)
#define PG8_SB(b, h) ((4 + (b) * 2 + (h)) * HTB)
#define PG8_STAGE(bufoff, gbase, voff) do { _Pragma("unroll") for (int _i = 0; _i < 2; ++_i) \
        __builtin_amdgcn_global_load_lds((const unsigned*)((const char*)(gbase) + (voff)[_i]), (PG8_LAS unsigned*)(lds + (bufoff) + ldsw + _i * 8192), 16, 0, 0); } while (0)
#define PG8_LDA(dst, b, h) do { _Pragma("unroll") for (int m = 0; m < MFR; ++m) _Pragma("unroll") for (int k = 0; k < 2; ++k) dst[m][k] = *(const PG8_LAS bf16x8*)(lds + PG8_SA(b, h) + aoff + m * 2048 + k * 1024); } while (0)
#define PG8_LDB(dst, b, h) do { _Pragma("unroll") for (int n = 0; n < 2; ++n) _Pragma("unroll") for (int k = 0; k < 2; ++k) dst[n][k] = *(const PG8_LAS bf16x8*)(lds + PG8_SB(b, h) + boff + n * 2048 + k * 1024); } while (0)
#define PG8_MMA(ai, bj, At, Bt) do { __builtin_amdgcn_s_setprio(1); _Pragma("unroll") for (int m = 0; m < MFR; ++m) _Pragma("unroll") for (int n = 0; n < 2; ++n) _Pragma("unroll") for (int k = 0; k < 2; ++k) \
        acc[ai][bj][m][n] = __builtin_amdgcn_mfma_f32_16x16x32_bf16(Bt[n][k], At[m][k], acc[ai][bj][m][n], 0, 0, 0); __builtin_amdgcn_s_setprio(0); } while (0)
#define PG8_WAIT_V(n) asm volatile("s_waitcnt vmcnt(" #n ")" ::: "memory")
#define PG8_WAIT_VS(nf, ns) do { if (shortA) PG8_WAIT_V(ns); else PG8_WAIT_V(nf); } while (0)
#define PG8_STAGE_A(bufoff, gbase) do { __builtin_amdgcn_global_load_lds((const unsigned*)((const char*)(gbase) + voffA[0]), (PG8_LAS unsigned*)(lds + (bufoff) + ldsw), 16, 0, 0); \
        if (!shortA) __builtin_amdgcn_global_load_lds((const unsigned*)((const char*)(gbase) + voffA[1]), (PG8_LAS unsigned*)(lds + (bufoff) + ldsw + 8192), 16, 0, 0); } while (0)
#define PG8_WAIT_L(n) asm volatile("s_waitcnt lgkmcnt(" #n ")" ::: "memory")
#define PG8_BAR __builtin_amdgcn_s_barrier()
#define PG8_SCHED __builtin_amdgcn_sched_barrier(0)
    Unit cur, nxt; int ui = 0;
    if (!S.next(0, cur)) return;
#ifdef PG8_TIME
    const bool tme = epi_timed<Epi>::value && (wid == PG8_TWAVE && blockIdx.x == PG8_TBLK); unsigned long long tk0 = 0;
#endif
    typename epi_state<Epi>::type est; (void)est;
    f32x4 acc[2][2][MFR][2];
#pragma unroll
    for (int a = 0; a < 2; ++a)
#pragma unroll
        for (int b = 0; b < 2; ++b)
#pragma unroll
            for (int m = 0; m < MFR; ++m)
#pragma unroll
                for (int n = 0; n < 2; ++n) acc[a][b][m][n] = (f32x4){0.f, 0.f, 0.f, 0.f};
    bf16x8 At[MFR][2], B0[2][2], B1[2][2];
    const char* cA = (const char*)g.A + (size_t)cur.pm * tstepA + (size_t)cur.half * hstepA; const char* cB = (const char*)g.Bt + (size_t)cur.pn * tstep;
    S.a_ready(cur);
    if constexpr (epi_pre<Epi>::value) E.pre(cur, lds + STAGE_BYTES + Epi::PRE_SLOT, wr, wc, lane);
    if constexpr (SP2) {
        PG8_STAGE(PG8_SB(0, 0), cB, voffB); PG8_STAGE(PG8_SB(0, 1), cB + hstep, voffB); PG8_STAGE_A(PG8_SA(0, 0), cA); PG8_STAGE_A(PG8_SA(0, 1), cA + hstepA);
        if (wr == 1) PG8_BAR;
        PG8_WAIT_VS(2, 1); PG8_BAR;
        PG8_STAGE(PG8_SB(1, 0), cB + kstep, voffB); PG8_STAGE_A(PG8_SA(1, 0), cA + kstep); PG8_STAGE(PG8_SB(1, 1), cB + hstep + kstep, voffB);
        PG8_WAIT_VS(6, 5); PG8_BAR;
    } else {
        PG8_STAGE(PG8_SB(0, 0), cB, voffB); PG8_STAGE_A(PG8_SA(0, 0), cA); PG8_STAGE(PG8_SB(0, 1), cB + hstep, voffB); PG8_STAGE_A(PG8_SA(0, 1), cA + hstepA);
        if (wr == 1) PG8_BAR;
        PG8_WAIT_V(4); PG8_BAR;
        PG8_STAGE(PG8_SB(1, 0), cB + kstep, voffB); PG8_STAGE_A(PG8_SA(1, 0), cA + kstep); PG8_STAGE(PG8_SB(1, 1), cB + hstep + kstep, voffB);
        PG8_WAIT_V(6); PG8_BAR;
    }
    for (;;) {
        const bool has_next = S.next(ui + 1, nxt);
        const char* nA = has_next ? (const char*)g.A + (size_t)nxt.pm * tstepA + (size_t)nxt.half * hstepA : cA; const char* nB = has_next ? (const char*)g.Bt + (size_t)nxt.pn * tstep : cB;
#ifdef PG8_TIME
        if (tme) tk0 = __builtin_amdgcn_s_memrealtime();
#endif
        for (int t = 0; t < nt; t += 2) {
            const bool last = (t == nt - 2);
            const char* a1 = cA + (size_t)(t + 1) * kstep;
            const char* a2 = last ? nA : cA + (size_t)(t + 2) * kstep; const char* b2 = last ? nB : cB + (size_t)(t + 2) * kstep;
            const char* a3 = a2 + kstep; const char* b3 = b2 + kstep;
            if (last && has_next) S.a_ready(nxt);
            if constexpr (SP2) {
            PG8_LDB(B0, 0, 0); PG8_LDB(B1, 0, 1); PG8_SCHED; PG8_LDA(At, 0, 0); PG8_STAGE_A(PG8_SA(1, 1), a1 + hstepA);
            PG8_WAIT_VS(8, 6); PG8_WAIT_L(0); PG8_BAR; PG8_MMA(0, 0, At, B0); PG8_MMA(0, 1, At, B1); PG8_BAR; PG8_SCHED;
            PG8_LDA(At, 0, 1); PG8_STAGE(PG8_SB(0, 0), b2, voffB); PG8_STAGE(PG8_SB(0, 1), b2 + hstep, voffB); PG8_STAGE_A(PG8_SA(0, 0), a2);
            PG8_WAIT_VS(8, 6); PG8_WAIT_L(0); PG8_BAR; if constexpr (!HM) { PG8_MMA(1, 0, At, B0); PG8_MMA(1, 1, At, B1); } PG8_BAR; PG8_SCHED;
            PG8_LDB(B0, 1, 0); PG8_LDB(B1, 1, 1); PG8_SCHED; PG8_LDA(At, 1, 0); PG8_STAGE_A(PG8_SA(0, 1), a2 + hstepA);
            PG8_WAIT_VS(8, 6); PG8_WAIT_L(0); PG8_BAR; PG8_MMA(0, 0, At, B0); PG8_MMA(0, 1, At, B1); PG8_BAR; PG8_SCHED;
            PG8_LDA(At, 1, 1); PG8_STAGE(PG8_SB(1, 0), b3, voffB); PG8_STAGE(PG8_SB(1, 1), b3 + hstep, voffB); PG8_STAGE_A(PG8_SA(1, 0), a3);
            PG8_WAIT_VS(8, 6); PG8_WAIT_L(0); PG8_BAR; if constexpr (!HM) { PG8_MMA(1, 0, At, B0); PG8_MMA(1, 1, At, B1); } PG8_BAR; PG8_SCHED;
            } else {
            PG8_LDB(B0, 0, 0); PG8_SCHED; PG8_LDA(At, 0, 0); PG8_STAGE_A(PG8_SA(1, 1), a1 + hstepA);
            PG8_WAIT_L(8); PG8_BAR; PG8_WAIT_L(0); PG8_MMA(0, 0, At, B0); PG8_BAR; PG8_SCHED;
            PG8_LDB(B1, 0, 1); PG8_STAGE(PG8_SB(0, 0), b2, voffB);
            PG8_BAR; PG8_WAIT_L(0); PG8_MMA(0, 1, At, B1); PG8_BAR;
            PG8_LDA(At, 0, 1); PG8_STAGE_A(PG8_SA(0, 0), a2);
            PG8_BAR; PG8_WAIT_L(0); PG8_MMA(1, 0, At, B0); PG8_BAR; PG8_SCHED;
            PG8_STAGE(PG8_SB(0, 1), b2 + hstep, voffB);
            PG8_WAIT_V(6); PG8_BAR; PG8_MMA(1, 1, At, B1); PG8_BAR;
            PG8_LDB(B0, 1, 0); PG8_SCHED; PG8_LDA(At, 1, 0); PG8_STAGE_A(PG8_SA(0, 1), a2 + hstepA);
            PG8_WAIT_L(8); PG8_BAR; PG8_WAIT_L(0); PG8_MMA(0, 0, At, B0); PG8_BAR; PG8_SCHED;
            PG8_LDB(B1, 1, 1); PG8_STAGE(PG8_SB(1, 0), b3, voffB);
            PG8_BAR; PG8_WAIT_L(0); PG8_MMA(0, 1, At, B1); PG8_BAR;
            PG8_LDA(At, 1, 1); PG8_STAGE_A(PG8_SA(1, 0), a3);
            PG8_BAR; PG8_WAIT_L(0); PG8_MMA(1, 0, At, B0); PG8_BAR; PG8_SCHED;
            PG8_STAGE(PG8_SB(1, 1), b3 + hstep, voffB);
            PG8_WAIT_V(6); PG8_BAR; PG8_MMA(1, 1, At, B1); PG8_BAR;
            }
        }
#ifdef PG8_TIME
#ifdef PG8_TUI
        if (tme) { const unsigned long long t1 = __builtin_amdgcn_s_memrealtime(); if (ui == PG8_TUI) pg8_tacc[0] += t1 - tk0; tk0 = t1; }
#else
        if (tme) { const unsigned long long t1 = __builtin_amdgcn_s_memrealtime(); pg8_tacc[0] += t1 - tk0; tk0 = t1; }
#endif
#endif
        typename epi_early<Epi>::type eev; (void)eev;
        if constexpr (epi_early<Epi>::value) eev = E.early(cur, wr, fr, fq);
        if constexpr (ALIGN_EPI) { if (wr == 0) PG8_BAR; }
        if constexpr (!Epi::AFTER_DRAIN) { if constexpr (epi_state<Epi>::value) E(acc, cur, wr, wc, fr, fq, est); else if constexpr (epi_early<Epi>::value) E(acc, cur, wr, wc, fr, fq, lds + STAGE_BYTES + Epi::PRE_SLOT + (ui & 1) * Epi::PRE_BYTES, eev);
            else if constexpr (epi_pre<Epi>::value) E(acc, cur, wr, wc, fr, fq, lds + STAGE_BYTES + Epi::PRE_SLOT + (ui & 1) * Epi::PRE_BYTES);
            else E(acc, cur, wr, wc, fr, fq); S.done(cur);
            if constexpr (epi_pre<Epi>::value) { if (has_next) E.pre(nxt, lds + STAGE_BYTES + Epi::PRE_SLOT + ((ui + 1) & 1) * Epi::PRE_BYTES, wr, wc, lane); } }
#ifdef PG8_TIME
        if (tme) { const unsigned long long t1 = __builtin_amdgcn_s_memrealtime(); pg8_tacc[1] += t1 - tk0; }
#endif
        if (!has_next) break;
#pragma unroll
        for (int a = 0; a < 2; ++a)
#pragma unroll
            for (int b = 0; b < 2; ++b)
#pragma unroll
                for (int m = 0; m < MFR; ++m)
#pragma unroll
                    for (int n = 0; n < 2; ++n) acc[a][b][m][n] = (f32x4){0.f, 0.f, 0.f, 0.f};
        cur = nxt; cA = nA; cB = nB; ++ui;
        if constexpr (ALIGN_EPI) { if (wr == 1) PG8_BAR; }
    }
    PG8_WAIT_V(0);
    if constexpr (!ALIGN_EPI) { if (wr == 0) PG8_BAR; }
    PG8_BAR;
    if constexpr (Epi::AFTER_DRAIN) { E.fused(acc, cur, wr, wc, fr, fq, lds, wid, lane); S.done(cur); }
#undef PG8_SA
#undef PG8_SB
#undef PG8_STAGE
#undef PG8_LDA
#undef PG8_LDB
#undef PG8_MMA
#undef PG8_WAIT_V
#undef PG8_WAIT_VS
#undef PG8_STAGE_A
#undef PG8_WAIT_L
#undef PG8_BAR
#undef PG8_SCHED
}
}

#ifndef PROBE_MASK
#define PROBE_MASK 0
#endif
#define PROBE_MULT 8
#ifndef PROBE_BLK
#define PROBE_BLK (((PROBE_MASK >> 13) & 0x61) ? gridDim.x / 2 : 0)
#endif
#ifndef PB_DUP1
#define PB_DUP1 1
#endif
#ifndef PG8_SP2
#define PG8_SP2 true
#endif
#ifndef PG8_ALIGN
#define PG8_ALIGN true
#endif

#define LAS __attribute__((address_space(3)))
using pg8::bf16_t; using pg8::f32x4; using pg8::bf16x8; using pg8::u32x4;
typedef unsigned u32x2 __attribute__((ext_vector_type(2)));
typedef float f32x2 __attribute__((ext_vector_type(2)));

constexpr int DM = 1024;
constexpr int RP = 8192, RS = 4096, R = 12288;
constexpr int SEQP = 256, SEQS = 2048, PAST = 512, KVS = PAST + SEQS;
constexpr int KVR = RP + 2 * KVS;
constexpr int NH = 8;
constexpr int INC = 5216, INP = 5376;
constexpr int DFF = 2816, UPN = 5632;
constexpr float EPS = 1e-6f;
constexpr float ATT_SCALE = 0.07216878364870322f;

enum { I_XP = 0, I_XS, I_C, I_CKV, I_CKR, I_SSD, I_CCTX, I_WADA, I_BADA, I_GATTN, I_WIN, I_GQ, I_GKV, I_WUQ, I_WUKV, I_WOMLA,
       I_CONVW, I_CONVB, I_DTB, I_ALOG, I_SSDD, I_GSSD, I_WOSSD, I_WOUT, I_GFFN, I_WUP, I_FCW, I_FCB, I_WDOWN, I_GFIN };

constexpr size_t O_Y = 0, O_CKV = (size_t)R * DM, O_KR = O_CKV + (size_t)RP * 256, O_SSD = O_KR + (size_t)RP * 64;

constexpr size_t MiB = 1u << 20;
constexpr size_t WS_CTL = 0, CTL_ZERO = 65536;
constexpr size_t WS_MOD = 64 * 1024;
constexpr size_t WS_CUP = 160 * 1024;
constexpr size_t WS_ROPE = 256 * 1024;
constexpr size_t WS_CST = 800 * 1024;
constexpr size_t WS_SSQ_CQ = 1 * MiB;
constexpr size_t WS_SSQ_CKV = 1 * MiB + 204800;
constexpr size_t WS_SSQ_Y = 1 * MiB + 430080;
constexpr size_t WS_SSQ2 = 1 * MiB + 1216512;
constexpr size_t WS_DT = 3 * MiB;
constexpr size_t WS_DEC = 3 * MiB + 1572864;
constexpr size_t WS_ZERO = WS_DEC + 16384;
constexpr size_t WS_WIN = 5 * MiB;
constexpr size_t WS_WUQ = WS_WIN + (size_t)INP * 1024 * 2;
constexpr size_t WS_WUKV = WS_WUQ + 1536 * 256 * 2;
constexpr size_t WS_WOMLA = WS_WUKV + 2048 * 256 * 2;
constexpr size_t WS_WOSSD = WS_WOMLA + 2 * MiB;
constexpr size_t WS_WOUT = WS_WOSSD + 2 * MiB;
constexpr size_t WS_WUP = WS_WOUT + 2 * MiB;
constexpr size_t WS_WDOWN = WS_WUP + (size_t)UPN * 1024 * 2;
static_assert(WS_WDOWN + (size_t)1024 * DFF * 2 <= 40 * MiB, "weights");
constexpr size_t WS_CQ = 40 * MiB;
constexpr size_t WS_CKVA = 46 * MiB;
constexpr size_t WS_KROPE = 46 * MiB + (size_t)KVR * 256 * 2;
constexpr size_t WS_Z = 55 * MiB;
constexpr size_t WS_XBC = 79 * MiB;
constexpr size_t WS_H = 115 * MiB;
constexpr size_t WS_QN = 115 * MiB;
constexpr size_t WS_QR = 139 * MiB;
constexpr size_t WS_KV = 151 * MiB;
constexpr size_t WS_ST = 203 * MiB;
constexpr size_t WS_MERGED = 151 * MiB;
constexpr size_t WS_A1 = 83 * MiB;
constexpr size_t WS_U = 115 * MiB;
constexpr size_t WS_UG = 115 * MiB;
constexpr size_t WS_HALO = 182 * MiB;
constexpr size_t WS_X1 = 203 * MiB;
constexpr size_t WS_END = 251 * MiB;
static_assert(WS_KROPE + (size_t)KVR * 64 * 2 <= WS_Z && WS_KV + (size_t)KVR * 2048 * 2 <= WS_ST && WS_ST + (size_t)R * 1024 * 4 <= WS_END, "map");
static_assert(WS_UG + (size_t)R * DFF * 2 <= WS_HALO && WS_HALO + (size_t)192 * 4 * UPN * 2 <= WS_END, "map2");
static_assert(WS_A1 + (size_t)R * 1024 * 2 <= WS_UG, "a1 clear of ug");

constexpr int SCANCNT = 12300;
constexpr int MODCNT = 12200;
constexpr int LDS_BYTES = 147456;
constexpr int NT = 512;

struct Params { const float* in[30]; float* out; unsigned char* ws; };
#define PHASE_IDS int tid = threadIdx.x; asm volatile("" : "+v"(tid)); const int lane = tid & 63, wave = __builtin_amdgcn_readfirstlane(tid >> 6), G = gridDim.x; (void)lane; (void)wave; (void)G;

#define LDS_WAIT() asm volatile("s_waitcnt lgkmcnt(0)" ::: "memory")
__device__ __forceinline__ unsigned f2bf(float f) { unsigned u = __builtin_bit_cast(unsigned, f); return (u + 0x7fffu + ((u >> 16) & 1u)) >> 16; }
__device__ __forceinline__ float bf2f(unsigned short b) { return __builtin_bit_cast(float, (unsigned)b << 16); }
typedef __bf16 bf16x2_t __attribute__((ext_vector_type(2)));
__device__ __forceinline__ unsigned pk2(float lo, float hi) { const f32x2 v = {lo, hi}; const bf16x2_t b = __builtin_convertvector(v, bf16x2_t); return __builtin_bit_cast(unsigned, b); }
__device__ __forceinline__ float bflo(unsigned w) { return __builtin_bit_cast(float, w << 16); }
__device__ __forceinline__ float bfhi(unsigned w) { return __builtin_bit_cast(float, w & 0xffff0000u); }
__device__ __forceinline__ float wave_sum(float v) {
#pragma unroll
    for (int o = 1; o < 64; o <<= 1) v += __shfl_xor(v, o);
    return v;
}
__device__ __forceinline__ float wave_max(float v) {
#pragma unroll
    for (int o = 1; o < 64; o <<= 1) v = fmaxf(v, __shfl_xor(v, o));
    return v;
}
__device__ __forceinline__ void unpack8(const u32x4 w, float* f) {
#pragma unroll
    for (int e = 0; e < 4; ++e) { f[2 * e] = bflo(w[e]); f[2 * e + 1] = bfhi(w[e]); }
}
__device__ __forceinline__ float sigm(float x) { return __builtin_amdgcn_rcpf(1.f + __expf(-x)); }
__device__ __forceinline__ float siluf(float x) { return x * sigm(x); }
__device__ __forceinline__ float softplusf(float x) { return fmaxf(x, 0.f) + __logf(1.f + __expf(-fabsf(x))); }
__device__ __forceinline__ int grp_of_row(int row) { return row < RP ? 0 : 1 + ((row - RP) >> 11); }
__device__ __forceinline__ int kvrow_of_row(int row) { return row < RP ? row : RP + ((row - RP) >> 11) * KVS + PAST + ((row - RP) & 2047); }
__device__ __forceinline__ const float* xrow_ptr(const Params& P, int row) { return row < RP ? P.in[I_XP] + (size_t)row * DM : P.in[I_XS] + (size_t)(row - RP) * DM; }

__device__ __forceinline__ void cnt_arrive(unsigned* cnt) {
    asm volatile("s_waitcnt vmcnt(0)" ::: "memory");
    __syncthreads();
    if (threadIdx.x == 0) { __builtin_amdgcn_fence(__ATOMIC_RELEASE, "agent"); asm volatile("s_waitcnt vmcnt(0)" ::: "memory");
        __hip_atomic_fetch_add(cnt, 1u, __ATOMIC_RELAXED, __HIP_MEMORY_SCOPE_AGENT); }
}
__device__ __forceinline__ void cnt_wait(unsigned* cnt, unsigned target) {
    if (threadIdx.x == 0) { unsigned sp = 0;
        while (__hip_atomic_load(cnt, __ATOMIC_RELAXED, __HIP_MEMORY_SCOPE_AGENT) < target) { __builtin_amdgcn_s_sleep(4); if (++sp > (1u << 22)) break; }
        __builtin_amdgcn_fence(__ATOMIC_ACQUIRE, "agent"); asm volatile("s_waitcnt vmcnt(0)" ::: "memory"); }
    __syncthreads();
}
__device__ __forceinline__ int pair_pos(int i) { return 8 * ((i & 15) >> 2) + (i & 3) + (i >= 16 ? 4 : 0); }
__device__ __forceinline__ void transpose_item(const float* W, int K, int N, bf16_t* WT, int k0, int n0, int drow0, const float* kscale, LAS float* scr, int lane, bool pairs = false) {
    float wv[32];
#pragma unroll
    for (int i = 0; i < 32; ++i) wv[i] = __builtin_nontemporal_load(W + (size_t)(k0 + 2 * i + (lane >> 5)) * N + n0 + (lane & 31));
#pragma unroll
    for (int i = 0; i < 32; ++i) { const int kk = 2 * i + (lane >> 5); float w = wv[i]; if (kscale) w *= kscale[k0 + kk]; scr[kk * 33 + (lane & 31)] = w; }
    LDS_WAIT(); asm volatile("" ::: "memory");
    const int c = lane & 7;
#pragma unroll
    for (int j = 0; j < 4; ++j) { const int n = (lane >> 3) + 8 * j; const LAS float* s = scr + (8 * c) * 33 + n;
        u32x4 o; o.x = pk2(s[0 * 33], s[1 * 33]); o.y = pk2(s[2 * 33], s[3 * 33]); o.z = pk2(s[4 * 33], s[5 * 33]); o.w = pk2(s[6 * 33], s[7 * 33]);
        *(u32x4*)(WT + (size_t)(drow0 + (pairs ? pair_pos(n) : n)) * K + k0 + 8 * c) = o; }
    LDS_WAIT(); asm volatile("" ::: "memory");
}
__device__ __forceinline__ int win_dst(int n0) {
    if (n0 < 512) return n0;
    if (n0 < 576) return 5120 + (n0 - 512);
    if (n0 < 1600) return 512 + (n0 - 576);
    if (n0 < 2624) return 1536 + (n0 - 1600);
    if (n0 < 2880) return 2560 + (n0 - 2624);
    if (n0 < 3136) return 2816 + (n0 - 2880);
    if (n0 < 3168) return 5184 + (n0 - 3136);
    if (n0 < 4192) return 3072 + (n0 - 3168);
    return 4096 + (n0 - 4192);
}
__device__ __forceinline__ int wup_dst(int n0) { const bool isv = n0 >= DFF; const int j = isv ? n0 - DFF : n0; return (j >> 7) * 256 + (isv ? 128 : 0) + (j & 127); }
__device__ __forceinline__ int wuq_dst(int n0) { const int h = n0 / 192, d0 = n0 - h * 192; return d0 < 128 ? h * 128 + d0 : 1024 + h * 64 + (d0 - 128); }

template <int CW>
__device__ __forceinline__ void gemv3_block(const LAS float* vec  , const float* W, int N, int col0, const float* bias, float* out, int ldo, LAS float* red, int tid) {
    const int j = tid & 31, kq = tid >> 5;
    float a0 = 0.f, a1 = 0.f, a2 = 0.f;
    if (j < CW) {
        const float* wp = W + (size_t)(kq * 64) * N + col0 + j;
#pragma unroll 32
        for (int k = 0; k < 64; ++k) { const float w = __builtin_nontemporal_load(wp + (size_t)k * N); const int kk = kq * 64 + k; a0 += vec[kk] * w; a1 += vec[1024 + kk] * w; a2 += vec[2048 + kk] * w; }
    }
    red[(kq * 3 + 0) * 32 + j] = a0; red[(kq * 3 + 1) * 32 + j] = a1; red[(kq * 3 + 2) * 32 + j] = a2;
    __syncthreads();
    if (tid < 96) { const int g = tid >> 5, jj = tid & 31;
        if (jj < CW) { float s = 0.f;
#pragma unroll
            for (int q = 0; q < 16; ++q) s += red[(q * 3 + g) * 32 + jj];
            __hip_atomic_store(out + (size_t)g * ldo + col0 + jj, s + (bias ? bias[col0 + jj] : 0.f), __ATOMIC_RELAXED, __HIP_MEMORY_SCOPE_AGENT); } }
    asm volatile("s_waitcnt vmcnt(0)" ::: "memory");
    __syncthreads();
}

__device__ __forceinline__ void phase_p0(const Params& P, LAS unsigned char* lds) {
    PHASE_IDS unsigned char* ws = P.ws;
    {
        LAS float* sc = (LAS float*)lds; LAS float* red = sc + 3072;
        for (int i = tid; i < 3072; i += NT) { const int g = i >> 10, k = i & 1023; const float c = (g == 0) ? P.in[I_CCTX][k] : P.in[I_C][(g - 1) * 1024 + k]; sc[i] = siluf(c); }
        __syncthreads();
        for (int cb = blockIdx.x; cb < 192; cb += G) { gemv3_block<32>(sc, P.in[I_WADA], 6144, cb * 32, P.in[I_BADA], (float*)(ws + WS_MOD), 6144, red, tid);
            if (tid == 0) __hip_atomic_fetch_add((unsigned*)(ws + WS_CTL) + MODCNT, 1u, __ATOMIC_RELAXED, __HIP_MEMORY_SCOPE_AGENT); }
    }
    {
        LAS float* scr = (LAS float*)(lds + wave * 16384);
        const int NGW = G * 8, gw = blockIdx.x * 8 + wave;
        constexpr int I_IN = 16 * 163, I_UQ = 4 * 48, I_UKV = 4 * 64, I_SQ = 16 * 32, I_UP = 16 * 176, I_DN = 44 * 32;
        const int NITEMS = I_IN + I_UQ + I_UKV + 3 * I_SQ + I_UP + (G == 256 ? 0 : I_DN);
        for (int it = gw; it < NITEMS; it += NGW) {
            int r = it;
            if (r < I_IN) { const int kb = r / 163, nb = r % 163; transpose_item(P.in[I_WIN], 1024, INC, (bf16_t*)(ws + WS_WIN), kb * 64, nb * 32, win_dst(nb * 32), nullptr, scr, lane, win_dst(nb * 32) >= 5120); continue; } r -= I_IN;
            if (r < I_UQ) { const int kb = r / 48, nb = r % 48; transpose_item(P.in[I_WUQ], 256, 1536, (bf16_t*)(ws + WS_WUQ), kb * 64, nb * 32, wuq_dst(nb * 32), P.in[I_GQ], scr, lane); continue; } r -= I_UQ;
            if (r < I_UKV) { const int kb = r / 64, nb = r % 64; transpose_item(P.in[I_WUKV], 256, 2048, (bf16_t*)(ws + WS_WUKV), kb * 64, nb * 32, nb * 32, P.in[I_GKV], scr, lane); continue; } r -= I_UKV;
            if (r < I_SQ) { const int kb = r / 32, nb = r % 32; transpose_item(P.in[I_WOMLA], 1024, 1024, (bf16_t*)(ws + WS_WOMLA), kb * 64, nb * 32, nb * 32, nullptr, scr, lane); continue; } r -= I_SQ;
            if (r < I_SQ) { const int kb = r / 32, nb = r % 32; transpose_item(P.in[I_WOSSD], 1024, 1024, (bf16_t*)(ws + WS_WOSSD), kb * 64, nb * 32, nb * 32, P.in[I_GSSD], scr, lane); continue; } r -= I_SQ;
            if (r < I_SQ) { const int kb = r / 32, nb = r % 32; transpose_item(P.in[I_WOUT], 1024, 1024, (bf16_t*)(ws + WS_WOUT), kb * 64, nb * 32, nb * 32, nullptr, scr, lane); continue; } r -= I_SQ;
            if (r < I_UP) { const int kb = r / 176, nb = r % 176; transpose_item(P.in[I_WUP], 1024, UPN, (bf16_t*)(ws + WS_WUP), kb * 64, nb * 32, wup_dst(nb * 32), nullptr, scr, lane); continue; } r -= I_UP;
            { const int kb = r / 32, nb = r % 32; transpose_item(P.in[I_WDOWN], DFF, 1024, (bf16_t*)(ws + WS_WDOWN), kb * 64, nb * 32, nb * 32, nullptr, scr, lane); }
        }
    }
    {
        const int gt = blockIdx.x * NT + tid, GT = G * NT;
        for (int i = gt; i < 8192 / 16; i += GT) *(u32x4*)(ws + WS_ZERO + (size_t)i * 16) = (u32x4){0u, 0u, 0u, 0u};
        for (int i = gt; i < 160 * 1024 / 8; i += GT) *(u32x4*)((bf16_t*)(ws + WS_WIN) + (size_t)5216 * 1024 + (size_t)i * 8) = (u32x4){0u, 0u, 0u, 0u};
        for (int i = gt; i < 2048 * 32; i += GT) { const int t = i >> 5, a = (i >> 4) & 1, fi = i & 15; const float pos = (float)(a ? (t & 63) : (t >> 6));
            const float inv = exp2f(-(float)fi * 0.8304820237218406f); const float ang = pos * inv;
            ((f32x2*)(ws + WS_ROPE))[i] = (f32x2){__cosf(ang), __sinf(ang)}; }
        for (int i = gt; i < 2 * PAST * 256; i += GT) { const int k = i & 255, s = (i >> 8) & 511, b = i >> 17;
            ((bf16_t*)(ws + WS_CKVA))[(size_t)(RP + b * KVS + s) * 256 + k] = (bf16_t)f2bf(P.in[I_CKV][i] / P.in[I_GKV][k]); }
        for (int i = gt; i < 2 * PAST * 64; i += GT) { const int j = i & 63, s = (i >> 6) & 511, b = i >> 15;
            ((bf16_t*)(ws + WS_KROPE))[(size_t)(RP + b * KVS + s) * 64 + j] = (bf16_t)f2bf(P.in[I_CKR][i]); }
        for (int i = gt; i < 2 * PAST; i += GT) { const int s = i & 511, b = i >> 9;
            *(f32x4*)((float*)(ws + WS_SSQ_CKV) + (size_t)(RP + b * KVS + s) * 4) = (f32x4){256.f * (1.f - EPS), 0.f, 0.f, 0.f}; }
    }
    cnt_wait((unsigned*)(ws + WS_CTL) + MODCNT, 192u);
    const float* mod = (const float*)(ws + WS_MOD); const int gw = blockIdx.x * 8 + wave, NGW = G * 8;
    const float* gat = P.in[I_GATTN];
    for (int row0 = gw * 2; row0 < R; row0 += NGW * 2) {
        const int g = grp_of_row(row0);
        f32x4 v[2][4]; float s[2] = {0.f, 0.f};
#pragma unroll
        for (int q = 0; q < 2; ++q) { const f32x4* xr = (const f32x4*)xrow_ptr(P, row0 + q) + lane;
#pragma unroll
            for (int j = 0; j < 4; ++j) v[q][j] = __builtin_nontemporal_load(xr + 64 * j); }
#pragma unroll
        for (int q = 0; q < 2; ++q)
#pragma unroll
            for (int j = 0; j < 4; ++j) s[q] += (v[q][j].x * v[q][j].x + v[q][j].y * v[q][j].y) + (v[q][j].z * v[q][j].z + v[q][j].w * v[q][j].w);
        const float rs0 = rsqrtf(wave_sum(s[0]) * (1.f / DM) + EPS), rs1 = rsqrtf(wave_sum(s[1]) * (1.f / DM) + EPS);
#pragma unroll
        for (int j = 0; j < 4; ++j) { const int c = 4 * lane + 256 * j;
            const f32x4 gg = *(const f32x4*)(gat + c), sc = *(const f32x4*)(mod + g * 6144 + 1024 + c), sh = *(const f32x4*)(mod + g * 6144 + c);
            const f32x4 gs = gg * (sc + 1.f);
            const f32x4 h0 = v[0][j] * rs0 * gs + sh, h1 = v[1][j] * rs1 * gs + sh;
            ((u32x2*)((bf16_t*)(ws + WS_H) + (size_t)row0 * DM) + lane)[64 * j] = (u32x2){pk2(h0.x, h0.y), pk2(h0.z, h0.w)};
            ((u32x2*)((bf16_t*)(ws + WS_H) + (size_t)(row0 + 1) * DM) + lane)[64 * j] = (u32x2){pk2(h1.x, h1.y), pk2(h1.z, h1.w)}; }
    }
}


__device__ __forceinline__ void phase_wdown(const Params& P, LAS unsigned char* lds, int first, int nblk) {
    PHASE_IDS
    if ((int)blockIdx.x < first || (int)blockIdx.x >= first + nblk) return;
    LAS float* scr = (LAS float*)(lds + wave * 16384);
    for (int r = ((int)blockIdx.x - first) * 8 + wave; r < 44 * 32; r += nblk * 8) { const int kb = r / 32, nb = r % 32;
        transpose_item(P.in[I_WDOWN], DFF, 1024, (bf16_t*)(P.ws + WS_WDOWN), kb * 64, nb * 32, nb * 32, nullptr, scr, lane); }
}
__device__ __forceinline__ void phase_cup(const Params& P, int first, int nblk) {
    PHASE_IDS unsigned char* ws = P.ws; const float* mod = (const float*)(ws + WS_MOD);
    if ((int)blockIdx.x < first || (int)blockIdx.x >= first + nblk) return;
    const int gw = ((int)blockIdx.x - first) * 8 + wave, NGW = nblk * 8;
    {
        float s2[3][16];
#pragma unroll
        for (int g = 0; g < 3; ++g)
#pragma unroll
            for (int q = 0; q < 4; ++q) { const f32x4 a = *(const f32x4*)(mod + g * 6144 + 3072 + (q >> 1) * 512 + 8 * lane + 4 * (q & 1));
#pragma unroll
                for (int e = 0; e < 4; ++e) s2[g][4 * q + e] = a[e]; }
        const bf16_t* wt = (const bf16_t*)(ws + WS_WUP);
        for (int j = gw; j < UPN; j += NGW) {
            const size_t jr = (size_t)(wup_dst(j & ~31) + (j & 31)) * 1024;
            float wf[16]; unpack8(*(const u32x4*)(wt + jr + 8 * lane), wf); unpack8(*(const u32x4*)(wt + jr + 512 + 8 * lane), wf + 8);
            float a0 = 0.f, a1 = 0.f, a2 = 0.f;
#pragma unroll
            for (int e = 0; e < 16; ++e) { a0 += s2[0][e] * wf[e]; a1 += s2[1][e] * wf[e]; a2 += s2[2][e] * wf[e]; }
            a0 = wave_sum(a0); a1 = wave_sum(a1); a2 = wave_sum(a2);
            if (lane == 0) { float* cu = (float*)(ws + WS_CUP); cu[j] = a0; cu[UPN + j] = a1; cu[2 * UPN + j] = a2;
                const float* fw = P.in[I_FCW]; const float wsum = (fw[j] + fw[UPN + j]) + fw[2 * UPN + j], bb = P.in[I_FCB][j]; float* cs = (float*)(ws + WS_CST);
                cs[j] = a0 * wsum + bb; cs[UPN + j] = a1 * wsum + bb; cs[2 * UPN + j] = a2 * wsum + bb; }
        }
    }
}

typedef const f32x4 (&AccRef)[2][2][4][2];
typedef const f32x4 (&AccRef3)[2][2][3][2];
#define EPI_ROWS_M(pm, MFR) _Pragma("unroll") for (int ai = 0; ai < 2; ++ai) _Pragma("unroll") for (int m = 0; m < (MFR); ++m) { const int row = (pm) * (64 * (MFR)) + ai * (32 * (MFR)) + wr * (16 * (MFR)) + m * 16 + fr;
#define EPI_ROWS(pm) _Pragma("unroll") for (int ai = 0; ai < 2; ++ai) _Pragma("unroll") for (int m = 0; m < 4; ++m) { const int row = (pm) * 256 + ai * 128 + wr * 64 + m * 16 + fr;
#define EPI_COLS _Pragma("unroll") for (int bj = 0; bj < 2; ++bj) _Pragma("unroll") for (int n = 0; n < 2; ++n) { const int col = bj * 128 + wc * 32 + n * 16 + fq * 4; const f32x4 v = acc[ai][bj][m][n];
#define EPI_END }
#define EPI_COLS8 _Pragma("unroll") for (int bj = 0; bj < 2; ++bj) { const int col = bj * 128 + wc * 32 + fq * 8; const f32x4 v0 = acc[ai][bj][m][0], v1 = acc[ai][bj][m][1];
__device__ __forceinline__ void st_bf8(bf16_t* p, f32x4 a, f32x4 b) { *(u32x4*)p = (u32x4){pk2(a.x, a.y), pk2(a.z, a.w), pk2(b.x, b.y), pk2(b.z, b.w)}; }
__device__ __forceinline__ void st_bf4(bf16_t* p, f32x4 v) { *(u32x2*)p = (u32x2){pk2(v.x, v.y), pk2(v.z, v.w)}; }
__device__ __forceinline__ f32x4 ld_bf4(const bf16_t* p) { const u32x2 w = *(const u32x2*)p; return (f32x4){bflo(w.x), bfhi(w.x), bflo(w.y), bfhi(w.y)}; }
__device__ __forceinline__ float quad_sum16(float s) { s += __shfl_xor(s, 16); s += __shfl_xor(s, 32); return s; }

struct EpiInMain {
    static constexpr bool PERM = true, AFTER_DRAIN = false;
#if defined(PG8_TIME) && PG8_TPH == 1
    static constexpr bool TIMED = true;
#endif
    bf16_t *cq, *ckv, *z, *xbc, *sgm, *sgs; float *ssq_cq, *ssq_ckv, *new_ckv;
    bf16_t* krope; float *dt, *new_krope; const float* dt_bias; const f32x2* rope;
    __device__ __forceinline__ void operator()(AccRef acc, const pg8::Unit& u, int wr, int wc, int fr, int fq) const {
        const int pn = u.pn;
#ifdef G1_GAP
        { const unsigned t0 = (unsigned)__builtin_amdgcn_s_memrealtime(); while ((unsigned)__builtin_amdgcn_s_memrealtime() - t0 < (unsigned)G1_GAP) __builtin_amdgcn_s_sleep(4); }
#endif
        if (pn == 20) {
            if (wc < 2) {
                EPI_ROWS(u.pm)
                    const f32x4 x0 = acc[ai][0][m][0], x1 = acc[ai][0][m][1]; const int i0 = fq * 4;
                    if (row < RP) {
                        st_bf4(krope + (size_t)row * 64 + wc * 32 + i0, x0); st_bf4(krope + (size_t)row * 64 + wc * 32 + 16 + i0, x1);
                        *(f32x4*)(new_krope + (size_t)row * 64 + wc * 32 + i0) = x0; *(f32x4*)(new_krope + (size_t)row * 64 + wc * 32 + 16 + i0) = x1;
                    } else {
                        const int t = (row - RP) & 2047; const f32x2* rp = rope + t * 32 + wc * 16 + i0; f32x4 o0, o1;
#pragma unroll
                        for (int e = 0; e < 4; ++e) { const f32x2 cs = rp[e]; o0[e] = x0[e] * cs.x - x1[e] * cs.y; o1[e] = x0[e] * cs.y + x1[e] * cs.x; }
                        bf16_t* dst = krope + (size_t)kvrow_of_row(row) * 64 + wc * 32 + i0; st_bf4(dst, o0); st_bf4(dst + 16, o1);
                    }
                EPI_END
            } else if (wc == 2) {
                EPI_ROWS(u.pm)
#pragma unroll
                    for (int n = 0; n < 2; ++n) { const int j = n * 16 + fq * 4; const f32x4 v = acc[ai][0][m][n]; const f32x4 b = *(const f32x4*)(dt_bias + j);
                        *(f32x4*)(dt + (size_t)row * 32 + j) = (f32x4){softplusf(v.x + b.x), softplusf(v.y + b.y), softplusf(v.z + b.z), softplusf(v.w + b.w)}; }
                EPI_END
            }
        } else if (pn < 2) {
            EPI_ROWS(u.pm)
                const int orow = pn == 0 ? row : kvrow_of_row(row); bf16_t* dst = (pn == 0 ? cq : ckv) + (size_t)orow * 256; float s = 0.f;
                EPI_COLS8
                    st_bf8(dst + col, v0, v1); s += ((v0.x * v0.x + v0.y * v0.y) + (v0.z * v0.z + v0.w * v0.w)) + ((v1.x * v1.x + v1.y * v1.y) + (v1.z * v1.z + v1.w * v1.w));
                    if (pn == 1 && row < RP) { *(f32x4*)(new_ckv + (size_t)row * 256 + col) = v0; *(f32x4*)(new_ckv + (size_t)row * 256 + col + 4) = v1; }
                EPI_END
                s = quad_sum16(s);
                if (fq == 0) (pn == 0 ? ssq_cq : ssq_ckv)[(size_t)orow * 4 + wc] = s;
            EPI_END
        } else if (pn < 12) {
            bf16_t* base = pn < 6 ? z : xbc; const int ld = pn < 6 ? 1024 : 1536, c0 = pn < 6 ? (pn - 2) * 256 : (pn - 6) * 256;
            EPI_ROWS(u.pm)
                bf16_t* dst = base + (size_t)row * ld + c0;
                EPI_COLS8 st_bf8(dst + col, v0, v1); EPI_END
            EPI_END
        } else {
            bf16_t* base = pn < 16 ? sgm : sgs; const int c0 = (pn & 3) * 256;
            EPI_ROWS(u.pm)
                bf16_t* dst = base + (size_t)row * 1024 + c0;
                EPI_COLS8 __builtin_nontemporal_store((u32x4){pk2(sigm(v0.x), sigm(v0.y)), pk2(sigm(v0.z), sigm(v0.w)), pk2(sigm(v1.x), sigm(v1.y)), pk2(sigm(v1.z), sigm(v1.w))}, (u32x4*)(dst + col)); EPI_END
            EPI_END
        }
    }
};
struct EpiInTail {
    static constexpr bool PERM = false, AFTER_DRAIN = false;
    bf16_t* krope; float *dt, *new_krope; const float* dt_bias; const f32x2* rope;
    __device__ __forceinline__ void operator()(AccRef acc, const pg8::Unit& u, int wr, int wc, int fr, int fq) const {
        if (wc < 2) {
            EPI_ROWS(u.pm)
                const f32x4 x0 = acc[ai][0][m][0], x1 = acc[ai][0][m][1]; const int i0 = fq * 4;
                if (row < RP) {
                    st_bf4(krope + (size_t)row * 64 + wc * 32 + i0, x0); st_bf4(krope + (size_t)row * 64 + wc * 32 + 16 + i0, x1);
                    *(f32x4*)(new_krope + (size_t)row * 64 + wc * 32 + i0) = x0; *(f32x4*)(new_krope + (size_t)row * 64 + wc * 32 + 16 + i0) = x1;
                } else {
                    const int t = (row - RP) & 2047; const f32x2* rp = rope + t * 32 + wc * 16 + i0; f32x4 o0, o1;
#pragma unroll
                    for (int e = 0; e < 4; ++e) { const f32x2 cs = rp[e]; o0[e] = x0[e] * cs.x - x1[e] * cs.y; o1[e] = x0[e] * cs.y + x1[e] * cs.x; }
                    bf16_t* dst = krope + (size_t)kvrow_of_row(row) * 64 + wc * 32 + i0; st_bf4(dst, o0); st_bf4(dst + 16, o1);
                }
            EPI_END
        } else if (wc == 2) {
            EPI_ROWS(u.pm)
#pragma unroll
                for (int n = 0; n < 2; ++n) { const int j = n * 16 + fq * 4; const f32x4 v = acc[ai][0][m][n]; const f32x4 b = *(const f32x4*)(dt_bias + j);
                    *(f32x4*)(dt + (size_t)row * 32 + j) = (f32x4){softplusf(v.x + b.x), softplusf(v.y + b.y), softplusf(v.z + b.z), softplusf(v.w + b.w)}; }
            EPI_END
        }
    }
};

struct EpiQR {
    static constexpr bool PERM = false, AFTER_DRAIN = false;
    bf16_t* qr; const float* ssq; const f32x2* rope;
    __device__ __forceinline__ void operator()(AccRef acc, const pg8::Unit& u, int wr, int wc, int fr, int fq) const {
        EPI_ROWS(u.pm)
            const f32x4 sq = *(const f32x4*)(ssq + (size_t)row * 4); const float rs = rsqrtf(((sq.x + sq.y) + (sq.z + sq.w)) * (1.f / 256.f) + EPS);
            bf16_t* dst = qr + (size_t)row * 512 + u.pn * 256;
#pragma unroll
            for (int bj = 0; bj < 2; ++bj) { const int cb = bj * 128 + wc * 32, i0 = fq * 4; const f32x4 x0 = acc[ai][bj][m][0] * rs, x1 = acc[ai][bj][m][1] * rs;
                if (row < RP) { st_bf4(dst + cb + i0, x0); st_bf4(dst + cb + 16 + i0, x1); }
                else { const int t = (row - RP) & 2047; const f32x2* rp = rope + t * 32 + (wc & 1) * 16 + i0; f32x4 o0, o1;
#pragma unroll
                    for (int e = 0; e < 4; ++e) { const f32x2 cs = rp[e]; o0[e] = x0[e] * cs.x - x1[e] * cs.y; o1[e] = x0[e] * cs.y + x1[e] * cs.x; }
                    st_bf4(dst + cb + i0, o0); st_bf4(dst + cb + 16 + i0, o1); } }
        EPI_END
    }
};
template <int MFR> struct EpiMla {
    static constexpr bool PERM = true, AFTER_DRAIN = false;
    const bf16_t* sgm; float* t;
    __device__ __forceinline__ void operator()(const f32x4 (&acc)[2][2][MFR][2], const pg8::Unit& u, int wr, int wc, int fr, int fq) const {
        EPI_ROWS_M(u.pm, MFR)
            const size_t off = (size_t)row * 1024 + u.pn * 256;
            EPI_COLS8 const u32x4 gw = *(const u32x4*)(sgm + off + col);
                *(f32x4*)(t + off + col) = (f32x4){bflo(gw.x), bfhi(gw.x), bflo(gw.y), bfhi(gw.y)} * v0; *(f32x4*)(t + off + col + 4) = (f32x4){bflo(gw.z), bfhi(gw.z), bflo(gw.w), bfhi(gw.w)} * v1; EPI_END
        EPI_END
    }
};
template <int MFR> struct EpiSsd {
    static constexpr bool PERM = true, AFTER_DRAIN = false;
    const bf16_t* sgs; const float* t; const float* ssq_y; bf16_t* merged;
    __device__ __forceinline__ void operator()(const f32x4 (&acc)[2][2][MFR][2], const pg8::Unit& u, int wr, int wc, int fr, int fq) const {
        EPI_ROWS_M(u.pm, MFR)
            float s = 0.f;
#pragma unroll
            for (int q = 0; q < 4; ++q) { const f32x4 a = *(const f32x4*)(ssq_y + (size_t)row * 16 + q * 4); s += (a.x + a.y) + (a.z + a.w); }
            const float rs = rsqrtf(s * (1.f / 1024.f) + EPS); const size_t off = (size_t)row * 1024 + u.pn * 256;
            EPI_COLS8 const u32x4 gw = *(const u32x4*)(sgs + off + col);
                st_bf8(merged + off + col, *(const f32x4*)(t + off + col) + (f32x4){bflo(gw.x), bfhi(gw.x), bflo(gw.y), bfhi(gw.y)} * (v0 * rs),
                       *(const f32x4*)(t + off + col + 4) + (f32x4){bflo(gw.z), bfhi(gw.z), bflo(gw.w), bfhi(gw.w)} * (v1 * rs)); EPI_END
        EPI_END
    }
};
template <int MFR> struct EpiOut {
    static constexpr bool PERM = true, AFTER_DRAIN = false;
    const float *xp, *xs, *mod, *gffn; bf16_t* x1; bf16_t* a1; float* ssq2;
    __device__ __forceinline__ void operator()(const f32x4 (&acc)[2][2][MFR][2], const pg8::Unit& u, int wr, int wc, int fr, int fq) const {
        EPI_ROWS_M(u.pm, MFR)
            const float* md = mod + grp_of_row(row) * 6144;
            const float* xr = row < RP ? xp + (size_t)row * DM : xs + (size_t)(row - RP) * DM; const size_t off = (size_t)row * 1024; float s = 0.f;
            EPI_COLS8
                const int c = u.pn * 256 + col;
                const f32x4 xa = __builtin_nontemporal_load((const f32x4*)(xr + c)) + *(const f32x4*)(md + 2048 + c) * v0, xb = __builtin_nontemporal_load((const f32x4*)(xr + c + 4)) + *(const f32x4*)(md + 2048 + c + 4) * v1;
                st_bf8(x1 + off + c, xa, xb);
                s += ((xa.x * xa.x + xa.y * xa.y) + (xa.z * xa.z + xa.w * xa.w)) + ((xb.x * xb.x + xb.y * xb.y) + (xb.z * xb.z + xb.w * xb.w));
                st_bf8(a1 + off + c, xa * *(const f32x4*)(gffn + c) * (*(const f32x4*)(md + 4096 + c) + 1.f), xb * *(const f32x4*)(gffn + c + 4) * (*(const f32x4*)(md + 4096 + c + 4) + 1.f));
            EPI_END
            s = quad_sum16(s);
            if (fq == 0) ssq2[(size_t)row * 16 + u.pn * 4 + wc] = s;
        EPI_END
    }
};
struct EpiUp {
    static constexpr bool PERM = true, AFTER_DRAIN = false;
    const float *ssq2, *cup; bf16_t* uo; int pm_off;
    __device__ __forceinline__ void operator()(AccRef acc, const pg8::Unit& u, int wr, int wc, int fr, int fq) const {
        const int pmo = u.pm + pm_off; const int g = pmo < 32 ? 0 : 1 + ((pmo - 32) >> 3); const float* cu = cup + g * UPN + u.pn * 256;
        EPI_ROWS(pmo)
            float s = 0.f;
#pragma unroll
            for (int q = 0; q < 4; ++q) { const f32x4 a = *(const f32x4*)(ssq2 + (size_t)row * 16 + q * 4); s += (a.x + a.y) + (a.z + a.w); }
            const float rs = rsqrtf(s * (1.f / 1024.f) + EPS); bf16_t* dst = uo + (size_t)row * UPN + u.pn * 256;
            EPI_COLS8 st_bf8(dst + col, v0 * rs + *(const f32x4*)(cu + col), v1 * rs + *(const f32x4*)(cu + col + 4)); EPI_END
        EPI_END
    }
};
constexpr int CG_RB = 16;
struct CgW { float wg[3][8], wv[3][8], bg[8], bv[8]; };
__device__ __forceinline__ void cg_load_w(CgW& W, const float* fw, const float* fb, int c) {
#pragma unroll
    for (int k = 0; k < 3; ++k)
#pragma unroll
        for (int q = 0; q < 2; ++q) { const f32x4 a = *(const f32x4*)(fw + k * UPN + c + 4 * q), b = *(const f32x4*)(fw + k * UPN + DFF + c + 4 * q);
#pragma unroll
            for (int e = 0; e < 4; ++e) { W.wg[k][4 * q + e] = a[e]; W.wv[k][4 * q + e] = b[e]; } }
#pragma unroll
    for (int q = 0; q < 2; ++q) { const f32x4 a = *(const f32x4*)(fb + c + 4 * q), b = *(const f32x4*)(fb + DFF + c + 4 * q);
#pragma unroll
        for (int e = 0; e < 4; ++e) { W.bg[4 * q + e] = a[e]; W.bv[4 * q + e] = b[e]; } }
}
__device__ __forceinline__ float dpp_row_prev(float cur, float prv) {
    const int o = __builtin_amdgcn_update_dpp(0, __float_as_int(prv), 0x121, 0xf, 0xf, true);
    return __int_as_float(__builtin_amdgcn_update_dpp(o, __float_as_int(cur), 0x111, 0xf, 0xf, false)); }
__device__ __forceinline__ float dpp_row_next(float cur, float nxt) {
    const int o = __builtin_amdgcn_update_dpp(0, __float_as_int(nxt), 0x12F, 0xf, 0xf, true);
    return __int_as_float(__builtin_amdgcn_update_dpp(o, __float_as_int(cur), 0x101, 0xf, 0xf, false)); }
__device__ __forceinline__ void conv4_rows(float (&c)[4], float a0, float a1, float a2, float a3, float r0, float r1, float r2, float r3,
                                           float w0, float w1, float w2, float cs) {
    float t0, t1, t2, t3, z; const unsigned long long mlo = 0x0001000100010001ull, mhi = 0x8000800080008000ull;
    asm volatile(
        "v_cndmask_b32_e64 %[z], 0, %[w0], %[mlo]\n\t"
        "v_mul_f32 %[t0], %[a0], %[r0]\n\t" "v_mul_f32 %[t1], %[a1], %[r1]\n\t" "v_mul_f32 %[t2], %[a2], %[r2]\n\t" "v_mul_f32 %[t3], %[a3], %[r3]\n\t"
        "v_fma_f32 %[c0], %[w1], %[t0], %[cs]\n\t" "v_fma_f32 %[c1], %[w1], %[t1], %[cs]\n\t" "v_fma_f32 %[c2], %[w1], %[t2], %[cs]\n\t" "v_fma_f32 %[c3], %[w1], %[t3], %[cs]\n\t"
        "v_fmac_f32_dpp %[c0], %[t0], %[w0] row_shr:1 row_mask:0xf bank_mask:0xf bound_ctrl:1\n\t"
        "v_fmac_f32_dpp %[c1], %[t1], %[w0] row_shr:1 row_mask:0xf bank_mask:0xf bound_ctrl:1\n\t"
        "v_fmac_f32_dpp %[c2], %[t2], %[w0] row_shr:1 row_mask:0xf bank_mask:0xf bound_ctrl:1\n\t"
        "v_fmac_f32_dpp %[c3], %[t3], %[w0] row_shr:1 row_mask:0xf bank_mask:0xf bound_ctrl:1\n\t"
        "v_fmac_f32_dpp %[c0], %[t0], %[w2] row_shl:1 row_mask:0xf bank_mask:0xf bound_ctrl:1\n\t"
        "v_fmac_f32_dpp %[c1], %[t1], %[w2] row_shl:1 row_mask:0xf bank_mask:0xf bound_ctrl:1\n\t"
        "v_fmac_f32_dpp %[c2], %[t2], %[w2] row_shl:1 row_mask:0xf bank_mask:0xf bound_ctrl:1\n\t"
        "v_fmac_f32_dpp %[c3], %[t3], %[w2] row_shl:1 row_mask:0xf bank_mask:0xf bound_ctrl:1\n\t"
        "v_fmac_f32_dpp %[c1], %[t0], %[z] row_ror:1 row_mask:0xf bank_mask:0xf\n\t"
        "v_fmac_f32_dpp %[c2], %[t1], %[z] row_ror:1 row_mask:0xf bank_mask:0xf\n\t"
        "v_fmac_f32_dpp %[c3], %[t2], %[z] row_ror:1 row_mask:0xf bank_mask:0xf\n\t"
        "v_cndmask_b32_e64 %[z], 0, %[w2], %[mhi]\n\t"
        "v_fmac_f32_dpp %[c0], %[t1], %[z] row_ror:15 row_mask:0xf bank_mask:0xf\n\t"
        "v_fmac_f32_dpp %[c1], %[t2], %[z] row_ror:15 row_mask:0xf bank_mask:0xf\n\t"
        "v_fmac_f32_dpp %[c2], %[t3], %[z] row_ror:15 row_mask:0xf bank_mask:0xf"
        : [c0] "=&v"(c[0]), [c1] "=&v"(c[1]), [c2] "=&v"(c[2]), [c3] "=&v"(c[3]), [t0] "=&v"(t0), [t1] "=&v"(t1), [t2] "=&v"(t2), [t3] "=&v"(t3), [z] "=&v"(z)
        : [a0] "v"(a0), [a1] "v"(a1), [a2] "v"(a2), [a3] "v"(a3), [r0] "v"(r0), [r1] "v"(r1), [r2] "v"(r2), [r3] "v"(r3),
          [w0] "v"(w0), [w1] "v"(w1), [w2] "v"(w2), [cs] "v"(cs), [mlo] "s"(mlo), [mhi] "s"(mhi));
}
__device__ __forceinline__ void conv4_taps(float (&c)[4], float t0, float t1, float t2, float t3, float w0, float w2) {
    float z; const unsigned long long mlo = 0x0001000100010001ull, mhi = 0x8000800080008000ull;
    asm volatile(
        "v_cndmask_b32_e64 %[z], 0, %[w0], %[mlo]\n\t" "s_nop 1\n\t"
        "v_fmac_f32_dpp %[c0], %[t0], %[w0] row_shr:1 row_mask:0xf bank_mask:0xf bound_ctrl:1\n\t"
        "v_fmac_f32_dpp %[c1], %[t1], %[w0] row_shr:1 row_mask:0xf bank_mask:0xf bound_ctrl:1\n\t"
        "v_fmac_f32_dpp %[c2], %[t2], %[w0] row_shr:1 row_mask:0xf bank_mask:0xf bound_ctrl:1\n\t"
        "v_fmac_f32_dpp %[c3], %[t3], %[w0] row_shr:1 row_mask:0xf bank_mask:0xf bound_ctrl:1\n\t"
        "v_fmac_f32_dpp %[c0], %[t0], %[w2] row_shl:1 row_mask:0xf bank_mask:0xf bound_ctrl:1\n\t"
        "v_fmac_f32_dpp %[c1], %[t1], %[w2] row_shl:1 row_mask:0xf bank_mask:0xf bound_ctrl:1\n\t"
        "v_fmac_f32_dpp %[c2], %[t2], %[w2] row_shl:1 row_mask:0xf bank_mask:0xf bound_ctrl:1\n\t"
        "v_fmac_f32_dpp %[c3], %[t3], %[w2] row_shl:1 row_mask:0xf bank_mask:0xf bound_ctrl:1\n\t"
        "v_fmac_f32_dpp %[c1], %[t0], %[z] row_ror:1 row_mask:0xf bank_mask:0xf\n\t"
        "v_fmac_f32_dpp %[c2], %[t1], %[z] row_ror:1 row_mask:0xf bank_mask:0xf\n\t"
        "v_fmac_f32_dpp %[c3], %[t2], %[z] row_ror:1 row_mask:0xf bank_mask:0xf\n\t"
        "v_cndmask_b32_e64 %[z], 0, %[w2], %[mhi]\n\t"
        "v_fmac_f32_dpp %[c0], %[t1], %[z] row_ror:15 row_mask:0xf bank_mask:0xf\n\t"
        "v_fmac_f32_dpp %[c1], %[t2], %[z] row_ror:15 row_mask:0xf bank_mask:0xf\n\t"
        "v_fmac_f32_dpp %[c2], %[t3], %[z] row_ror:15 row_mask:0xf bank_mask:0xf"
        : [c0] "+v"(c[0]), [c1] "+v"(c[1]), [c2] "+v"(c[2]), [c3] "+v"(c[3]), [z] "=&v"(z)
        : [t0] "v"(t0), [t1] "v"(t1), [t2] "v"(t2), [t3] "v"(t3), [w0] "v"(w0), [w2] "v"(w2), [mlo] "s"(mlo), [mhi] "s"(mhi));
}
struct EpiUpGate {
    static constexpr bool PERM = true, AFTER_DRAIN = false;
#if defined(PG8_TIME) && PG8_TPH == 5
    static constexpr bool TIMED = true;
#endif
    static constexpr bool HALF_M = true;
    static constexpr int PRE_SLOT = 1024, PRE_BYTES = 5120;
    const float *ssq2, *cup, *fcw, *cstp; bf16_t *ug, *halo;
    __device__ __forceinline__ void pre(const pg8::Unit& u, LAS unsigned char* slot, int wr, int wc, int lane) const {
        if (wr != 0) return;
        asm volatile("" : "+v"(lane));
        const int g = u.pm < 32 ? 0 : 1 + ((u.pm - 32) >> 3); const int cb = u.pn * 128 + wc * 32; const int a = lane >> 4, hv = (lane >> 3) & 1, c4 = lane & 7;
        const float* src = (a < 3 ? fcw + a * UPN : cstp + g * UPN) + hv * DFF + cb + c4 * 4;
        __builtin_amdgcn_global_load_lds((const unsigned*)src, (LAS unsigned*)(slot + wc * 1280), 16, 0, 0);
        if (lane < 16) __builtin_amdgcn_global_load_lds((const unsigned*)(cup + g * UPN + hv * DFF + cb + c4 * 4), (LAS unsigned*)(slot + wc * 1280 + 1024), 16, 0, 0);
    }
    struct Early { f32x4 raw[4]; };
    __device__ __forceinline__ Early early(const pg8::Unit& u, int wr, int fr, int fq) const {
        asm volatile("" : "+v"(fr), "+v"(fq));
        const char* sb = (const char*)(ssq2 + (size_t)(u.pm * 256 + u.half * 128 + wr * 64) * 16); const size_t slo = (unsigned)fr * 64u + (unsigned)fq * 16u; Early e;
#pragma unroll
        for (int m = 0; m < 4; ++m) e.raw[m] = *(const f32x4*)(sb + m * 1024 + slo);
        return e;
    }
    __device__ __forceinline__ void operator()(const f32x4 (&acc)[2][2][4][2], const pg8::Unit& u, int wr, int wc, int fr, int fq, LAS unsigned char* slot, const Early& ev) const {
        asm volatile("" : "+v"(fr), "+v"(fq));
        const int cb = u.pn * 128 + wc * 32;
        LAS const unsigned char* cl = slot + wc * 1280 + fq * 32;
        const char* sb = (const char*)(ssq2 + (size_t)(u.pm * 256 + u.half * 128 + wr * 64) * 16); const size_t slo = (unsigned)fr * 64u + (unsigned)fq * 16u;
        f32x4 raw[4]; float part[4] = {0.f, 0.f, 0.f, 0.f};
#pragma unroll
        for (int m = 0; m < 4; ++m) raw[m] = ev.raw[m];
#pragma unroll
        for (int ai = 0; ai < 2; ++ai) {
            if (ai == 1 && u.hm) continue;
            const int row0 = u.pm * 256 + u.half * 128 + ai * 128 + wr * 64;
            float rsv[4];
#pragma unroll
            for (int m = 0; m < 4; ++m) rsv[m] = rsqrtf(quad_sum16(ai == 0 ? (raw[m].x + raw[m].y) + (raw[m].z + raw[m].w) : part[m]) * (1.f / 1024.f) + EPS);
            if (ai == 0) {
#pragma unroll
                for (int m = 0; m < 4; ++m) raw[m] = *(const f32x4*)(sb + 128 * 64 + m * 1024 + slo); }
            unsigned pk[4][4];
#ifdef CG_REP
            for (int rep = 0; rep < CG_REP; ++rep)
#endif
            f32x2 cw[2][4][2];
#pragma unroll
            for (int a = 0; a < 4; ++a)
#pragma unroll
                for (int hv = 0; hv < 2; ++hv) cw[0][a][hv] = *(LAS const f32x2*)(cl + a * 256 + hv * 128);
#pragma unroll
            for (int h = 0; h < 4; ++h) {
                if (h < 3) {
#pragma unroll
                    for (int a = 0; a < 4; ++a)
#pragma unroll
                        for (int hv = 0; hv < 2; ++hv) cw[(h + 1) & 1][a][hv] = *(LAS const f32x2*)(cl + a * 256 + hv * 128 + (h + 1) * 8); }
                const f32x2 (&w0)[2] = cw[h & 1][0], (&w1)[2] = cw[h & 1][1], (&w2)[2] = cw[h & 1][2], (&cst)[2] = cw[h & 1][3];
                float o[4][2];
                f32x2 tp[2][4], cp[2][4];
#pragma unroll
                for (int hv = 0; hv < 2; ++hv)
#pragma unroll
                    for (int m = 0; m < 4; ++m) { const f32x4 a4 = acc[ai][hv][m][h >> 1]; const f32x2 a2 = (h & 1) ? (f32x2){a4.z, a4.w} : (f32x2){a4.x, a4.y};
                        tp[hv][m] = a2 * rsv[m]; cp[hv][m] = w1[hv] * tp[hv][m] + cst[hv]; }
#pragma unroll
                for (int e2 = 0; e2 < 2; ++e2) {
                    float cv[2][4];
#pragma unroll
                    for (int hv = 0; hv < 2; ++hv) {
#pragma unroll
                        for (int m = 0; m < 4; ++m) cv[hv][m] = cp[hv][m][e2];
                        conv4_taps(cv[hv], tp[hv][0][e2], tp[hv][1][e2], tp[hv][2][e2], tp[hv][3][e2], w0[hv][e2], w2[hv][e2]); }
#pragma unroll
                    for (int m = 0; m < 4; ++m) o[m][e2] = siluf(cv[0][m]) * cv[1][m];
                }
#pragma unroll
                for (int m = 0; m < 4; ++m) pk[m][h] = pk2(o[m][0], o[m][1]);
                if (ai == 0 && h == 0) {
#pragma unroll
                    for (int m = 0; m < 4; ++m) part[m] = (raw[m].x + raw[m].y) + (raw[m].z + raw[m].w); }
                __builtin_amdgcn_sched_barrier(0);
            }
            { char* ub = (char*)(ug + (size_t)row0 * DFF + cb); const size_t lo = (unsigned)fr * (unsigned)(DFF * 2) + (unsigned)fq * 16u;
#pragma unroll
                for (int m = 0; m < 4; ++m) { const bool edge = (m == 0 && fr == 0) || (m == 3 && fr == 15);
#if 1
                    if (!edge) __builtin_nontemporal_store((u32x4){pk[m][0], pk[m][1], pk[m][2], pk[m][3]}, (u32x4*)(ub + (size_t)m * 16 * DFF * 2 + lo)); } }
#else
                    if (!edge) *(u32x4*)(ub + (size_t)m * 16 * DFF * 2 + lo) = (u32x4){pk[m][0], pk[m][1], pk[m][2], pk[m][3]}; } }
#endif
            const int slab = u.pm * 4 + u.half * 2 + ai * 2 + wr; char* hb = (char*)(halo + (size_t)slab * 4 * UPN + cb);
#pragma unroll
            for (int mm = 0; mm < 2; ++mm) { const int m = mm * 3; const bool act = mm == 0 ? (fr < 2) : (fr >= 14); const unsigned r4 = mm == 0 ? fr : fr - 12;
                if (act) { const size_t ho = r4 * (unsigned)(UPN * 2) + (unsigned)fq * 16u;
#pragma unroll
                    for (int hv = 0; hv < 2; ++hv) { const f32x4 c0 = *(LAS const f32x4*)(cl + 1024 + hv * 128), c1 = *(LAS const f32x4*)(cl + 1024 + hv * 128 + 16);
                        st_bf8((bf16_t*)(hb + hv * DFF * 2 + ho), acc[ai][hv][m][0] * rsv[m] + c0, acc[ai][hv][m][1] * rsv[m] + c1); } } }
        }
#ifdef EPI_DRAIN
        asm volatile("s_waitcnt vmcnt(0)" ::: "memory");
#endif
    }
};
__device__ __forceinline__ void fixup_rows(const Params& P, int row_lo, int row_hi, int tid) {
    if (tid >= DFF / 8) return;
    unsigned char* ws = P.ws; const bf16_t* halo = (const bf16_t*)(ws + WS_HALO); bf16_t* ug = (bf16_t*)(ws + WS_UG); const int c = tid * 8;
    CgW W; cg_load_w(W, P.in[I_FCW], P.in[I_FCB], c);
    const u32x4 zero = {0u, 0u, 0u, 0u};
#pragma unroll 3
    for (int k = row_lo / 64; k < row_hi / 64; ++k)
#pragma unroll
        for (int wh = 0; wh < 2; ++wh) {
            const int row = 64 * k + (wh ? 63 : 0); const int t = row < RP ? (row & 255) : ((row - RP) & 2047), L = row < RP ? SEQP : SEQS;
            const bf16_t* hp = nullptr; const bf16_t* hc; const bf16_t* hn = nullptr;
            if (wh == 0) { hc = halo + ((size_t)k * 4 + 0) * UPN; hn = halo + ((size_t)k * 4 + 1) * UPN; if (t > 0) hp = halo + ((size_t)(k - 1) * 4 + 3) * UPN; }
            else { hp = halo + ((size_t)k * 4 + 2) * UPN; hc = halo + ((size_t)k * 4 + 3) * UPN; if (t < L - 1) hn = halo + ((size_t)(k + 1) * 4 + 0) * UPN; }
            const u32x4 gp = hp ? *(const u32x4*)(hp + c) : zero, vp = hp ? *(const u32x4*)(hp + DFF + c) : zero;
            const u32x4 gc = *(const u32x4*)(hc + c), vc = *(const u32x4*)(hc + DFF + c);
            const u32x4 gn = hn ? *(const u32x4*)(hn + c) : zero, vn = hn ? *(const u32x4*)(hn + DFF + c) : zero;
            float a[8], b[8], x[8];
#pragma unroll
            for (int e = 0; e < 8; ++e) { a[e] = W.bg[e]; b[e] = W.bv[e]; }
            unpack8(gp, x);
#pragma unroll
            for (int e = 0; e < 8; ++e) a[e] += x[e] * W.wg[0][e];
            unpack8(gc, x);
#pragma unroll
            for (int e = 0; e < 8; ++e) a[e] += x[e] * W.wg[1][e];
            unpack8(gn, x);
#pragma unroll
            for (int e = 0; e < 8; ++e) a[e] += x[e] * W.wg[2][e];
            unpack8(vp, x);
#pragma unroll
            for (int e = 0; e < 8; ++e) b[e] += x[e] * W.wv[0][e];
            unpack8(vc, x);
#pragma unroll
            for (int e = 0; e < 8; ++e) b[e] += x[e] * W.wv[1][e];
            unpack8(vn, x);
#pragma unroll
            for (int e = 0; e < 8; ++e) b[e] += x[e] * W.wv[2][e];
            u32x4 o;
#pragma unroll
            for (int e = 0; e < 4; ++e) o[e] = pk2(siluf(a[2 * e]) * b[2 * e], siluf(a[2 * e + 1]) * b[2 * e + 1]);
            *(u32x4*)(ug + (size_t)row * DFF + c) = o;
        }
}

template <int MFR> struct EpiDown {
    static constexpr bool PERM = true, AFTER_DRAIN = false;
    const float* mod; float* x; const bf16_t* x1;
    __device__ __forceinline__ void operator()(const f32x4 (&acc)[2][2][MFR][2], const pg8::Unit& u, int wr, int wc, int fr, int fq) const {
        EPI_ROWS_M(u.pm, MFR)
            const float* g2 = mod + grp_of_row(row) * 6144 + 5120 + u.pn * 256;
            float* xr = x + (size_t)row * 1024 + u.pn * 256; const bf16_t* x1r = x1 + (size_t)row * 1024 + u.pn * 256;
            EPI_COLS8 const u32x4 w = *(const u32x4*)(x1r + col);
                *(f32x4*)(xr + col) = (f32x4){bflo(w.x), bfhi(w.x), bflo(w.y), bfhi(w.y)} + *(const f32x4*)(g2 + col) * v0; *(f32x4*)(xr + col + 4) = (f32x4){bflo(w.z), bfhi(w.z), bflo(w.w), bfhi(w.w)} + *(const f32x4*)(g2 + col + 4) * v1; EPI_END
        EPI_END
    }
};

struct EpiDownNorm {
    static constexpr bool PERM = true, AFTER_DRAIN = true;
#if defined(PG8_TIME) && PG8_TPH == 6
    static constexpr bool TIMED = true;
#endif
    const float* mod; float* x; const bf16_t* x1; const float* gfin; float* xbuf; unsigned* cnt;
    __device__ __forceinline__ void fused(f32x4 (&acc)[2][2][3][2], const pg8::Unit& u, int wr, int wc, int fr, int fq, LAS unsigned char* lds, int wid, int lane) const {
        LAS float* Pt = (LAS float*)lds;
        LAS float* St = (LAS float*)(lds + 4096);
        EPI_ROWS_M(u.pm, 3)
            const float* g2 = mod + grp_of_row(row) * 6144 + 5120 + u.pn * 256; const bf16_t* xr = x1 + (size_t)row * 1024 + u.pn * 256; float s = 0.f;
#pragma unroll
            for (int bj = 0; bj < 2; ++bj) { const int col = bj * 128 + wc * 32 + fq * 8; const u32x4 w = *(const u32x4*)(xr + col);
                const f32x4 a = (f32x4){bflo(w.x), bfhi(w.x), bflo(w.y), bfhi(w.y)} + *(const f32x4*)(g2 + col) * acc[ai][bj][m][0], b = (f32x4){bflo(w.z), bfhi(w.z), bflo(w.w), bfhi(w.w)} + *(const f32x4*)(g2 + col + 4) * acc[ai][bj][m][1];
                acc[ai][bj][m][0] = a; acc[ai][bj][m][1] = b;
                s += ((a.x * a.x + a.y * a.y) + (a.z * a.z + a.w * a.w)) + ((b.x * b.x + b.y * b.y) + (b.z * b.z + b.w * b.w)); }
            s = quad_sum16(s);
            if (fq == 0) Pt[(ai * 96 + wr * 48 + m * 16 + fr) * 4 + wc] = s;
        EPI_END
        asm volatile("s_waitcnt lgkmcnt(0)" ::: "memory"); __builtin_amdgcn_s_barrier(); asm volatile("" ::: "memory");
        const int rloc = wid * 32 + (lane & 31);
        if (lane < 32 && rloc < 192) { const float tot = (Pt[rloc * 4 + 0] + Pt[rloc * 4 + 1]) + (Pt[rloc * 4 + 2] + Pt[rloc * 4 + 3]);
            __hip_atomic_store(xbuf + ((size_t)(u.pm * 192 + rloc) * 4 + u.pn), tot, __ATOMIC_RELAXED, __HIP_MEMORY_SCOPE_AGENT); }
        asm volatile("s_waitcnt vmcnt(0)" ::: "memory");
        if (lane == 0) __hip_atomic_fetch_add(cnt + 16 * u.pm, 1u, __ATOMIC_RELAXED, __HIP_MEMORY_SCOPE_AGENT);
        if (wid == 0) { unsigned sp = 0;
            while ((unsigned)__builtin_amdgcn_readfirstlane(__hip_atomic_load(cnt + 16 * u.pm, __ATOMIC_RELAXED, __HIP_MEMORY_SCOPE_AGENT)) < 32u) { __builtin_amdgcn_s_sleep(2); if (++sp > (1u << 22)) break; }
            __builtin_amdgcn_fence(__ATOMIC_ACQUIRE, "agent"); }
        asm volatile("s_waitcnt vmcnt(0) lgkmcnt(0)" ::: "memory"); __builtin_amdgcn_s_barrier(); asm volatile("" ::: "memory");
        if (lane < 32 && rloc < 192) { const float* sl = xbuf + (size_t)(u.pm * 192 + rloc) * 4; float tot = 0.f;
#pragma unroll
            for (int t = 0; t < 4; ++t) tot += __hip_atomic_load(sl + t, __ATOMIC_RELAXED, __HIP_MEMORY_SCOPE_AGENT);
            St[rloc] = rsqrtf(tot * (1.f / 1024.f) + EPS); }
        asm volatile("s_waitcnt lgkmcnt(0)" ::: "memory"); __builtin_amdgcn_s_barrier(); asm volatile("" ::: "memory");
        EPI_ROWS_M(u.pm, 3)
            const float rs = St[ai * 96 + wr * 48 + m * 16 + fr]; float* xr = x + (size_t)row * 1024 + u.pn * 256; const float* gf = gfin + u.pn * 256;
#pragma unroll
            for (int bj = 0; bj < 2; ++bj) { const int col = bj * 128 + wc * 32 + fq * 8;
                *(f32x4*)(xr + col) = acc[ai][bj][m][0] * rs * *(const f32x4*)(gf + col); *(f32x4*)(xr + col + 4) = acc[ai][bj][m][1] * rs * *(const f32x4*)(gf + col + 4); }
        EPI_END
    }
};

struct Gemm2Order {
    int G, c;
    __device__ void init(int G_, int c_) { G = G_; c = c_; }
    __device__ bool next(int i, pg8::Unit& u) const {
        const int L = i * G + c; if (L >= 608) return false;
        if (L < 416) { u.pm = 48 + L % 52; u.pn = 6 + L / 52; } else { const int l = L - 416; u.pm = l % 48; u.pn = l / 48; }
        return true;
    }
    __device__ __forceinline__ void a_ready(const pg8::Unit&) const {}
    __device__ __forceinline__ void done(const pg8::Unit&) const {}
};
struct EpiG2 {
    static constexpr bool PERM = true, AFTER_DRAIN = false;
#if defined(PG8_TIME) && PG8_TPH == 2
    static constexpr bool TIMED = true;
#endif
    bf16_t *qn, *kv; const float *ssq_cq, *ssq_ckv;
    __device__ __forceinline__ void operator()(AccRef acc, const pg8::Unit& u, int wr, int wc, int fr, int fq) const {
        if (u.pn >= 6) {
            const int pm = u.pm - 48, pn = u.pn - 6;
            EPI_ROWS(pm)
                const f32x4 sq = *(const f32x4*)(ssq_ckv + (size_t)row * 4); const float rs = rsqrtf(((sq.x + sq.y) + (sq.z + sq.w)) * (1.f / 256.f) + EPS);
                bf16_t* dst = kv + (size_t)row * 2048 + pn * 256;
                EPI_COLS8 st_bf8(dst + col, v0 * rs, v1 * rs); EPI_END
            EPI_END
        } else {
            EPI_ROWS(u.pm)
                const f32x4 sq = *(const f32x4*)(ssq_cq + (size_t)row * 4); const float rs = rsqrtf(((sq.x + sq.y) + (sq.z + sq.w)) * (1.f / 256.f) + EPS);
                bf16_t* dst = qn + (size_t)row * 1024 + u.pn * 256;
                EPI_COLS8 st_bf8(dst + col, v0 * rs, v1 * rs); EPI_END
            EPI_END
        }
    }
};
static_assert(WS_CKVA - WS_CQ == (size_t)48 * 256 * 256 * 2 && WS_WUKV - WS_WUQ == (size_t)6 * 256 * 256 * 2, "GEMM2 addressing");

struct PairOrder {
    int nwg, G, c;
    __device__ void init(int G_, int c_) { nwg = 256; G = G_; c = c_; }
    __device__ bool next(int i, pg8::Unit& u) const {
        const int k = i >> 1; const long L = (long)k * G + c; if (L >= nwg) return false;
        int wgid = (int)L; { const int q = nwg / 8, xcd = wgid % 8, off = wgid / 8; wgid = xcd * q + off; }
        const int nig = 8 * 4, gid = wgid / nig, fm = gid * 8; const int pm = fm + ((wgid % nig) % 8), pn = (wgid % nig) / 8;
        if ((i & 1) == 0) { u.pm = pm + 160; u.pn = pn; } else { u.pm = pm; u.pn = pn + 4; }
        return true;
    }
    __device__ __forceinline__ void a_ready(const pg8::Unit&) const {}
    __device__ __forceinline__ void done(const pg8::Unit&) const {}
};
struct EpiMerged {
    static constexpr bool PERM = true, AFTER_DRAIN = false;
#if defined(PG8_TIME) && PG8_TPH == 3
    static constexpr bool TIMED = true;
#endif
    struct State { u32x4 t[2][3][2]; };
    const bf16_t *sgm, *sgs; const float* ssq_y; bf16_t* merged;
    __device__ __forceinline__ void operator()(const f32x4 (&acc)[2][2][3][2], const pg8::Unit& u, int wr, int wc, int fr, int fq, State& st) const {
        if (u.pn < 4) {
            const int pm = u.pm - 160;
            EPI_ROWS_M(pm, 3)
                const size_t off = (size_t)row * 1024 + u.pn * 256;
                EPI_COLS8 const u32x4 gw = __builtin_nontemporal_load((const u32x4*)(sgm + off + col));
                    const f32x4 a = (f32x4){bflo(gw.x), bfhi(gw.x), bflo(gw.y), bfhi(gw.y)} * v0, b = (f32x4){bflo(gw.z), bfhi(gw.z), bflo(gw.w), bfhi(gw.w)} * v1;
                    st.t[ai][m][bj] = (u32x4){pk2(a.x, a.y), pk2(a.z, a.w), pk2(b.x, b.y), pk2(b.z, b.w)}; EPI_END
            EPI_END
        } else {
            const int pn = u.pn - 4;
            EPI_ROWS_M(u.pm, 3)
                const f32x4 a = *(const f32x4*)(ssq_y + (size_t)row * 16 + fq * 4);
                const float rs = rsqrtf(quad_sum16((a.x + a.y) + (a.z + a.w)) * (1.f / 1024.f) + EPS); const size_t off = (size_t)row * 1024 + pn * 256;
                EPI_COLS8 const u32x4 gw = __builtin_nontemporal_load((const u32x4*)(sgs + off + col)); const u32x4 tw = st.t[ai][m][bj];
                    st_bf8(merged + off + col, (f32x4){bflo(tw.x), bfhi(tw.x), bflo(tw.y), bfhi(tw.y)} + (f32x4){bflo(gw.x), bfhi(gw.x), bflo(gw.y), bfhi(gw.y)} * (v0 * rs),
                           (f32x4){bflo(tw.z), bfhi(tw.z), bflo(tw.w), bfhi(tw.w)} + (f32x4){bflo(gw.z), bfhi(gw.z), bflo(gw.w), bfhi(gw.w)} * (v1 * rs)); EPI_END
            EPI_END
        }
    }
};
static_assert(WS_QN - WS_Z == (size_t)160 * 192 * 1024 * 2 && WS_WOSSD - WS_WOMLA == (size_t)4 * 256 * 1024 * 2, "GEMM3 pair addressing");

struct UpMain {
    pg8::StaticOrder S; int G;
    __device__ void init(int M, int N, int G_, int c_) { S.init(M, N, G_, c_); G = G_; }
    __device__ __forceinline__ bool next(int i, pg8::Unit& u) const { if (G == 256 && i >= 4) return false; pg8::Unit t; const bool ok = S.next(i, t); u.pm = t.pm; u.pn = t.pn; u.half = 0; u.hm = 0; return ok; }
    __device__ __forceinline__ void a_ready(const pg8::Unit&) const {}
    __device__ __forceinline__ void done(const pg8::Unit&) const {}
};
struct UpTail {
    pg8::StaticOrder S; int c;
    __device__ void init(int M, int N, int G_, int c_) { S.init(M, N, G_, c_); c = c_; }
    __device__ __forceinline__ bool next(int i, pg8::Unit& u) const { if (i > 0 || c >= 64) return false; pg8::Unit t; const bool ok = S.at(1024 + (c & 7) + 8 * (c >> 4), t); u.pm = t.pm; u.pn = t.pn; u.half = (c >> 3) & 1; u.hm = 1; return ok; }
    __device__ __forceinline__ void a_ready(const pg8::Unit&) const {}
    __device__ __forceinline__ void done(const pg8::Unit&) const {}
};
template <class Epi>
__device__ __forceinline__ void run_gemm(LAS unsigned char* lds, const bf16_t* A, const bf16_t* Bt, int M, int N, int K, int G, int c, const Epi& E) {
    pg8::Gemm g{A, Bt, M, N, K}; pg8::StaticOrder S; S.init(M, N, G, c);
    pg8::gemm_phase<Epi, pg8::StaticOrder, PG8_ALIGN, PG8_SP2>(lds, g, S, E);
}
template <class Epi>
__device__ __forceinline__ void run_gemm192(LAS unsigned char* lds, const bf16_t* A, const bf16_t* Bt, int M, int N, int K, int G, int c, const Epi& E) {
    pg8::Gemm g{A, Bt, M, N, K}; pg8::StaticOrder S; S.init(M, N, G, c, 192);
    pg8::gemm_phase<Epi, pg8::StaticOrder, PG8_ALIGN, PG8_SP2, 3>(lds, g, S, E);
}

__device__ __forceinline__ void norm_new_ckv(const Params& P, int first, int nblk) {
    PHASE_IDS
    if ((int)blockIdx.x < first || (int)blockIdx.x >= first + nblk) return;
    const int gw = ((int)blockIdx.x - first) * 8 + wave, NGW = nblk * 8;
    float* nck = P.out + O_CKV; const float* ssq = (const float*)(P.ws + WS_SSQ_CKV); const float* gk = P.in[I_GKV];
    for (int row = gw; row < RP; row += NGW) {
        const f32x4 sq = *(const f32x4*)(ssq + (size_t)row * 4); const float rs = rsqrtf(((sq.x + sq.y) + (sq.z + sq.w)) * (1.f / 256.f) + EPS);
        f32x4* p = (f32x4*)(nck + (size_t)row * 256) + lane; *p = *p * rs * *(const f32x4*)(gk + 4 * lane);
    }
}
namespace att {
using s16x4 = __attribute__((ext_vector_type(4))) short;
using f32x16 = __attribute__((ext_vector_type(16))) float;
constexpr int QBLK = 32, KVBLK = 64;
constexpr float SCALE = ATT_SCALE, THR = 8.f;
constexpr int SHM_V = 16384, SHM_K = 16384, SHM_KR = 8192;
constexpr int L_V = 0, L_K = 2 * SHM_V, L_KR = L_K + 2 * SHM_K, L_WS = L_KR + 2 * SHM_KR, L_QR = L_WS + 8 * 64 * 4, L_END = L_QR + 8 * 4096;
#define KSWZ(row, colB) ((row) * 256 + ((colB) ^ (((row) & 7) << 4)))
#define KRSWZ(row, colB) ((row) * 128 + ((colB) ^ ((((row) >> 1) & 7) << 4)))
#define SBAR() __builtin_amdgcn_sched_barrier(0)
__device__ __forceinline__ int crow(int r, int hi) { return (r & 3) + 8 * (r >> 2) + 4 * hi; }
__device__ __forceinline__ unsigned cvtpk(float lo, float hi) { unsigned r; asm volatile("v_cvt_pk_bf16_f32 %0, %1, %2" : "=v"(r) : "v"(lo), "v"(hi)); return r; }
__device__ __forceinline__ void partialSM(f32x16& p0, f32x16& p1, float& m_reg, float& mn, float& alpha) {
  constexpr float C = SCALE * 1.4426950408889634f;
  float pmax = p0[0];
#pragma unroll
  for (int r = 1; r < 16; ++r) pmax = fmaxf(pmax, p0[r]);
#pragma unroll
  for (int r = 0; r < 16; ++r) pmax = fmaxf(pmax, p1[r]);
  { auto rr = __builtin_amdgcn_permlane32_swap(__float_as_uint(pmax), __float_as_uint(pmax), false, false);
    pmax = fmaxf(__uint_as_float(rr[0]), __uint_as_float(rr[1])); }
  if (__builtin_expect(__all(pmax - m_reg <= THR / SCALE), 1)) { mn = m_reg; alpha = 1.f; }
  else { mn = fmaxf(m_reg, pmax); alpha = __builtin_amdgcn_exp2f((m_reg - mn) * C); m_reg = mn; }
  float mnC = -mn * C;
#pragma unroll
  for (int r = 0; r < 16; ++r) p0[r] = fmaf(p0[r], C, mnC);
#pragma unroll
  for (int r = 0; r < 16; ++r) p1[r] = fmaf(p1[r], C, mnC);
#pragma unroll
  for (int r = 0; r < 16; ++r) p0[r] = __builtin_amdgcn_exp2f(p0[r]);
}
__device__ __forceinline__ void finishSM(f32x16& p0, f32x16& p1, float alpha, float& l_reg, bf16x8& pa0, bf16x8& pa1, bf16x8& pa2, bf16x8& pa3) {
#pragma unroll
  for (int r = 0; r < 16; ++r) p1[r] = __builtin_amdgcn_exp2f(p1[r]);
  float ps = 0;
#pragma unroll
  for (int r = 0; r < 16; ++r) ps += p0[r];
#pragma unroll
  for (int r = 0; r < 16; ++r) ps += p1[r];
  { auto rr = __builtin_amdgcn_permlane32_swap(__float_as_uint(ps), __float_as_uint(ps), false, false);
    ps = __uint_as_float(rr[0]) + __uint_as_float(rr[1]); }
  l_reg = l_reg * alpha + ps;
#define PK4(P, BASE, OUT) do { unsigned a0 = cvtpk(P[BASE + 0], P[BASE + 1]), a1 = cvtpk(P[BASE + 2], P[BASE + 3]);   \
    unsigned b0 = cvtpk(P[BASE + 4], P[BASE + 5]), b1 = cvtpk(P[BASE + 6], P[BASE + 7]);                              \
    auto r0 = __builtin_amdgcn_permlane32_swap(a0, b0, false, false); auto r1 = __builtin_amdgcn_permlane32_swap(a1, b1, false, false); \
    u32x4 w = {r0[0], r1[0], r0[1], r1[1]}; OUT = *reinterpret_cast<bf16x8*>(&w); } while (0)
  PK4(p0, 0, pa0); PK4(p0, 8, pa1); PK4(p1, 0, pa2); PK4(p1, 8, pa3);
#undef PK4
}
__device__ __forceinline__ void qkt(f32x16& p0, f32x16& p1, const LAS char* Ks, const LAS char* Krs, const bf16x8* qr, const LAS char* qrl, int r32, int hi) {
  p0 = f32x16{}; p1 = f32x16{};
#pragma unroll
  for (int d0 = 0; d0 < 8; ++d0) { const int cb = (d0 * 16 + hi * 8) * 2;
    const bf16x8 b0 = *reinterpret_cast<const LAS bf16x8*>(Ks + KSWZ(r32, cb));
    const bf16x8 b1 = *reinterpret_cast<const LAS bf16x8*>(Ks + KSWZ(32 + r32, cb));
    p0 = __builtin_amdgcn_mfma_f32_32x32x16_bf16(b0, qr[d0], p0, 0, 0, 0);
    p1 = __builtin_amdgcn_mfma_f32_32x32x16_bf16(b1, qr[d0], p1, 0, 0, 0); }
#pragma unroll
  for (int d0 = 0; d0 < 4; ++d0) { const int cb = (d0 * 16 + hi * 8) * 2;
    const bf16x8 b0 = *reinterpret_cast<const LAS bf16x8*>(Krs + KRSWZ(r32, cb));
    const bf16x8 b1 = *reinterpret_cast<const LAS bf16x8*>(Krs + KRSWZ(32 + r32, cb));
    const bf16x8 qq = *reinterpret_cast<const LAS bf16x8*>(qrl + d0 * 1024);
    p0 = __builtin_amdgcn_mfma_f32_32x32x16_bf16(b0, qq, p0, 0, 0, 0);
    p1 = __builtin_amdgcn_mfma_f32_32x32x16_bf16(b1, qq, p1, 0, 0, 0); }
}
__device__ __forceinline__ int v_st(int k, int c) { const int kk = (k & ~0xC) | ((k & 4) << 1) | ((k & 8) >> 1); return ((kk >> 3) * 4 + (c >> 5)) * 512 + ((kk & 7) * 32 + (c & 31)) * 2; }
__device__ __forceinline__ int v_rd_base(int lane) { return ((lane & 3) << 3) | (((lane >> 2) & 3) << 6) | (((lane >> 4) & 1) << 5) | (((lane >> 5) & 1) << 8); }
constexpr int v_rd_off(int d0, int ks, int half) { return d0 * 512 + ks * 4096 + half * 2048; }
template <int OFF> __device__ __forceinline__ s16x4 tr_read(int vb) {
  s16x4 r; asm volatile("ds_read_b64_tr_b16 %0, %1 offset:%2" : "=&v"(r) : "v"(vb), "i"(OFF) : "memory"); return r;
}
template <int D0> __device__ __forceinline__ void pv_one(f32x16& od, int vb, bf16x8 pa0, bf16x8 pa1, bf16x8 pa2, bf16x8 pa3) {
  const s16x4 l0 = tr_read<v_rd_off(D0, 0, 0)>(vb), h0 = tr_read<v_rd_off(D0, 0, 1)>(vb), l1 = tr_read<v_rd_off(D0, 1, 0)>(vb), h1 = tr_read<v_rd_off(D0, 1, 1)>(vb);
  const s16x4 l2 = tr_read<v_rd_off(D0, 2, 0)>(vb), h2 = tr_read<v_rd_off(D0, 2, 1)>(vb), l3 = tr_read<v_rd_off(D0, 3, 0)>(vb), h3 = tr_read<v_rd_off(D0, 3, 1)>(vb);
  asm volatile("s_waitcnt lgkmcnt(0)" ::: "memory"); SBAR();
#define PK(L, H) (bf16x8){L[0], L[1], L[2], L[3], H[0], H[1], H[2], H[3]}
  od = __builtin_amdgcn_mfma_f32_32x32x16_bf16(pa0, PK(l0, h0), od, 0, 0, 0);
  od = __builtin_amdgcn_mfma_f32_32x32x16_bf16(pa1, PK(l1, h1), od, 0, 0, 0);
  od = __builtin_amdgcn_mfma_f32_32x32x16_bf16(pa2, PK(l2, h2), od, 0, 0, 0);
  od = __builtin_amdgcn_mfma_f32_32x32x16_bf16(pa3, PK(l3, h3), od, 0, 0, 0);
#undef PK
}
__device__ __forceinline__ void pv_d0(f32x16* o, int vb, bf16x8 pa0, bf16x8 pa1, bf16x8 pa2, bf16x8 pa3) {
  pv_one<0>(o[0], vb, pa0, pa1, pa2, pa3); pv_one<1>(o[1], vb, pa0, pa1, pa2, pa3); pv_one<2>(o[2], vb, pa0, pa1, pa2, pa3); pv_one<3>(o[3], vb, pa0, pa1, pa2, pa3);
}
__device__ __forceinline__ void attn_unit(const bf16_t* __restrict__ Qn, const bf16_t* __restrict__ Qr, const bf16_t* __restrict__ Kh, const bf16_t* __restrict__ Vh,
                                          const bf16_t* __restrict__ Krh, bf16_t* Ob, int seq, LAS char* lds, int tid) {
  constexpr int LDQ = 1024, LDQR = 512, LDK = 2048, LDKR = 64, LDO = 1024;
  const int wid = tid >> 6, lane = tid & 63, r32 = lane & 31, hi = lane >> 5;
  LAS char* V_lds = lds + L_V; LAS char* K_lds = lds + L_K; LAS char* KR_lds = lds + L_KR;
  LAS float* wsf = (LAS float*)(lds + L_WS) + wid * 64; LAS float* li_l = wsf; LAS float* al_l = wsf + 32;
  float m_reg = -1e30f, l_reg = 0; f32x16 o[4] = {}; bf16x8 qr[8];
  LAS char* qrl = lds + L_QR + wid * 4096 + lane * 16;
  { const unsigned qo = (unsigned)((wid * QBLK + r32) * LDQ + hi * 8);
#pragma unroll
    for (int d0 = 0; d0 < 8; ++d0) qr[d0] = *reinterpret_cast<const bf16x8*>(Qn + (qo + d0 * 16));
    const unsigned qo2 = (unsigned)((wid * QBLK + r32) * LDQR + hi * 8);
#pragma unroll
    for (int d0 = 0; d0 < 4; ++d0) *reinterpret_cast<LAS bf16x8*>(qrl + d0 * 1024) = *reinterpret_cast<const bf16x8*>(Qr + (qo2 + d0 * 16)); }
  const int sr = tid >> 4, sc = (tid & 15) * 8, vst0 = v_st(sr, sc), vst1 = v_st(32 + sr, sc);
  const int rr_ = tid >> 3, rc_ = (tid & 7) * 8, krst = KRSWZ(rr_, rc_ * 2);
  const int vb0 = (int)(unsigned)(uintptr_t)V_lds + v_rd_base(lane);
  constexpr int SDEPTH = 1;
  struct { bf16x8 vs0, vs1, ks0, ks1, kr; } sr_[SDEPTH];
  const unsigned kvo = (unsigned)(sr * LDK + sc), kro = (unsigned)(rr_ * LDKR + rc_);
#define SLOAD(i, k0) do { const bf16_t* vp_ = Vh + (size_t)(k0) * LDK; const bf16_t* kp_ = Kh + (size_t)(k0) * LDK; const bf16_t* rp_ = Krh + (size_t)(k0) * LDKR; \
    sr_[i].vs0 = *reinterpret_cast<const bf16x8*>(vp_ + kvo); sr_[i].vs1 = *reinterpret_cast<const bf16x8*>(vp_ + (kvo + 32u * LDK)); \
    sr_[i].ks0 = *reinterpret_cast<const bf16x8*>(kp_ + kvo); sr_[i].ks1 = *reinterpret_cast<const bf16x8*>(kp_ + (kvo + 32u * LDK)); \
    sr_[i].kr = *reinterpret_cast<const bf16x8*>(rp_ + kro); } while (0)
#define SWRITE(b, i) do { *(LAS bf16x8*)(V_lds + (b) * SHM_V + vst0) = sr_[i].vs0; *(LAS bf16x8*)(V_lds + (b) * SHM_V + vst1) = sr_[i].vs1; const int kc = sc * 2; \
    *(LAS bf16x8*)(K_lds + (b) * SHM_K + KSWZ(sr, kc)) = sr_[i].ks0; *(LAS bf16x8*)(K_lds + (b) * SHM_K + KSWZ(32 + sr, kc)) = sr_[i].ks1; \
    *(LAS bf16x8*)(KR_lds + (b) * SHM_KR + krst) = sr_[i].kr; } while (0)
#define SWAIT() do { if constexpr (SDEPTH == 2) asm volatile("s_waitcnt vmcnt(5)" ::: "memory"); else asm volatile("s_waitcnt vmcnt(0)" ::: "memory"); } while (0)
#define RESC(a) do { if (__any((a) < 1.f)) { if (hi == 0) al_l[r32] = (a); asm volatile("s_waitcnt lgkmcnt(0)" ::: "memory"); \
    _Pragma("unroll") for (int d = 0; d < 4; ++d) _Pragma("unroll") for (int r = 0; r < 16; ++r) o[d][r] *= al_l[crow(r, hi)]; } } while (0)
  f32x16 pA0, pA1, pB0, pB1; float mnA, mnB, alA, alB; bf16x8 pa0, pa1, pa2, pa3; const int NTL = seq / KVBLK;
  constexpr int SE = 0, SO = SDEPTH - 1;
  SLOAD(SE, 0); asm volatile("s_waitcnt vmcnt(0)" ::: "memory"); SWRITE(0, SE); __syncthreads();
  qkt(pA0, pA1, K_lds, KR_lds, qr, qrl, r32, hi); partialSM(pA0, pA1, m_reg, mnA, alA);
  SLOAD(SO, KVBLK); if constexpr (SDEPTH == 2) { if (2 < NTL) SLOAD(SE, 2 * KVBLK); }
  SWAIT(); SWRITE(1, SO); __syncthreads();
  for (int j = 1; j + 1 < NTL; j += 2) {
    SBAR(); qkt(pB0, pB1, K_lds + SHM_K, KR_lds + SHM_KR, qr, qrl, r32, hi);
    finishSM(pA0, pA1, alA, l_reg, pa0, pa1, pa2, pa3); SBAR();
    SLOAD(SO, (j + SDEPTH) * KVBLK); SBAR();
    pv_d0(o, vb0, pa0, pa1, pa2, pa3); partialSM(pB0, pB1, m_reg, mnB, alB);
    __syncthreads(); SWAIT(); SWRITE(0, SE);
    RESC(alB); __syncthreads();
    SBAR(); qkt(pA0, pA1, K_lds, KR_lds, qr, qrl, r32, hi);
    finishSM(pB0, pB1, alB, l_reg, pa0, pa1, pa2, pa3); SBAR();
    if (SDEPTH == 1 || j + 3 < NTL) SLOAD(SE, (j + 1 + SDEPTH) * KVBLK); SBAR();
    pv_d0(o, vb0 + SHM_V, pa0, pa1, pa2, pa3); partialSM(pA0, pA1, m_reg, mnA, alA);
    __syncthreads(); SWAIT(); SWRITE(1, SO);
    RESC(alA); __syncthreads();
  }
  SBAR(); qkt(pB0, pB1, K_lds + SHM_K, KR_lds + SHM_KR, qr, qrl, r32, hi);
  finishSM(pA0, pA1, alA, l_reg, pa0, pa1, pa2, pa3); SBAR();
  pv_d0(o, vb0, pa0, pa1, pa2, pa3); partialSM(pB0, pB1, m_reg, mnB, alB);
  __syncthreads(); RESC(alB);
  finishSM(pB0, pB1, alB, l_reg, pa0, pa1, pa2, pa3); SBAR();
  pv_d0(o, vb0 + SHM_V, pa0, pa1, pa2, pa3);
  if (hi == 0) li_l[r32] = l_reg; asm volatile("s_waitcnt lgkmcnt(0)" ::: "memory");
  float rli[16];
#pragma unroll
  for (int r = 0; r < 16; ++r) rli[r] = __builtin_amdgcn_rcpf(li_l[crow(r, hi)]);
#pragma unroll
  for (int r = 0; r < 16; ++r) { const unsigned oo = (unsigned)((wid * QBLK + crow(r, hi)) * LDO + r32);
#pragma unroll
    for (int d0 = 0; d0 < 4; ++d0) Ob[oo + d0 * 32] = (bf16_t)f2bf(o[d0][r] * rli[r]); }
  __syncthreads();
#undef SLOAD
#undef SWRITE
#undef SWAIT
#undef RESC
}
}

namespace ssd {
typedef short v4i16_t __attribute__((ext_vector_type(4)));
constexpr int RSB = 144;
constexpr int TB = 128 * RSB;
constexpr int L_X = 0, L_B = TB, L_C = 2 * TB, L_HF = 3 * TB, L_HB = 3 * TB + 64 * RSB, L_ARR = 3 * TB + 128 * RSB, L_SC = L_ARR + 2048, L_END = L_SC + 64;
struct UnitInfo { int b, c, h, nc, row0; bool smp; };
__device__ __forceinline__ UnitInfo decode(int u) { UnitInfo I; if (u < 512) { I.smp = true; I.b = u >> 8; I.c = (u >> 4) & 15; I.h = u & 15; I.nc = 16; I.row0 = RP + I.b * SEQS + I.c * 128; }
    else { const int q = u - 512; I.smp = false; I.b = q >> 5; I.c = (q >> 4) & 1; I.h = q & 15; I.nc = 2; I.row0 = I.b * SEQP + I.c * 128; } return I; }
__device__ __forceinline__ int unit_id(bool smp, int b, int c, int h) { return smp ? ((b * 16 + c) * 16 + h) : 512 + ((b * 2 + c) * 16 + h); }
__device__ __forceinline__ bf16x8 tr2(const LAS char* p0, const LAS char* p1) {
    const v4i16_t a = __builtin_amdgcn_ds_read_tr16_b64_v4i16((LAS v4i16_t*)p0), b = __builtin_amdgcn_ds_read_tr16_b64_v4i16((LAS v4i16_t*)p1);
    return (bf16x8){a[0], a[1], a[2], a[3], b[0], b[1], b[2], b[3]};
}
__device__ __forceinline__ float wave_incl_scan(float v, int lane) {
#pragma unroll
    for (int o = 1; o < 64; o <<= 1) { const float t = __shfl_up(v, o); if (lane >= o) v += t; }
    return v;
}
__device__ __forceinline__ void chunk_scalars(const float* dt, int row0, int h, float Af, float Ab, LAS f32x4* arr, LAS float* sc, int lane) {
    const float df0 = dt[(size_t)(row0 + lane) * 32 + h], df1 = dt[(size_t)(row0 + 64 + lane) * 32 + h];
    const float db0 = dt[(size_t)(row0 + lane) * 32 + 16 + h], db1 = dt[(size_t)(row0 + 64 + lane) * 32 + 16 + h];
    const float af0 = df0 * Af, af1 = df1 * Af, ab0 = db0 * Ab, ab1 = db1 * Ab;
    const float s0 = wave_incl_scan(af0, lane), t0 = __shfl(s0, 63), s1 = wave_incl_scan(af1, lane) + t0;
    const float r0 = wave_incl_scan(ab0, lane), u0 = __shfl(r0, 63), r1 = wave_incl_scan(ab1, lane) + u0, tot = __shfl(r1, 63);
    arr[lane] = (f32x4){s0, tot - (r0 - ab0), df0, db0};
    arr[64 + lane] = (f32x4){s1, tot - (r1 - ab1), df1, db1};
    if (lane == 63) { sc[0] = s1; sc[1] = tot; }
}
constexpr int G_B = 0, G_C = TB, G_X = 2 * TB, G_ARR = 6 * TB, G_SC = G_ARR + 4 * 2048, G_END = G_SC + 64;
struct GInfo { int b, c, g, nc, row0; bool smp; };
__device__ __forceinline__ GInfo gdecode(int gu) { GInfo I; if (gu < 128) { I.smp = true; I.b = gu >> 6; I.c = (gu >> 2) & 15; I.g = gu & 3; I.nc = 16; I.row0 = RP + I.b * SEQS + I.c * 128; }
    else { const int q = gu - 128; I.smp = false; I.b = q >> 3; I.c = (q >> 2) & 1; I.g = q & 3; I.nc = 2; I.row0 = I.b * SEQP + I.c * 128; } return I; }
template <bool WITH_C>
__device__ __forceinline__ void stage_group(const Params& P, const GInfo& I, LAS char* lds, int tid) {
    const bf16_t* xbc = (const bf16_t*)(P.ws + WS_XBC); const int lane = tid & 63, wave = tid >> 6;
    if (wave >= 6) {
        const float* dt = (const float*)(P.ws + WS_DT);
#pragma unroll 1
        for (int q = 0; q < 2; ++q) { const int hl = 2 * (wave - 6) + q, h = 4 * I.g + hl;
            chunk_scalars(dt, I.row0, h, -__expf(P.in[I_ALOG][h]), -__expf(P.in[I_ALOG][16 + h]), (LAS f32x4*)(lds + G_ARR + hl * 2048), (LAS float*)(lds + G_SC + hl * 16), lane); }
        return;
    }
    if (!WITH_C && wave == 5) return;
    const int p8 = lane & 7, rs = lane >> 3;
    const int cbase = (wave == 0 ? 1024 + I.g * 64 : wave == 5 ? 1280 + I.g * 64 : (4 * I.g + wave - 1) * 64) + p8 * 8;
    const int lbase = (wave == 0 ? G_B : wave == 5 ? G_C : G_X + (wave - 1) * TB) + p8 * 16;
    const float* cw = P.in[I_CONVW]; const float* cb = P.in[I_CONVB];
    float w[3][8], bb[8];
#pragma unroll
    for (int q = 0; q < 2; ++q) { const f32x4 b4 = *(const f32x4*)(cb + cbase + 4 * q);
#pragma unroll
        for (int e = 0; e < 4; ++e) bb[4 * q + e] = b4[e];
#pragma unroll
        for (int k = 0; k < 3; ++k) { const f32x4 a = *(const f32x4*)(cw + k * 1536 + cbase + 4 * q);
#pragma unroll
            for (int e = 0; e < 4; ++e) w[k][4 * q + e] = a[e]; } }
    const int r0 = rs * 16; const bf16_t* xr = xbc + (size_t)(I.row0 + r0) * 1536 + cbase;
    const bool first = (I.c == 0 && rs == 0), last = (I.c == I.nc - 1 && rs == 7);
    const u32x4 zero = {0u, 0u, 0u, 0u};
    u32x4 rows[18];
    rows[0] = first ? zero : *(const u32x4*)(xr - 1536);
#pragma unroll
    for (int i = 0; i < 16; ++i) rows[1 + i] = *(const u32x4*)(xr + (size_t)i * 1536);
    rows[17] = last ? zero : *(const u32x4*)(xr + (size_t)16 * 1536);
#pragma unroll
    for (int i = 0; i < 16; ++i) {
        float a[8], x[8];
        unpack8(rows[i], x);
#pragma unroll
        for (int e = 0; e < 8; ++e) a[e] = bb[e] + x[e] * w[0][e];
        unpack8(rows[i + 1], x);
#pragma unroll
        for (int e = 0; e < 8; ++e) a[e] += x[e] * w[1][e];
        unpack8(rows[i + 2], x);
#pragma unroll
        for (int e = 0; e < 8; ++e) a[e] += x[e] * w[2][e];
        u32x4 o;
#pragma unroll
        for (int e = 0; e < 4; ++e) o[e] = pk2(siluf(a[2 * e]), siluf(a[2 * e + 1]));
        *(LAS u32x4*)(lds + lbase + (r0 + i) * RSB) = o;
    }
}
__device__ __forceinline__ void pass_a_group(const Params& P, int gu, LAS char* lds, int tid) {
    unsigned char* ws = P.ws;
    const int lane = tid & 63, wave = tid >> 6; const GInfo I = gdecode(gu);
    stage_group<false>(P, I, lds, tid);
    __syncthreads();
    { const int hl = wave >> 1, d = wave & 1, h = 4 * I.g + hl, gq = lane >> 4, q4 = (lane >> 2) & 3, p4 = lane & 3, li = lane & 15;
      const LAS f32x4* arr = (const LAS f32x4*)(lds + G_ARR + hl * 2048); const float tot = ((const LAS float*)(lds + G_SC + hl * 16))[d];
      const LAS char* xb = lds + G_X + hl * TB + (8 * gq + q4) * RSB + (4 * p4) * 2;
      const LAS char* bb = lds + G_B + (8 * gq + q4) * RSB + (4 * p4) * 2;
      f32x4 acc[4][4] = {};
#pragma unroll
      for (int s4 = 0; s4 < 4; ++s4) {
          float wj[8];
#pragma unroll
          for (int jj = 0; jj < 8; ++jj) { const f32x4 a = arr[32 * s4 + 8 * gq + jj]; wj[jj] = d ? a.w * __expf(tot - a.y) : a.z * __expf(tot - a.x); }
          bf16x8 bfr[4];
#pragma unroll
          for (int nt = 0; nt < 4; ++nt) bfr[nt] = tr2(bb + s4 * 32 * RSB + nt * 32, bb + s4 * 32 * RSB + 4 * RSB + nt * 32);
#pragma unroll
          for (int pt = 0; pt < 4; ++pt) { const bf16x8 xr_ = tr2(xb + s4 * 32 * RSB + pt * 32, xb + s4 * 32 * RSB + 4 * RSB + pt * 32);
              const u32x4 xw = *reinterpret_cast<const u32x4*>(&xr_); u32x4 sw;
#pragma unroll
              for (int e = 0; e < 4; ++e) sw[e] = pk2(bflo(xw[e]) * wj[2 * e], bfhi(xw[e]) * wj[2 * e + 1]);
              const bf16x8 xf = *reinterpret_cast<const bf16x8*>(&sw);
#pragma unroll
              for (int nt = 0; nt < 4; ++nt) acc[pt][nt] = __builtin_amdgcn_mfma_f32_16x16x32_bf16(bfr[nt], xf, acc[pt][nt], 0, 0, 0); } }
      const int u = unit_id(I.smp, I.b, I.c, h);
      bf16_t* So = (bf16_t*)(ws + WS_ST) + ((size_t)u * 2 + d) * 4096;
#pragma unroll
      for (int pt = 0; pt < 4; ++pt)
#pragma unroll
          for (int nt = 0; nt < 4; ++nt) st_bf4(So + (16 * pt + li) * 64 + nt * 16 + 4 * gq, acc[pt][nt]);
      if (lane == 0) ((float*)(ws + WS_DEC))[(size_t)u * 2 + d] = __expf(tot);
    }
    __syncthreads();
}
__device__ __forceinline__ bf16x8 ld_h_frag(const bf16_t* H, int p, int n) { return *(const bf16x8*)(H + p * 64 + n); }
__device__ __forceinline__ void pass_b_group(const Params& P, int gu, LAS char* lds, int tid) {
    unsigned char* ws = P.ws;
    const bf16_t* ST = (const bf16_t*)(ws + WS_ST);
    const int lane = tid & 63, wave = tid >> 6; const GInfo I = gdecode(gu);
    stage_group<true>(P, I, lds, tid);
    const int hl = wave >> 1, half = wave & 1, h = 4 * I.g + hl, li = lane & 15, gq = lane >> 4, q4 = (lane >> 2) & 3, p4 = lane & 3;
    const bf16_t *Hf, *Hb;
    if (I.smp) { const int u = unit_id(true, I.b, I.c, h); Hf = ST + ((size_t)u * 2) * 4096; Hb = ST + ((size_t)u * 2 + 1) * 4096; }
    else { const bf16_t* zp = (const bf16_t*)(ws + WS_ZERO); Hf = I.c == 1 ? ST + ((size_t)unit_id(false, I.b, 0, h) * 2) * 4096 : zp; Hb = I.c == 0 ? ST + ((size_t)unit_id(false, I.b, 1, h) * 2 + 1) * 4096 : zp; }
    __syncthreads();
    const LAS f32x4* arr = (const LAS f32x4*)(lds + G_ARR + hl * 2048); const LAS char* Xl = lds + G_X + hl * TB;
    const float Dh = P.in[I_SSDD][h];
#pragma unroll 1
    for (int st = 0; st < 4; st += 2) {
        int ii[2], tdiag[2]; bf16x8 cf[2][2]; f32x4 ai[2]; bf16_t* zrow[2]; u32x2 zw[2][4]; bf16x8 pf[2][4];
#pragma unroll
        for (int u = 0; u < 2; ++u) { ii[u] = 64 * half + 16 * (st + u) + li; tdiag[u] = __builtin_amdgcn_readfirstlane(4 * half + st + u);
#pragma unroll
            for (int ks = 0; ks < 2; ++ks) cf[u][ks] = *(const LAS bf16x8*)(lds + G_C + ii[u] * RSB + (8 * gq + 32 * ks) * 2);
            ai[u] = arr[ii[u]];
            zrow[u] = (bf16_t*)(ws + WS_Z) + (size_t)(I.row0 + ii[u]) * 1024 + h * 64;
#pragma unroll
            for (int pt = 0; pt < 4; ++pt) zw[u][pt] = *(const u32x2*)(zrow[u] + 16 * pt + 4 * gq); }
#pragma unroll
        for (int s4 = 0; s4 < 4; ++s4) {
            unsigned pk[2][4];
#pragma unroll
            for (int hf2 = 0; hf2 < 2; ++hf2) { const int t = 2 * s4 + hf2, jb = 16 * t + 4 * gq;
                f32x4 sacc[2] = {{0.f, 0.f, 0.f, 0.f}, {0.f, 0.f, 0.f, 0.f}};
#pragma unroll
                for (int ks = 0; ks < 2; ++ks) { const bf16x8 bfr = *(const LAS bf16x8*)(lds + G_B + (16 * t + li) * RSB + (8 * gq + 32 * ks) * 2);
                    sacc[0] = __builtin_amdgcn_mfma_f32_16x16x32_bf16(bfr, cf[0][ks], sacc[0], 0, 0, 0);
                    sacc[1] = __builtin_amdgcn_mfma_f32_16x16x32_bf16(bfr, cf[1][ks], sacc[1], 0, 0, 0); }
                f32x4 aj[4];
#pragma unroll
                for (int r = 0; r < 4; ++r) aj[r] = arr[jb + r];
#pragma unroll
                for (int u = 0; u < 2; ++u) {
                    float m[4];
                    if (t < tdiag[u]) {
#pragma unroll
                        for (int r = 0; r < 4; ++r) m[r] = sacc[u][r] * (__expf(ai[u].x - aj[r].x) * aj[r].z);
                    } else if (t > tdiag[u]) {
#pragma unroll
                        for (int r = 0; r < 4; ++r) m[r] = sacc[u][r] * (__expf(ai[u].y - aj[r].y) * aj[r].w);
                    } else {
#pragma unroll
                        for (int r = 0; r < 4; ++r) { const int j = jb + r;
                            const bool lower = j < ii[u]; const float arg = lower ? ai[u].x - aj[r].x : ai[u].y - aj[r].y; const float w = lower ? aj[r].z : aj[r].w;
                            float mm = __expf(arg) * w; if (j == ii[u]) mm = ai[u].z + ai[u].w; m[r] = sacc[u][r] * mm; }
                    }
                    pk[u][hf2 * 2 + 0] = pk2(m[0], m[1]); pk[u][hf2 * 2 + 1] = pk2(m[2], m[3]); } }
#pragma unroll
            for (int u = 0; u < 2; ++u) { const u32x4 w4 = {pk[u][0], pk[u][1], pk[u][2], pk[u][3]}; pf[u][s4] = *reinterpret_cast<const bf16x8*>(&w4); }
            __builtin_amdgcn_sched_barrier(0);
        }
        float ef[2], eb[2], ssq[2] = {0.f, 0.f};
#pragma unroll
        for (int u = 0; u < 2; ++u) { ef[u] = __expf(ai[u].x); eb[u] = __expf(ai[u].y); }
        bf16x8 hfc[2], hbc[2], hfn[2], hbn[2];
#pragma unroll
        for (int ks = 0; ks < 2; ++ks) { hfc[ks] = ld_h_frag(Hf, li, 8 * gq + 32 * ks); hbc[ks] = ld_h_frag(Hb, li, 8 * gq + 32 * ks); }
#pragma unroll
        for (int pt = 0; pt < 4; ++pt) {
            if (pt < 3) {
#pragma unroll
                for (int ks = 0; ks < 2; ++ks) { hfn[ks] = ld_h_frag(Hf, 16 * (pt + 1) + li, 8 * gq + 32 * ks); hbn[ks] = ld_h_frag(Hb, 16 * (pt + 1) + li, 8 * gq + 32 * ks); } }
            f32x4 yd[2] = {{0.f, 0.f, 0.f, 0.f}, {0.f, 0.f, 0.f, 0.f}}, yf[2] = {{0.f, 0.f, 0.f, 0.f}, {0.f, 0.f, 0.f, 0.f}}, yb[2] = {{0.f, 0.f, 0.f, 0.f}, {0.f, 0.f, 0.f, 0.f}};
#pragma unroll
            for (int s4 = 0; s4 < 4; ++s4) { const LAS char* xb = Xl + (32 * s4 + 4 * gq + q4) * RSB + (16 * pt + 4 * p4) * 2; const bf16x8 xf = tr2(xb, xb + 16 * RSB);
                yd[0] = __builtin_amdgcn_mfma_f32_16x16x32_bf16(xf, pf[0][s4], yd[0], 0, 0, 0);
                yd[1] = __builtin_amdgcn_mfma_f32_16x16x32_bf16(xf, pf[1][s4], yd[1], 0, 0, 0); }
#pragma unroll
            for (int ks = 0; ks < 2; ++ks)
#pragma unroll
                for (int u = 0; u < 2; ++u) { yf[u] = __builtin_amdgcn_mfma_f32_16x16x32_bf16(hfc[ks], cf[u][ks], yf[u], 0, 0, 0);
                    yb[u] = __builtin_amdgcn_mfma_f32_16x16x32_bf16(hbc[ks], cf[u][ks], yb[u], 0, 0, 0); }
            const int pc = 16 * pt + 4 * gq;
#pragma unroll
            for (int u = 0; u < 2; ++u) {
                const u32x2 xw = *(const LAS u32x2*)(Xl + ii[u] * RSB + pc * 2);
                const f32x4 xx = {bflo(xw.x), bfhi(xw.x), bflo(xw.y), bfhi(xw.y)};
                const f32x4 zz = {bflo(zw[u][pt].x), bfhi(zw[u][pt].x), bflo(zw[u][pt].y), bfhi(zw[u][pt].y)};
                f32x4 y = yd[u] + yf[u] * ef[u] + yb[u] * eb[u] + xx * Dh;
                y = y * (f32x4){siluf(zz.x), siluf(zz.y), siluf(zz.z), siluf(zz.w)};
                ssq[u] += (y.x * y.x + y.y * y.y) + (y.z * y.z + y.w * y.w);
                st_bf4(zrow[u] + pc, y); }
#pragma unroll
            for (int ks = 0; ks < 2; ++ks) { hfc[ks] = hfn[ks]; hbc[ks] = hbn[ks]; }
            __builtin_amdgcn_sched_barrier(0);
        }
#pragma unroll
        for (int u = 0; u < 2; ++u) { float sq = ssq[u]; sq += __shfl_xor(sq, 16); sq += __shfl_xor(sq, 32);
            if (gq == 0) ((float*)(ws + WS_SSQ_Y))[(size_t)(I.row0 + ii[u]) * 16 + h] = sq; }
    }
    __syncthreads();
}
}

__device__ __forceinline__ void cg_rowblock(const bf16_t* u, bf16_t* ug, const CgW& W, int rb, int c) {
    const int r0 = rb * CG_RB; const int t0 = r0 < RP ? (r0 & 255) : ((r0 - RP) & 2047), L = r0 < RP ? SEQP : SEQS;
    const u32x4 zero = {0u, 0u, 0u, 0u};
    u32x4 gp = zero, vp = zero, gc, vc, gn, vn;
    if (t0 > 0) { gp = *(const u32x4*)(u + (size_t)(r0 - 1) * UPN + c); vp = *(const u32x4*)(u + (size_t)(r0 - 1) * UPN + DFF + c); }
    gc = *(const u32x4*)(u + (size_t)r0 * UPN + c); vc = *(const u32x4*)(u + (size_t)r0 * UPN + DFF + c);
#pragma unroll 16
    for (int i = 0; i < CG_RB; ++i) {
        const int row = r0 + i;
        if (t0 + i + 1 < L) { gn = *(const u32x4*)(u + (size_t)(row + 1) * UPN + c); vn = *(const u32x4*)(u + (size_t)(row + 1) * UPN + DFF + c); } else { gn = zero; vn = zero; }
        float a[8], b[8], x[8];
#pragma unroll
        for (int e = 0; e < 8; ++e) { a[e] = W.bg[e]; b[e] = W.bv[e]; }
        unpack8(gp, x);
#pragma unroll
        for (int e = 0; e < 8; ++e) a[e] += x[e] * W.wg[0][e];
        unpack8(gc, x);
#pragma unroll
        for (int e = 0; e < 8; ++e) a[e] += x[e] * W.wg[1][e];
        unpack8(gn, x);
#pragma unroll
        for (int e = 0; e < 8; ++e) a[e] += x[e] * W.wg[2][e];
        unpack8(vp, x);
#pragma unroll
        for (int e = 0; e < 8; ++e) b[e] += x[e] * W.wv[0][e];
        unpack8(vc, x);
#pragma unroll
        for (int e = 0; e < 8; ++e) b[e] += x[e] * W.wv[1][e];
        unpack8(vn, x);
#pragma unroll
        for (int e = 0; e < 8; ++e) b[e] += x[e] * W.wv[2][e];
        u32x4 o;
#pragma unroll
        for (int e = 0; e < 4; ++e) o[e] = pk2(siluf(a[2 * e]) * b[2 * e], siluf(a[2 * e + 1]) * b[2 * e + 1]);
        *(u32x4*)(ug + (size_t)row * DFF + c) = o;
        gp = gc; vp = vc; gc = gn; vc = vn;
    }
}
constexpr int CG_ROWS1 = 46 * 256, CG_SPLIT = CG_ROWS1 / CG_RB - 1, CG_ITEMS = R / CG_RB;
__device__ __forceinline__ void phase_convgate_queue(const Params& P, LAS unsigned char* lds, unsigned* c1, unsigned* c2, unsigned* q) {
    PHASE_IDS unsigned char* ws = P.ws; const bf16_t* u = (const bf16_t*)(ws + WS_U); bf16_t* ug = (bf16_t*)(ws + WS_UG);
    volatile LAS int* slot = (volatile LAS int*)(lds + 1024);
    const int c = tid * 8; const bool act = tid < DFF / 8;
    CgW W; if (act) cg_load_w(W, P.in[I_FCW], P.in[I_FCB], c);
    bool w1 = false, w2 = false;
    for (;;) {
        if (tid == 0) *slot = (int)__hip_atomic_fetch_add(q, 1u, __ATOMIC_RELAXED, __HIP_MEMORY_SCOPE_AGENT);
        __syncthreads();
        const int rb = *slot;
        __syncthreads();
        if (rb >= CG_ITEMS) break;
        if (!w1) { cnt_wait(c1, (unsigned)G); w1 = true; }
        if (rb >= CG_SPLIT && !w2) { cnt_wait(c2, (unsigned)G); w2 = true; }
        if (act) cg_rowblock(u, ug, W, rb, c);
    }
}
__device__ __forceinline__ void phase_final(const Params& P) {
    PHASE_IDS const int gw = blockIdx.x * 8 + wave, NGW = G * 8; const float* gf = P.in[I_GFIN];
    for (int row = gw; row < R; row += NGW) {
        f32x4* xr = (f32x4*)(P.out + (size_t)row * DM) + lane; f32x4 v[4]; float s = 0.f;
#pragma unroll
        for (int j = 0; j < 4; ++j) { v[j] = xr[64 * j]; s += (v[j].x * v[j].x + v[j].y * v[j].y) + (v[j].z * v[j].z + v[j].w * v[j].w); }
        const float rs = rsqrtf(wave_sum(s) * (1.f / DM) + EPS);
#pragma unroll
        for (int j = 0; j < 4; ++j) xr[64 * j] = v[j] * rs * *(const f32x4*)(gf + 4 * lane + 256 * j);
    }
}

constexpr int G_SLOT_OFF = 126 * 1024;
__device__ __forceinline__ void phase_ssd_a(const Params& P, LAS unsigned char* lds) {
    PHASE_IDS
    norm_new_ckv(P, 0, G);
    unsigned* qa = (unsigned*)(P.ws + WS_CTL) + 8192 + 256; volatile LAS int* slot = (volatile LAS int*)(lds + G_SLOT_OFF);
    for (;;) {
        if (tid == 0) *slot = (int)__hip_atomic_fetch_add(qa, 1u, __ATOMIC_RELAXED, __HIP_MEMORY_SCOPE_AGENT);
        __syncthreads();
        const int gu = *slot;
        __syncthreads();
        if (gu >= 384) break;
        int t2 = tid; asm volatile("" : "+v"(t2)); ssd::pass_a_group(P, gu, (LAS char*)lds, t2);
    }
}
__device__ __forceinline__ void phase_ssd_scan(const Params& P) {
    PHASE_IDS unsigned char* ws = P.ws; bf16_t* ST = (bf16_t*)(ws + WS_ST); const float* DEC = (const float*)(ws + WS_DEC);
    const int gt = blockIdx.x * NT + tid, GT = G * NT;
    for (int it = gt; it < 64 * 512; it += GT) {
        const int chain = it >> 9, e = (it & 511) * 8, b = chain >> 5, h = (chain >> 1) & 15, d = chain & 1;
        float H[8];
        { const float* h0 = P.in[I_SSD] + (((size_t)b * 2 + d) * 16 + h) * 4096 + e; const f32x4 a = *(const f32x4*)h0, c4 = *(const f32x4*)(h0 + 4);
#pragma unroll
          for (int q = 0; q < 4; ++q) { H[q] = a[q]; H[4 + q] = c4[q]; } }
        u32x4 S[16]; float dc[16];
#pragma unroll
        for (int c = 0; c < 16; ++c) { const int u = ssd::unit_id(true, b, c, h); S[c] = *(const u32x4*)(ST + ((size_t)u * 2 + d) * 4096 + e); dc[c] = DEC[(size_t)u * 2 + d]; }
#define SCAN_STEP(c) { const int u = ssd::unit_id(true, b, (c), h); \
            *(u32x4*)(ST + ((size_t)u * 2 + d) * 4096 + e) = (u32x4){pk2(H[0], H[1]), pk2(H[2], H[3]), pk2(H[4], H[5]), pk2(H[6], H[7])}; \
            float sv[8]; unpack8(S[(c)], sv); _Pragma("unroll") for (int q = 0; q < 8; ++q) H[q] = H[q] * dc[(c)] + sv[q]; }
        if (d == 0) {
#pragma unroll
            for (int c = 0; c < 16; ++c) SCAN_STEP(c)
        } else {
#pragma unroll
            for (int c = 15; c >= 0; --c) SCAN_STEP(c)
        }
#undef SCAN_STEP
    }
    for (int it = gt; it < 1024 * 512; it += GT) {
        const int bhd = it >> 9, e = (it & 511) * 8, b = bhd >> 5, d = (bhd >> 4) & 1, h = bhd & 15;
        const int ufirst = ssd::unit_id(false, b, d ? 1 : 0, h), ulast = ssd::unit_id(false, b, d ? 0 : 1, h);
        float f[8], l[8]; unpack8(*(const u32x4*)(ST + ((size_t)ufirst * 2 + d) * 4096 + e), f); unpack8(*(const u32x4*)(ST + ((size_t)ulast * 2 + d) * 4096 + e), l);
        const float dl = DEC[(size_t)ulast * 2 + d]; float* o = P.out + O_SSD + (((size_t)b * 2 + d) * 16 + h) * 4096 + e;
        *(f32x4*)o = (f32x4){f[0] * dl + l[0], f[1] * dl + l[1], f[2] * dl + l[2], f[3] * dl + l[3]};
        *(f32x4*)(o + 4) = (f32x4){f[4] * dl + l[4], f[5] * dl + l[5], f[6] * dl + l[6], f[7] * dl + l[7]};
    }
}
template <int PART>
__device__ __forceinline__ void phase_mix(const Params& P, LAS unsigned char* lds) {
    PHASE_IDS unsigned char* ws = P.ws; bf16_t* qn = (bf16_t*)(ws + WS_QN); const bf16_t* qr = (const bf16_t*)(ws + WS_QR);
    const bf16_t* kv = (const bf16_t*)(ws + WS_KV); const bf16_t* kr = (const bf16_t*)(ws + WS_KROPE);
    const int nbA = G / 2, bx = blockIdx.x;
    if (bx < nbA) {
        if (PART != 2) for (int u = bx; u < 128; u += nbA) {
            const int x = u & 7, k = u >> 3, bh = x + 8 * (k >> 3), qb = k & 7, b = bh >> 3, h = bh & 7, row0 = RP + b * SEQS + qb * 256, kv0 = RP + b * KVS;
            int t2 = tid; asm volatile("" : "+v"(t2));
            att::attn_unit(qn + (size_t)row0 * 1024 + h * 128, qr + (size_t)row0 * 512 + h * 64, kv + (size_t)kv0 * 2048 + h * 256, kv + (size_t)kv0 * 2048 + h * 256 + 128,
                           kr + (size_t)kv0 * 64, qn + (size_t)row0 * 1024 + h * 128, KVS, (LAS char*)lds, t2);
        }
    } else {
        const int k0 = bx - nbA, nb2 = G - nbA;
        if (PART != 2) for (int q = k0; q < 256; q += nb2) {
            const int b = q >> 3, h = q & 7, row0 = b * SEQP;
            int t2 = tid; asm volatile("" : "+v"(t2));
            att::attn_unit(qn + (size_t)row0 * 1024 + h * 128, qr + (size_t)row0 * 512 + h * 64, kv + (size_t)row0 * 2048 + h * 256, kv + (size_t)row0 * 2048 + h * 256 + 128,
                           kr + (size_t)row0 * 64, qn + (size_t)row0 * 1024 + h * 128, SEQP, (LAS char*)lds, t2);
        }
        if (PART != 1) for (int gu = k0; gu < 384; gu += nb2) { int t2 = tid; asm volatile("" : "+v"(t2)); ssd::pass_b_group(P, gu, (LAS char*)lds, t2); }
    }
}
#define XB_TMO      128
#define XB_XCNT(j)  (256  + 64 * (j))
#define XB_XSUB(j)  (1280 + 64 * (j))
#define XB_XGEN(j)  (2304 + 64 * (j))
#define XB_TOP      3328
#define XB_TOPGEN   3392
#define XCD_BAR_WORDS 3456
#define XB_SPIN_CAP (1u << 18)

__device__ __forceinline__ unsigned xb_ld(unsigned* p)              { return __hip_atomic_load(p, __ATOMIC_RELAXED, __HIP_MEMORY_SCOPE_AGENT); }
__device__ __forceinline__ unsigned xb_add(unsigned* p, unsigned v) { return __hip_atomic_fetch_add(p, v, __ATOMIC_RELAXED, __HIP_MEMORY_SCOPE_AGENT); }
__device__ __forceinline__ unsigned xb_xcc_id() { return (unsigned)__builtin_amdgcn_s_getreg((3 << 11) | 20) & 0xFu; }
#define XB_SPIN(cond, bar) do { unsigned _sp = 0; while (cond) { __builtin_amdgcn_s_sleep(1); \
    if ((++_sp & 255u) == 0u) { if (xb_ld(&(bar)[XB_TMO])) break; if (_sp > XB_SPIN_CAP) { atomicAdd(&(bar)[XB_TMO], 1u); break; } } } } while (0)

struct XcdBarrier {
    unsigned* bar; unsigned x;
    volatile LAS unsigned* st;
};

__device__ __forceinline__ XcdBarrier xcd_barrier_post(unsigned* bar, volatile LAS unsigned* st) {
    XcdBarrier b; b.bar = bar; b.x = xb_xcc_id(); b.st = st;
    if (threadIdx.x == 0) (void)xb_add(&bar[XB_XCNT(b.x)], 1u);
    return b;
}
__device__ __forceinline__ void xcd_barrier_complete(unsigned* bar, unsigned x, unsigned& nloc, unsigned& nx) {
    const unsigned G = gridDim.x * gridDim.y * gridDim.z;
    unsigned sum, cnt, mine, sp = 0u;
    for (;;) {
        sum = 0u; cnt = 0u; mine = 0u;
#pragma unroll
        for (unsigned j = 0; j < 16; ++j) { const unsigned c = xb_ld(&bar[XB_XCNT(j)]); sum += c; cnt += (c > 0u) ? 1u : 0u; mine = (j == x) ? c : mine; }
        if (sum == G) break;
        __builtin_amdgcn_s_sleep(1);
        if ((++sp & 255u) == 0u) { if (xb_ld(&bar[XB_TMO])) break; if (sp > XB_SPIN_CAP) { atomicAdd(&bar[XB_TMO], 1u); break; } }
    }
    nloc = mine > 0u ? mine : 1u; nx = cnt > 0u ? cnt : 1u;
}

__device__ __forceinline__ void xcd_barrier(const XcdBarrier& b) {
    asm volatile("s_waitcnt vmcnt(0)" ::: "memory");
    __syncthreads();
    if (threadIdx.x == 0) {
        unsigned* bar = b.bar;
        __builtin_amdgcn_s_waitcnt(0);
        unsigned nloc = b.st[0], nx = b.st[1];
        if (nloc == 0u) { xcd_barrier_complete(bar, b.x, nloc, nx); b.st[0] = nloc; b.st[1] = nx; }
#ifdef EARLY_WB
        __builtin_amdgcn_fence(__ATOMIC_RELEASE, "agent"); asm volatile("s_waitcnt vmcnt(0)" ::: "memory");
#endif
        const unsigned old = xb_add(&bar[XB_XSUB(b.x)], 1u);
        const unsigned gen = old / nloc;
        if (old + 1u == (gen + 1u) * nloc) {
            __builtin_amdgcn_fence(__ATOMIC_RELEASE, "agent");
            asm volatile("s_waitcnt vmcnt(0)" ::: "memory");
            const unsigned og = xb_add(&bar[XB_TOP], 1u);
            const unsigned tg = og / nx;
            if (og + 1u == (tg + 1u) * nx) xb_add(&bar[XB_TOPGEN], 1u);
            else XB_SPIN(xb_ld(&bar[XB_TOPGEN]) == tg, bar);
            __builtin_amdgcn_fence(__ATOMIC_ACQUIRE, "agent");
            xb_add(&bar[XB_XGEN(b.x)], 1u);
            asm volatile("s_waitcnt vmcnt(0)" ::: "memory");
        } else {
            XB_SPIN(xb_ld(&bar[XB_XGEN(b.x)]) == gen, bar);
            __builtin_amdgcn_fence(__ATOMIC_ACQUIRE, "agent");
            asm volatile("s_waitcnt vmcnt(0)" ::: "memory");
        }
    }
    __syncthreads();
}

__global__ void __launch_bounds__(NT, 2) mega_fwd(Params P) {
    extern __shared__ __attribute__((aligned(16))) unsigned char lds_raw[];
    LAS unsigned char* lds = (LAS unsigned char*)lds_raw;
    const int G = gridDim.x, bx = blockIdx.x;
    unsigned char* ws = P.ws;
    volatile LAS unsigned* misc = (volatile LAS unsigned*)(lds + 131072);
    if (threadIdx.x < 4) misc[threadIdx.x] = 0u;
    __syncthreads();
    const XcdBarrier xbar = xcd_barrier_post((unsigned*)(ws + WS_CTL) + 1024, misc);
#define GSYNC() xcd_barrier(xbar)
    unsigned long long pt0 = 0, pacc = 0; (void)pt0; (void)pacc;
#define PB(k) do { if ((PROBE_MASK >> (k)) & 1) pt0 = __builtin_amdgcn_s_memrealtime(); } while (0)
#define PE(k) do { if ((PROBE_MASK >> (k)) & 1) pacc += __builtin_amdgcn_s_memrealtime() - pt0; } while (0)
#ifdef PROBE_BUSY
#define BB(k) do { if (PROBE_BUSY == (k) && threadIdx.x == 0) ((unsigned*)(lds + 131072))[8] = (unsigned)__builtin_amdgcn_s_memrealtime(); } while (0)
#ifdef PROBE_ARG
#define BE(k) do { if (PROBE_BUSY == (k) && threadIdx.x == 0) atomicMax((unsigned*)(P.ws + WS_CTL) + 12000, (((unsigned)__builtin_amdgcn_s_memrealtime() - ((unsigned*)(lds + 131072))[8]) << 8) | (blockIdx.x & 255u)); } while (0)
#else
#define BE(k) do { if (PROBE_BUSY == (k) && threadIdx.x == 0) atomicMax((unsigned*)(P.ws + WS_CTL) + 12000, (unsigned)__builtin_amdgcn_s_memrealtime() - ((unsigned*)(lds + 131072))[8]); } while (0)
#endif
#define BA(k) do { if (PROBE_BUSY == (k) && threadIdx.x == 0) ((unsigned*)(lds + 131072))[9] = __hip_atomic_load((unsigned*)(P.ws + WS_CTL) + 12000, __ATOMIC_RELAXED, __HIP_MEMORY_SCOPE_AGENT); } while (0)
#else
#define BB(k)
#define BE(k)
#define BA(k)
#endif

#ifdef PG8_TIME
    if (blockIdx.x == 0 && threadIdx.x == 0) { pg8::pg8_tacc[0] = 0; pg8::pg8_tacc[1] = 0; }
#endif
    PB(0); phase_p0(P, lds);
    GSYNC(); PE(0);
    PB(2); PB(20); BB(2);
    {
        EpiInMain E{(bf16_t*)(ws + WS_CQ), (bf16_t*)(ws + WS_CKVA), (bf16_t*)(ws + WS_Z), (bf16_t*)(ws + WS_XBC), (bf16_t*)P.out, (bf16_t*)P.out + (size_t)R * 1024,
                    (float*)(ws + WS_SSQ_CQ), (float*)(ws + WS_SSQ_CKV), P.out + O_CKV,
                    (bf16_t*)(ws + WS_KROPE), (float*)(ws + WS_DT), P.out + O_KR, P.in[I_DTB], (const f32x2*)(ws + WS_ROPE)};
        run_gemm(lds, (const bf16_t*)(ws + WS_H), (const bf16_t*)(ws + WS_WIN), R, 5376, 1024, G, bx, E);
    }
    PE(20); BE(2);
    GSYNC(); PE(2); BA(2);
    PB(4); BB(4);
    {
        EpiG2 E{(bf16_t*)(ws + WS_QN), (bf16_t*)(ws + WS_KV), (const float*)(ws + WS_SSQ_CQ), (const float*)(ws + WS_SSQ_CKV)};
        pg8::Gemm g{(const bf16_t*)(ws + WS_CQ), (const bf16_t*)(ws + WS_WUQ), R + KVR, 3584, 256}; Gemm2Order S; S.init(G, bx);
        pg8::gemm_phase<EpiG2, Gemm2Order, PG8_ALIGN, PG8_SP2>(lds, g, S, E);
        EpiQR EQR{(bf16_t*)(ws + WS_QR), (const float*)(ws + WS_SSQ_CQ), (const f32x2*)(ws + WS_ROPE)};
        run_gemm(lds, (const bf16_t*)(ws + WS_CQ), (const bf16_t*)(ws + WS_WUQ) + (size_t)1024 * 256, R, 512, 256, G, (bx + 160) % G, EQR);
        phase_ssd_a(P, lds);
    }
    GSYNC();
    PB(14); phase_ssd_scan(P);
    if (G == 256) { if (bx < 64) cnt_arrive((unsigned*)(ws + WS_CTL) + SCANCNT); else phase_cup(P, 64, 192); } else phase_cup(P, 0, G);
    PE(14);
    BE(4);
    if (G != 256) GSYNC();
    PE(4); BA(4);
    BB(5); PB(5); PB(12); PB(13); PB(18); phase_mix<1>(P, lds); PE(18);
    if (G == 256 && bx >= 128) cnt_wait((unsigned*)(ws + WS_CTL) + SCANCNT, 64u);
    PB(19); phase_mix<2>(P, lds); PE(19); PE(12); PE(13);
    BE(5);
    GSYNC(); PE(5); BA(5);
    PB(6); BB(6);
    {
        EpiMerged E{(const bf16_t*)P.out, (const bf16_t*)P.out + (size_t)R * 1024, (const float*)(ws + WS_SSQ_Y), (bf16_t*)(ws + WS_MERGED)};
        pg8::Gemm g{(const bf16_t*)(ws + WS_Z), (const bf16_t*)(ws + WS_WOMLA), R, 1024, 1024}; PairOrder S; S.init(G, bx);
        pg8::gemm_phase<EpiMerged, PairOrder, PG8_ALIGN, PG8_SP2, 3>(lds, g, S, E);
    }
    BE(6);
    GSYNC(); PE(6); BA(6);
    PB(7); BB(7);
    {
        EpiOut<3> E{P.in[I_XP], P.in[I_XS], (const float*)(ws + WS_MOD), P.in[I_GFFN], (bf16_t*)(ws + WS_X1), (bf16_t*)(ws + WS_A1), (float*)(ws + WS_SSQ2)};
        run_gemm192(lds, (const bf16_t*)(ws + WS_MERGED), (const bf16_t*)(ws + WS_WOUT), R, 1024, 1024, G, bx, E);
    }
    BE(7);
    GSYNC(); PE(7); BA(7);
    PB(8); BB(8);
    {
        EpiUpGate E{(const float*)(ws + WS_SSQ2), (const float*)(ws + WS_CUP), P.in[I_FCW], (const float*)(ws + WS_CST), (bf16_t*)(ws + WS_UG), (bf16_t*)(ws + WS_HALO)};
#ifdef WARM_WUP
        {
            const u32x4* wp = (const u32x4*)(ws + WS_WUP); u32x4 x = {0u, 0u, 0u, 0u};
            for (unsigned i = (unsigned)bx * NT + threadIdx.x; i < (unsigned)((size_t)UPN * 1024 * 2 / 16); i += (unsigned)G * NT) x ^= wp[i];
            if ((x.x ^ x.y ^ x.z ^ x.w) == 0x9e3779b9u) ((volatile unsigned*)(ws + WS_CTL))[8000] = x.x;
        }
#endif
        { pg8::Gemm g{(const bf16_t*)(ws + WS_A1), (const bf16_t*)(ws + WS_WUP), R, UPN, 1024}; UpMain S; S.init(R, UPN, G, bx);
          pg8::gemm_phase<EpiUpGate, UpMain, PG8_ALIGN, PG8_SP2>(lds, g, S, E);
          if (G == 256) { UpTail T; T.init(R, UPN, G, bx); pg8::gemm_phase<EpiUpGate, UpTail, PG8_ALIGN, PG8_SP2, 4, true>(lds, g, T, E); } }
        if (G == 256 && bx >= 64) {
            pg8::StaticOrder S5; S5.init(R, UPN, G, bx); const int x = bx & 7, j = (bx >> 3) - 8; u32x4 xa = {0u, 0u, 0u, 0u};
            const char* pan[8];
#pragma unroll
            for (int q = 0; q < 4; ++q) { pg8::Unit u5; S5.at(1024 + x + 8 * q, u5); pan[2 * q] = (const char*)(ws + WS_A1) + (size_t)u5.pm * 256 * 2048; pan[2 * q + 1] = (const char*)(ws + WS_WUP) + (size_t)u5.pn * 256 * 2048; }
            for (int i = j * NT + (int)threadIdx.x; i < 16 * 16384; i += 24 * NT) { const int kt = i >> 14, r = i & 16383, pq = r >> 11, row = (r >> 3) & 255, pc = r & 7;
                const char* base = pan[0];
#pragma unroll
                for (int q = 1; q < 8; ++q) base = (pq == q) ? pan[q] : base;
                xa ^= *(const u32x4*)(base + (size_t)row * 2048 + kt * 128 + pc * 16); }
            if ((xa.x ^ xa.y ^ xa.z ^ xa.w) == 0x9e3779b9u) ((volatile unsigned*)(ws + WS_CTL))[8000] = xa.x;
        }
        if (G == 256) { phase_wdown(P, lds, 64, 192);
            if (bx >= 64 && bx < 72) { asm volatile("s_waitcnt vmcnt(0)" ::: "memory"); __syncthreads(); if (threadIdx.x == 0) { __builtin_amdgcn_fence(__ATOMIC_RELEASE, "agent"); asm volatile("s_waitcnt vmcnt(0)" ::: "memory"); } } }
    }
    BE(8);
    GSYNC(); PE(8); BA(8);
    PB(9); PE(9);
    PB(10);
    const bool fuse_final = (G == 256);
    if (fuse_final) {
        { pg8::StaticOrder S0; S0.init(R, 1024, G, bx, 192); pg8::Unit u0; if (S0.next(0, u0)) fixup_rows(P, u0.pm * 192, u0.pm * 192 + 192, threadIdx.x);
          asm volatile("s_waitcnt vmcnt(0)" ::: "memory"); __syncthreads(); }
        EpiDownNorm E{(const float*)(ws + WS_MOD), P.out, (const bf16_t*)(ws + WS_X1), P.in[I_GFIN], (float*)(ws + WS_SSQ_CQ), (unsigned*)(ws + WS_CTL) + 4608};
        pg8::Gemm g{(const bf16_t*)(ws + WS_UG), (const bf16_t*)(ws + WS_WDOWN), R, 1024, DFF}; pg8::StaticOrder S; S.init(R, 1024, G, bx, 192);
        pg8::gemm_phase<EpiDownNorm, pg8::StaticOrder, false, PG8_SP2, 3>(lds, g, S, E);
        PE(10);
#ifdef PROBE_BUSY
#ifdef PROBE_ARG
        if (threadIdx.x == 0) pacc += (((unsigned*)(lds + 131072))[9] & 255u) * 25u;
#else
        if (threadIdx.x == 0) pacc += ((unsigned*)(lds + 131072))[9];
#endif
#endif
#ifdef PG8_TIME
        if (blockIdx.x == 0 && threadIdx.x == 0) pacc += pg8::pg8_tacc[PG8_TIME];
#endif
        if (PROBE_MASK != 0 && blockIdx.x == PROBE_BLK && threadIdx.x == 0) { const unsigned long long te = __builtin_amdgcn_s_memrealtime() + (unsigned long long)PROBE_MULT * pacc; while (__builtin_amdgcn_s_memrealtime() < te) __builtin_amdgcn_s_sleep(32); }
        return;
    }
    for (int k = bx; k < R / 64; k += G) fixup_rows(P, 64 * k, 64 * k + 64, threadIdx.x);
    GSYNC();
    {
        EpiDown<3> E{(const float*)(ws + WS_MOD), P.out, (const bf16_t*)(ws + WS_X1)};
        run_gemm192(lds, (const bf16_t*)(ws + WS_UG), (const bf16_t*)(ws + WS_WDOWN), R, 1024, DFF, G, bx, E);
    }
    GSYNC(); PE(10);
    PB(11); phase_final(P); PE(11);
    if (PROBE_MASK != 0 && blockIdx.x == PROBE_BLK && threadIdx.x == 0) { const unsigned long long te = __builtin_amdgcn_s_memrealtime() + (unsigned long long)PROBE_MULT * pacc; while (__builtin_amdgcn_s_memrealtime() < te) __builtin_amdgcn_s_sleep(32); }
}

extern "C" void kernel_launch(void* const* d_in, const int* in_sizes, int n_in, void* d_out, int out_size, void* d_ws, size_t ws_size, hipStream_t stream) {
    static int grid = 0;
    if (grid == 0) {
        if (n_in != 30 || ws_size < WS_END || out_size != (int)(O_SSD + (size_t)32 * 2 * 16 * 64 * 64)) {
            fprintf(stderr, "kernel_launch: unexpected shapes: n_in %d out %d ws %zu (need %zu)\n", n_in, out_size, ws_size, (size_t)WS_END); grid = -1; return; }
        int dev = 0, cus = 0, per_cu = 0;
        if (hipGetDevice(&dev) != hipSuccess || hipDeviceGetAttribute(&cus, hipDeviceAttributeMultiprocessorCount, dev) != hipSuccess) { grid = -1; return; }
        if (hipFuncSetAttribute((const void*)mega_fwd, hipFuncAttributeMaxDynamicSharedMemorySize, LDS_BYTES) != hipSuccess) { fprintf(stderr, "kernel_launch: hipFuncSetAttribute failed\n"); grid = -1; return; }
        if (hipOccupancyMaxActiveBlocksPerMultiprocessor(&per_cu, (const void*)mega_fwd, NT, LDS_BYTES) != hipSuccess || per_cu < 1) { fprintf(stderr, "kernel_launch: occupancy query failed (%d)\n", per_cu); (void)hipGetLastError(); grid = -1; return; }
        grid = cus;
    }
    if (grid < 0) return;
    (void)hipMemsetAsync((char*)d_ws + WS_CTL, 0, CTL_ZERO, stream);
    Params p{};
    for (int i = 0; i < 30; ++i) p.in[i] = (const float*)d_in[i];
    p.out = (float*)d_out; p.ws = (unsigned char*)d_ws;
    void* args[] = {&p};
    hipError_t e = hipLaunchCooperativeKernel((const void*)mega_fwd, dim3(grid), dim3(NT), args, LDS_BYTES, stream);
    if (e != hipSuccess) fprintf(stderr, "kernel_launch: cooperative launch failed: %s (grid %d)\n", hipGetErrorString(e), grid);
}
```
